# Optimizing an MI355X kernel written in HIP

```python
import jax, jax.numpy as jnp
from jax import lax
import numpy as np

D_MODEL = 1024
BATCH = 8
SEQ = 4096
DEPTH = 1

ATTN_HEADS = 8
ATTN_HEAD_DIM = 64
ATTN_WIDTH = ATTN_HEADS * ATTN_HEAD_DIM
DILATED_BRANCHES = ((128, 1), (512, 4), (2048, 16))
PAD_MULT = max(w for w, _ in DILATED_BRANCHES)
RET_HEADS = 4
RET_KEY_DIM = 64
RET_VALUE_DIM = 128
RET_QK_WIDTH = RET_HEADS * RET_KEY_DIM
RET_V_WIDTH = RET_HEADS * RET_VALUE_DIM
RET_CHUNK = 128
MIX_WIDTH = ATTN_WIDTH + RET_V_WIDTH
IN_SPLITS = (ATTN_WIDTH, ATTN_WIDTH, ATTN_WIDTH, ATTN_WIDTH,
             RET_QK_WIDTH, RET_QK_WIDTH, RET_V_WIDTH, RET_V_WIDTH)
IN_WIDTH = sum(IN_SPLITS)
ROPE_THETA = 10000.0
NORM_EPS = 1e-6
GN_EPS = 1e-5

kernel_name = "hymba_dilated_attn_retention_block"


def rms_norm(x, g):
    xf = x.astype(jnp.float32)
    y = xf * lax.rsqrt(jnp.mean(xf * xf, axis=-1, keepdims=True) + NORM_EPS)
    return (y * g.astype(jnp.float32)).astype(x.dtype)


def rope_half(x, pos):
    half = x.shape[-1] // 2
    inv = ROPE_THETA ** (-jnp.arange(half, dtype=jnp.float32) / half)
    ang = pos.astype(jnp.float32)[:, None] * inv[None, :]
    cos, sin = jnp.cos(ang).astype(x.dtype), jnp.sin(ang).astype(x.dtype)
    x1, x2 = x[..., :half], x[..., half:]
    return jnp.concatenate([x1 * cos - x2 * sin, x2 * cos + x1 * sin], axis=-1)


def retnet_rotate(x, pos):
    dk = x.shape[-1]
    half = dk // 2
    inv = 1.0 / (ROPE_THETA ** jnp.linspace(0.0, 1.0, half, dtype=jnp.float32))
    ang = pos.astype(jnp.float32)[:, None] * inv[None, :]
    cos, sin = jnp.cos(ang).astype(x.dtype), jnp.sin(ang).astype(x.dtype)
    xp = x.reshape(x.shape[:-1] + (half, 2))
    x1, x2 = xp[..., 0], xp[..., 1]
    out = jnp.stack([x1 * cos - x2 * sin, x2 * cos + x1 * sin], axis=-1)
    return out.reshape(x.shape)


def dilated_branch(q, k, v, window, dilation):
    B, H, Sp, Dh = q.shape
    steps = window // dilation
    L = Sp // dilation
    nb = L // steps

    def gather_stride(t):
        t = t.reshape(B, H, L, dilation, Dh).transpose(0, 1, 3, 2, 4)
        return t.reshape(B, H, dilation, nb, steps, Dh)

    def with_prev(t):
        prev = jnp.pad(t, ((0, 0), (0, 0), (0, 0), (1, 0), (0, 0), (0, 0)))[:, :, :, :-1]
        return jnp.concatenate([prev, t], axis=4)

    qb = gather_stride(q)
    kb = with_prev(gather_stride(k))
    vb = with_prev(gather_stride(v))
    s = jnp.einsum('bhrnqd,bhrnkd->bhrnqk', qb, kb,
                   preferred_element_type=jnp.float32) * (Dh ** -0.5)
    qi = jnp.arange(steps)[:, None]
    kj = jnp.arange(2 * steps)[None, :]
    dist = steps + qi - kj
    band = (dist >= 0) & (dist <= steps)
    has_prev = (jnp.arange(nb) > 0)[:, None, None]
    mask = band[None] & (has_prev | (kj >= steps)[None])
    s = jnp.where(mask, s, jnp.finfo(jnp.float32).min)
    m = jnp.max(s, axis=-1, keepdims=True)
    p = jnp.exp(s - m)
    den = jnp.sum(p, axis=-1, keepdims=True)
    o = jnp.einsum('bhrnqk,bhrnkd->bhrnqd', p.astype(v.dtype), vb,
                   preferred_element_type=jnp.float32) / den
    lse = (m + jnp.log(den))[..., 0]
    o = o.reshape(B, H, dilation, L, Dh).transpose(0, 1, 3, 2, 4).reshape(B, H, Sp, Dh)
    lse = lse.reshape(B, H, dilation, L).transpose(0, 1, 3, 2).reshape(B, H, Sp)
    return o, lse


def dilated_attention(q, k, v):
    B, H, S, Dh = q.shape
    Sp = -(-S // PAD_MULT) * PAD_MULT
    pad = ((0, 0), (0, 0), (0, Sp - S), (0, 0))
    pos = jnp.arange(Sp)
    qp = rope_half(jnp.pad(q, pad), pos)
    kp = rope_half(jnp.pad(k, pad), pos)
    vp = jnp.pad(v, pad)
    outs, lses = [], []
    for window, dilation in DILATED_BRANCHES:
        o, lse = dilated_branch(qp, kp, vp, window, dilation)
        outs.append(o)
        lses.append(lse)
    w = jax.nn.softmax(jnp.stack(lses, axis=0), axis=0)
    o = jnp.sum(w[..., None] * jnp.stack(outs, axis=0), axis=0)
    return o[:, :, :S].astype(q.dtype)


def retention(q, k, v):
    B, H, S, Dk = q.shape
    Dv = v.shape[-1]
    C = RET_CHUNK
    N = S // C
    pos = jnp.arange(S)
    q = retnet_rotate(q, pos).astype(jnp.float32)
    k = (retnet_rotate(k, pos) * (Dk ** -0.5)).astype(jnp.float32)
    v = v.astype(jnp.float32)
    log_gamma = jnp.log1p(-(2.0 ** (-5.0 - jnp.arange(H, dtype=jnp.float32))))
    cpos = jnp.arange(C, dtype=jnp.float32)
    diff = cpos[:, None] - cpos[None, :]
    decay = jnp.where(diff[None] >= 0, jnp.exp(jnp.maximum(diff, 0.0)[None] * log_gamma[:, None, None]), 0.0)
    qc = q.reshape(B, H, N, C, Dk)
    kc = k.reshape(B, H, N, C, Dk)
    vc = v.reshape(B, H, N, C, Dv)
    s = jnp.einsum('bhnid,bhnjd->bhnij', qc, kc) * decay[None, :, None]
    o_intra = jnp.einsum('bhnij,bhnjv->bhniv', s, vc)
    k_dec = jnp.exp((C - 1 - cpos)[None, :] * log_gamma[:, None])
    q_dec = jnp.exp((cpos + 1)[None, :] * log_gamma[:, None])
    chunk_decay = jnp.exp(C * log_gamma)[None, :, None, None]
    kv = jnp.einsum('bhnjd,hj,bhnjv->nbhdv', kc, k_dec, vc)

    def step(state, kv_n):
        return state * chunk_decay + kv_n, state

    _, state_prev = lax.scan(step, jnp.zeros((B, H, Dk, Dv), jnp.float32), kv)
    o_inter = jnp.einsum('bhnid,hi,nbhdv->bhniv', qc, q_dec, state_prev)
    o = (o_intra + o_inter).reshape(B, H, S, Dv)
    mu = jnp.mean(o, axis=-1, keepdims=True)
    var = jnp.mean(jnp.square(o - mu), axis=-1, keepdims=True)
    return (o - mu) * lax.rsqrt(var + GN_EPS)


def split_heads(t, n_heads):
    B, S, W = t.shape
    return t.reshape(B, S, n_heads, W // n_heads).transpose(0, 2, 1, 3)


def merge_heads(t):
    B, H, S, Dh = t.shape
    return t.transpose(0, 2, 1, 3).reshape(B, S, H * Dh)


def hybrid_mixer(h, w_in, ret_gn_gain, w_out):
    proj = h @ w_in
    cuts = [int(c) for c in np.cumsum(IN_SPLITS)[:-1]]
    qa, ka, va, ga, qr, kr, vr, gr = jnp.split(proj, cuts, axis=-1)
    attn = merge_heads(dilated_attention(split_heads(qa, ATTN_HEADS),
                                         split_heads(ka, ATTN_HEADS),
                                         split_heads(va, ATTN_HEADS)))
    ret = merge_heads(retention(split_heads(qr, RET_HEADS),
                                split_heads(kr, RET_HEADS),
                                split_heads(vr, RET_HEADS)))
    ret = (ret * ret_gn_gain.astype(jnp.float32)).astype(h.dtype)
    mixed = jnp.concatenate([jax.nn.silu(ga) * attn, jax.nn.silu(gr) * ret], axis=-1)
    return mixed @ w_out


def setup_inputs(seed: int = 0) -> dict:
    key = jax.random.key(seed)
    ks = jax.random.split(key, 7)
    x = jax.random.normal(ks[0], (BATCH, SEQ, D_MODEL), jnp.float32)
    norm_gain = 1.0 + 0.02 * jax.random.normal(ks[1], (DEPTH, D_MODEL), jnp.float32)
    w_in = jax.random.normal(ks[2], (DEPTH, D_MODEL, IN_WIDTH), jnp.float32) * D_MODEL ** -0.5
    ret_gn_gain = 1.0 + 0.02 * jax.random.normal(ks[3], (DEPTH, RET_V_WIDTH), jnp.float32)
    w_out = jax.random.normal(ks[4], (DEPTH, MIX_WIDTH, D_MODEL), jnp.float32) * MIX_WIDTH ** -0.5
    final_gain = 1.0 + 0.02 * jax.random.normal(ks[5], (D_MODEL,), jnp.float32)
    return {"x": x, "norm_gain": norm_gain, "w_in": w_in, "ret_gn_gain": ret_gn_gain,
            "w_out": w_out, "final_gain": final_gain}


def reference(x, norm_gain, w_in, ret_gn_gain, w_out, final_gain):
    for layer in range(DEPTH):
        h = rms_norm(x, norm_gain[layer])
        x = x + hybrid_mixer(h, w_in[layer], ret_gn_gain[layer], w_out[layer])
    return rms_norm(x, final_gain)
```

```cpp
#include <hip/hip_runtime.h>
#include <hip/hip_cooperative_groups.h>
#include <cstdint>
#include <cstdio>
namespace cg = cooperative_groups;

typedef unsigned short bf16_t;
typedef short bf16x8 __attribute__((ext_vector_type(8)));
typedef float f32x4 __attribute__((ext_vector_type(4)));
typedef unsigned u32x4 __attribute__((ext_vector_type(4)));
typedef unsigned u32x2 __attribute__((ext_vector_type(2)));

constexpr int T_TOK = 32768, DM = 1024, NW = 3584, SEQ = 4096;
constexpr int OFF_QA = 0, OFF_KA = 512, OFF_VA = 1024, OFF_GA = 1536, OFF_QR = 2048, OFF_KR = 2304, OFF_VR = 2560, OFF_GR = 3072;

struct Params {
  const float* x; const float* ng; const float* w_in; const float* gn; const float* w_out; const float* fg;
  float* out;
  bf16_t* xb; bf16_t* proj; bf16_t* mixed; bf16_t* winT; bf16_t* woutT;
  float* rstd; float* rowss; float2* ropeT; float2* retT; float* kvT; bf16_t* stT;
};

#define DI __device__ __forceinline__
DI unsigned short f2bf(float x) { unsigned u = __float_as_uint(x); u += 0x7fffu + ((u >> 16) & 1u); return (unsigned short)(u >> 16); }
DI float bf2f(unsigned short b) { return __uint_as_float(((unsigned)b) << 16); }
DI unsigned pack2(float lo, float hi) { return (unsigned)f2bf(lo) | ((unsigned)f2bf(hi) << 16); }
DI float bflo(unsigned w) { return __uint_as_float(w << 16); }
DI float bfhi(unsigned w) { return __uint_as_float(w & 0xffff0000u); }
DI int perm32(int rho) { const int n = rho >> 4, i = rho & 15; return 8 * (i >> 2) + 4 * n + (i & 3); }
DI int cmap(int p) { return (p & ~31) + perm32(p & 31); }

DI void phase_prep(const Params& p, int bid, int nb) {
  const int tid = threadIdx.x, lane = tid & 63, wid = tid >> 6, nw = blockDim.x >> 6;
  for (int row = bid * nw + wid; row < T_TOK; row += nb * nw) {
    const float* xr = p.x + (size_t)row * DM;
    float ss = 0.f;
    f32x4 v[4];
#pragma unroll
    for (int it = 0; it < 4; ++it) { v[it] = *(const f32x4*)(xr + it * 256 + lane * 4); ss += v[it][0] * v[it][0] + v[it][1] * v[it][1] + v[it][2] * v[it][2] + v[it][3] * v[it][3]; }
#pragma unroll
    for (int o = 32; o >= 1; o >>= 1) ss += __shfl_xor(ss, o);
#pragma unroll
    for (int it = 0; it < 4; ++it) { u32x2 w; w.x = pack2(v[it][0], v[it][1]); w.y = pack2(v[it][2], v[it][3]); *(u32x2*)(p.xb + (size_t)row * DM + it * 256 + lane * 4) = w; }
    if (lane == 0) { p.rstd[row] = rsqrtf(ss * (1.0f / DM) + 1e-6f); p.rowss[row] = 0.f; }
  }
  const int gt = bid * blockDim.x + tid, gn = nb * blockDim.x;
  for (int idx = gt; idx < NW * 128; idx += gn) {
    const int pp = idx % NW, kc = idx / NW, c = cmap(pp);
    float f[8];
#pragma unroll
    for (int j = 0; j < 8; ++j) { const int k = kc * 8 + j; f[j] = p.ng[k] * p.w_in[(size_t)k * NW + c]; }
    u32x4 w; w.x = pack2(f[0], f[1]); w.y = pack2(f[2], f[3]); w.z = pack2(f[4], f[5]); w.w = pack2(f[6], f[7]);
    *(u32x4*)(p.winT + (size_t)pp * DM + kc * 8) = w;
  }
  for (int idx = gt; idx < DM * 128; idx += gn) {
    const int pp = idx % DM, kc = idx / DM, c = cmap(pp);
    float f[8];
#pragma unroll
    for (int j = 0; j < 8; ++j) { const int k = kc * 8 + j; f[j] = p.w_out[(size_t)k * DM + c]; }
    u32x4 w; w.x = pack2(f[0], f[1]); w.y = pack2(f[2], f[3]); w.z = pack2(f[4], f[5]); w.w = pack2(f[6], f[7]);
    *(u32x4*)(p.woutT + (size_t)pp * DM + kc * 8) = w;
  }
  for (int idx = gt; idx < SEQ * 32; idx += gn) {
    const int pos = idx >> 5, i = idx & 31;
    const float inv1 = powf(10000.0f, -(float)i / 32.0f);
    const float inv2 = 1.0f / powf(10000.0f, (float)i / 31.0f);
    const float a1 = (float)pos * inv1, a2 = (float)pos * inv2;
    p.ropeT[idx] = make_float2(cosf(a1), sinf(a1));
    p.retT[idx] = make_float2(cosf(a2), sinf(a2));
  }
}

constexpr int BM = 256, BK = 64, HALF = 128, HT = HALF * BK;
constexpr int GEMM_LDS = 8 * HT * 2;
DI int lds_byte(int r, int c) { int st = (r >> 4) * 2 + (c >> 5), rr = r & 15, cc = c & 31, ob = rr * 64 + cc * 2; return st * 1024 + (ob ^ (((ob >> 9) & 1) << 5)); }
DI void stage_rc(int b, int& R, int& C) { int st = b / 1024, sb = b % 1024, swz = sb ^ (((sb >> 9) & 1) << 5); R = (st >> 1) * 16 + swz / 64; C = (st & 1) * 32 + (swz % 64) / 2; }

#define LAS __attribute__((address_space(3)))
template <int EPI>
DI void gemm_tile(LAS unsigned char* lds, const bf16_t* __restrict__ A, const bf16_t* __restrict__ Bt, const int brow, const int bcol, const Params& p) {
  constexpr int K = 1024, nt = K / BK, HTB = HALF * BK * 2;
  const int tid = threadIdx.x, wid = __builtin_amdgcn_readfirstlane(tid >> 6), lane = tid & 63, wr = wid >> 2, wc = wid & 3, fr = lane & 15, fq = lane >> 4;
  unsigned voff[2];
#pragma unroll
  for (int i = 0; i < 2; ++i) { int R, C; stage_rc(tid * 16 + i * 8192, R, C); voff[i] = (unsigned)(R * K + C) * 2u; }
  const unsigned ldsw = (unsigned)wid * 1024u;
  const int aoff = lds_byte(wr * 64 + fr, fq * 8), boff = lds_byte(wc * 32 + fr, fq * 8);
  const char* cA0 = (const char*)A + (size_t)brow * K * 2; const char* cA1 = cA0 + (size_t)HALF * K * 2;
  const char* cB0 = (const char*)Bt + (size_t)bcol * K * 2; const char* cB1 = cB0 + (size_t)HALF * K * 2;
#define SAo(b, h) (((b) * 2 + (h)) * HTB)
#define SBo(b, h) ((4 + (b) * 2 + (h)) * HTB)
#define STAGE(bufoff, gb, kt) do { _Pragma("unroll") for (int _i = 0; _i < 2; ++_i) \
    __builtin_amdgcn_global_load_lds((const unsigned*)((gb) + (size_t)(kt) * (BK * 2) + voff[_i]), (LAS unsigned*)(lds + (bufoff) + ldsw + _i * 8192), 16, 0, 0); } while (0)
#define LDA(dst, b, h) do { _Pragma("unroll") for (int m = 0; m < 4; ++m) _Pragma("unroll") for (int k = 0; k < 2; ++k) \
    dst[m][k] = *(const LAS bf16x8*)(lds + SAo(b, h) + aoff + m * 2048 + k * 1024); } while (0)
#define LDB(dst, b, h) do { _Pragma("unroll") for (int n = 0; n < 2; ++n) _Pragma("unroll") for (int k = 0; k < 2; ++k) \
    dst[n][k] = *(const LAS bf16x8*)(lds + SBo(b, h) + boff + n * 2048 + k * 1024); } while (0)
#define MMA(ai, bj, At, Bt_) do { __builtin_amdgcn_s_setprio(1); \
    _Pragma("unroll") for (int m = 0; m < 4; ++m) _Pragma("unroll") for (int n = 0; n < 2; ++n) _Pragma("unroll") for (int k = 0; k < 2; ++k) \
      acc[ai][bj][m][n] = __builtin_amdgcn_mfma_f32_16x16x32_bf16(Bt_[n][k], At[m][k], acc[ai][bj][m][n], 0, 0, 0); \
    __builtin_amdgcn_s_setprio(0); } while (0)
#define WAIT_V(n) asm volatile("s_waitcnt vmcnt(" #n ")" ::: "memory")
#define WAIT_L(n) asm volatile("s_waitcnt lgkmcnt(" #n ")" ::: "memory")
#define BAR __builtin_amdgcn_s_barrier()
#define SCHED __builtin_amdgcn_sched_barrier(0)
  f32x4 acc[2][2][4][2];
#pragma unroll
  for (int a = 0; a < 2; ++a)
#pragma unroll
    for (int b = 0; b < 2; ++b)
#pragma unroll
      for (int m = 0; m < 4; ++m)
#pragma unroll
        for (int n = 0; n < 2; ++n) acc[a][b][m][n] = (f32x4){0.f, 0.f, 0.f, 0.f};
  bf16x8 At[4][2], B0[2][2], B1[2][2];
  WAIT_V(0);
  STAGE(SBo(0, 0), cB0, 0); STAGE(SAo(0, 0), cA0, 0);
  STAGE(SBo(0, 1), cB1, 0); STAGE(SAo(0, 1), cA1, 0);
  if (wr == 1) BAR;
  WAIT_V(4); BAR;
  STAGE(SBo(1, 0), cB0, 1); STAGE(SAo(1, 0), cA0, 1); STAGE(SBo(1, 1), cB1, 1);
  WAIT_V(6); BAR;
  for (int t = 0; t < nt - 2; t += 2) {
    LDB(B0, 0, 0); SCHED; LDA(At, 0, 0); STAGE(SAo(1, 1), cA1, t + 1);
    WAIT_L(8); BAR; WAIT_L(0); MMA(0, 0, At, B0); BAR; SCHED;
    LDB(B1, 0, 1); STAGE(SBo(0, 0), cB0, t + 2);
    BAR; WAIT_L(0); MMA(0, 1, At, B1); BAR;
    LDA(At, 0, 1); STAGE(SAo(0, 0), cA0, t + 2);
    BAR; WAIT_L(0); MMA(1, 0, At, B0); BAR; SCHED;
    STAGE(SBo(0, 1), cB1, t + 2);
    WAIT_V(6); BAR; MMA(1, 1, At, B1); BAR;
    LDB(B0, 1, 0); SCHED; LDA(At, 1, 0); STAGE(SAo(0, 1), cA1, t + 2);
    WAIT_L(8); BAR; WAIT_L(0); MMA(0, 0, At, B0); BAR; SCHED;
    LDB(B1, 1, 1); STAGE(SBo(1, 0), cB0, t + 3);
    BAR; WAIT_L(0); MMA(0, 1, At, B1); BAR;
    LDA(At, 1, 1); STAGE(SAo(1, 0), cA0, t + 3);
    BAR; WAIT_L(0); MMA(1, 0, At, B0); BAR; SCHED;
    STAGE(SBo(1, 1), cB1, t + 3);
    WAIT_V(6); BAR; MMA(1, 1, At, B1); BAR;
  }
  { LDB(B0, 0, 0); LDA(At, 0, 0); STAGE(SAo(1, 1), cA1, nt - 1);
    BAR; WAIT_L(0); MMA(0, 0, At, B0); BAR;
    LDB(B1, 0, 1); BAR; WAIT_L(0); MMA(0, 1, At, B1); BAR;
    LDA(At, 0, 1); WAIT_V(4); BAR; WAIT_L(0); MMA(1, 0, At, B0); MMA(1, 1, At, B1); BAR; }
  { LDB(B0, 1, 0); LDA(At, 1, 0); WAIT_V(2); BAR; WAIT_L(0); MMA(0, 0, At, B0); BAR;
    LDB(B1, 1, 1); WAIT_V(0); BAR; WAIT_L(0); MMA(0, 1, At, B1); BAR;
    LDA(At, 1, 1); BAR; WAIT_L(0); MMA(1, 0, At, B0); MMA(1, 1, At, B1); BAR; }
  if (wr == 0) BAR;
  if (EPI == 1) {
#pragma unroll
    for (int ai = 0; ai < 2; ++ai)
#pragma unroll
      for (int m = 0; m < 4; ++m) {
        const int row = brow + ai * HALF + wr * 64 + m * 16 + fr;
        const float rs = p.rstd[row];
#pragma unroll
        for (int bj = 0; bj < 2; ++bj) {
          const f32x4 v0 = acc[ai][bj][m][0] * rs, v1 = acc[ai][bj][m][1] * rs;
          u32x4 w; w.x = pack2(v0[0], v0[1]); w.y = pack2(v0[2], v0[3]); w.z = pack2(v1[0], v1[1]); w.w = pack2(v1[2], v1[3]);
          *(u32x4*)(p.proj + (size_t)row * NW + bcol + bj * HALF + wc * 32 + 8 * fq) = w;
        }
      }
  } else {
#pragma unroll
    for (int ai = 0; ai < 2; ++ai)
#pragma unroll
      for (int m = 0; m < 4; ++m) {
        const int row = brow + ai * HALF + wr * 64 + m * 16 + fr;
        float ss = 0.f;
#pragma unroll
        for (int bj = 0; bj < 2; ++bj) {
          const size_t off = (size_t)row * DM + bcol + bj * HALF + wc * 32 + 8 * fq;
          const f32x4 x0 = *(const f32x4*)(p.x + off), x1 = *(const f32x4*)(p.x + off + 4);
          const f32x4 y0 = acc[ai][bj][m][0] + x0, y1 = acc[ai][bj][m][1] + x1;
          *(f32x4*)(p.out + off) = y0; *(f32x4*)(p.out + off + 4) = y1;
          ss += y0[0] * y0[0] + y0[1] * y0[1] + y0[2] * y0[2] + y0[3] * y0[3] + y1[0] * y1[0] + y1[1] * y1[1] + y1[2] * y1[2] + y1[3] * y1[3];
        }
        ss += __shfl_xor(ss, 16); ss += __shfl_xor(ss, 32);
        if (fq == 0) atomicAdd(p.rowss + row, ss);
      }
  }
}

DI void tile_of(int L, int nM, int nN, int& pm, int& pn) {
  const int nwg = nM * nN, NX = 8, WGM = 8;
  int wgid = L; { const int q = nwg / NX, r = nwg % NX, xcd = wgid % NX, off = wgid / NX; wgid = (xcd < r ? xcd * (q + 1) : r * (q + 1) + (xcd - r) * q) + off; }
  const int nig = WGM * nN, gid = wgid / nig, fm = gid * WGM, gsz = (nM - fm) < WGM ? (nM - fm) : WGM;
  pm = fm + ((wgid % nig) % gsz); pn = (wgid % nig) / gsz;
}

template <int EPI>
DI void phase_gemm(LAS unsigned char* shm, const Params& p, int bid, int nb) {
  const int nM = T_TOK / BM, nN = (EPI == 1 ? NW : DM) / BM;
  for (int L = bid; L < nM * nN; L += nb) {
    int pm, pn; tile_of(L, nM, nN, pm, pn);
    if (EPI == 1) gemm_tile<1>(shm, p.xb, p.winT, pm * BM, pn * BM, p);
    else gemm_tile<2>(shm, p.mixed, p.woutT, pm * BM, pn * BM, p);
  }
}

DI void phase_rotary(const Params& p, int bid, int nb) {
  const long total = (long)T_TOK * 768;
  for (long idx = (long)bid * blockDim.x + threadIdx.x; idx < total; idx += (long)nb * blockDim.x) {
    const int tok = (int)(idx / 768); int j = (int)(idx % 768);
    const int pos = tok & (SEQ - 1);
    int a, b; float sc; const float2* tab;
    if (j < 256) { const int h = j >> 5, i = j & 31; a = OFF_QA + h * 64 + i; b = a + 32; sc = 0.125f; tab = p.ropeT + pos * 32 + i; }
    else if (j < 512) { j -= 256; const int h = j >> 5, i = j & 31; a = OFF_KA + h * 64 + i; b = a + 32; sc = 1.f; tab = p.ropeT + pos * 32 + i; }
    else if (j < 640) { j -= 512; const int h = j >> 5, i = j & 31; a = OFF_QR + h * 64 + 2 * i; b = a + 1; sc = 1.f; tab = p.retT + pos * 32 + i; }
    else { j -= 640; const int h = j >> 5, i = j & 31; a = OFF_KR + h * 64 + 2 * i; b = a + 1; sc = 0.125f; tab = p.retT + pos * 32 + i; }
    const float2 cs = *tab;
    bf16_t* row = p.proj + (size_t)tok * NW;
    const float x1 = bf2f(row[a]), x2 = bf2f(row[b]);
    row[a] = f2bf((x1 * cs.x - x2 * cs.y) * sc);
    row[b] = f2bf((x2 * cs.x + x1 * cs.y) * sc);
  }
}

DI void load_row64(const bf16_t* src, float* dst) {
#pragma unroll
  for (int c = 0; c < 8; ++c) {
    const u32x4 w = *(const u32x4*)(src + c * 8);
    dst[c * 8 + 0] = bflo(w.x); dst[c * 8 + 1] = bfhi(w.x); dst[c * 8 + 2] = bflo(w.y); dst[c * 8 + 3] = bfhi(w.y);
    dst[c * 8 + 4] = bflo(w.z); dst[c * 8 + 5] = bfhi(w.z); dst[c * 8 + 6] = bflo(w.w); dst[c * 8 + 7] = bfhi(w.w);
  }
}

DI void phase_attn_naive(const Params& p, int bid, int nb) {
  const long total = (long)T_TOK * 8;
  for (long idx = (long)bid * blockDim.x + threadIdx.x; idx < total; idx += (long)nb * blockDim.x) {
    const int h = (int)(idx & 7), tok = (int)(idx >> 3);
    const int pos = tok & (SEQ - 1), tb = tok - pos;
    float q[64], o[64];
    load_row64(p.proj + (size_t)tok * NW + OFF_QA + h * 64, q);
#pragma unroll
    for (int d = 0; d < 64; ++d) o[d] = 0.f;
    float m = -1e30f, l = 0.f;
    for (int br = 0; br < 3; ++br) {
      const int dl = br == 0 ? 1 : (br == 1 ? 4 : 16);
      for (int j = 0; j <= 128; ++j) {
        const int pk = pos - j * dl; if (pk < 0) break;
        const bf16_t* kr = p.proj + (size_t)(tb + pk) * NW + OFF_KA + h * 64;
        float s = 0.f;
#pragma unroll
        for (int c = 0; c < 8; ++c) {
          const u32x4 w = *(const u32x4*)(kr + c * 8);
          s += q[c * 8 + 0] * bflo(w.x) + q[c * 8 + 1] * bfhi(w.x) + q[c * 8 + 2] * bflo(w.y) + q[c * 8 + 3] * bfhi(w.y)
             + q[c * 8 + 4] * bflo(w.z) + q[c * 8 + 5] * bfhi(w.z) + q[c * 8 + 6] * bflo(w.w) + q[c * 8 + 7] * bfhi(w.w);
        }
        const float mn = fmaxf(m, s), al = __expf(m - mn), pe = __expf(s - mn);
        m = mn; l = l * al + pe;
        const bf16_t* vr = kr + (OFF_VA - OFF_KA);
#pragma unroll
        for (int c = 0; c < 8; ++c) {
          const u32x4 w = *(const u32x4*)(vr + c * 8);
          o[c * 8 + 0] = o[c * 8 + 0] * al + pe * bflo(w.x); o[c * 8 + 1] = o[c * 8 + 1] * al + pe * bfhi(w.x);
          o[c * 8 + 2] = o[c * 8 + 2] * al + pe * bflo(w.y); o[c * 8 + 3] = o[c * 8 + 3] * al + pe * bfhi(w.y);
          o[c * 8 + 4] = o[c * 8 + 4] * al + pe * bflo(w.z); o[c * 8 + 5] = o[c * 8 + 5] * al + pe * bfhi(w.z);
          o[c * 8 + 6] = o[c * 8 + 6] * al + pe * bflo(w.w); o[c * 8 + 7] = o[c * 8 + 7] * al + pe * bfhi(w.w);
        }
      }
    }
    const float il = 1.0f / l;
    const bf16_t* gr = p.proj + (size_t)tok * NW + OFF_GA + h * 64;
    bf16_t* mo = p.mixed + (size_t)tok * DM + h * 64;
#pragma unroll
    for (int c = 0; c < 8; ++c) {
      const u32x4 w = *(const u32x4*)(gr + c * 8);
      float g[8] = {bflo(w.x), bfhi(w.x), bflo(w.y), bfhi(w.y), bflo(w.z), bfhi(w.z), bflo(w.w), bfhi(w.w)};
      float r[8];
#pragma unroll
      for (int e = 0; e < 8; ++e) r[e] = o[c * 8 + e] * il * (g[e] / (1.0f + __expf(-g[e])));
      u32x4 ww; ww.x = pack2(r[0], r[1]); ww.y = pack2(r[2], r[3]); ww.z = pack2(r[4], r[5]); ww.w = pack2(r[6], r[7]);
      *(u32x4*)(mo + c * 8) = ww;
    }
  }
}

DI float ret_log2g(int h) { return log2f(1.0f - exp2f(-5.0f - (float)h)); }

DI void phase_retkv_naive(const Params& p, int bid, int nb) {
  const long total = 1024L * 8192;
  for (long idx = (long)bid * blockDim.x + threadIdx.x; idx < total; idx += (long)nb * blockDim.x) {
    const int d = (int)(idx & 63), v = (int)((idx >> 6) & 127), u = (int)(idx >> 13);
    const int n = u & 31, h = (u >> 5) & 3, b = u >> 7;
    const float lg = ret_log2g(h);
    const bf16_t* base = p.proj + (size_t)(b * SEQ + n * 128) * NW;
    float s = 0.f;
    for (int j = 0; j < 128; ++j) {
      const float kk = bf2f(base[(size_t)j * NW + OFF_KR + h * 64 + d]), vv = bf2f(base[(size_t)j * NW + OFF_VR + h * 128 + v]);
      s += kk * exp2f((float)(127 - j) * lg) * vv;
    }
    p.kvT[idx] = s;
  }
}
DI void phase_retscan(const Params& p, int bid, int nb) {
  const long total = 32L * 8192;
  for (long idx = (long)bid * blockDim.x + threadIdx.x; idx < total; idx += (long)nb * blockDim.x) {
    const int e = (int)(idx & 8191), bh = (int)(idx >> 13), h = bh & 3;
    const float cd = exp2f(128.0f * ret_log2g(h));
    float s = 0.f;
    for (int n = 0; n < 32; ++n) {
      const size_t o = ((size_t)(bh * 32 + n) << 13) + e;
      p.stT[o] = f2bf(s);
      s = s * cd + p.kvT[o];
    }
  }
}
DI void phase_retout_naive(const Params& p, int bid, int nb) {
  const long total = 1024L * 128;
  for (long idx = (long)bid * blockDim.x + threadIdx.x; idx < total; idx += (long)nb * blockDim.x) {
    const int i = (int)(idx & 127), u = (int)(idx >> 7);
    const int n = u & 31, h = (u >> 5) & 3, b = u >> 7;
    const float lg = ret_log2g(h);
    const int tok0 = b * SEQ + n * 128, tok = tok0 + i;
    float o[128];
#pragma unroll
    for (int v = 0; v < 128; ++v) o[v] = 0.f;
    const bf16_t* qrow = p.proj + (size_t)tok * NW + OFF_QR + h * 64;
    for (int j = 0; j <= i; ++j) {
      const bf16_t* krow = p.proj + (size_t)(tok0 + j) * NW + OFF_KR + h * 64;
      float s = 0.f;
#pragma unroll
      for (int c = 0; c < 8; ++c) {
        const u32x4 a = *(const u32x4*)(qrow + c * 8), w = *(const u32x4*)(krow + c * 8);
        s += bflo(a.x) * bflo(w.x) + bfhi(a.x) * bfhi(w.x) + bflo(a.y) * bflo(w.y) + bfhi(a.y) * bfhi(w.y)
           + bflo(a.z) * bflo(w.z) + bfhi(a.z) * bfhi(w.z) + bflo(a.w) * bflo(w.w) + bfhi(a.w) * bfhi(w.w);
      }
      s *= exp2f((float)(i - j) * lg);
      const bf16_t* vrow = p.proj + (size_t)(tok0 + j) * NW + OFF_VR + h * 128;
#pragma unroll
      for (int c = 0; c < 16; ++c) {
        const u32x4 w = *(const u32x4*)(vrow + c * 8);
        o[c * 8 + 0] += s * bflo(w.x); o[c * 8 + 1] += s * bfhi(w.x); o[c * 8 + 2] += s * bflo(w.y); o[c * 8 + 3] += s * bfhi(w.y);
        o[c * 8 + 4] += s * bflo(w.z); o[c * 8 + 5] += s * bfhi(w.z); o[c * 8 + 6] += s * bflo(w.w); o[c * 8 + 7] += s * bfhi(w.w);
      }
    }
    const float qd = exp2f((float)(i + 1) * lg);
    const bf16_t* st = p.stT + ((size_t)u << 13);
    for (int d = 0; d < 64; ++d) {
      const float qq = bf2f(qrow[d]) * qd;
#pragma unroll
      for (int v = 0; v < 128; ++v) o[v] += qq * bf2f(st[v * 64 + d]);
    }
    float mu = 0.f;
#pragma unroll
    for (int v = 0; v < 128; ++v) mu += o[v];
    mu *= (1.0f / 128.0f);
    float var = 0.f;
#pragma unroll
    for (int v = 0; v < 128; ++v) { const float dd = o[v] - mu; var += dd * dd; }
    const float rs = rsqrtf(var * (1.0f / 128.0f) + 1e-5f);
    const bf16_t* gr = p.proj + (size_t)tok * NW + OFF_GR + h * 128;
    bf16_t* mo = p.mixed + (size_t)tok * DM + 512 + h * 128;
#pragma unroll
    for (int c = 0; c < 16; ++c) {
      const u32x4 w = *(const u32x4*)(gr + c * 8);
      float g[8] = {bflo(w.x), bfhi(w.x), bflo(w.y), bfhi(w.y), bflo(w.z), bfhi(w.z), bflo(w.w), bfhi(w.w)};
      float r[8];
#pragma unroll
      for (int e = 0; e < 8; ++e) r[e] = (o[c * 8 + e] - mu) * rs * p.gn[h * 128 + c * 8 + e] * (g[e] / (1.0f + __expf(-g[e])));
      u32x4 ww; ww.x = pack2(r[0], r[1]); ww.y = pack2(r[2], r[3]); ww.z = pack2(r[4], r[5]); ww.w = pack2(r[6], r[7]);
      *(u32x4*)(mo + c * 8) = ww;
    }
  }
}

DI void phase_final(const Params& p, int bid, int nb) {
  const int tid = threadIdx.x, lane = tid & 63, wid = tid >> 6, nw = blockDim.x >> 6;
  for (int row = bid * nw + wid; row < T_TOK; row += nb * nw) {
    const float rs = rsqrtf(p.rowss[row] * (1.0f / DM) + 1e-6f);
    float* yr = p.out + (size_t)row * DM;
#pragma unroll
    for (int it = 0; it < 4; ++it) {
      const f32x4 v = *(const f32x4*)(yr + it * 256 + lane * 4), g = *(const f32x4*)(p.fg + it * 256 + lane * 4);
      *(f32x4*)(yr + it * 256 + lane * 4) = v * rs * g;
    }
  }
}

template <int PH>
__global__ void __launch_bounds__(512) k_phase(Params p) {
  extern __shared__ __attribute__((aligned(16))) unsigned char shm_[];
  LAS unsigned char* shm = (LAS unsigned char*)shm_;
  const int bid = blockIdx.x, nb = gridDim.x;
  if (PH == 0) phase_prep(p, bid, nb);
  if (PH == 1) phase_gemm<1>(shm, p, bid, nb);
  if (PH == 2) phase_rotary(p, bid, nb);
  if (PH == 3) phase_attn_naive(p, bid, nb);
  if (PH == 4) phase_retkv_naive(p, bid, nb);
  if (PH == 5) phase_retscan(p, bid, nb);
  if (PH == 6) phase_retout_naive(p, bid, nb);
  if (PH == 7) phase_gemm<2>(shm, p, bid, nb);
  if (PH == 8) phase_final(p, bid, nb);
}

extern "C" void kernel_launch(void* const* d_in, const int* in_sizes, int n_in, void* d_out, int out_size, void* d_ws, size_t ws_size, hipStream_t stream) {
  Params p{};
  p.x = (const float*)d_in[0]; p.ng = (const float*)d_in[1]; p.w_in = (const float*)d_in[2]; p.gn = (const float*)d_in[3];
  p.w_out = (const float*)d_in[4]; p.fg = (const float*)d_in[5];
  p.out = (float*)d_out;
  char* w = (char*)d_ws; size_t o = 0;
  auto take = [&](size_t bytes) { char* r = w + o; o += (bytes + 255) & ~(size_t)255; return r; };
  p.xb = (bf16_t*)take((size_t)T_TOK * DM * 2);
  p.proj = (bf16_t*)take((size_t)T_TOK * NW * 2);
  p.mixed = (bf16_t*)take((size_t)T_TOK * DM * 2);
  p.winT = (bf16_t*)take((size_t)NW * DM * 2);
  p.woutT = (bf16_t*)take((size_t)DM * DM * 2);
  p.rstd = (float*)take((size_t)T_TOK * 4);
  p.rowss = (float*)take((size_t)T_TOK * 4);
  p.ropeT = (float2*)take((size_t)SEQ * 32 * 8);
  p.retT = (float2*)take((size_t)SEQ * 32 * 8);
  p.kvT = (float*)take((size_t)1024 * 8192 * 4);
  p.stT = (bf16_t*)take((size_t)1024 * 8192 * 2);
  static bool attr_set = false;
  if (!attr_set) {
    (void)hipFuncSetAttribute((const void*)k_phase<1>, hipFuncAttributeMaxDynamicSharedMemorySize, GEMM_LDS);
    (void)hipFuncSetAttribute((const void*)k_phase<7>, hipFuncAttributeMaxDynamicSharedMemorySize, GEMM_LDS);
    attr_set = true;
  }
  hipLaunchKernelGGL(k_phase<0>, dim3(1024), dim3(512), 0, stream, p);
  hipLaunchKernelGGL(k_phase<1>, dim3(256), dim3(512), GEMM_LDS, stream, p);
  hipLaunchKernelGGL(k_phase<2>, dim3(1024), dim3(512), 0, stream, p);
  hipLaunchKernelGGL(k_phase<3>, dim3(1024), dim3(512), 0, stream, p);
  hipLaunchKernelGGL(k_phase<4>, dim3(1024), dim3(512), 0, stream, p);
  hipLaunchKernelGGL(k_phase<5>, dim3(512), dim3(512), 0, stream, p);
  hipLaunchKernelGGL(k_phase<6>, dim3(256), dim3(512), 0, stream, p);
  hipLaunchKernelGGL(k_phase<7>, dim3(256), dim3(512), GEMM_LDS, stream, p);
  hipLaunchKernelGGL(k_phase<8>, dim3(1024), dim3(512), 0, stream, p);
}
```

```cpp
#include <hip/hip_runtime.h>
#include <hip/hip_cooperative_groups.h>
#include <cstdint>
#include <cstdio>
namespace cg = cooperative_groups;

typedef unsigned short bf16_t;
typedef short bf16x8 __attribute__((ext_vector_type(8)));
typedef float f32x4 __attribute__((ext_vector_type(4)));
typedef unsigned u32x4 __attribute__((ext_vector_type(4)));
typedef unsigned u32x2 __attribute__((ext_vector_type(2)));

constexpr int T_TOK = 32768, DM = 1024, NW = 3584, SEQ = 4096;
constexpr int OFF_QA = 0, OFF_KA = 512, OFF_VA = 1024, OFF_GA = 1536, OFF_QR = 2048, OFF_KR = 2304, OFF_VR = 2560, OFF_GR = 3072;

struct Params {
  const float* x; const float* ng; const float* w_in; const float* gn; const float* w_out; const float* fg;
  float* out;
  bf16_t* xb; bf16_t* proj; bf16_t* mixed; bf16_t* winT; bf16_t* woutT;
  float* rstd; float* rowss; float2* ropeT; float2* retT; float* kvT; bf16_t* stT;
};

#define DI __device__ __forceinline__
DI unsigned short f2bf(float x) { unsigned u = __float_as_uint(x); u += 0x7fffu + ((u >> 16) & 1u); return (unsigned short)(u >> 16); }
DI float bf2f(unsigned short b) { return __uint_as_float(((unsigned)b) << 16); }
DI unsigned pack2(float lo, float hi) { return (unsigned)f2bf(lo) | ((unsigned)f2bf(hi) << 16); }
DI float bflo(unsigned w) { return __uint_as_float(w << 16); }
DI float bfhi(unsigned w) { return __uint_as_float(w & 0xffff0000u); }
DI int perm32(int rho) { const int n = rho >> 4, i = rho & 15; return 8 * (i >> 2) + 4 * n + (i & 3); }
DI int cmap(int p) { return (p & ~31) + perm32(p & 31); }

DI void phase_prep(const Params& p, int bid, int nb) {
  const int tid = threadIdx.x, lane = tid & 63, wid = tid >> 6, nw = blockDim.x >> 6;
  for (int row = bid * nw + wid; row < T_TOK; row += nb * nw) {
    const float* xr = p.x + (size_t)row * DM;
    float ss = 0.f;
    f32x4 v[4];
#pragma unroll
    for (int it = 0; it < 4; ++it) { v[it] = *(const f32x4*)(xr + it * 256 + lane * 4); ss += v[it][0] * v[it][0] + v[it][1] * v[it][1] + v[it][2] * v[it][2] + v[it][3] * v[it][3]; }
#pragma unroll
    for (int o = 32; o >= 1; o >>= 1) ss += __shfl_xor(ss, o);
#pragma unroll
    for (int it = 0; it < 4; ++it) { u32x2 w; w.x = pack2(v[it][0], v[it][1]); w.y = pack2(v[it][2], v[it][3]); *(u32x2*)(p.xb + (size_t)row * DM + it * 256 + lane * 4) = w; }
    if (lane == 0) { p.rstd[row] = rsqrtf(ss * (1.0f / DM) + 1e-6f); p.rowss[row] = 0.f; }
  }
  const int gt = bid * blockDim.x + tid, gn = nb * blockDim.x;
  for (int idx = gt; idx < NW * 128; idx += gn) {
    const int pp = idx % NW, kc = idx / NW, c = cmap(pp);
    float f[8];
#pragma unroll
    for (int j = 0; j < 8; ++j) { const int k = kc * 8 + j; f[j] = p.ng[k] * p.w_in[(size_t)k * NW + c]; }
    u32x4 w; w.x = pack2(f[0], f[1]); w.y = pack2(f[2], f[3]); w.z = pack2(f[4], f[5]); w.w = pack2(f[6], f[7]);
    *(u32x4*)(p.winT + (size_t)pp * DM + kc * 8) = w;
  }
  for (int idx = gt; idx < DM * 128; idx += gn) {
    const int pp = idx % DM, kc = idx / DM, c = cmap(pp);
    float f[8];
#pragma unroll
    for (int j = 0; j < 8; ++j) { const int k = kc * 8 + j; f[j] = p.w_out[(size_t)k * DM + c]; }
    u32x4 w; w.x = pack2(f[0], f[1]); w.y = pack2(f[2], f[3]); w.z = pack2(f[4], f[5]); w.w = pack2(f[6], f[7]);
    *(u32x4*)(p.woutT + (size_t)pp * DM + kc * 8) = w;
  }
  for (int idx = gt; idx < SEQ * 32; idx += gn) {
    const int pos = idx >> 5, i = idx & 31;
    const float inv1 = powf(10000.0f, -(float)i / 32.0f);
    const float inv2 = 1.0f / powf(10000.0f, (float)i / 31.0f);
    const float a1 = (float)pos * inv1, a2 = (float)pos * inv2;
    p.ropeT[idx] = make_float2(cosf(a1), sinf(a1));
    p.retT[idx] = make_float2(cosf(a2), sinf(a2));
  }
}

constexpr int BM = 256, BK = 64, HALF = 128, HT = HALF * BK;
constexpr int GEMM_LDS = 8 * HT * 2;
DI int lds_byte(int r, int c) { int st = (r >> 4) * 2 + (c >> 5), rr = r & 15, cc = c & 31, ob = rr * 64 + cc * 2; return st * 1024 + (ob ^ (((ob >> 9) & 1) << 5)); }
DI void stage_rc(int b, int& R, int& C) { int st = b / 1024, sb = b % 1024, swz = sb ^ (((sb >> 9) & 1) << 5); R = (st >> 1) * 16 + swz / 64; C = (st & 1) * 32 + (swz % 64) / 2; }

#define LAS __attribute__((address_space(3)))
template <int EPI>
DI void gemm_tile(LAS unsigned char* lds, const bf16_t* __restrict__ A, const bf16_t* __restrict__ Bt, const int brow, const int bcol, const Params& p) {
  constexpr int K = 1024, nt = K / BK, HTB = HALF * BK * 2;
  const int tid = threadIdx.x, wid = __builtin_amdgcn_readfirstlane(tid >> 6), lane = tid & 63, wr = wid >> 2, wc = wid & 3, fr = lane & 15, fq = lane >> 4;
  unsigned voff[2];
#pragma unroll
  for (int i = 0; i < 2; ++i) { int R, C; stage_rc(tid * 16 + i * 8192, R, C); voff[i] = (unsigned)(R * K + C) * 2u; }
  const unsigned ldsw = (unsigned)wid * 1024u;
  const int aoff = lds_byte(wr * 64 + fr, fq * 8), boff = lds_byte(wc * 32 + fr, fq * 8);
  const char* cA0 = (const char*)A + (size_t)brow * K * 2; const char* cA1 = cA0 + (size_t)HALF * K * 2;
  const char* cB0 = (const char*)Bt + (size_t)bcol * K * 2; const char* cB1 = cB0 + (size_t)HALF * K * 2;
#define SAo(b, h) (((b) * 2 + (h)) * HTB)
#define SBo(b, h) ((4 + (b) * 2 + (h)) * HTB)
#define STAGE(bufoff, gb, kt) do { _Pragma("unroll") for (int _i = 0; _i < 2; ++_i) \
    __builtin_amdgcn_global_load_lds((const unsigned*)((gb) + (size_t)(kt) * (BK * 2) + voff[_i]), (LAS unsigned*)(lds + (bufoff) + ldsw + _i * 8192), 16, 0, 0); } while (0)
#define LDA(dst, b, h) do { _Pragma("unroll") for (int m = 0; m < 4; ++m) _Pragma("unroll") for (int k = 0; k < 2; ++k) \
    dst[m][k] = *(const LAS bf16x8*)(lds + SAo(b, h) + aoff + m * 2048 + k * 1024); } while (0)
#define LDB(dst, b, h) do { _Pragma("unroll") for (int n = 0; n < 2; ++n) _Pragma("unroll") for (int k = 0; k < 2; ++k) \
    dst[n][k] = *(const LAS bf16x8*)(lds + SBo(b, h) + boff + n * 2048 + k * 1024); } while (0)
#define MMA(ai, bj, At, Bt_) do { __builtin_amdgcn_s_setprio(1); \
    _Pragma("unroll") for (int m = 0; m < 4; ++m) _Pragma("unroll") for (int n = 0; n < 2; ++n) _Pragma("unroll") for (int k = 0; k < 2; ++k) \
      acc[ai][bj][m][n] = __builtin_amdgcn_mfma_f32_16x16x32_bf16(Bt_[n][k], At[m][k], acc[ai][bj][m][n], 0, 0, 0); \
    __builtin_amdgcn_s_setprio(0); } while (0)
#define WAIT_V(n) asm volatile("s_waitcnt vmcnt(" #n ")" ::: "memory")
#define WAIT_L(n) asm volatile("s_waitcnt lgkmcnt(" #n ")" ::: "memory")
#define BAR __builtin_amdgcn_s_barrier()
#define SCHED __builtin_amdgcn_sched_barrier(0)
  f32x4 acc[2][2][4][2];
#pragma unroll
  for (int a = 0; a < 2; ++a)
#pragma unroll
    for (int b = 0; b < 2; ++b)
#pragma unroll
      for (int m = 0; m < 4; ++m)
#pragma unroll
        for (int n = 0; n < 2; ++n) acc[a][b][m][n] = (f32x4){0.f, 0.f, 0.f, 0.f};
  bf16x8 At[4][2], B0[2][2], B1[2][2];
  WAIT_V(0);
  STAGE(SBo(0, 0), cB0, 0); STAGE(SAo(0, 0), cA0, 0);
  STAGE(SBo(0, 1), cB1, 0); STAGE(SAo(0, 1), cA1, 0);
  if (wr == 1) BAR;
  WAIT_V(4); BAR;
  STAGE(SBo(1, 0), cB0, 1); STAGE(SAo(1, 0), cA0, 1); STAGE(SBo(1, 1), cB1, 1);
  WAIT_V(6); BAR;
  for (int t = 0; t < nt - 2; t += 2) {
    LDB(B0, 0, 0); SCHED; LDA(At, 0, 0); STAGE(SAo(1, 1), cA1, t + 1);
    WAIT_L(8); BAR; WAIT_L(0); MMA(0, 0, At, B0); BAR; SCHED;
    LDB(B1, 0, 1); STAGE(SBo(0, 0), cB0, t + 2);
    BAR; WAIT_L(0); MMA(0, 1, At, B1); BAR;
    LDA(At, 0, 1); STAGE(SAo(0, 0), cA0, t + 2);
    BAR; WAIT_L(0); MMA(1, 0, At, B0); BAR; SCHED;
    STAGE(SBo(0, 1), cB1, t + 2);
    WAIT_V(6); BAR; MMA(1, 1, At, B1); BAR;
    LDB(B0, 1, 0); SCHED; LDA(At, 1, 0); STAGE(SAo(0, 1), cA1, t + 2);
    WAIT_L(8); BAR; WAIT_L(0); MMA(0, 0, At, B0); BAR; SCHED;
    LDB(B1, 1, 1); STAGE(SBo(1, 0), cB0, t + 3);
    BAR; WAIT_L(0); MMA(0, 1, At, B1); BAR;
    LDA(At, 1, 1); STAGE(SAo(1, 0), cA0, t + 3);
    BAR; WAIT_L(0); MMA(1, 0, At, B0); BAR; SCHED;
    STAGE(SBo(1, 1), cB1, t + 3);
    WAIT_V(6); BAR; MMA(1, 1, At, B1); BAR;
  }
  { LDB(B0, 0, 0); LDA(At, 0, 0); STAGE(SAo(1, 1), cA1, nt - 1);
    BAR; WAIT_L(0); MMA(0, 0, At, B0); BAR;
    LDB(B1, 0, 1); BAR; WAIT_L(0); MMA(0, 1, At, B1); BAR;
    LDA(At, 0, 1); WAIT_V(4); BAR; WAIT_L(0); MMA(1, 0, At, B0); MMA(1, 1, At, B1); BAR; }
  { LDB(B0, 1, 0); LDA(At, 1, 0); WAIT_V(2); BAR; WAIT_L(0); MMA(0, 0, At, B0); BAR;
    LDB(B1, 1, 1); WAIT_V(0); BAR; WAIT_L(0); MMA(0, 1, At, B1); BAR;
    LDA(At, 1, 1); BAR; WAIT_L(0); MMA(1, 0, At, B0); MMA(1, 1, At, B1); BAR; }
  if (wr == 0) BAR;
  if (EPI == 1) {
#pragma unroll
    for (int ai = 0; ai < 2; ++ai)
#pragma unroll
      for (int m = 0; m < 4; ++m) {
        const int row = brow + ai * HALF + wr * 64 + m * 16 + fr;
        const float rs = p.rstd[row];
#pragma unroll
        for (int bj = 0; bj < 2; ++bj) {
          const f32x4 v0 = acc[ai][bj][m][0] * rs, v1 = acc[ai][bj][m][1] * rs;
          u32x4 w; w.x = pack2(v0[0], v0[1]); w.y = pack2(v0[2], v0[3]); w.z = pack2(v1[0], v1[1]); w.w = pack2(v1[2], v1[3]);
          *(u32x4*)(p.proj + (size_t)row * NW + bcol + bj * HALF + wc * 32 + 8 * fq) = w;
        }
      }
  } else {
#pragma unroll
    for (int ai = 0; ai < 2; ++ai)
#pragma unroll
      for (int m = 0; m < 4; ++m) {
        const int row = brow + ai * HALF + wr * 64 + m * 16 + fr;
        float ss = 0.f;
#pragma unroll
        for (int bj = 0; bj < 2; ++bj) {
          const size_t off = (size_t)row * DM + bcol + bj * HALF + wc * 32 + 8 * fq;
          const f32x4 x0 = *(const f32x4*)(p.x + off), x1 = *(const f32x4*)(p.x + off + 4);
          const f32x4 y0 = acc[ai][bj][m][0] + x0, y1 = acc[ai][bj][m][1] + x1;
          *(f32x4*)(p.out + off) = y0; *(f32x4*)(p.out + off + 4) = y1;
          ss += y0[0] * y0[0] + y0[1] * y0[1] + y0[2] * y0[2] + y0[3] * y0[3] + y1[0] * y1[0] + y1[1] * y1[1] + y1[2] * y1[2] + y1[3] * y1[3];
        }
        ss += __shfl_xor(ss, 16); ss += __shfl_xor(ss, 32);
        if (fq == 0) atomicAdd(p.rowss + row, ss);
      }
  }
}

DI void tile_of(int L, int nM, int nN, int& pm, int& pn) {
  const int nwg = nM * nN, NX = 8, WGM = 8;
  int wgid = L; { const int q = nwg / NX, r = nwg % NX, xcd = wgid % NX, off = wgid / NX; wgid = (xcd < r ? xcd * (q + 1) : r * (q + 1) + (xcd - r) * q) + off; }
  const int nig = WGM * nN, gid = wgid / nig, fm = gid * WGM, gsz = (nM - fm) < WGM ? (nM - fm) : WGM;
  pm = fm + ((wgid % nig) % gsz); pn = (wgid % nig) / gsz;
}

template <int EPI>
DI void phase_gemm(LAS unsigned char* shm, const Params& p, int bid, int nb) {
  const int nM = T_TOK / BM, nN = (EPI == 1 ? NW : DM) / BM;
  for (int L = bid; L < nM * nN; L += nb) {
    int pm, pn; tile_of(L, nM, nN, pm, pn);
    if (EPI == 1) gemm_tile<1>(shm, p.xb, p.winT, pm * BM, pn * BM, p);
    else gemm_tile<2>(shm, p.mixed, p.woutT, pm * BM, pn * BM, p);
  }
}

DI void phase_rotary(const Params& p, int bid, int nb) {
  const long total = (long)T_TOK * 768;
  for (long idx = (long)bid * blockDim.x + threadIdx.x; idx < total; idx += (long)nb * blockDim.x) {
    const int tok = (int)(idx / 768); int j = (int)(idx % 768);
    const int pos = tok & (SEQ - 1);
    int a, b; float sc; const float2* tab;
    if (j < 256) { const int h = j >> 5, i = j & 31; a = OFF_QA + h * 64 + i; b = a + 32; sc = 0.125f; tab = p.ropeT + pos * 32 + i; }
    else if (j < 512) { j -= 256; const int h = j >> 5, i = j & 31; a = OFF_KA + h * 64 + i; b = a + 32; sc = 1.f; tab = p.ropeT + pos * 32 + i; }
    else if (j < 640) { j -= 512; const int h = j >> 5, i = j & 31; a = OFF_QR + h * 64 + 2 * i; b = a + 1; sc = 1.f; tab = p.retT + pos * 32 + i; }
    else { j -= 640; const int h = j >> 5, i = j & 31; a = OFF_KR + h * 64 + 2 * i; b = a + 1; sc = 0.125f; tab = p.retT + pos * 32 + i; }
    const float2 cs = *tab;
    bf16_t* row = p.proj + (size_t)tok * NW;
    const float x1 = bf2f(row[a]), x2 = bf2f(row[b]);
    row[a] = f2bf((x1 * cs.x - x2 * cs.y) * sc);
    row[b] = f2bf((x2 * cs.x + x1 * cs.y) * sc);
  }
}

DI void load_row64(const bf16_t* src, float* dst) {
#pragma unroll
  for (int c = 0; c < 8; ++c) {
    const u32x4 w = *(const u32x4*)(src + c * 8);
    dst[c * 8 + 0] = bflo(w.x); dst[c * 8 + 1] = bfhi(w.x); dst[c * 8 + 2] = bflo(w.y); dst[c * 8 + 3] = bfhi(w.y);
    dst[c * 8 + 4] = bflo(w.z); dst[c * 8 + 5] = bfhi(w.z); dst[c * 8 + 6] = bflo(w.w); dst[c * 8 + 7] = bfhi(w.w);
  }
}

DI void phase_attn_naive(const Params& p, int bid, int nb) {
  const long total = (long)T_TOK * 8;
  for (long idx = (long)bid * blockDim.x + threadIdx.x; idx < total; idx += (long)nb * blockDim.x) {
    const int h = (int)(idx & 7), tok = (int)(idx >> 3);
    const int pos = tok & (SEQ - 1), tb = tok - pos;
    float q[64], o[64];
    load_row64(p.proj + (size_t)tok * NW + OFF_QA + h * 64, q);
#pragma unroll
    for (int d = 0; d < 64; ++d) o[d] = 0.f;
    float m = -1e30f, l = 0.f;
    for (int br = 0; br < 3; ++br) {
      const int dl = br == 0 ? 1 : (br == 1 ? 4 : 16);
      for (int j = 0; j <= 128; ++j) {
        const int pk = pos - j * dl; if (pk < 0) break;
        const bf16_t* kr = p.proj + (size_t)(tb + pk) * NW + OFF_KA + h * 64;
        float s = 0.f;
#pragma unroll
        for (int c = 0; c < 8; ++c) {
          const u32x4 w = *(const u32x4*)(kr + c * 8);
          s += q[c * 8 + 0] * bflo(w.x) + q[c * 8 + 1] * bfhi(w.x) + q[c * 8 + 2] * bflo(w.y) + q[c * 8 + 3] * bfhi(w.y)
             + q[c * 8 + 4] * bflo(w.z) + q[c * 8 + 5] * bfhi(w.z) + q[c * 8 + 6] * bflo(w.w) + q[c * 8 + 7] * bfhi(w.w);
        }
        const float mn = fmaxf(m, s), al = __expf(m - mn), pe = __expf(s - mn);
        m = mn; l = l * al + pe;
        const bf16_t* vr = kr + (OFF_VA - OFF_KA);
#pragma unroll
        for (int c = 0; c < 8; ++c) {
          const u32x4 w = *(const u32x4*)(vr + c * 8);
          o[c * 8 + 0] = o[c * 8 + 0] * al + pe * bflo(w.x); o[c * 8 + 1] = o[c * 8 + 1] * al + pe * bfhi(w.x);
          o[c * 8 + 2] = o[c * 8 + 2] * al + pe * bflo(w.y); o[c * 8 + 3] = o[c * 8 + 3] * al + pe * bfhi(w.y);
          o[c * 8 + 4] = o[c * 8 + 4] * al + pe * bflo(w.z); o[c * 8 + 5] = o[c * 8 + 5] * al + pe * bfhi(w.z);
          o[c * 8 + 6] = o[c * 8 + 6] * al + pe * bflo(w.w); o[c * 8 + 7] = o[c * 8 + 7] * al + pe * bfhi(w.w);
        }
      }
    }
    const float il = 1.0f / l;
    const bf16_t* gr = p.proj + (size_t)tok * NW + OFF_GA + h * 64;
    bf16_t* mo = p.mixed + (size_t)tok * DM + h * 64;
#pragma unroll
    for (int c = 0; c < 8; ++c) {
      const u32x4 w = *(const u32x4*)(gr + c * 8);
      float g[8] = {bflo(w.x), bfhi(w.x), bflo(w.y), bfhi(w.y), bflo(w.z), bfhi(w.z), bflo(w.w), bfhi(w.w)};
      float r[8];
#pragma unroll
      for (int e = 0; e < 8; ++e) r[e] = o[c * 8 + e] * il * (g[e] / (1.0f + __expf(-g[e])));
      u32x4 ww; ww.x = pack2(r[0], r[1]); ww.y = pack2(r[2], r[3]); ww.z = pack2(r[4], r[5]); ww.w = pack2(r[6], r[7]);
      *(u32x4*)(mo + c * 8) = ww;
    }
  }
}

DI float ret_log2g(int h) { return log2f(1.0f - exp2f(-5.0f - (float)h)); }

DI void phase_retkv_naive(const Params& p, int bid, int nb) {
  const long total = 1024L * 8192;
  for (long idx = (long)bid * blockDim.x + threadIdx.x; idx < total; idx += (long)nb * blockDim.x) {
    const int d = (int)(idx & 63), v = (int)((idx >> 6) & 127), u = (int)(idx >> 13);
    const int n = u & 31, h = (u >> 5) & 3, b = u >> 7;
    const float lg = ret_log2g(h);
    const bf16_t* base = p.proj + (size_t)(b * SEQ + n * 128) * NW;
    float s = 0.f;
    for (int j = 0; j < 128; ++j) {
      const float kk = bf2f(base[(size_t)j * NW + OFF_KR + h * 64 + d]), vv = bf2f(base[(size_t)j * NW + OFF_VR + h * 128 + v]);
      s += kk * exp2f((float)(127 - j) * lg) * vv;
    }
    p.kvT[idx] = s;
  }
}
DI void phase_retscan(const Params& p, int bid, int nb) {
  const long total = 32L * 8192;
  for (long idx = (long)bid * blockDim.x + threadIdx.x; idx < total; idx += (long)nb * blockDim.x) {
    const int e = (int)(idx & 8191), bh = (int)(idx >> 13), h = bh & 3;
    const float cd = exp2f(128.0f * ret_log2g(h));
    float s = 0.f;
    for (int n = 0; n < 32; ++n) {
      const size_t o = ((size_t)(bh * 32 + n) << 13) + e;
      p.stT[o] = f2bf(s);
      s = s * cd + p.kvT[o];
    }
  }
}
DI void phase_retout_naive(const Params& p, int bid, int nb) {
  const long total = 1024L * 256;
  for (long idx = (long)bid * blockDim.x + threadIdx.x; idx < total; idx += (long)nb * blockDim.x) {
    const int vh = (int)(idx & 1), i = (int)((idx >> 1) & 127), u = (int)(idx >> 8);
    const int n = u & 31, h = (u >> 5) & 3, b = u >> 7;
    const float lg = ret_log2g(h);
    const int tok0 = b * SEQ + n * 128, tok = tok0 + i;
    float o[64];
#pragma unroll
    for (int v = 0; v < 64; ++v) o[v] = 0.f;
    const bf16_t* qrow = p.proj + (size_t)tok * NW + OFF_QR + h * 64;
    for (int j = 0; j <= i; ++j) {
      const bf16_t* krow = p.proj + (size_t)(tok0 + j) * NW + OFF_KR + h * 64;
      float s = 0.f;
#pragma unroll
      for (int c = 0; c < 8; ++c) {
        const u32x4 a = *(const u32x4*)(qrow + c * 8), w = *(const u32x4*)(krow + c * 8);
        s += bflo(a.x) * bflo(w.x) + bfhi(a.x) * bfhi(w.x) + bflo(a.y) * bflo(w.y) + bfhi(a.y) * bfhi(w.y)
           + bflo(a.z) * bflo(w.z) + bfhi(a.z) * bfhi(w.z) + bflo(a.w) * bflo(w.w) + bfhi(a.w) * bfhi(w.w);
      }
      s *= exp2f((float)(i - j) * lg);
      const bf16_t* vrow = p.proj + (size_t)(tok0 + j) * NW + OFF_VR + h * 128 + vh * 64;
#pragma unroll
      for (int c = 0; c < 8; ++c) {
        const u32x4 w = *(const u32x4*)(vrow + c * 8);
        o[c * 8 + 0] += s * bflo(w.x); o[c * 8 + 1] += s * bfhi(w.x); o[c * 8 + 2] += s * bflo(w.y); o[c * 8 + 3] += s * bfhi(w.y);
        o[c * 8 + 4] += s * bflo(w.z); o[c * 8 + 5] += s * bfhi(w.z); o[c * 8 + 6] += s * bflo(w.w); o[c * 8 + 7] += s * bfhi(w.w);
      }
    }
    const float qd = exp2f((float)(i + 1) * lg);
    const bf16_t* st = p.stT + ((size_t)u << 13) + vh * 64 * 64;
    for (int d = 0; d < 64; ++d) {
      const float qq = bf2f(qrow[d]) * qd;
#pragma unroll
      for (int v = 0; v < 64; ++v) o[v] += qq * bf2f(st[v * 64 + d]);
    }
    float mu = 0.f;
#pragma unroll
    for (int v = 0; v < 64; ++v) mu += o[v];
    mu += __shfl_xor(mu, 1);
    mu *= (1.0f / 128.0f);
    float var = 0.f;
#pragma unroll
    for (int v = 0; v < 64; ++v) { const float dd = o[v] - mu; var += dd * dd; }
    var += __shfl_xor(var, 1);
    const float rs = rsqrtf(var * (1.0f / 128.0f) + 1e-5f);
    const bf16_t* gr = p.proj + (size_t)tok * NW + OFF_GR + h * 128 + vh * 64;
    bf16_t* mo = p.mixed + (size_t)tok * DM + 512 + h * 128 + vh * 64;
#pragma unroll
    for (int c = 0; c < 8; ++c) {
      const u32x4 w = *(const u32x4*)(gr + c * 8);
      float g[8] = {bflo(w.x), bfhi(w.x), bflo(w.y), bfhi(w.y), bflo(w.z), bfhi(w.z), bflo(w.w), bfhi(w.w)};
      float r[8];
#pragma unroll
      for (int e = 0; e < 8; ++e) r[e] = (o[c * 8 + e] - mu) * rs * p.gn[h * 128 + vh * 64 + c * 8 + e] * (g[e] / (1.0f + __expf(-g[e])));
      u32x4 ww; ww.x = pack2(r[0], r[1]); ww.y = pack2(r[2], r[3]); ww.z = pack2(r[4], r[5]); ww.w = pack2(r[6], r[7]);
      *(u32x4*)(mo + c * 8) = ww;
    }
  }
}

typedef float f32x16 __attribute__((ext_vector_type(16)));
typedef short s16x4 __attribute__((ext_vector_type(4)));
#define MFMA32(a, b, c) __builtin_amdgcn_mfma_f32_32x32x16_bf16((a), (b), (c), 0, 0, 0)
DI s16x4 tr_read(LAS unsigned char* a) { return __builtin_amdgcn_ds_read_tr16_b64_v4i16((LAS s16x4*)a); }
DI bf16x8 tr_frag(LAS unsigned char* a, int rowstride8) {
  const s16x4 lo = tr_read(a), hi = tr_read(a + rowstride8);
  return __builtin_shufflevector(lo, hi, 0, 1, 2, 3, 4, 5, 6, 7);
}
DI bf16x8 pack8(const f32x16& x, int s) {
  u32x4 w;
  w.x = pack2(x[8 * s + 0], x[8 * s + 1]); w.y = pack2(x[8 * s + 2], x[8 * s + 3]); w.z = pack2(x[8 * s + 4], x[8 * s + 5]); w.w = pack2(x[8 * s + 6], x[8 * s + 7]);
  return __builtin_bit_cast(bf16x8, w);
}
DI float fexp2(float x) { return __builtin_amdgcn_exp2f(x); }
DI float silu(float g) { return g / (1.0f + __expf(-g)); }

constexpr int AT_ROWB = 136, AT_LS = 512 * AT_ROWB, AT_VST = AT_LS + 2048, VROW = 192, VST_W = 32 * VROW;
constexpr float LOG2E = 1.4426950408889634f;

DI void attn_task(const Params& p, LAS unsigned char* lds, LAS unsigned char* vst, const int lane, const int tokbase, const int hh, const int pbase,
                  const int sh, const int r_res, const int l0, const bool first) {
  const int r = lane & 31, h = lane >> 5;
  const int i16 = lane & 15, q4 = i16 >> 2, pp = i16 & 3, blk = (lane >> 4) & 1;
  LAS unsigned char* trp = vst + (4 * h + q4) * VROW + 32 * blk + 8 * pp;
  const int pq = r_res + ((l0 + r) << sh), qloc = pq - pbase;
  const bf16_t* qp = p.proj + (size_t)(tokbase + pq) * NW + OFF_QA + hh * 64 + 8 * h;
  bf16x8 Qf[4];
#pragma unroll
  for (int ks = 0; ks < 4; ++ks) Qf[ks] = *(const bf16x8*)(qp + 16 * ks);
  f32x16 O0, O1;
#pragma unroll
  for (int i = 0; i < 16; ++i) { O0[i] = 0.f; O1[i] = 0.f; }
  float m = -1e30f, l = 0.f;
  const int kt0 = (l0 >= 128) ? 0 : (4 - (l0 >> 5));
  bf16x8 Kn[4]; u32x4 Vn[4];
#define LOAD_KV(kt_) do { const int lk0_ = l0 - 128 + 32 * (kt_); \
    const bf16_t* kp_ = p.proj + (size_t)(tokbase + r_res + ((lk0_ + r) << sh)) * NW + OFF_KA + hh * 64 + 8 * h; \
    const bf16_t* vp_ = p.proj + (size_t)(tokbase + r_res + ((lk0_ + (lane >> 1)) << sh)) * NW + OFF_VA + hh * 64 + 32 * (lane & 1); \
    _Pragma("unroll") for (int c_ = 0; c_ < 4; ++c_) { Kn[c_] = *(const bf16x8*)(kp_ + 16 * c_); Vn[c_] = *(const u32x4*)(vp_ + 8 * c_); } } while (0)
  LOAD_KV(kt0);
  for (int kt = kt0; kt < 5; ++kt) {
    bf16x8 Kc[4]; u32x4 Vc[4];
#pragma unroll
    for (int c = 0; c < 4; ++c) { Kc[c] = Kn[c]; Vc[c] = Vn[c]; }
    if (kt < 4) LOAD_KV(kt + 1);
#pragma unroll
    for (int c = 0; c < 4; ++c) *(LAS u32x4*)(vst + (lane >> 1) * VROW + (lane & 1) * 64 + c * 16) = Vc[c];
    f32x16 S;
#pragma unroll
    for (int i = 0; i < 16; ++i) S[i] = 0.f;
#pragma unroll
    for (int ks = 0; ks < 4; ++ks) S = MFMA32(Kc[ks], Qf[ks], S);
    const bool m0 = (kt == 0), m4 = (kt == 4);
    float mx = -1e30f;
#pragma unroll
    for (int i = 0; i < 16; ++i) {
      const int keyrow = (i & 3) + 8 * (i >> 2) + 4 * h;
      const bool bad = (m0 && keyrow < r) || (m4 && keyrow > r);
      S[i] = bad ? -1e30f : S[i] * LOG2E;
      mx = fmaxf(mx, S[i]);
    }
    mx = fmaxf(mx, __shfl_xor(mx, 32));
    const float mn = fmaxf(m, mx), al = fexp2(m - mn);
    m = mn;
    float ps = 0.f;
#pragma unroll
    for (int i = 0; i < 16; ++i) { S[i] = fexp2(S[i] - mn); ps += S[i]; }
    ps += __shfl_xor(ps, 32);
    l = l * al + ps;
#pragma unroll
    for (int i = 0; i < 16; ++i) { O0[i] *= al; O1[i] *= al; }
#pragma unroll
    for (int s = 0; s < 2; ++s) {
      const bf16x8 Pb = pack8(S, s);
      const bf16x8 V0 = tr_frag(trp + 16 * s * VROW, 8 * VROW), V1 = tr_frag(trp + 16 * s * VROW + 64, 8 * VROW);
      O0 = MFMA32(V0, Pb, O0);
      O1 = MFMA32(V1, Pb, O1);
    }
  }
#undef LOAD_KV
  float lse = m + __log2f(l);
  float w1 = 1.0f / l, w0 = 0.f;
  LAS float* LS = (LAS float*)(lds + AT_LS);
  if (!first) {
    const float lp = LS[qloc];
    const float M = fmaxf(lse, lp), e1 = fexp2(lse - M), e0 = fexp2(lp - M), den = e0 + e1, id = 1.0f / den;
    w1 *= e1 * id; w0 = e0 * id; lse = M + __log2f(den);
  }
  LAS unsigned char* ob = lds + qloc * AT_ROWB + 8 * h;
#pragma unroll
  for (int dt = 0; dt < 2; ++dt)
#pragma unroll
    for (int g = 0; g < 4; ++g) {
      float f0, f1, f2, f3;
      if (dt == 0) { f0 = O0[4 * g] * w1; f1 = O0[4 * g + 1] * w1; f2 = O0[4 * g + 2] * w1; f3 = O0[4 * g + 3] * w1; }
      else { f0 = O1[4 * g] * w1; f1 = O1[4 * g + 1] * w1; f2 = O1[4 * g + 2] * w1; f3 = O1[4 * g + 3] * w1; }
      LAS u32x2* a = (LAS u32x2*)(ob + 64 * dt + 16 * g);
      if (!first) { const u32x2 pv = *a; f0 += w0 * bflo(pv.x); f1 += w0 * bfhi(pv.x); f2 += w0 * bflo(pv.y); f3 += w0 * bfhi(pv.y); }
      u32x2 wv; wv.x = pack2(f0, f1); wv.y = pack2(f2, f3);
      *a = wv;
    }
  if (h == 0) LS[qloc] = lse;
}

DI void phase_attn(LAS unsigned char* lds, const Params& p, int bid, int nb) {
  const int tid = threadIdx.x, wid = __builtin_amdgcn_readfirstlane(tid >> 6), lane = tid & 63;
  LAS unsigned char* vst = lds + AT_VST + wid * VST_W;
  for (int unit = bid; unit < 512; unit += nb) {
    const int u = unit & 7, hh = (unit >> 3) & 7, b = unit >> 6;
    const int tokbase = b * SEQ, pbase = 512 * u;
    for (int stage = 0; stage < 3; ++stage) {
      const int sh = stage == 0 ? 4 : (stage == 1 ? 2 : 0);
      for (int tk = 0; tk < 2; ++tk) {
        const int idx = wid + 8 * tk;
        int r_res, l0;
        if (stage == 0) { r_res = idx; l0 = 32 * u; }
        else if (stage == 1) { r_res = idx >> 2; l0 = 128 * u + 32 * (idx & 3); }
        else { r_res = 0; l0 = 512 * u + 32 * idx; }
        attn_task(p, lds, vst, lane, tokbase, hh, pbase, sh, r_res, l0, stage == 0);
      }
      __syncthreads();
    }
#pragma unroll
    for (int it = 0; it < 8; ++it) {
      const int c = tid + 512 * it, qloc = c >> 3, dc = c & 7;
      const u32x2 a0 = *(LAS u32x2*)(lds + qloc * AT_ROWB + dc * 16), a1 = *(LAS u32x2*)(lds + qloc * AT_ROWB + dc * 16 + 8);
      const size_t tok = (size_t)(tokbase + pbase + qloc);
      const u32x4 g = *(const u32x4*)(p.proj + tok * NW + OFF_GA + hh * 64 + dc * 8);
      u32x4 w;
      w.x = pack2(bflo(a0.x) * silu(bflo(g.x)), bfhi(a0.x) * silu(bfhi(g.x)));
      w.y = pack2(bflo(a0.y) * silu(bflo(g.y)), bfhi(a0.y) * silu(bfhi(g.y)));
      w.z = pack2(bflo(a1.x) * silu(bflo(g.z)), bfhi(a1.x) * silu(bfhi(g.z)));
      w.w = pack2(bflo(a1.y) * silu(bflo(g.w)), bfhi(a1.y) * silu(bfhi(g.w)));
      *(u32x4*)(p.mixed + tok * DM + hh * 64 + dc * 8) = w;
    }
    __syncthreads();
  }
}

constexpr int RV_ROW = 320, RK_ROW = 192, RV_OFF = 0, RK_OFF = 128 * RV_ROW  , RRED_OFF = RK_OFF + 128 * RK_ROW  ;

DI void phase_retkv(LAS unsigned char* lds, const Params& p, int bid, int nb) {
  const int tid = threadIdx.x, wid = __builtin_amdgcn_readfirstlane(tid >> 6), lane = tid & 63;
  const int r = lane & 31, h = lane >> 5, i16 = lane & 15, q4 = i16 >> 2, pp = i16 & 3, blk = (lane >> 4) & 1;
  const int vt = wid >> 1, dt = wid & 1;
  for (int u = bid; u < 1024; u += nb) {
    const int n = u & 31, hh = (u >> 5) & 3, b = u >> 7;
    const float lg = ret_log2g(hh);
    const bf16_t* base = p.proj + (size_t)(b * SEQ + n * 128) * NW;
#pragma unroll
    for (int it = 0; it < 4; ++it) {
      const int c = tid + 512 * it, j = c >> 4, cc = c & 15;
      *(LAS u32x4*)(lds + RV_OFF + j * RV_ROW + cc * 16) = *(const u32x4*)(base + (size_t)j * NW + OFF_VR + hh * 128 + cc * 8);
    }
#pragma unroll
    for (int it = 0; it < 2; ++it) {
      const int c = tid + 512 * it, j = c >> 3, cc = c & 7;
      const u32x4 w = *(const u32x4*)(base + (size_t)j * NW + OFF_KR + hh * 64 + cc * 8);
      const float dk = exp2f((float)(127 - j) * lg);
      u32x4 o;
      o.x = pack2(bflo(w.x) * dk, bfhi(w.x) * dk); o.y = pack2(bflo(w.y) * dk, bfhi(w.y) * dk);
      o.z = pack2(bflo(w.z) * dk, bfhi(w.z) * dk); o.w = pack2(bflo(w.w) * dk, bfhi(w.w) * dk);
      *(LAS u32x4*)(lds + RK_OFF + j * RK_ROW + cc * 16) = o;
    }
    __syncthreads();
    f32x16 acc;
#pragma unroll
    for (int i = 0; i < 16; ++i) acc[i] = 0.f;
    LAS unsigned char* va = lds + RV_OFF + (4 * h + q4) * RV_ROW + (32 * vt + 16 * blk + 4 * pp) * 2;
    LAS unsigned char* ka = lds + RK_OFF + (4 * h + q4) * RK_ROW + (32 * dt + 16 * blk + 4 * pp) * 2;
#pragma unroll
    for (int s = 0; s < 8; ++s) {
      const bf16x8 A = tr_frag(va + 16 * s * RV_ROW, 8 * RV_ROW), B = tr_frag(ka + 16 * s * RK_ROW, 8 * RK_ROW);
      acc = MFMA32(A, B, acc);
    }
    float* o = p.kvT + ((size_t)u << 13) + (32 * vt + 4 * h) * 64 + 32 * dt + r;
#pragma unroll
    for (int i = 0; i < 16; ++i) o[((i & 3) + 8 * (i >> 2)) * 64] = acc[i];
    __syncthreads();
  }
}

DI void phase_retout(LAS unsigned char* lds, const Params& p, int bid, int nb) {
  const int tid = threadIdx.x, wid = __builtin_amdgcn_readfirstlane(tid >> 6), lane = tid & 63;
  const int r = lane & 31, h = lane >> 5, i16 = lane & 15, q4 = i16 >> 2, pp = i16 & 3, blk = (lane >> 4) & 1;
  const int it = wid & 3, vh = wid >> 2;
  LAS float* red = (LAS float*)(lds + RRED_OFF);
  for (int u = bid; u < 1024; u += nb) {
    const int n = u & 31, hh = (u >> 5) & 3, b = u >> 7;
    const float lg = ret_log2g(hh);
    const int tok0 = b * SEQ + n * 128;
    const bf16_t* base = p.proj + (size_t)tok0 * NW;
#pragma unroll
    for (int k = 0; k < 4; ++k) {
      const int c = tid + 512 * k, j = c >> 4, cc = c & 15;
      *(LAS u32x4*)(lds + RV_OFF + j * RV_ROW + cc * 16) = *(const u32x4*)(base + (size_t)j * NW + OFF_VR + hh * 128 + cc * 8);
    }
    const int qi = 32 * it + r;
    const bf16_t* qp = base + (size_t)qi * NW + OFF_QR + hh * 64 + 8 * h;
    bf16x8 Qf[4];
#pragma unroll
    for (int ks = 0; ks < 4; ++ks) Qf[ks] = *(const bf16x8*)(qp + 16 * ks);
    f32x16 O0, O1;
#pragma unroll
    for (int i = 0; i < 16; ++i) { O0[i] = 0.f; O1[i] = 0.f; }
    {
      const bf16_t* st = p.stT + ((size_t)u << 13) + (size_t)(64 * vh + r) * 64 + 8 * h;
#pragma unroll
      for (int ks = 0; ks < 4; ++ks) {
        const bf16x8 A0 = *(const bf16x8*)(st + 16 * ks), A1 = *(const bf16x8*)(st + 32 * 64 + 16 * ks);
        O0 = MFMA32(A0, Qf[ks], O0);
        O1 = MFMA32(A1, Qf[ks], O1);
      }
      const float qd = exp2f((float)(qi + 1) * lg);
#pragma unroll
      for (int i = 0; i < 16; ++i) { O0[i] *= qd; O1[i] *= qd; }
    }
    __syncthreads();
    LAS unsigned char* va = lds + RV_OFF + (4 * h + q4) * RV_ROW + (64 * vh + 16 * blk + 4 * pp) * 2;
    for (int jt = 0; jt <= it; ++jt) {
      const bf16_t* kp = base + (size_t)(32 * jt + r) * NW + OFF_KR + hh * 64 + 8 * h;
      f32x16 S;
#pragma unroll
      for (int i = 0; i < 16; ++i) S[i] = 0.f;
#pragma unroll
      for (int ks = 0; ks < 4; ++ks) { const bf16x8 Kf = *(const bf16x8*)(kp + 16 * ks); S = MFMA32(Kf, Qf[ks], S); }
#pragma unroll
      for (int i = 0; i < 16; ++i) {
        const int dj = qi - (32 * jt + (i & 3) + 8 * (i >> 2) + 4 * h);
        S[i] = dj >= 0 ? S[i] * fexp2((float)dj * lg) : 0.f;
      }
#pragma unroll
      for (int s = 0; s < 2; ++s) {
        const bf16x8 Pb = pack8(S, s);
        const bf16x8 V0 = tr_frag(va + (32 * jt + 16 * s) * RV_ROW, 8 * RV_ROW), V1 = tr_frag(va + (32 * jt + 16 * s) * RV_ROW + 64, 8 * RV_ROW);
        O0 = MFMA32(V0, Pb, O0);
        O1 = MFMA32(V1, Pb, O1);
      }
    }
    float s1 = 0.f, s2 = 0.f;
#pragma unroll
    for (int i = 0; i < 16; ++i) { s1 += O0[i] + O1[i]; s2 += O0[i] * O0[i] + O1[i] * O1[i]; }
    s1 += __shfl_xor(s1, 32); s2 += __shfl_xor(s2, 32);
    if (h == 0) { red[(vh * 128 + qi) * 2] = s1; red[(vh * 128 + qi) * 2 + 1] = s2; }
    __syncthreads();
    s1 += red[((vh ^ 1) * 128 + qi) * 2]; s2 += red[((vh ^ 1) * 128 + qi) * 2 + 1];
    const float mu = s1 * (1.0f / 128.0f), var = fmaxf(s2 * (1.0f / 128.0f) - mu * mu, 0.f), rs = rsqrtf(var + 1e-5f);
    const size_t tok = (size_t)(tok0 + qi);
    const bf16_t* gr = p.proj + tok * NW + OFF_GR + hh * 128 + 64 * vh + 4 * h;
    bf16_t* mo = p.mixed + tok * DM + 512 + hh * 128 + 64 * vh + 4 * h;
    const float* gnp = p.gn + hh * 128 + 64 * vh + 4 * h;
#pragma unroll
    for (int dt = 0; dt < 2; ++dt)
#pragma unroll
      for (int g = 0; g < 4; ++g) {
        const int vo = 32 * dt + 8 * g;
        const u32x2 gw = *(const u32x2*)(gr + vo);
        const f32x4 gnv = *(const f32x4*)(gnp + vo);
        float f0, f1, f2, f3;
        if (dt == 0) { f0 = O0[4 * g]; f1 = O0[4 * g + 1]; f2 = O0[4 * g + 2]; f3 = O0[4 * g + 3]; }
        else { f0 = O1[4 * g]; f1 = O1[4 * g + 1]; f2 = O1[4 * g + 2]; f3 = O1[4 * g + 3]; }
        f0 = (f0 - mu) * rs * gnv[0] * silu(bflo(gw.x)); f1 = (f1 - mu) * rs * gnv[1] * silu(bfhi(gw.x));
        f2 = (f2 - mu) * rs * gnv[2] * silu(bflo(gw.y)); f3 = (f3 - mu) * rs * gnv[3] * silu(bfhi(gw.y));
        u32x2 wv; wv.x = pack2(f0, f1); wv.y = pack2(f2, f3);
        *(u32x2*)(mo + vo) = wv;
      }
    __syncthreads();
  }
}

DI void phase_final(const Params& p, int bid, int nb) {
  const int tid = threadIdx.x, lane = tid & 63, wid = tid >> 6, nw = blockDim.x >> 6;
  for (int row = bid * nw + wid; row < T_TOK; row += nb * nw) {
    const float rs = rsqrtf(p.rowss[row] * (1.0f / DM) + 1e-6f);
    float* yr = p.out + (size_t)row * DM;
#pragma unroll
    for (int it = 0; it < 4; ++it) {
      const f32x4 v = *(const f32x4*)(yr + it * 256 + lane * 4), g = *(const f32x4*)(p.fg + it * 256 + lane * 4);
      *(f32x4*)(yr + it * 256 + lane * 4) = v * rs * g;
    }
  }
}

__global__ void __launch_bounds__(512) k_mega(Params p) {
  extern __shared__ __attribute__((aligned(16))) unsigned char shm_[];
  LAS unsigned char* shm = (LAS unsigned char*)shm_;
  cg::grid_group grid = cg::this_grid();
  const int bid = blockIdx.x, nb = gridDim.x;
  phase_prep(p, bid, nb);
  grid.sync();
  phase_gemm<1>(shm, p, bid, nb);
  grid.sync();
  phase_rotary(p, bid, nb);
  grid.sync();
  phase_attn(shm, p, bid, nb);
  phase_retkv(shm, p, bid, nb);
  grid.sync();
  phase_retscan(p, bid, nb);
  grid.sync();
  phase_retout(shm, p, bid, nb);
  grid.sync();
  phase_gemm<2>(shm, p, bid, nb);
  grid.sync();
  phase_final(p, bid, nb);
}

extern "C" void kernel_launch(void* const* d_in, const int* in_sizes, int n_in, void* d_out, int out_size, void* d_ws, size_t ws_size, hipStream_t stream) {
  Params p{};
  p.x = (const float*)d_in[0]; p.ng = (const float*)d_in[1]; p.w_in = (const float*)d_in[2]; p.gn = (const float*)d_in[3];
  p.w_out = (const float*)d_in[4]; p.fg = (const float*)d_in[5];
  p.out = (float*)d_out;
  char* w = (char*)d_ws; size_t o = 0;
  auto take = [&](size_t bytes) { char* r = w + o; o += (bytes + 255) & ~(size_t)255; return r; };
  p.xb = (bf16_t*)take((size_t)T_TOK * DM * 2);
  p.proj = (bf16_t*)take((size_t)T_TOK * NW * 2);
  p.mixed = (bf16_t*)take((size_t)T_TOK * DM * 2);
  p.winT = (bf16_t*)take((size_t)NW * DM * 2);
  p.woutT = (bf16_t*)take((size_t)DM * DM * 2);
  p.rstd = (float*)take((size_t)T_TOK * 4);
  p.rowss = (float*)take((size_t)T_TOK * 4);
  p.ropeT = (float2*)take((size_t)SEQ * 32 * 8);
  p.retT = (float2*)take((size_t)SEQ * 32 * 8);
  p.kvT = (float*)take((size_t)1024 * 8192 * 4);
  p.stT = (bf16_t*)take((size_t)1024 * 8192 * 2);
  static int grid_blocks = 0;
  if (!grid_blocks) {
    (void)hipFuncSetAttribute((const void*)k_mega, hipFuncAttributeMaxDynamicSharedMemorySize, GEMM_LDS);
    int dev = 0, cus = 0, per_cu = 0;
    (void)hipGetDevice(&dev);
    (void)hipDeviceGetAttribute(&cus, hipDeviceAttributeMultiprocessorCount, dev);
    (void)hipOccupancyMaxActiveBlocksPerMultiprocessor(&per_cu, k_mega, 512, GEMM_LDS);
    if (per_cu < 1) per_cu = 1;
    grid_blocks = cus;
  }
  void* args[] = {&p};
  hipError_t e = hipLaunchCooperativeKernel((void*)k_mega, dim3(grid_blocks), dim3(512), args, GEMM_LDS, stream);
  if (e != hipSuccess) fprintf(stderr, "cooperative launch failed: %s (grid %d)\n", hipGetErrorString(e), grid_blocks);
}
```

```cpp
#include <hip/hip_runtime.h>
#include <hip/hip_cooperative_groups.h>
#include <cstdint>
#include <cstdio>
namespace cg = cooperative_groups;

typedef unsigned short bf16_t;
typedef short bf16x8 __attribute__((ext_vector_type(8)));
typedef float f32x4 __attribute__((ext_vector_type(4)));
typedef unsigned u32x4 __attribute__((ext_vector_type(4)));
typedef unsigned u32x2 __attribute__((ext_vector_type(2)));

constexpr int T_TOK = 32768, DM = 1024, NW = 3584, SEQ = 4096;
constexpr int OFF_QA = 0, OFF_KA = 512, OFF_VA = 1024, OFF_GA = 1536, OFF_QR = 2048, OFF_KR = 2304, OFF_VR = 2560, OFF_GR = 3072;

struct Params {
  const float* x; const float* ng; const float* w_in; const float* gn; const float* w_out; const float* fg;
  float* out;
  bf16_t* xb; bf16_t* proj; bf16_t* mixed; bf16_t* winT; bf16_t* woutT;
  float* rstd; float* rowss; float2* ropeT; float2* retT; float* kvT; bf16_t* stT;
};

#define DI __device__ __forceinline__
DI unsigned short f2bf(float x) { unsigned u = __float_as_uint(x); u += 0x7fffu + ((u >> 16) & 1u); return (unsigned short)(u >> 16); }
DI float bf2f(unsigned short b) { return __uint_as_float(((unsigned)b) << 16); }
DI unsigned pack2(float lo, float hi) { return (unsigned)f2bf(lo) | ((unsigned)f2bf(hi) << 16); }
DI float bflo(unsigned w) { return __uint_as_float(w << 16); }
DI float bfhi(unsigned w) { return __uint_as_float(w & 0xffff0000u); }
DI int perm32(int rho) { const int n = rho >> 4, i = rho & 15; return 8 * (i >> 2) + 4 * n + (i & 3); }
DI int cmap(int p) { return (p & ~31) + perm32(p & 31); }
DI int cmapA(int p) { return (p & ~127) + ((p >> 6) & 1) * 64 + ((p >> 4) & 1) * 32 + ((p >> 5) & 1) * 16 + (p & 15); }

DI void phase_prep(const Params& p, int bid, int nb) {
  const int tid = threadIdx.x, lane = tid & 63, wid = tid >> 6, nw = blockDim.x >> 6;
  for (int row = bid * nw + wid; row < T_TOK; row += nb * nw) {
    const float* xr = p.x + (size_t)row * DM;
    float ss = 0.f;
    f32x4 v[4];
#pragma unroll
    for (int it = 0; it < 4; ++it) { v[it] = *(const f32x4*)(xr + it * 256 + lane * 4); ss += v[it][0] * v[it][0] + v[it][1] * v[it][1] + v[it][2] * v[it][2] + v[it][3] * v[it][3]; }
#pragma unroll
    for (int o = 32; o >= 1; o >>= 1) ss += __shfl_xor(ss, o);
#pragma unroll
    for (int it = 0; it < 4; ++it) { u32x2 w; w.x = pack2(v[it][0], v[it][1]); w.y = pack2(v[it][2], v[it][3]); *(u32x2*)(p.xb + (size_t)row * DM + it * 256 + lane * 4) = w; }
    if (lane == 0) { p.rstd[row] = rsqrtf(ss * (1.0f / DM) + 1e-6f); p.rowss[row] = 0.f; }
  }
  const int gt = bid * blockDim.x + tid, gn = nb * blockDim.x;
  for (int idx = gt; idx < NW * 128; idx += gn) {
    const int pp = idx % NW, kc = idx / NW, c = pp < 1024 ? cmapA(pp) : cmap(pp);
    float f[8];
#pragma unroll
    for (int j = 0; j < 8; ++j) { const int k = kc * 8 + j; f[j] = p.ng[k] * p.w_in[(size_t)k * NW + c]; }
    u32x4 w; w.x = pack2(f[0], f[1]); w.y = pack2(f[2], f[3]); w.z = pack2(f[4], f[5]); w.w = pack2(f[6], f[7]);
    *(u32x4*)(p.winT + (size_t)pp * DM + kc * 8) = w;
  }
  for (int idx = gt; idx < DM * 128; idx += gn) {
    const int pp = idx % DM, kc = idx / DM, c = cmap(pp);
    float f[8];
#pragma unroll
    for (int j = 0; j < 8; ++j) { const int k = kc * 8 + j; f[j] = p.w_out[(size_t)k * DM + c]; }
    u32x4 w; w.x = pack2(f[0], f[1]); w.y = pack2(f[2], f[3]); w.z = pack2(f[4], f[5]); w.w = pack2(f[6], f[7]);
    *(u32x4*)(p.woutT + (size_t)pp * DM + kc * 8) = w;
  }
  for (int idx = gt; idx < SEQ * 32; idx += gn) {
    const int pos = idx >> 5, i = idx & 31;
    const float inv1 = powf(10000.0f, -(float)i / 32.0f);
    const float inv2 = 1.0f / powf(10000.0f, (float)i / 31.0f);
    const float a1 = (float)pos * inv1, a2 = (float)pos * inv2;
    p.ropeT[idx] = make_float2(cosf(a1), sinf(a1));
    p.retT[idx] = make_float2(cosf(a2), sinf(a2));
  }
}

constexpr int BM = 256, BK = 64, HALF = 128, HT = HALF * BK;
constexpr int GEMM_LDS = 8 * HT * 2;
DI int lds_byte(int r, int c) { int st = (r >> 4) * 2 + (c >> 5), rr = r & 15, cc = c & 31, ob = rr * 64 + cc * 2; return st * 1024 + (ob ^ (((ob >> 9) & 1) << 5)); }
DI void stage_rc(int b, int& R, int& C) { int st = b / 1024, sb = b % 1024, swz = sb ^ (((sb >> 9) & 1) << 5); R = (st >> 1) * 16 + swz / 64; C = (st & 1) * 32 + (swz % 64) / 2; }

#define LAS __attribute__((address_space(3)))
template <int EPI>
DI void gemm_tile(LAS unsigned char* lds, const bf16_t* __restrict__ A, const bf16_t* __restrict__ Bt, const int brow, const int bcol, const Params& p) {
  constexpr int K = 1024, nt = K / BK, HTB = HALF * BK * 2;
  const int tid = threadIdx.x, wid = __builtin_amdgcn_readfirstlane(tid >> 6), lane = tid & 63, wr = wid >> 2, wc = wid & 3, fr = lane & 15, fq = lane >> 4;
  unsigned voff[2];
#pragma unroll
  for (int i = 0; i < 2; ++i) { int R, C; stage_rc(tid * 16 + i * 8192, R, C); voff[i] = (unsigned)(R * K + C) * 2u; }
  const unsigned ldsw = (unsigned)wid * 1024u;
  const int aoff = lds_byte(wr * 64 + fr, fq * 8), boff = lds_byte(wc * 32 + fr, fq * 8);
  const char* cA0 = (const char*)A + (size_t)brow * K * 2; const char* cA1 = cA0 + (size_t)HALF * K * 2;
  const char* cB0 = (const char*)Bt + (size_t)bcol * K * 2; const char* cB1 = cB0 + (size_t)HALF * K * 2;
#define SAo(b, h) (((b) * 2 + (h)) * HTB)
#define SBo(b, h) ((4 + (b) * 2 + (h)) * HTB)
#define STAGE(bufoff, gb, kt) do { _Pragma("unroll") for (int _i = 0; _i < 2; ++_i) \
    __builtin_amdgcn_global_load_lds((const unsigned*)((gb) + (size_t)(kt) * (BK * 2) + voff[_i]), (LAS unsigned*)(lds + (bufoff) + ldsw + _i * 8192), 16, 0, 0); } while (0)
#define LDA(dst, b, h) do { _Pragma("unroll") for (int m = 0; m < 4; ++m) _Pragma("unroll") for (int k = 0; k < 2; ++k) \
    dst[m][k] = *(const LAS bf16x8*)(lds + SAo(b, h) + aoff + m * 2048 + k * 1024); } while (0)
#define LDB(dst, b, h) do { _Pragma("unroll") for (int n = 0; n < 2; ++n) _Pragma("unroll") for (int k = 0; k < 2; ++k) \
    dst[n][k] = *(const LAS bf16x8*)(lds + SBo(b, h) + boff + n * 2048 + k * 1024); } while (0)
#define MMA(ai, bj, At, Bt_) do { __builtin_amdgcn_s_setprio(1); \
    _Pragma("unroll") for (int m = 0; m < 4; ++m) _Pragma("unroll") for (int n = 0; n < 2; ++n) _Pragma("unroll") for (int k = 0; k < 2; ++k) \
      acc[ai][bj][m][n] = __builtin_amdgcn_mfma_f32_16x16x32_bf16(Bt_[n][k], At[m][k], acc[ai][bj][m][n], 0, 0, 0); \
    __builtin_amdgcn_s_setprio(0); } while (0)
#define WAIT_V(n) asm volatile("s_waitcnt vmcnt(" #n ")" ::: "memory")
#define WAIT_L(n) asm volatile("s_waitcnt lgkmcnt(" #n ")" ::: "memory")
#define BAR __builtin_amdgcn_s_barrier()
#define SCHED __builtin_amdgcn_sched_barrier(0)
  f32x4 acc[2][2][4][2];
#pragma unroll
  for (int a = 0; a < 2; ++a)
#pragma unroll
    for (int b = 0; b < 2; ++b)
#pragma unroll
      for (int m = 0; m < 4; ++m)
#pragma unroll
        for (int n = 0; n < 2; ++n) acc[a][b][m][n] = (f32x4){0.f, 0.f, 0.f, 0.f};
  bf16x8 At[4][2], B0[2][2], B1[2][2];
  WAIT_V(0);
  STAGE(SBo(0, 0), cB0, 0); STAGE(SAo(0, 0), cA0, 0);
  STAGE(SBo(0, 1), cB1, 0); STAGE(SAo(0, 1), cA1, 0);
  if (wr == 1) BAR;
  WAIT_V(4); BAR;
  STAGE(SBo(1, 0), cB0, 1); STAGE(SAo(1, 0), cA0, 1); STAGE(SBo(1, 1), cB1, 1);
  WAIT_V(6); BAR;
  for (int t = 0; t < nt - 2; t += 2) {
    LDB(B0, 0, 0); SCHED; LDA(At, 0, 0); STAGE(SAo(1, 1), cA1, t + 1);
    WAIT_L(8); BAR; WAIT_L(0); MMA(0, 0, At, B0); BAR; SCHED;
    LDB(B1, 0, 1); STAGE(SBo(0, 0), cB0, t + 2);
    BAR; WAIT_L(0); MMA(0, 1, At, B1); BAR;
    LDA(At, 0, 1); STAGE(SAo(0, 0), cA0, t + 2);
    BAR; WAIT_L(0); MMA(1, 0, At, B0); BAR; SCHED;
    STAGE(SBo(0, 1), cB1, t + 2);
    WAIT_V(6); BAR; MMA(1, 1, At, B1); BAR;
    LDB(B0, 1, 0); SCHED; LDA(At, 1, 0); STAGE(SAo(0, 1), cA1, t + 2);
    WAIT_L(8); BAR; WAIT_L(0); MMA(0, 0, At, B0); BAR; SCHED;
    LDB(B1, 1, 1); STAGE(SBo(1, 0), cB0, t + 3);
    BAR; WAIT_L(0); MMA(0, 1, At, B1); BAR;
    LDA(At, 1, 1); STAGE(SAo(1, 0), cA0, t + 3);
    BAR; WAIT_L(0); MMA(1, 0, At, B0); BAR; SCHED;
    STAGE(SBo(1, 1), cB1, t + 3);
    WAIT_V(6); BAR; MMA(1, 1, At, B1); BAR;
  }
  { LDB(B0, 0, 0); LDA(At, 0, 0); STAGE(SAo(1, 1), cA1, nt - 1);
    BAR; WAIT_L(0); MMA(0, 0, At, B0); BAR;
    LDB(B1, 0, 1); BAR; WAIT_L(0); MMA(0, 1, At, B1); BAR;
    LDA(At, 0, 1); WAIT_V(4); BAR; WAIT_L(0); MMA(1, 0, At, B0); MMA(1, 1, At, B1); BAR; }
  { LDB(B0, 1, 0); LDA(At, 1, 0); WAIT_V(2); BAR; WAIT_L(0); MMA(0, 0, At, B0); BAR;
    LDB(B1, 1, 1); WAIT_V(0); BAR; WAIT_L(0); MMA(0, 1, At, B1); BAR;
    LDA(At, 1, 1); BAR; WAIT_L(0); MMA(1, 0, At, B0); MMA(1, 1, At, B1); BAR; }
  if (wr == 0) BAR;
  if (EPI == 1) {
    const int pn = bcol >> 8;
    if (pn < 4) {
      const float sc = pn < 2 ? 0.125f : 1.0f;
      const int i0 = 16 * (wc & 1) + 4 * fq;
#pragma unroll
      for (int ai = 0; ai < 2; ++ai)
#pragma unroll
        for (int m = 0; m < 4; ++m) {
          const int row = brow + ai * HALF + wr * 64 + m * 16 + fr;
          const float rs = p.rstd[row] * sc;
          const float* tb = (const float*)(p.ropeT + (row & (SEQ - 1)) * 32 + i0);
          const f32x4 t0 = *(const f32x4*)tb, t1 = *(const f32x4*)(tb + 4);
#pragma unroll
          for (int bj = 0; bj < 2; ++bj) {
            const f32x4 x1 = acc[ai][bj][m][0] * rs, x2 = acc[ai][bj][m][1] * rs;
            u32x2 wa, wb;
            wa.x = pack2(x1[0] * t0[0] - x2[0] * t0[1], x1[1] * t0[2] - x2[1] * t0[3]);
            wa.y = pack2(x1[2] * t1[0] - x2[2] * t1[1], x1[3] * t1[2] - x2[3] * t1[3]);
            wb.x = pack2(x2[0] * t0[0] + x1[0] * t0[1], x2[1] * t0[2] + x1[1] * t0[3]);
            wb.y = pack2(x2[2] * t1[0] + x1[2] * t1[1], x2[3] * t1[2] + x1[3] * t1[3]);
            bf16_t* o = p.proj + (size_t)row * NW + bcol + bj * HALF + (wc >> 1) * 64 + i0;
            *(u32x2*)o = wa; *(u32x2*)(o + 32) = wb;
          }
        }
    } else if (pn == 8 || pn == 9) {
      const float sc = pn == 9 ? 0.125f : 1.0f;
      const int i0 = 16 * (wc & 1) + 4 * fq;
#pragma unroll
      for (int ai = 0; ai < 2; ++ai)
#pragma unroll
        for (int m = 0; m < 4; ++m) {
          const int row = brow + ai * HALF + wr * 64 + m * 16 + fr;
          const float rs = p.rstd[row] * sc;
          const float* tb = (const float*)(p.retT + (row & (SEQ - 1)) * 32 + i0);
          const f32x4 t0 = *(const f32x4*)tb, t1 = *(const f32x4*)(tb + 4);
#pragma unroll
          for (int bj = 0; bj < 2; ++bj) {
            const f32x4 v0 = acc[ai][bj][m][0] * rs, v1 = acc[ai][bj][m][1] * rs;
            u32x4 w;
            w.x = pack2(v0[0] * t0[0] - v0[1] * t0[1], v0[1] * t0[0] + v0[0] * t0[1]);
            w.y = pack2(v0[2] * t0[2] - v0[3] * t0[3], v0[3] * t0[2] + v0[2] * t0[3]);
            w.z = pack2(v1[0] * t1[0] - v1[1] * t1[1], v1[1] * t1[0] + v1[0] * t1[1]);
            w.w = pack2(v1[2] * t1[2] - v1[3] * t1[3], v1[3] * t1[2] + v1[2] * t1[3]);
            *(u32x4*)(p.proj + (size_t)row * NW + bcol + bj * HALF + wc * 32 + 8 * fq) = w;
          }
        }
    } else {
#pragma unroll
    for (int ai = 0; ai < 2; ++ai)
#pragma unroll
      for (int m = 0; m < 4; ++m) {
        const int row = brow + ai * HALF + wr * 64 + m * 16 + fr;
        const float rs = p.rstd[row];
#pragma unroll
        for (int bj = 0; bj < 2; ++bj) {
          const f32x4 v0 = acc[ai][bj][m][0] * rs, v1 = acc[ai][bj][m][1] * rs;
          u32x4 w; w.x = pack2(v0[0], v0[1]); w.y = pack2(v0[2], v0[3]); w.z = pack2(v1[0], v1[1]); w.w = pack2(v1[2], v1[3]);
          *(u32x4*)(p.proj + (size_t)row * NW + bcol + bj * HALF + wc * 32 + 8 * fq) = w;
        }
      }
    }
  } else {
#pragma unroll
    for (int ai = 0; ai < 2; ++ai)
#pragma unroll
      for (int m = 0; m < 4; ++m) {
        const int row = brow + ai * HALF + wr * 64 + m * 16 + fr;
        float ss = 0.f;
#pragma unroll
        for (int bj = 0; bj < 2; ++bj) {
          const size_t off = (size_t)row * DM + bcol + bj * HALF + wc * 32 + 8 * fq;
          const f32x4 x0 = *(const f32x4*)(p.x + off), x1 = *(const f32x4*)(p.x + off + 4);
          const f32x4 y0 = acc[ai][bj][m][0] + x0, y1 = acc[ai][bj][m][1] + x1;
          *(f32x4*)(p.out + off) = y0; *(f32x4*)(p.out + off + 4) = y1;
          ss += y0[0] * y0[0] + y0[1] * y0[1] + y0[2] * y0[2] + y0[3] * y0[3] + y1[0] * y1[0] + y1[1] * y1[1] + y1[2] * y1[2] + y1[3] * y1[3];
        }
        ss += __shfl_xor(ss, 16); ss += __shfl_xor(ss, 32);
        if (fq == 0) atomicAdd(p.rowss + row, ss);
      }
  }
}

DI void tile_of(int L, int nM, int nN, int& pm, int& pn) {
  const int nwg = nM * nN, NX = 8, WGM = 8;
  int wgid = L; { const int q = nwg / NX, r = nwg % NX, xcd = wgid % NX, off = wgid / NX; wgid = (xcd < r ? xcd * (q + 1) : r * (q + 1) + (xcd - r) * q) + off; }
  const int nig = WGM * nN, gid = wgid / nig, fm = gid * WGM, gsz = (nM - fm) < WGM ? (nM - fm) : WGM;
  pm = fm + ((wgid % nig) % gsz); pn = (wgid % nig) / gsz;
}

template <int EPI>
DI void phase_gemm(LAS unsigned char* shm, const Params& p, int bid, int nb) {
  const int nM = T_TOK / BM, nN = (EPI == 1 ? NW : DM) / BM;
  for (int L = bid; L < nM * nN; L += nb) {
    int pm, pn; tile_of(L, nM, nN, pm, pn);
    if (EPI == 1) gemm_tile<1>(shm, p.xb, p.winT, pm * BM, pn * BM, p);
    else gemm_tile<2>(shm, p.mixed, p.woutT, pm * BM, pn * BM, p);
  }
}

DI void phase_rotary(const Params& p, int bid, int nb) {
  const long total = (long)T_TOK * 768;
  for (long idx = (long)bid * blockDim.x + threadIdx.x; idx < total; idx += (long)nb * blockDim.x) {
    const int tok = (int)(idx / 768); int j = (int)(idx % 768);
    const int pos = tok & (SEQ - 1);
    int a, b; float sc; const float2* tab;
    if (j < 256) { const int h = j >> 5, i = j & 31; a = OFF_QA + h * 64 + i; b = a + 32; sc = 0.125f; tab = p.ropeT + pos * 32 + i; }
    else if (j < 512) { j -= 256; const int h = j >> 5, i = j & 31; a = OFF_KA + h * 64 + i; b = a + 32; sc = 1.f; tab = p.ropeT + pos * 32 + i; }
    else if (j < 640) { j -= 512; const int h = j >> 5, i = j & 31; a = OFF_QR + h * 64 + 2 * i; b = a + 1; sc = 1.f; tab = p.retT + pos * 32 + i; }
    else { j -= 640; const int h = j >> 5, i = j & 31; a = OFF_KR + h * 64 + 2 * i; b = a + 1; sc = 0.125f; tab = p.retT + pos * 32 + i; }
    const float2 cs = *tab;
    bf16_t* row = p.proj + (size_t)tok * NW;
    const float x1 = bf2f(row[a]), x2 = bf2f(row[b]);
    row[a] = f2bf((x1 * cs.x - x2 * cs.y) * sc);
    row[b] = f2bf((x2 * cs.x + x1 * cs.y) * sc);
  }
}

DI void load_row64(const bf16_t* src, float* dst) {
#pragma unroll
  for (int c = 0; c < 8; ++c) {
    const u32x4 w = *(const u32x4*)(src + c * 8);
    dst[c * 8 + 0] = bflo(w.x); dst[c * 8 + 1] = bfhi(w.x); dst[c * 8 + 2] = bflo(w.y); dst[c * 8 + 3] = bfhi(w.y);
    dst[c * 8 + 4] = bflo(w.z); dst[c * 8 + 5] = bfhi(w.z); dst[c * 8 + 6] = bflo(w.w); dst[c * 8 + 7] = bfhi(w.w);
  }
}

DI void phase_attn_naive(const Params& p, int bid, int nb) {
  const long total = (long)T_TOK * 8;
  for (long idx = (long)bid * blockDim.x + threadIdx.x; idx < total; idx += (long)nb * blockDim.x) {
    const int h = (int)(idx & 7), tok = (int)(idx >> 3);
    const int pos = tok & (SEQ - 1), tb = tok - pos;
    float q[64], o[64];
    load_row64(p.proj + (size_t)tok * NW + OFF_QA + h * 64, q);
#pragma unroll
    for (int d = 0; d < 64; ++d) o[d] = 0.f;
    float m = -1e30f, l = 0.f;
    for (int br = 0; br < 3; ++br) {
      const int dl = br == 0 ? 1 : (br == 1 ? 4 : 16);
      for (int j = 0; j <= 128; ++j) {
        const int pk = pos - j * dl; if (pk < 0) break;
        const bf16_t* kr = p.proj + (size_t)(tb + pk) * NW + OFF_KA + h * 64;
        float s = 0.f;
#pragma unroll
        for (int c = 0; c < 8; ++c) {
          const u32x4 w = *(const u32x4*)(kr + c * 8);
          s += q[c * 8 + 0] * bflo(w.x) + q[c * 8 + 1] * bfhi(w.x) + q[c * 8 + 2] * bflo(w.y) + q[c * 8 + 3] * bfhi(w.y)
             + q[c * 8 + 4] * bflo(w.z) + q[c * 8 + 5] * bfhi(w.z) + q[c * 8 + 6] * bflo(w.w) + q[c * 8 + 7] * bfhi(w.w);
        }
        const float mn = fmaxf(m, s), al = __expf(m - mn), pe = __expf(s - mn);
        m = mn; l = l * al + pe;
        const bf16_t* vr = kr + (OFF_VA - OFF_KA);
#pragma unroll
        for (int c = 0; c < 8; ++c) {
          const u32x4 w = *(const u32x4*)(vr + c * 8);
          o[c * 8 + 0] = o[c * 8 + 0] * al + pe * bflo(w.x); o[c * 8 + 1] = o[c * 8 + 1] * al + pe * bfhi(w.x);
          o[c * 8 + 2] = o[c * 8 + 2] * al + pe * bflo(w.y); o[c * 8 + 3] = o[c * 8 + 3] * al + pe * bfhi(w.y);
          o[c * 8 + 4] = o[c * 8 + 4] * al + pe * bflo(w.z); o[c * 8 + 5] = o[c * 8 + 5] * al + pe * bfhi(w.z);
          o[c * 8 + 6] = o[c * 8 + 6] * al + pe * bflo(w.w); o[c * 8 + 7] = o[c * 8 + 7] * al + pe * bfhi(w.w);
        }
      }
    }
    const float il = 1.0f / l;
    const bf16_t* gr = p.proj + (size_t)tok * NW + OFF_GA + h * 64;
    bf16_t* mo = p.mixed + (size_t)tok * DM + h * 64;
#pragma unroll
    for (int c = 0; c < 8; ++c) {
      const u32x4 w = *(const u32x4*)(gr + c * 8);
      float g[8] = {bflo(w.x), bfhi(w.x), bflo(w.y), bfhi(w.y), bflo(w.z), bfhi(w.z), bflo(w.w), bfhi(w.w)};
      float r[8];
#pragma unroll
      for (int e = 0; e < 8; ++e) r[e] = o[c * 8 + e] * il * (g[e] / (1.0f + __expf(-g[e])));
      u32x4 ww; ww.x = pack2(r[0], r[1]); ww.y = pack2(r[2], r[3]); ww.z = pack2(r[4], r[5]); ww.w = pack2(r[6], r[7]);
      *(u32x4*)(mo + c * 8) = ww;
    }
  }
}

DI float ret_log2g(int h) { return log2f(1.0f - exp2f(-5.0f - (float)h)); }

DI void phase_retkv_naive(const Params& p, int bid, int nb) {
  const long total = 1024L * 8192;
  for (long idx = (long)bid * blockDim.x + threadIdx.x; idx < total; idx += (long)nb * blockDim.x) {
    const int d = (int)(idx & 63), v = (int)((idx >> 6) & 127), u = (int)(idx >> 13);
    const int n = u & 31, h = (u >> 5) & 3, b = u >> 7;
    const float lg = ret_log2g(h);
    const bf16_t* base = p.proj + (size_t)(b * SEQ + n * 128) * NW;
    float s = 0.f;
    for (int j = 0; j < 128; ++j) {
      const float kk = bf2f(base[(size_t)j * NW + OFF_KR + h * 64 + d]), vv = bf2f(base[(size_t)j * NW + OFF_VR + h * 128 + v]);
      s += kk * exp2f((float)(127 - j) * lg) * vv;
    }
    p.kvT[idx] = s;
  }
}
DI void phase_retscan(const Params& p, int bid, int nb) {
  const long total = 32L * 8192;
  for (long idx = (long)bid * blockDim.x + threadIdx.x; idx < total; idx += (long)nb * blockDim.x) {
    const int e = (int)(idx & 8191), bh = (int)(idx >> 13), h = bh & 3;
    const float cd = exp2f(128.0f * ret_log2g(h));
    float s = 0.f;
    for (int n = 0; n < 32; ++n) {
      const size_t o = ((size_t)(bh * 32 + n) << 13) + e;
      p.stT[o] = f2bf(s);
      s = s * cd + p.kvT[o];
    }
  }
}
DI void phase_retout_naive(const Params& p, int bid, int nb) {
  const long total = 1024L * 256;
  for (long idx = (long)bid * blockDim.x + threadIdx.x; idx < total; idx += (long)nb * blockDim.x) {
    const int vh = (int)(idx & 1), i = (int)((idx >> 1) & 127), u = (int)(idx >> 8);
    const int n = u & 31, h = (u >> 5) & 3, b = u >> 7;
    const float lg = ret_log2g(h);
    const int tok0 = b * SEQ + n * 128, tok = tok0 + i;
    float o[64];
#pragma unroll
    for (int v = 0; v < 64; ++v) o[v] = 0.f;
    const bf16_t* qrow = p.proj + (size_t)tok * NW + OFF_QR + h * 64;
    for (int j = 0; j <= i; ++j) {
      const bf16_t* krow = p.proj + (size_t)(tok0 + j) * NW + OFF_KR + h * 64;
      float s = 0.f;
#pragma unroll
      for (int c = 0; c < 8; ++c) {
        const u32x4 a = *(const u32x4*)(qrow + c * 8), w = *(const u32x4*)(krow + c * 8);
        s += bflo(a.x) * bflo(w.x) + bfhi(a.x) * bfhi(w.x) + bflo(a.y) * bflo(w.y) + bfhi(a.y) * bfhi(w.y)
           + bflo(a.z) * bflo(w.z) + bfhi(a.z) * bfhi(w.z) + bflo(a.w) * bflo(w.w) + bfhi(a.w) * bfhi(w.w);
      }
      s *= exp2f((float)(i - j) * lg);
      const bf16_t* vrow = p.proj + (size_t)(tok0 + j) * NW + OFF_VR + h * 128 + vh * 64;
#pragma unroll
      for (int c = 0; c < 8; ++c) {
        const u32x4 w = *(const u32x4*)(vrow + c * 8);
        o[c * 8 + 0] += s * bflo(w.x); o[c * 8 + 1] += s * bfhi(w.x); o[c * 8 + 2] += s * bflo(w.y); o[c * 8 + 3] += s * bfhi(w.y);
        o[c * 8 + 4] += s * bflo(w.z); o[c * 8 + 5] += s * bfhi(w.z); o[c * 8 + 6] += s * bflo(w.w); o[c * 8 + 7] += s * bfhi(w.w);
      }
    }
    const float qd = exp2f((float)(i + 1) * lg);
    const bf16_t* st = p.stT + ((size_t)u << 13) + vh * 64 * 64;
    for (int d = 0; d < 64; ++d) {
      const float qq = bf2f(qrow[d]) * qd;
#pragma unroll
      for (int v = 0; v < 64; ++v) o[v] += qq * bf2f(st[v * 64 + d]);
    }
    float mu = 0.f;
#pragma unroll
    for (int v = 0; v < 64; ++v) mu += o[v];
    mu += __shfl_xor(mu, 1);
    mu *= (1.0f / 128.0f);
    float var = 0.f;
#pragma unroll
    for (int v = 0; v < 64; ++v) { const float dd = o[v] - mu; var += dd * dd; }
    var += __shfl_xor(var, 1);
    const float rs = rsqrtf(var * (1.0f / 128.0f) + 1e-5f);
    const bf16_t* gr = p.proj + (size_t)tok * NW + OFF_GR + h * 128 + vh * 64;
    bf16_t* mo = p.mixed + (size_t)tok * DM + 512 + h * 128 + vh * 64;
#pragma unroll
    for (int c = 0; c < 8; ++c) {
      const u32x4 w = *(const u32x4*)(gr + c * 8);
      float g[8] = {bflo(w.x), bfhi(w.x), bflo(w.y), bfhi(w.y), bflo(w.z), bfhi(w.z), bflo(w.w), bfhi(w.w)};
      float r[8];
#pragma unroll
      for (int e = 0; e < 8; ++e) r[e] = (o[c * 8 + e] - mu) * rs * p.gn[h * 128 + vh * 64 + c * 8 + e] * (g[e] / (1.0f + __expf(-g[e])));
      u32x4 ww; ww.x = pack2(r[0], r[1]); ww.y = pack2(r[2], r[3]); ww.z = pack2(r[4], r[5]); ww.w = pack2(r[6], r[7]);
      *(u32x4*)(mo + c * 8) = ww;
    }
  }
}

typedef float f32x16 __attribute__((ext_vector_type(16)));
typedef short s16x4 __attribute__((ext_vector_type(4)));
#define MFMA32(a, b, c) __builtin_amdgcn_mfma_f32_32x32x16_bf16((a), (b), (c), 0, 0, 0)
DI s16x4 tr_read(LAS unsigned char* a) { return __builtin_amdgcn_ds_read_tr16_b64_v4i16((LAS s16x4*)a); }
DI bf16x8 tr_frag(LAS unsigned char* a, int rowstride8) {
  const s16x4 lo = tr_read(a), hi = tr_read(a + rowstride8);
  return __builtin_shufflevector(lo, hi, 0, 1, 2, 3, 4, 5, 6, 7);
}
DI bf16x8 pack8(const f32x16& x, int s) {
  u32x4 w;
  w.x = pack2(x[8 * s + 0], x[8 * s + 1]); w.y = pack2(x[8 * s + 2], x[8 * s + 3]); w.z = pack2(x[8 * s + 4], x[8 * s + 5]); w.w = pack2(x[8 * s + 6], x[8 * s + 7]);
  return __builtin_bit_cast(bf16x8, w);
}
DI float fexp2(float x) { return __builtin_amdgcn_exp2f(x); }
DI float silu(float g) { return g / (1.0f + __expf(-g)); }

constexpr int AT_ROWB = 136, AT_LS = 512 * AT_ROWB, AT_VST = AT_LS + 2048, VROW = 192, VST_W = 32 * VROW;
constexpr float LOG2E = 1.4426950408889634f;

DI void attn_task(const Params& p, LAS unsigned char* lds, LAS unsigned char* vst, const int lane, const int tokbase, const int hh, const int pbase,
                  const int sh, const int r_res, const int l0, const bool first) {
  const int r = lane & 31, h = lane >> 5;
  const int i16 = lane & 15, q4 = i16 >> 2, pp = i16 & 3, blk = (lane >> 4) & 1;
  LAS unsigned char* trp = vst + (4 * h + q4) * VROW + 32 * blk + 8 * pp;
  const int pq = r_res + ((l0 + r) << sh), qloc = pq - pbase;
  const bf16_t* qp = p.proj + (size_t)(tokbase + pq) * NW + OFF_QA + hh * 64 + 8 * h;
  bf16x8 Qf[4];
#pragma unroll
  for (int ks = 0; ks < 4; ++ks) Qf[ks] = *(const bf16x8*)(qp + 16 * ks);
  f32x16 O0, O1;
#pragma unroll
  for (int i = 0; i < 16; ++i) { O0[i] = 0.f; O1[i] = 0.f; }
  float m = -1e30f, l = 0.f;
  const int kt0 = (l0 >= 128) ? 0 : (4 - (l0 >> 5));
  bf16x8 Kn[4]; u32x4 Vn[4];
#define LOAD_KV(kt_) do { const int lk0_ = l0 - 128 + 32 * (kt_); \
    const bf16_t* kp_ = p.proj + (size_t)(tokbase + r_res + ((lk0_ + r) << sh)) * NW + OFF_KA + hh * 64 + 8 * h; \
    const bf16_t* vp_ = p.proj + (size_t)(tokbase + r_res + ((lk0_ + (lane >> 1)) << sh)) * NW + OFF_VA + hh * 64 + 32 * (lane & 1); \
    _Pragma("unroll") for (int c_ = 0; c_ < 4; ++c_) { Kn[c_] = *(const bf16x8*)(kp_ + 16 * c_); Vn[c_] = *(const u32x4*)(vp_ + 8 * c_); } } while (0)
  LOAD_KV(kt0);
  for (int kt = kt0; kt < 5; ++kt) {
    bf16x8 Kc[4]; u32x4 Vc[4];
#pragma unroll
    for (int c = 0; c < 4; ++c) { Kc[c] = Kn[c]; Vc[c] = Vn[c]; }
    if (kt < 4) LOAD_KV(kt + 1);
#pragma unroll
    for (int c = 0; c < 4; ++c) *(LAS u32x4*)(vst + (lane >> 1) * VROW + (lane & 1) * 64 + c * 16) = Vc[c];
    f32x16 S;
#pragma unroll
    for (int i = 0; i < 16; ++i) S[i] = 0.f;
#pragma unroll
    for (int ks = 0; ks < 4; ++ks) S = MFMA32(Kc[ks], Qf[ks], S);
    const bool m0 = (kt == 0), m4 = (kt == 4);
    float mx = -1e30f;
#pragma unroll
    for (int i = 0; i < 16; ++i) {
      const int keyrow = (i & 3) + 8 * (i >> 2) + 4 * h;
      const bool bad = (m0 && keyrow < r) || (m4 && keyrow > r);
      S[i] = bad ? -1e30f : S[i] * LOG2E;
      mx = fmaxf(mx, S[i]);
    }
    mx = fmaxf(mx, __shfl_xor(mx, 32));
    const float mn = fmaxf(m, mx), al = fexp2(m - mn);
    m = mn;
    float ps = 0.f;
#pragma unroll
    for (int i = 0; i < 16; ++i) { S[i] = fexp2(S[i] - mn); ps += S[i]; }
    ps += __shfl_xor(ps, 32);
    l = l * al + ps;
#pragma unroll
    for (int i = 0; i < 16; ++i) { O0[i] *= al; O1[i] *= al; }
#pragma unroll
    for (int s = 0; s < 2; ++s) {
      const bf16x8 Pb = pack8(S, s);
      const bf16x8 V0 = tr_frag(trp + 16 * s * VROW, 8 * VROW), V1 = tr_frag(trp + 16 * s * VROW + 64, 8 * VROW);
      O0 = MFMA32(V0, Pb, O0);
      O1 = MFMA32(V1, Pb, O1);
    }
  }
#undef LOAD_KV
  float lse = m + __log2f(l);
  float w1 = 1.0f / l, w0 = 0.f;
  LAS float* LS = (LAS float*)(lds + AT_LS);
  if (!first) {
    const float lp = LS[qloc];
    const float M = fmaxf(lse, lp), e1 = fexp2(lse - M), e0 = fexp2(lp - M), den = e0 + e1, id = 1.0f / den;
    w1 *= e1 * id; w0 = e0 * id; lse = M + __log2f(den);
  }
  LAS unsigned char* ob = lds + qloc * AT_ROWB + 8 * h;
#pragma unroll
  for (int dt = 0; dt < 2; ++dt)
#pragma unroll
    for (int g = 0; g < 4; ++g) {
      float f0, f1, f2, f3;
      if (dt == 0) { f0 = O0[4 * g] * w1; f1 = O0[4 * g + 1] * w1; f2 = O0[4 * g + 2] * w1; f3 = O0[4 * g + 3] * w1; }
      else { f0 = O1[4 * g] * w1; f1 = O1[4 * g + 1] * w1; f2 = O1[4 * g + 2] * w1; f3 = O1[4 * g + 3] * w1; }
      LAS u32x2* a = (LAS u32x2*)(ob + 64 * dt + 16 * g);
      if (!first) { const u32x2 pv = *a; f0 += w0 * bflo(pv.x); f1 += w0 * bfhi(pv.x); f2 += w0 * bflo(pv.y); f3 += w0 * bfhi(pv.y); }
      u32x2 wv; wv.x = pack2(f0, f1); wv.y = pack2(f2, f3);
      *a = wv;
    }
  if (h == 0) LS[qloc] = lse;
}

DI void phase_attn(LAS unsigned char* lds, const Params& p, int bid, int nb) {
  const int tid = threadIdx.x, wid = __builtin_amdgcn_readfirstlane(tid >> 6), lane = tid & 63;
  LAS unsigned char* vst = lds + AT_VST + wid * VST_W;
  for (int unit = bid; unit < 512; unit += nb) {
    const int u = unit & 7, hh = (unit >> 3) & 7, b = unit >> 6;
    const int tokbase = b * SEQ, pbase = 512 * u;
    for (int stage = 0; stage < 3; ++stage) {
      const int sh = stage == 0 ? 4 : (stage == 1 ? 2 : 0);
      for (int tk = 0; tk < 2; ++tk) {
        const int idx = wid + 8 * tk;
        int r_res, l0;
        if (stage == 0) { r_res = idx; l0 = 32 * u; }
        else if (stage == 1) { r_res = idx >> 2; l0 = 128 * u + 32 * (idx & 3); }
        else { r_res = 0; l0 = 512 * u + 32 * idx; }
        attn_task(p, lds, vst, lane, tokbase, hh, pbase, sh, r_res, l0, stage == 0);
      }
      __syncthreads();
    }
#pragma unroll
    for (int it = 0; it < 8; ++it) {
      const int c = tid + 512 * it, qloc = c >> 3, dc = c & 7;
      const u32x2 a0 = *(LAS u32x2*)(lds + qloc * AT_ROWB + dc * 16), a1 = *(LAS u32x2*)(lds + qloc * AT_ROWB + dc * 16 + 8);
      const size_t tok = (size_t)(tokbase + pbase + qloc);
      const u32x4 g = *(const u32x4*)(p.proj + tok * NW + OFF_GA + hh * 64 + dc * 8);
      u32x4 w;
      w.x = pack2(bflo(a0.x) * silu(bflo(g.x)), bfhi(a0.x) * silu(bfhi(g.x)));
      w.y = pack2(bflo(a0.y) * silu(bflo(g.y)), bfhi(a0.y) * silu(bfhi(g.y)));
      w.z = pack2(bflo(a1.x) * silu(bflo(g.z)), bfhi(a1.x) * silu(bfhi(g.z)));
      w.w = pack2(bflo(a1.y) * silu(bflo(g.w)), bfhi(a1.y) * silu(bfhi(g.w)));
      *(u32x4*)(p.mixed + tok * DM + hh * 64 + dc * 8) = w;
    }
    __syncthreads();
  }
}

constexpr int RV_ROW = 320, RK_ROW = 192, RV_OFF = 0, RK_OFF = 128 * RV_ROW  , RRED_OFF = RK_OFF + 128 * RK_ROW  ;

DI void phase_retkv(LAS unsigned char* lds, const Params& p, int bid, int nb) {
  const int tid = threadIdx.x, wid = __builtin_amdgcn_readfirstlane(tid >> 6), lane = tid & 63;
  const int r = lane & 31, h = lane >> 5, i16 = lane & 15, q4 = i16 >> 2, pp = i16 & 3, blk = (lane >> 4) & 1;
  const int vt = wid >> 1, dt = wid & 1;
  for (int u = bid; u < 1024; u += nb) {
    const int n = u & 31, hh = (u >> 5) & 3, b = u >> 7;
    const float lg = ret_log2g(hh);
    const bf16_t* base = p.proj + (size_t)(b * SEQ + n * 128) * NW;
#pragma unroll
    for (int it = 0; it < 4; ++it) {
      const int c = tid + 512 * it, j = c >> 4, cc = c & 15;
      *(LAS u32x4*)(lds + RV_OFF + j * RV_ROW + cc * 16) = *(const u32x4*)(base + (size_t)j * NW + OFF_VR + hh * 128 + cc * 8);
    }
#pragma unroll
    for (int it = 0; it < 2; ++it) {
      const int c = tid + 512 * it, j = c >> 3, cc = c & 7;
      const u32x4 w = *(const u32x4*)(base + (size_t)j * NW + OFF_KR + hh * 64 + cc * 8);
      const float dk = exp2f((float)(127 - j) * lg);
      u32x4 o;
      o.x = pack2(bflo(w.x) * dk, bfhi(w.x) * dk); o.y = pack2(bflo(w.y) * dk, bfhi(w.y) * dk);
      o.z = pack2(bflo(w.z) * dk, bfhi(w.z) * dk); o.w = pack2(bflo(w.w) * dk, bfhi(w.w) * dk);
      *(LAS u32x4*)(lds + RK_OFF + j * RK_ROW + cc * 16) = o;
    }
    __syncthreads();
    f32x16 acc;
#pragma unroll
    for (int i = 0; i < 16; ++i) acc[i] = 0.f;
    LAS unsigned char* va = lds + RV_OFF + (4 * h + q4) * RV_ROW + (32 * vt + 16 * blk + 4 * pp) * 2;
    LAS unsigned char* ka = lds + RK_OFF + (4 * h + q4) * RK_ROW + (32 * dt + 16 * blk + 4 * pp) * 2;
#pragma unroll
    for (int s = 0; s < 8; ++s) {
      const bf16x8 A = tr_frag(va + 16 * s * RV_ROW, 8 * RV_ROW), B = tr_frag(ka + 16 * s * RK_ROW, 8 * RK_ROW);
      acc = MFMA32(A, B, acc);
    }
    float* o = p.kvT + ((size_t)u << 13) + (32 * vt + 4 * h) * 64 + 32 * dt + r;
#pragma unroll
    for (int i = 0; i < 16; ++i) o[((i & 3) + 8 * (i >> 2)) * 64] = acc[i];
    __syncthreads();
  }
}

DI void phase_retout(LAS unsigned char* lds, const Params& p, int bid, int nb) {
  const int tid = threadIdx.x, wid = __builtin_amdgcn_readfirstlane(tid >> 6), lane = tid & 63;
  const int r = lane & 31, h = lane >> 5, i16 = lane & 15, q4 = i16 >> 2, pp = i16 & 3, blk = (lane >> 4) & 1;
  const int it = wid & 3, vh = wid >> 2;
  LAS float* red = (LAS float*)(lds + RRED_OFF);
  for (int u = bid; u < 1024; u += nb) {
    const int n = u & 31, hh = (u >> 5) & 3, b = u >> 7;
    const float lg = ret_log2g(hh);
    const int tok0 = b * SEQ + n * 128;
    const bf16_t* base = p.proj + (size_t)tok0 * NW;
#pragma unroll
    for (int k = 0; k < 4; ++k) {
      const int c = tid + 512 * k, j = c >> 4, cc = c & 15;
      *(LAS u32x4*)(lds + RV_OFF + j * RV_ROW + cc * 16) = *(const u32x4*)(base + (size_t)j * NW + OFF_VR + hh * 128 + cc * 8);
    }
    const int qi = 32 * it + r;
    const bf16_t* qp = base + (size_t)qi * NW + OFF_QR + hh * 64 + 8 * h;
    bf16x8 Qf[4];
#pragma unroll
    for (int ks = 0; ks < 4; ++ks) Qf[ks] = *(const bf16x8*)(qp + 16 * ks);
    f32x16 O0, O1;
#pragma unroll
    for (int i = 0; i < 16; ++i) { O0[i] = 0.f; O1[i] = 0.f; }
    {
      const bf16_t* st = p.stT + ((size_t)u << 13) + (size_t)(64 * vh + r) * 64 + 8 * h;
#pragma unroll
      for (int ks = 0; ks < 4; ++ks) {
        const bf16x8 A0 = *(const bf16x8*)(st + 16 * ks), A1 = *(const bf16x8*)(st + 32 * 64 + 16 * ks);
        O0 = MFMA32(A0, Qf[ks], O0);
        O1 = MFMA32(A1, Qf[ks], O1);
      }
      const float qd = exp2f((float)(qi + 1) * lg);
#pragma unroll
      for (int i = 0; i < 16; ++i) { O0[i] *= qd; O1[i] *= qd; }
    }
    __syncthreads();
    LAS unsigned char* va = lds + RV_OFF + (4 * h + q4) * RV_ROW + (64 * vh + 16 * blk + 4 * pp) * 2;
    for (int jt = 0; jt <= it; ++jt) {
      const bf16_t* kp = base + (size_t)(32 * jt + r) * NW + OFF_KR + hh * 64 + 8 * h;
      f32x16 S;
#pragma unroll
      for (int i = 0; i < 16; ++i) S[i] = 0.f;
#pragma unroll
      for (int ks = 0; ks < 4; ++ks) { const bf16x8 Kf = *(const bf16x8*)(kp + 16 * ks); S = MFMA32(Kf, Qf[ks], S); }
#pragma unroll
      for (int i = 0; i < 16; ++i) {
        const int dj = qi - (32 * jt + (i & 3) + 8 * (i >> 2) + 4 * h);
        S[i] = dj >= 0 ? S[i] * fexp2((float)dj * lg) : 0.f;
      }
#pragma unroll
      for (int s = 0; s < 2; ++s) {
        const bf16x8 Pb = pack8(S, s);
        const bf16x8 V0 = tr_frag(va + (32 * jt + 16 * s) * RV_ROW, 8 * RV_ROW), V1 = tr_frag(va + (32 * jt + 16 * s) * RV_ROW + 64, 8 * RV_ROW);
        O0 = MFMA32(V0, Pb, O0);
        O1 = MFMA32(V1, Pb, O1);
      }
    }
    float s1 = 0.f, s2 = 0.f;
#pragma unroll
    for (int i = 0; i < 16; ++i) { s1 += O0[i] + O1[i]; s2 += O0[i] * O0[i] + O1[i] * O1[i]; }
    s1 += __shfl_xor(s1, 32); s2 += __shfl_xor(s2, 32);
    if (h == 0) { red[(vh * 128 + qi) * 2] = s1; red[(vh * 128 + qi) * 2 + 1] = s2; }
    __syncthreads();
    s1 += red[((vh ^ 1) * 128 + qi) * 2]; s2 += red[((vh ^ 1) * 128 + qi) * 2 + 1];
    const float mu = s1 * (1.0f / 128.0f), var = fmaxf(s2 * (1.0f / 128.0f) - mu * mu, 0.f), rs = rsqrtf(var + 1e-5f);
    const size_t tok = (size_t)(tok0 + qi);
    const bf16_t* gr = p.proj + tok * NW + OFF_GR + hh * 128 + 64 * vh + 4 * h;
    bf16_t* mo = p.mixed + tok * DM + 512 + hh * 128 + 64 * vh + 4 * h;
    const float* gnp = p.gn + hh * 128 + 64 * vh + 4 * h;
#pragma unroll
    for (int dt = 0; dt < 2; ++dt)
#pragma unroll
      for (int g = 0; g < 4; ++g) {
        const int vo = 32 * dt + 8 * g;
        const u32x2 gw = *(const u32x2*)(gr + vo);
        const f32x4 gnv = *(const f32x4*)(gnp + vo);
        float f0, f1, f2, f3;
        if (dt == 0) { f0 = O0[4 * g]; f1 = O0[4 * g + 1]; f2 = O0[4 * g + 2]; f3 = O0[4 * g + 3]; }
        else { f0 = O1[4 * g]; f1 = O1[4 * g + 1]; f2 = O1[4 * g + 2]; f3 = O1[4 * g + 3]; }
        f0 = (f0 - mu) * rs * gnv[0] * silu(bflo(gw.x)); f1 = (f1 - mu) * rs * gnv[1] * silu(bfhi(gw.x));
        f2 = (f2 - mu) * rs * gnv[2] * silu(bflo(gw.y)); f3 = (f3 - mu) * rs * gnv[3] * silu(bfhi(gw.y));
        u32x2 wv; wv.x = pack2(f0, f1); wv.y = pack2(f2, f3);
        *(u32x2*)(mo + vo) = wv;
      }
    __syncthreads();
  }
}

DI void phase_final(const Params& p, int bid, int nb) {
  const int tid = threadIdx.x, lane = tid & 63, wid = tid >> 6, nw = blockDim.x >> 6;
  for (int row = bid * nw + wid; row < T_TOK; row += nb * nw) {
    const float rs = rsqrtf(p.rowss[row] * (1.0f / DM) + 1e-6f);
    float* yr = p.out + (size_t)row * DM;
#pragma unroll
    for (int it = 0; it < 4; ++it) {
      const f32x4 v = *(const f32x4*)(yr + it * 256 + lane * 4), g = *(const f32x4*)(p.fg + it * 256 + lane * 4);
      *(f32x4*)(yr + it * 256 + lane * 4) = v * rs * g;
    }
  }
}

__global__ void __launch_bounds__(512) k_mega(Params p) {
  extern __shared__ __attribute__((aligned(16))) unsigned char shm_[];
  LAS unsigned char* shm = (LAS unsigned char*)shm_;
  cg::grid_group grid = cg::this_grid();
  const int bid = blockIdx.x, nb = gridDim.x;
  phase_prep(p, bid, nb);
  grid.sync();
  phase_gemm<1>(shm, p, bid, nb);
  grid.sync();
  phase_attn(shm, p, bid, nb);
  phase_retkv(shm, p, bid, nb);
  grid.sync();
  phase_retscan(p, bid, nb);
  grid.sync();
  phase_retout(shm, p, bid, nb);
  grid.sync();
  phase_gemm<2>(shm, p, bid, nb);
  grid.sync();
  phase_final(p, bid, nb);
}

extern "C" void kernel_launch(void* const* d_in, const int* in_sizes, int n_in, void* d_out, int out_size, void* d_ws, size_t ws_size, hipStream_t stream) {
  Params p{};
  p.x = (const float*)d_in[0]; p.ng = (const float*)d_in[1]; p.w_in = (const float*)d_in[2]; p.gn = (const float*)d_in[3];
  p.w_out = (const float*)d_in[4]; p.fg = (const float*)d_in[5];
  p.out = (float*)d_out;
  char* w = (char*)d_ws; size_t o = 0;
  auto take = [&](size_t bytes) { char* r = w + o; o += (bytes + 255) & ~(size_t)255; return r; };
  p.xb = (bf16_t*)take((size_t)T_TOK * DM * 2);
  p.proj = (bf16_t*)take((size_t)T_TOK * NW * 2);
  p.mixed = (bf16_t*)take((size_t)T_TOK * DM * 2);
  p.winT = (bf16_t*)take((size_t)NW * DM * 2);
  p.woutT = (bf16_t*)take((size_t)DM * DM * 2);
  p.rstd = (float*)take((size_t)T_TOK * 4);
  p.rowss = (float*)take((size_t)T_TOK * 4);
  p.ropeT = (float2*)take((size_t)SEQ * 32 * 8);
  p.retT = (float2*)take((size_t)SEQ * 32 * 8);
  p.kvT = (float*)take((size_t)1024 * 8192 * 4);
  p.stT = (bf16_t*)take((size_t)1024 * 8192 * 2);
  static int grid_blocks = 0;
  if (!grid_blocks) {
    (void)hipFuncSetAttribute((const void*)k_mega, hipFuncAttributeMaxDynamicSharedMemorySize, GEMM_LDS);
    int dev = 0, cus = 0, per_cu = 0;
    (void)hipGetDevice(&dev);
    (void)hipDeviceGetAttribute(&cus, hipDeviceAttributeMultiprocessorCount, dev);
    (void)hipOccupancyMaxActiveBlocksPerMultiprocessor(&per_cu, k_mega, 512, GEMM_LDS);
    if (per_cu < 1) per_cu = 1;
    grid_blocks = cus;
  }
  void* args[] = {&p};
  hipError_t e = hipLaunchCooperativeKernel((void*)k_mega, dim3(grid_blocks), dim3(512), args, GEMM_LDS, stream);
  if (e != hipSuccess) fprintf(stderr, "cooperative launch failed: %s (grid %d)\n", hipGetErrorString(e), grid_blocks);
}
```

```cpp
#include <hip/hip_runtime.h>
#include <hip/hip_cooperative_groups.h>
#include <cstdint>
#include <cstdio>
namespace cg = cooperative_groups;

typedef unsigned short bf16_t;
typedef short bf16x8 __attribute__((ext_vector_type(8)));
typedef float f32x4 __attribute__((ext_vector_type(4)));
typedef unsigned u32x4 __attribute__((ext_vector_type(4)));
typedef unsigned u32x2 __attribute__((ext_vector_type(2)));

constexpr int T_TOK = 32768, DM = 1024, NW = 3584, SEQ = 4096;
constexpr int OFF_QA = 0, OFF_KA = 512, OFF_VA = 1024, OFF_GA = 1536, OFF_QR = 2048, OFF_KR = 2304, OFF_VR = 2560, OFF_GR = 3072;

struct Params {
  const float* x; const float* ng; const float* w_in; const float* gn; const float* w_out; const float* fg;
  float* out;
  bf16_t* xb; bf16_t* proj; bf16_t* mixed; bf16_t* winT; bf16_t* woutT;
  float* rstd; float* rowss; float2* ropeT; float2* retT; float* kvT; bf16_t* stT; unsigned* bar;
};

#define DI __device__ __forceinline__
DI unsigned short f2bf(float x) { unsigned u = __float_as_uint(x); u += 0x7fffu + ((u >> 16) & 1u); return (unsigned short)(u >> 16); }
DI float bf2f(unsigned short b) { return __uint_as_float(((unsigned)b) << 16); }
DI unsigned pack2(float lo, float hi) { return (unsigned)f2bf(lo) | ((unsigned)f2bf(hi) << 16); }
DI float bflo(unsigned w) { return __uint_as_float(w << 16); }
DI float bfhi(unsigned w) { return __uint_as_float(w & 0xffff0000u); }
DI int perm32(int rho) { const int n = rho >> 4, i = rho & 15; return 8 * (i >> 2) + 4 * n + (i & 3); }
DI int cmap(int p) { return (p & ~31) + perm32(p & 31); }
DI int cmapA(int p) { return (p & ~127) + ((p >> 6) & 1) * 64 + ((p >> 4) & 1) * 32 + ((p >> 5) & 1) * 16 + (p & 15); }

DI void phase_prep(const Params& p, int bid, int nb) {
  const int tid = threadIdx.x, lane = tid & 63, wid = tid >> 6, nw = blockDim.x >> 6;
  for (int row = bid * nw + wid; row < T_TOK; row += nb * nw) {
    const float* xr = p.x + (size_t)row * DM;
    float ss = 0.f;
    f32x4 v[4];
#pragma unroll
    for (int it = 0; it < 4; ++it) { v[it] = *(const f32x4*)(xr + it * 256 + lane * 4); ss += v[it][0] * v[it][0] + v[it][1] * v[it][1] + v[it][2] * v[it][2] + v[it][3] * v[it][3]; }
#pragma unroll
    for (int o = 32; o >= 1; o >>= 1) ss += __shfl_xor(ss, o);
#pragma unroll
    for (int it = 0; it < 4; ++it) { u32x2 w; w.x = pack2(v[it][0], v[it][1]); w.y = pack2(v[it][2], v[it][3]); *(u32x2*)(p.xb + (size_t)row * DM + it * 256 + lane * 4) = w; }
    if (lane == 0) p.rstd[row] = rsqrtf(ss * (1.0f / DM) + 1e-6f);
  }
  const int gt = bid * blockDim.x + tid, gn = nb * blockDim.x;
  for (int idx = gt; idx < NW * 128; idx += gn) {
    const int pp = idx % NW, kc = idx / NW, c = pp < 1024 ? cmapA(pp) : cmap(pp);
    float f[8];
#pragma unroll
    for (int j = 0; j < 8; ++j) { const int k = kc * 8 + j; f[j] = p.ng[k] * p.w_in[(size_t)k * NW + c]; }
    u32x4 w; w.x = pack2(f[0], f[1]); w.y = pack2(f[2], f[3]); w.z = pack2(f[4], f[5]); w.w = pack2(f[6], f[7]);
    *(u32x4*)(p.winT + (size_t)pp * DM + kc * 8) = w;
  }
  for (int idx = gt; idx < DM * 128; idx += gn) {
    const int pp = idx % DM, kc = idx / DM, c = cmap(pp);
    float f[8];
#pragma unroll
    for (int j = 0; j < 8; ++j) { const int k = kc * 8 + j; f[j] = p.w_out[(size_t)k * DM + c]; }
    u32x4 w; w.x = pack2(f[0], f[1]); w.y = pack2(f[2], f[3]); w.z = pack2(f[4], f[5]); w.w = pack2(f[6], f[7]);
    *(u32x4*)(p.woutT + (size_t)pp * DM + kc * 8) = w;
  }
  for (int idx = gt; idx < SEQ * 32; idx += gn) {
    const int pos = idx >> 5, i = idx & 31;
    const float inv1 = powf(10000.0f, -(float)i / 32.0f);
    const float inv2 = 1.0f / powf(10000.0f, (float)i / 31.0f);
    const float a1 = (float)pos * inv1, a2 = (float)pos * inv2;
    p.ropeT[idx] = make_float2(cosf(a1), sinf(a1));
    p.retT[idx] = make_float2(cosf(a2), sinf(a2));
  }
}

constexpr int BM = 256, BK = 64, HALF = 128, HT = HALF * BK;
constexpr int GEMM_LDS = 8 * HT * 2;
DI int lds_byte(int r, int c) { int st = (r >> 4) * 2 + (c >> 5), rr = r & 15, cc = c & 31, ob = rr * 64 + cc * 2; return st * 1024 + (ob ^ (((ob >> 9) & 1) << 5)); }
DI void stage_rc(int b, int& R, int& C) { int st = b / 1024, sb = b % 1024, swz = sb ^ (((sb >> 9) & 1) << 5); R = (st >> 1) * 16 + swz / 64; C = (st & 1) * 32 + (swz % 64) / 2; }

#define LAS __attribute__((address_space(3)))
template <int EPI>
DI void gemm_tile(LAS unsigned char* lds, const bf16_t* __restrict__ A, const bf16_t* __restrict__ Bt, const int brow, const int bcol, const Params& p) {
  constexpr int K = 1024, nt = K / BK, HTB = HALF * BK * 2;
  const int tid = threadIdx.x, wid = __builtin_amdgcn_readfirstlane(tid >> 6), lane = tid & 63, wr = wid >> 2, wc = wid & 3, fr = lane & 15, fq = lane >> 4;
  unsigned voff[2];
#pragma unroll
  for (int i = 0; i < 2; ++i) { int R, C; stage_rc(tid * 16 + i * 8192, R, C); voff[i] = (unsigned)(R * K + C) * 2u; }
  const unsigned ldsw = (unsigned)wid * 1024u;
  const int aoff = lds_byte(wr * 64 + fr, fq * 8), boff = lds_byte(wc * 32 + fr, fq * 8);
  const char* cA0 = (const char*)A + (size_t)brow * K * 2; const char* cA1 = cA0 + (size_t)HALF * K * 2;
  const char* cB0 = (const char*)Bt + (size_t)bcol * K * 2; const char* cB1 = cB0 + (size_t)HALF * K * 2;
#define SAo(b, h) (((b) * 2 + (h)) * HTB)
#define SBo(b, h) ((4 + (b) * 2 + (h)) * HTB)
#define STAGE(bufoff, gb, kt) do { _Pragma("unroll") for (int _i = 0; _i < 2; ++_i) \
    __builtin_amdgcn_global_load_lds((const unsigned*)((gb) + (size_t)(kt) * (BK * 2) + voff[_i]), (LAS unsigned*)(lds + (bufoff) + ldsw + _i * 8192), 16, 0, 0); } while (0)
#define LDA(dst, b, h) do { _Pragma("unroll") for (int m = 0; m < 4; ++m) _Pragma("unroll") for (int k = 0; k < 2; ++k) \
    dst[m][k] = *(const LAS bf16x8*)(lds + SAo(b, h) + aoff + m * 2048 + k * 1024); } while (0)
#define LDB(dst, b, h) do { _Pragma("unroll") for (int n = 0; n < 2; ++n) _Pragma("unroll") for (int k = 0; k < 2; ++k) \
    dst[n][k] = *(const LAS bf16x8*)(lds + SBo(b, h) + boff + n * 2048 + k * 1024); } while (0)
#define MMA(ai, bj, At, Bt_) do { __builtin_amdgcn_s_setprio(1); \
    _Pragma("unroll") for (int m = 0; m < 4; ++m) _Pragma("unroll") for (int n = 0; n < 2; ++n) _Pragma("unroll") for (int k = 0; k < 2; ++k) \
      acc[ai][bj][m][n] = __builtin_amdgcn_mfma_f32_16x16x32_bf16(Bt_[n][k], At[m][k], acc[ai][bj][m][n], 0, 0, 0); \
    __builtin_amdgcn_s_setprio(0); } while (0)
#define WAIT_V(n) asm volatile("s_waitcnt vmcnt(" #n ")" ::: "memory")
#define WAIT_L(n) asm volatile("s_waitcnt lgkmcnt(" #n ")" ::: "memory")
#define BAR __builtin_amdgcn_s_barrier()
#define SCHED __builtin_amdgcn_sched_barrier(0)
  f32x4 acc[2][2][4][2];
#pragma unroll
  for (int a = 0; a < 2; ++a)
#pragma unroll
    for (int b = 0; b < 2; ++b)
#pragma unroll
      for (int m = 0; m < 4; ++m)
#pragma unroll
        for (int n = 0; n < 2; ++n) acc[a][b][m][n] = (f32x4){0.f, 0.f, 0.f, 0.f};
  bf16x8 At[4][2], B0[2][2], B1[2][2];
  WAIT_V(0);
  STAGE(SBo(0, 0), cB0, 0); STAGE(SAo(0, 0), cA0, 0);
  STAGE(SBo(0, 1), cB1, 0); STAGE(SAo(0, 1), cA1, 0);
  if (wr == 1) BAR;
  WAIT_V(4); BAR;
  STAGE(SBo(1, 0), cB0, 1); STAGE(SAo(1, 0), cA0, 1); STAGE(SBo(1, 1), cB1, 1);
  WAIT_V(6); BAR;
  for (int t = 0; t < nt - 2; t += 2) {
    LDB(B0, 0, 0); SCHED; LDA(At, 0, 0); STAGE(SAo(1, 1), cA1, t + 1);
    WAIT_L(8); BAR; WAIT_L(0); MMA(0, 0, At, B0); BAR; SCHED;
    LDB(B1, 0, 1); STAGE(SBo(0, 0), cB0, t + 2);
    BAR; WAIT_L(0); MMA(0, 1, At, B1); BAR;
    LDA(At, 0, 1); STAGE(SAo(0, 0), cA0, t + 2);
    BAR; WAIT_L(0); MMA(1, 0, At, B0); BAR; SCHED;
    STAGE(SBo(0, 1), cB1, t + 2);
    WAIT_V(6); BAR; MMA(1, 1, At, B1); BAR;
    LDB(B0, 1, 0); SCHED; LDA(At, 1, 0); STAGE(SAo(0, 1), cA1, t + 2);
    WAIT_L(8); BAR; WAIT_L(0); MMA(0, 0, At, B0); BAR; SCHED;
    LDB(B1, 1, 1); STAGE(SBo(1, 0), cB0, t + 3);
    BAR; WAIT_L(0); MMA(0, 1, At, B1); BAR;
    LDA(At, 1, 1); STAGE(SAo(1, 0), cA0, t + 3);
    BAR; WAIT_L(0); MMA(1, 0, At, B0); BAR; SCHED;
    STAGE(SBo(1, 1), cB1, t + 3);
    WAIT_V(6); BAR; MMA(1, 1, At, B1); BAR;
  }
  { LDB(B0, 0, 0); LDA(At, 0, 0); STAGE(SAo(1, 1), cA1, nt - 1);
    BAR; WAIT_L(0); MMA(0, 0, At, B0); BAR;
    LDB(B1, 0, 1); BAR; WAIT_L(0); MMA(0, 1, At, B1); BAR;
    LDA(At, 0, 1); WAIT_V(4); BAR; WAIT_L(0); MMA(1, 0, At, B0); MMA(1, 1, At, B1); BAR; }
  { LDB(B0, 1, 0); LDA(At, 1, 0); WAIT_V(2); BAR; WAIT_L(0); MMA(0, 0, At, B0); BAR;
    LDB(B1, 1, 1); WAIT_V(0); BAR; WAIT_L(0); MMA(0, 1, At, B1); BAR;
    LDA(At, 1, 1); BAR; WAIT_L(0); MMA(1, 0, At, B0); MMA(1, 1, At, B1); BAR; }
  if (wr == 0) BAR;
  if (EPI == 1) {
    const int pn = bcol >> 8;
    if (pn < 4) {
      const float sc = pn < 2 ? 0.125f : 1.0f;
      const int i0 = 16 * (wc & 1) + 4 * fq;
#pragma unroll
      for (int ai = 0; ai < 2; ++ai)
#pragma unroll
        for (int m = 0; m < 4; ++m) {
          const int row = brow + ai * HALF + wr * 64 + m * 16 + fr;
          const float rs = p.rstd[row] * sc;
          const float* tb = (const float*)(p.ropeT + (row & (SEQ - 1)) * 32 + i0);
          const f32x4 t0 = *(const f32x4*)tb, t1 = *(const f32x4*)(tb + 4);
#pragma unroll
          for (int bj = 0; bj < 2; ++bj) {
            const f32x4 x1 = acc[ai][bj][m][0] * rs, x2 = acc[ai][bj][m][1] * rs;
            u32x2 wa, wb;
            wa.x = pack2(x1[0] * t0[0] - x2[0] * t0[1], x1[1] * t0[2] - x2[1] * t0[3]);
            wa.y = pack2(x1[2] * t1[0] - x2[2] * t1[1], x1[3] * t1[2] - x2[3] * t1[3]);
            wb.x = pack2(x2[0] * t0[0] + x1[0] * t0[1], x2[1] * t0[2] + x1[1] * t0[3]);
            wb.y = pack2(x2[2] * t1[0] + x1[2] * t1[1], x2[3] * t1[2] + x1[3] * t1[3]);
            bf16_t* o = p.proj + (size_t)row * NW + bcol + bj * HALF + (wc >> 1) * 64 + i0;
            *(u32x2*)o = wa; *(u32x2*)(o + 32) = wb;
          }
        }
    } else if (pn == 8 || pn == 9) {
      const float sc = pn == 9 ? 0.125f : 1.0f;
      const int i0 = 16 * (wc & 1) + 4 * fq;
#pragma unroll
      for (int ai = 0; ai < 2; ++ai)
#pragma unroll
        for (int m = 0; m < 4; ++m) {
          const int row = brow + ai * HALF + wr * 64 + m * 16 + fr;
          const float rs = p.rstd[row] * sc;
          const float* tb = (const float*)(p.retT + (row & (SEQ - 1)) * 32 + i0);
          const f32x4 t0 = *(const f32x4*)tb, t1 = *(const f32x4*)(tb + 4);
#pragma unroll
          for (int bj = 0; bj < 2; ++bj) {
            const f32x4 v0 = acc[ai][bj][m][0] * rs, v1 = acc[ai][bj][m][1] * rs;
            u32x4 w;
            w.x = pack2(v0[0] * t0[0] - v0[1] * t0[1], v0[1] * t0[0] + v0[0] * t0[1]);
            w.y = pack2(v0[2] * t0[2] - v0[3] * t0[3], v0[3] * t0[2] + v0[2] * t0[3]);
            w.z = pack2(v1[0] * t1[0] - v1[1] * t1[1], v1[1] * t1[0] + v1[0] * t1[1]);
            w.w = pack2(v1[2] * t1[2] - v1[3] * t1[3], v1[3] * t1[2] + v1[2] * t1[3]);
            *(u32x4*)(p.proj + (size_t)row * NW + bcol + bj * HALF + wc * 32 + 8 * fq) = w;
          }
        }
    } else {
#pragma unroll
    for (int ai = 0; ai < 2; ++ai)
#pragma unroll
      for (int m = 0; m < 4; ++m) {
        const int row = brow + ai * HALF + wr * 64 + m * 16 + fr;
        const float rs = p.rstd[row];
#pragma unroll
        for (int bj = 0; bj < 2; ++bj) {
          const f32x4 v0 = acc[ai][bj][m][0] * rs, v1 = acc[ai][bj][m][1] * rs;
          u32x4 w; w.x = pack2(v0[0], v0[1]); w.y = pack2(v0[2], v0[3]); w.z = pack2(v1[0], v1[1]); w.w = pack2(v1[2], v1[3]);
          *(u32x4*)(p.proj + (size_t)row * NW + bcol + bj * HALF + wc * 32 + 8 * fq) = w;
        }
      }
    }
  } else {
    const int pm = brow >> 8, pn = bcol >> 8;
    LAS float* part = (LAS float*)lds;
    LAS float* rsl = (LAS float*)(lds + 4096);
#pragma unroll
    for (int ai = 0; ai < 2; ++ai)
#pragma unroll
      for (int m = 0; m < 4; ++m) {
        const int rl = ai * HALF + wr * 64 + m * 16 + fr;
        float ss = 0.f;
#pragma unroll
        for (int bj = 0; bj < 2; ++bj) {
          const size_t off = (size_t)(brow + rl) * DM + bcol + bj * HALF + wc * 32 + 8 * fq;
          const f32x4 x0 = *(const f32x4*)(p.x + off), x1 = *(const f32x4*)(p.x + off + 4);
          const f32x4 y0 = acc[ai][bj][m][0] + x0, y1 = acc[ai][bj][m][1] + x1;
          acc[ai][bj][m][0] = y0; acc[ai][bj][m][1] = y1;
          ss += y0[0] * y0[0] + y0[1] * y0[1] + y0[2] * y0[2] + y0[3] * y0[3] + y1[0] * y1[0] + y1[1] * y1[1] + y1[2] * y1[2] + y1[3] * y1[3];
        }
        ss += __shfl_xor(ss, 16); ss += __shfl_xor(ss, 32);
        if (fq == 0) part[wc * 256 + rl] = ss;
      }
    __syncthreads();
    float* xs = p.rowss + (size_t)(pm * 4) * 256;
    if (tid < 256) {
      const float tot = part[tid] + part[256 + tid] + part[512 + tid] + part[768 + tid];
      __hip_atomic_store(xs + pn * 256 + tid, tot, __ATOMIC_RELAXED, __HIP_MEMORY_SCOPE_AGENT);
    }
    asm volatile("s_waitcnt vmcnt(0)" ::: "memory");
    __syncthreads();
    unsigned* cnt = p.bar + 64 + pm;
    if (tid == 0) __hip_atomic_fetch_add(cnt, 1u, __ATOMIC_RELAXED, __HIP_MEMORY_SCOPE_AGENT);
    if (wid == 0) {
      unsigned spins = 0;
      while (__hip_atomic_load(cnt, __ATOMIC_RELAXED, __HIP_MEMORY_SCOPE_AGENT) < 4u && spins < (1u << 20)) { __builtin_amdgcn_s_sleep(1); ++spins; }
      __builtin_amdgcn_fence(__ATOMIC_ACQUIRE, "agent");
      asm volatile("s_waitcnt vmcnt(0)" ::: "memory");
    }
    __syncthreads();
    if (tid < 256) {
      float t = 0.f;
#pragma unroll
      for (int q = 0; q < 4; ++q) t += __hip_atomic_load(xs + q * 256 + tid, __ATOMIC_RELAXED, __HIP_MEMORY_SCOPE_AGENT);
      rsl[tid] = rsqrtf(t * (1.0f / DM) + 1e-6f);
    }
    __syncthreads();
#pragma unroll
    for (int ai = 0; ai < 2; ++ai)
#pragma unroll
      for (int m = 0; m < 4; ++m) {
        const int rl = ai * HALF + wr * 64 + m * 16 + fr;
        const float rs = rsl[rl];
#pragma unroll
        for (int bj = 0; bj < 2; ++bj) {
          const int col = bcol + bj * HALF + wc * 32 + 8 * fq;
          const f32x4 g0 = *(const f32x4*)(p.fg + col), g1 = *(const f32x4*)(p.fg + col + 4);
          float* o = p.out + (size_t)(brow + rl) * DM + col;
          *(f32x4*)o = acc[ai][bj][m][0] * rs * g0; *(f32x4*)(o + 4) = acc[ai][bj][m][1] * rs * g1;
        }
      }
    __syncthreads();
  }
}

DI void tile_of(int L, int nM, int nN, int& pm, int& pn) {
  const int nwg = nM * nN, NX = 8, WGM = 8;
  int wgid = L; { const int q = nwg / NX, r = nwg % NX, xcd = wgid % NX, off = wgid / NX; wgid = (xcd < r ? xcd * (q + 1) : r * (q + 1) + (xcd - r) * q) + off; }
  const int nig = WGM * nN, gid = wgid / nig, fm = gid * WGM, gsz = (nM - fm) < WGM ? (nM - fm) : WGM;
  pm = fm + ((wgid % nig) % gsz); pn = (wgid % nig) / gsz;
}

template <int EPI>
DI void phase_gemm(LAS unsigned char* shm, const Params& p, int bid, int nb) {
  const int nM = T_TOK / BM, nN = (EPI == 1 ? NW : DM) / BM;
  for (int L = bid; L < nM * nN; L += nb) {
    int pm, pn; tile_of(L, nM, nN, pm, pn);
    if (EPI == 1) gemm_tile<1>(shm, p.xb, p.winT, pm * BM, pn * BM, p);
    else gemm_tile<2>(shm, p.mixed, p.woutT, pm * BM, pn * BM, p);
  }
}

DI void phase_rotary(const Params& p, int bid, int nb) {
  const long total = (long)T_TOK * 768;
  for (long idx = (long)bid * blockDim.x + threadIdx.x; idx < total; idx += (long)nb * blockDim.x) {
    const int tok = (int)(idx / 768); int j = (int)(idx % 768);
    const int pos = tok & (SEQ - 1);
    int a, b; float sc; const float2* tab;
    if (j < 256) { const int h = j >> 5, i = j & 31; a = OFF_QA + h * 64 + i; b = a + 32; sc = 0.125f; tab = p.ropeT + pos * 32 + i; }
    else if (j < 512) { j -= 256; const int h = j >> 5, i = j & 31; a = OFF_KA + h * 64 + i; b = a + 32; sc = 1.f; tab = p.ropeT + pos * 32 + i; }
    else if (j < 640) { j -= 512; const int h = j >> 5, i = j & 31; a = OFF_QR + h * 64 + 2 * i; b = a + 1; sc = 1.f; tab = p.retT + pos * 32 + i; }
    else { j -= 640; const int h = j >> 5, i = j & 31; a = OFF_KR + h * 64 + 2 * i; b = a + 1; sc = 0.125f; tab = p.retT + pos * 32 + i; }
    const float2 cs = *tab;
    bf16_t* row = p.proj + (size_t)tok * NW;
    const float x1 = bf2f(row[a]), x2 = bf2f(row[b]);
    row[a] = f2bf((x1 * cs.x - x2 * cs.y) * sc);
    row[b] = f2bf((x2 * cs.x + x1 * cs.y) * sc);
  }
}

DI void load_row64(const bf16_t* src, float* dst) {
#pragma unroll
  for (int c = 0; c < 8; ++c) {
    const u32x4 w = *(const u32x4*)(src + c * 8);
    dst[c * 8 + 0] = bflo(w.x); dst[c * 8 + 1] = bfhi(w.x); dst[c * 8 + 2] = bflo(w.y); dst[c * 8 + 3] = bfhi(w.y);
    dst[c * 8 + 4] = bflo(w.z); dst[c * 8 + 5] = bfhi(w.z); dst[c * 8 + 6] = bflo(w.w); dst[c * 8 + 7] = bfhi(w.w);
  }
}

DI void phase_attn_naive(const Params& p, int bid, int nb) {
  const long total = (long)T_TOK * 8;
  for (long idx = (long)bid * blockDim.x + threadIdx.x; idx < total; idx += (long)nb * blockDim.x) {
    const int h = (int)(idx & 7), tok = (int)(idx >> 3);
    const int pos = tok & (SEQ - 1), tb = tok - pos;
    float q[64], o[64];
    load_row64(p.proj + (size_t)tok * NW + OFF_QA + h * 64, q);
#pragma unroll
    for (int d = 0; d < 64; ++d) o[d] = 0.f;
    float m = -1e30f, l = 0.f;
    for (int br = 0; br < 3; ++br) {
      const int dl = br == 0 ? 1 : (br == 1 ? 4 : 16);
      for (int j = 0; j <= 128; ++j) {
        const int pk = pos - j * dl; if (pk < 0) break;
        const bf16_t* kr = p.proj + (size_t)(tb + pk) * NW + OFF_KA + h * 64;
        float s = 0.f;
#pragma unroll
        for (int c = 0; c < 8; ++c) {
          const u32x4 w = *(const u32x4*)(kr + c * 8);
          s += q[c * 8 + 0] * bflo(w.x) + q[c * 8 + 1] * bfhi(w.x) + q[c * 8 + 2] * bflo(w.y) + q[c * 8 + 3] * bfhi(w.y)
             + q[c * 8 + 4] * bflo(w.z) + q[c * 8 + 5] * bfhi(w.z) + q[c * 8 + 6] * bflo(w.w) + q[c * 8 + 7] * bfhi(w.w);
        }
        const float mn = fmaxf(m, s), al = __expf(m - mn), pe = __expf(s - mn);
        m = mn; l = l * al + pe;
        const bf16_t* vr = kr + (OFF_VA - OFF_KA);
#pragma unroll
        for (int c = 0; c < 8; ++c) {
          const u32x4 w = *(const u32x4*)(vr + c * 8);
          o[c * 8 + 0] = o[c * 8 + 0] * al + pe * bflo(w.x); o[c * 8 + 1] = o[c * 8 + 1] * al + pe * bfhi(w.x);
          o[c * 8 + 2] = o[c * 8 + 2] * al + pe * bflo(w.y); o[c * 8 + 3] = o[c * 8 + 3] * al + pe * bfhi(w.y);
          o[c * 8 + 4] = o[c * 8 + 4] * al + pe * bflo(w.z); o[c * 8 + 5] = o[c * 8 + 5] * al + pe * bfhi(w.z);
          o[c * 8 + 6] = o[c * 8 + 6] * al + pe * bflo(w.w); o[c * 8 + 7] = o[c * 8 + 7] * al + pe * bfhi(w.w);
        }
      }
    }
    const float il = 1.0f / l;
    const bf16_t* gr = p.proj + (size_t)tok * NW + OFF_GA + h * 64;
    bf16_t* mo = p.mixed + (size_t)tok * DM + h * 64;
#pragma unroll
    for (int c = 0; c < 8; ++c) {
      const u32x4 w = *(const u32x4*)(gr + c * 8);
      float g[8] = {bflo(w.x), bfhi(w.x), bflo(w.y), bfhi(w.y), bflo(w.z), bfhi(w.z), bflo(w.w), bfhi(w.w)};
      float r[8];
#pragma unroll
      for (int e = 0; e < 8; ++e) r[e] = o[c * 8 + e] * il * (g[e] / (1.0f + __expf(-g[e])));
      u32x4 ww; ww.x = pack2(r[0], r[1]); ww.y = pack2(r[2], r[3]); ww.z = pack2(r[4], r[5]); ww.w = pack2(r[6], r[7]);
      *(u32x4*)(mo + c * 8) = ww;
    }
  }
}

DI float ret_log2g(int h) { return log2f(1.0f - exp2f(-5.0f - (float)h)); }

DI void phase_retkv_naive(const Params& p, int bid, int nb) {
  const long total = 1024L * 8192;
  for (long idx = (long)bid * blockDim.x + threadIdx.x; idx < total; idx += (long)nb * blockDim.x) {
    const int d = (int)(idx & 63), v = (int)((idx >> 6) & 127), u = (int)(idx >> 13);
    const int n = u & 31, h = (u >> 5) & 3, b = u >> 7;
    const float lg = ret_log2g(h);
    const bf16_t* base = p.proj + (size_t)(b * SEQ + n * 128) * NW;
    float s = 0.f;
    for (int j = 0; j < 128; ++j) {
      const float kk = bf2f(base[(size_t)j * NW + OFF_KR + h * 64 + d]), vv = bf2f(base[(size_t)j * NW + OFF_VR + h * 128 + v]);
      s += kk * exp2f((float)(127 - j) * lg) * vv;
    }
    p.kvT[idx] = s;
  }
}
DI void phase_retscan(const Params& p, int bid, int nb) {
  const long total = 32L * 8192;
  const float* __restrict__ kv = p.kvT; bf16_t* __restrict__ stp = p.stT;
  for (long idx = (long)bid * blockDim.x + threadIdx.x; idx < total; idx += (long)nb * blockDim.x) {
    const int e = (int)(idx & 8191), bh = (int)(idx >> 13), h = bh & 3;
    const float cd = exp2f(128.0f * ret_log2g(h));
    float kr[31];
#pragma unroll
    for (int n = 0; n < 31; ++n) kr[n] = kv[((size_t)(bh * 32 + n) << 13) + e];
    float s = 0.f;
#pragma unroll
    for (int n = 0; n < 32; ++n) {
      stp[((size_t)(bh * 32 + n) << 13) + e] = f2bf(s);
      if (n < 31) s = s * cd + kr[n];
    }
  }
}
DI void phase_retout_naive(const Params& p, int bid, int nb) {
  const long total = 1024L * 256;
  for (long idx = (long)bid * blockDim.x + threadIdx.x; idx < total; idx += (long)nb * blockDim.x) {
    const int vh = (int)(idx & 1), i = (int)((idx >> 1) & 127), u = (int)(idx >> 8);
    const int n = u & 31, h = (u >> 5) & 3, b = u >> 7;
    const float lg = ret_log2g(h);
    const int tok0 = b * SEQ + n * 128, tok = tok0 + i;
    float o[64];
#pragma unroll
    for (int v = 0; v < 64; ++v) o[v] = 0.f;
    const bf16_t* qrow = p.proj + (size_t)tok * NW + OFF_QR + h * 64;
    for (int j = 0; j <= i; ++j) {
      const bf16_t* krow = p.proj + (size_t)(tok0 + j) * NW + OFF_KR + h * 64;
      float s = 0.f;
#pragma unroll
      for (int c = 0; c < 8; ++c) {
        const u32x4 a = *(const u32x4*)(qrow + c * 8), w = *(const u32x4*)(krow + c * 8);
        s += bflo(a.x) * bflo(w.x) + bfhi(a.x) * bfhi(w.x) + bflo(a.y) * bflo(w.y) + bfhi(a.y) * bfhi(w.y)
           + bflo(a.z) * bflo(w.z) + bfhi(a.z) * bfhi(w.z) + bflo(a.w) * bflo(w.w) + bfhi(a.w) * bfhi(w.w);
      }
      s *= exp2f((float)(i - j) * lg);
      const bf16_t* vrow = p.proj + (size_t)(tok0 + j) * NW + OFF_VR + h * 128 + vh * 64;
#pragma unroll
      for (int c = 0; c < 8; ++c) {
        const u32x4 w = *(const u32x4*)(vrow + c * 8);
        o[c * 8 + 0] += s * bflo(w.x); o[c * 8 + 1] += s * bfhi(w.x); o[c * 8 + 2] += s * bflo(w.y); o[c * 8 + 3] += s * bfhi(w.y);
        o[c * 8 + 4] += s * bflo(w.z); o[c * 8 + 5] += s * bfhi(w.z); o[c * 8 + 6] += s * bflo(w.w); o[c * 8 + 7] += s * bfhi(w.w);
      }
    }
    const float qd = exp2f((float)(i + 1) * lg);
    const bf16_t* st = p.stT + ((size_t)u << 13) + vh * 64 * 64;
    for (int d = 0; d < 64; ++d) {
      const float qq = bf2f(qrow[d]) * qd;
#pragma unroll
      for (int v = 0; v < 64; ++v) o[v] += qq * bf2f(st[v * 64 + d]);
    }
    float mu = 0.f;
#pragma unroll
    for (int v = 0; v < 64; ++v) mu += o[v];
    mu += __shfl_xor(mu, 1);
    mu *= (1.0f / 128.0f);
    float var = 0.f;
#pragma unroll
    for (int v = 0; v < 64; ++v) { const float dd = o[v] - mu; var += dd * dd; }
    var += __shfl_xor(var, 1);
    const float rs = rsqrtf(var * (1.0f / 128.0f) + 1e-5f);
    const bf16_t* gr = p.proj + (size_t)tok * NW + OFF_GR + h * 128 + vh * 64;
    bf16_t* mo = p.mixed + (size_t)tok * DM + 512 + h * 128 + vh * 64;
#pragma unroll
    for (int c = 0; c < 8; ++c) {
      const u32x4 w = *(const u32x4*)(gr + c * 8);
      float g[8] = {bflo(w.x), bfhi(w.x), bflo(w.y), bfhi(w.y), bflo(w.z), bfhi(w.z), bflo(w.w), bfhi(w.w)};
      float r[8];
#pragma unroll
      for (int e = 0; e < 8; ++e) r[e] = (o[c * 8 + e] - mu) * rs * p.gn[h * 128 + vh * 64 + c * 8 + e] * (g[e] / (1.0f + __expf(-g[e])));
      u32x4 ww; ww.x = pack2(r[0], r[1]); ww.y = pack2(r[2], r[3]); ww.z = pack2(r[4], r[5]); ww.w = pack2(r[6], r[7]);
      *(u32x4*)(mo + c * 8) = ww;
    }
  }
}

typedef float f32x16 __attribute__((ext_vector_type(16)));
typedef short s16x4 __attribute__((ext_vector_type(4)));
#define MFMA32(a, b, c) __builtin_amdgcn_mfma_f32_32x32x16_bf16((a), (b), (c), 0, 0, 0)
DI s16x4 tr_read(LAS unsigned char* a) { return __builtin_amdgcn_ds_read_tr16_b64_v4i16((LAS s16x4*)a); }
DI bf16x8 tr_frag(LAS unsigned char* a, int rowstride8) {
  const s16x4 lo = tr_read(a), hi = tr_read(a + rowstride8);
  return __builtin_shufflevector(lo, hi, 0, 1, 2, 3, 4, 5, 6, 7);
}
DI bf16x8 pack8(const f32x16& x, int s) {
  u32x4 w;
  w.x = pack2(x[8 * s + 0], x[8 * s + 1]); w.y = pack2(x[8 * s + 2], x[8 * s + 3]); w.z = pack2(x[8 * s + 4], x[8 * s + 5]); w.w = pack2(x[8 * s + 6], x[8 * s + 7]);
  return __builtin_bit_cast(bf16x8, w);
}
DI float fexp2(float x) { return __builtin_amdgcn_exp2f(x); }
DI float silu(float g) { return g / (1.0f + __expf(-g)); }

constexpr int AT_ROWB = 136, AT_LS = 512 * AT_ROWB, AT_VST = AT_LS + 2048, VROW = 192, VST_W = 32 * VROW;
constexpr float LOG2E = 1.4426950408889634f;

DI void attn_task(const Params& p, LAS unsigned char* lds, LAS unsigned char* vst, const int lane, const int tokbase, const int hh, const int pbase,
                  const int sh, const int r_res, const int l0, const bool first) {
  const int r = lane & 31, h = lane >> 5;
  const int i16 = lane & 15, q4 = i16 >> 2, pp = i16 & 3, blk = (lane >> 4) & 1;
  LAS unsigned char* trp = vst + (4 * h + q4) * VROW + 32 * blk + 8 * pp;
  const int pq = r_res + ((l0 + r) << sh), qloc = pq - pbase;
  const bf16_t* qp = p.proj + (size_t)(tokbase + pq) * NW + OFF_QA + hh * 64 + 8 * h;
  bf16x8 Qf[4];
#pragma unroll
  for (int ks = 0; ks < 4; ++ks) Qf[ks] = *(const bf16x8*)(qp + 16 * ks);
  f32x16 O0, O1;
#pragma unroll
  for (int i = 0; i < 16; ++i) { O0[i] = 0.f; O1[i] = 0.f; }
  float m = -1e30f, l = 0.f;
  const int kt0 = (l0 >= 128) ? 0 : (4 - (l0 >> 5));
  bf16x8 Kn[4]; u32x4 Vn[4];
#define LOAD_KV(kt_) do { const int lk0_ = l0 - 128 + 32 * (kt_); \
    const bf16_t* kp_ = p.proj + (size_t)(tokbase + r_res + ((lk0_ + r) << sh)) * NW + OFF_KA + hh * 64 + 8 * h; \
    const bf16_t* vp_ = p.proj + (size_t)(tokbase + r_res + ((lk0_ + (lane >> 1)) << sh)) * NW + OFF_VA + hh * 64 + 32 * (lane & 1); \
    _Pragma("unroll") for (int c_ = 0; c_ < 4; ++c_) { Kn[c_] = *(const bf16x8*)(kp_ + 16 * c_); Vn[c_] = *(const u32x4*)(vp_ + 8 * c_); } } while (0)
  LOAD_KV(kt0);
  for (int kt = kt0; kt < 5; ++kt) {
    bf16x8 Kc[4]; u32x4 Vc[4];
#pragma unroll
    for (int c = 0; c < 4; ++c) { Kc[c] = Kn[c]; Vc[c] = Vn[c]; }
    if (kt < 4) LOAD_KV(kt + 1);
#pragma unroll
    for (int c = 0; c < 4; ++c) *(LAS u32x4*)(vst + (lane >> 1) * VROW + (lane & 1) * 64 + c * 16) = Vc[c];
    f32x16 S;
#pragma unroll
    for (int i = 0; i < 16; ++i) S[i] = 0.f;
#pragma unroll
    for (int ks = 0; ks < 4; ++ks) S = MFMA32(Kc[ks], Qf[ks], S);
    const bool m0 = (kt == 0), m4 = (kt == 4);
    float mx = -1e30f;
#pragma unroll
    for (int i = 0; i < 16; ++i) {
      const int keyrow = (i & 3) + 8 * (i >> 2) + 4 * h;
      const bool bad = (m0 && keyrow < r) || (m4 && keyrow > r);
      S[i] = bad ? -1e30f : S[i] * LOG2E;
      mx = fmaxf(mx, S[i]);
    }
    mx = fmaxf(mx, __shfl_xor(mx, 32));
    const float mn = fmaxf(m, mx), al = fexp2(m - mn);
    m = mn;
    float ps = 0.f;
#pragma unroll
    for (int i = 0; i < 16; ++i) { S[i] = fexp2(S[i] - mn); ps += S[i]; }
    ps += __shfl_xor(ps, 32);
    l = l * al + ps;
#pragma unroll
    for (int i = 0; i < 16; ++i) { O0[i] *= al; O1[i] *= al; }
#pragma unroll
    for (int s = 0; s < 2; ++s) {
      const bf16x8 Pb = pack8(S, s);
      const bf16x8 V0 = tr_frag(trp + 16 * s * VROW, 8 * VROW), V1 = tr_frag(trp + 16 * s * VROW + 64, 8 * VROW);
      O0 = MFMA32(V0, Pb, O0);
      O1 = MFMA32(V1, Pb, O1);
    }
  }
#undef LOAD_KV
  float lse = m + __log2f(l);
  float w1 = 1.0f / l, w0 = 0.f;
  LAS float* LS = (LAS float*)(lds + AT_LS);
  if (!first) {
    const float lp = LS[qloc];
    const float M = fmaxf(lse, lp), e1 = fexp2(lse - M), e0 = fexp2(lp - M), den = e0 + e1, id = 1.0f / den;
    w1 *= e1 * id; w0 = e0 * id; lse = M + __log2f(den);
  }
  LAS unsigned char* ob = lds + qloc * AT_ROWB + 8 * h;
#pragma unroll
  for (int dt = 0; dt < 2; ++dt)
#pragma unroll
    for (int g = 0; g < 4; ++g) {
      float f0, f1, f2, f3;
      if (dt == 0) { f0 = O0[4 * g] * w1; f1 = O0[4 * g + 1] * w1; f2 = O0[4 * g + 2] * w1; f3 = O0[4 * g + 3] * w1; }
      else { f0 = O1[4 * g] * w1; f1 = O1[4 * g + 1] * w1; f2 = O1[4 * g + 2] * w1; f3 = O1[4 * g + 3] * w1; }
      LAS u32x2* a = (LAS u32x2*)(ob + 64 * dt + 16 * g);
      if (!first) { const u32x2 pv = *a; f0 += w0 * bflo(pv.x); f1 += w0 * bfhi(pv.x); f2 += w0 * bflo(pv.y); f3 += w0 * bfhi(pv.y); }
      u32x2 wv; wv.x = pack2(f0, f1); wv.y = pack2(f2, f3);
      *a = wv;
    }
  if (h == 0) LS[qloc] = lse;
}

DI void phase_attn(LAS unsigned char* lds, const Params& p, int bid, int nb) {
  const int tid = threadIdx.x, wid = __builtin_amdgcn_readfirstlane(tid >> 6), lane = tid & 63;
  LAS unsigned char* vst = lds + AT_VST + wid * VST_W;
  for (int unit = bid; unit < 512; unit += nb) {
    const int u = unit & 7, hh = (unit >> 3) & 7, b = unit >> 6;
    const int tokbase = b * SEQ, pbase = 512 * u;
    for (int stage = 0; stage < 3; ++stage) {
      const int sh = stage == 0 ? 4 : (stage == 1 ? 2 : 0);
      for (int tk = 0; tk < 2; ++tk) {
        const int idx = wid + 8 * tk;
        int r_res, l0;
        if (stage == 0) { r_res = idx; l0 = 32 * u; }
        else if (stage == 1) { r_res = idx >> 2; l0 = 128 * u + 32 * (idx & 3); }
        else { r_res = 0; l0 = 512 * u + 32 * idx; }
        attn_task(p, lds, vst, lane, tokbase, hh, pbase, sh, r_res, l0, stage == 0);
      }
      __syncthreads();
    }
#pragma unroll
    for (int it = 0; it < 8; ++it) {
      const int c = tid + 512 * it, qloc = c >> 3, dc = c & 7;
      const u32x2 a0 = *(LAS u32x2*)(lds + qloc * AT_ROWB + dc * 16), a1 = *(LAS u32x2*)(lds + qloc * AT_ROWB + dc * 16 + 8);
      const size_t tok = (size_t)(tokbase + pbase + qloc);
      const u32x4 g = *(const u32x4*)(p.proj + tok * NW + OFF_GA + hh * 64 + dc * 8);
      u32x4 w;
      w.x = pack2(bflo(a0.x) * silu(bflo(g.x)), bfhi(a0.x) * silu(bfhi(g.x)));
      w.y = pack2(bflo(a0.y) * silu(bflo(g.y)), bfhi(a0.y) * silu(bfhi(g.y)));
      w.z = pack2(bflo(a1.x) * silu(bflo(g.z)), bfhi(a1.x) * silu(bfhi(g.z)));
      w.w = pack2(bflo(a1.y) * silu(bflo(g.w)), bfhi(a1.y) * silu(bfhi(g.w)));
      *(u32x4*)(p.mixed + tok * DM + hh * 64 + dc * 8) = w;
    }
    __syncthreads();
  }
}

constexpr int RV_ROW = 320, RK_ROW = 192, RV_OFF = 0, RK_OFF = 128 * RV_ROW  , RRED_OFF = RK_OFF + 128 * RK_ROW  ;

DI void phase_retkv(LAS unsigned char* lds, const Params& p, int bid, int nb) {
  const int tid = threadIdx.x, wid = __builtin_amdgcn_readfirstlane(tid >> 6), lane = tid & 63;
  const int r = lane & 31, h = lane >> 5, i16 = lane & 15, q4 = i16 >> 2, pp = i16 & 3, blk = (lane >> 4) & 1;
  const int vt = wid >> 1, dt = wid & 1;
  for (int u = bid; u < 1024; u += nb) {
    const int n = u & 31, hh = (u >> 5) & 3, b = u >> 7;
    const float lg = ret_log2g(hh);
    const bf16_t* base = p.proj + (size_t)(b * SEQ + n * 128) * NW;
#pragma unroll
    for (int it = 0; it < 4; ++it) {
      const int c = tid + 512 * it, j = c >> 4, cc = c & 15;
      *(LAS u32x4*)(lds + RV_OFF + j * RV_ROW + cc * 16) = *(const u32x4*)(base + (size_t)j * NW + OFF_VR + hh * 128 + cc * 8);
    }
#pragma unroll
    for (int it = 0; it < 2; ++it) {
      const int c = tid + 512 * it, j = c >> 3, cc = c & 7;
      const u32x4 w = *(const u32x4*)(base + (size_t)j * NW + OFF_KR + hh * 64 + cc * 8);
      const float dk = exp2f((float)(127 - j) * lg);
      u32x4 o;
      o.x = pack2(bflo(w.x) * dk, bfhi(w.x) * dk); o.y = pack2(bflo(w.y) * dk, bfhi(w.y) * dk);
      o.z = pack2(bflo(w.z) * dk, bfhi(w.z) * dk); o.w = pack2(bflo(w.w) * dk, bfhi(w.w) * dk);
      *(LAS u32x4*)(lds + RK_OFF + j * RK_ROW + cc * 16) = o;
    }
    __syncthreads();
    f32x16 acc;
#pragma unroll
    for (int i = 0; i < 16; ++i) acc[i] = 0.f;
    LAS unsigned char* va = lds + RV_OFF + (4 * h + q4) * RV_ROW + (32 * vt + 16 * blk + 4 * pp) * 2;
    LAS unsigned char* ka = lds + RK_OFF + (4 * h + q4) * RK_ROW + (32 * dt + 16 * blk + 4 * pp) * 2;
#pragma unroll
    for (int s = 0; s < 8; ++s) {
      const bf16x8 A = tr_frag(va + 16 * s * RV_ROW, 8 * RV_ROW), B = tr_frag(ka + 16 * s * RK_ROW, 8 * RK_ROW);
      acc = MFMA32(A, B, acc);
    }
    float* o = p.kvT + ((size_t)u << 13) + (32 * vt + 4 * h) * 64 + 32 * dt + r;
#pragma unroll
    for (int i = 0; i < 16; ++i) o[((i & 3) + 8 * (i >> 2)) * 64] = acc[i];
    __syncthreads();
  }
}

DI void phase_retout(LAS unsigned char* lds, const Params& p, int bid, int nb) {
  const int tid = threadIdx.x, wid = __builtin_amdgcn_readfirstlane(tid >> 6), lane = tid & 63;
  const int r = lane & 31, h = lane >> 5, i16 = lane & 15, q4 = i16 >> 2, pp = i16 & 3, blk = (lane >> 4) & 1;
  const int it = wid & 3, vh = wid >> 2;
  LAS float* red = (LAS float*)(lds + RRED_OFF);
  for (int u = bid; u < 1024; u += nb) {
    const int n = u & 31, hh = (u >> 5) & 3, b = u >> 7;
    const float lg = ret_log2g(hh);
    const int tok0 = b * SEQ + n * 128;
    const bf16_t* base = p.proj + (size_t)tok0 * NW;
#pragma unroll
    for (int k = 0; k < 4; ++k) {
      const int c = tid + 512 * k, j = c >> 4, cc = c & 15;
      *(LAS u32x4*)(lds + RV_OFF + j * RV_ROW + cc * 16) = *(const u32x4*)(base + (size_t)j * NW + OFF_VR + hh * 128 + cc * 8);
    }
    const int qi = 32 * it + r;
    const bf16_t* qp = base + (size_t)qi * NW + OFF_QR + hh * 64 + 8 * h;
    bf16x8 Qf[4];
#pragma unroll
    for (int ks = 0; ks < 4; ++ks) Qf[ks] = *(const bf16x8*)(qp + 16 * ks);
    f32x16 O0, O1;
#pragma unroll
    for (int i = 0; i < 16; ++i) { O0[i] = 0.f; O1[i] = 0.f; }
    {
      const bf16_t* st = p.stT + ((size_t)u << 13) + (size_t)(64 * vh + r) * 64 + 8 * h;
#pragma unroll
      for (int ks = 0; ks < 4; ++ks) {
        const bf16x8 A0 = *(const bf16x8*)(st + 16 * ks), A1 = *(const bf16x8*)(st + 32 * 64 + 16 * ks);
        O0 = MFMA32(A0, Qf[ks], O0);
        O1 = MFMA32(A1, Qf[ks], O1);
      }
      const float qd = exp2f((float)(qi + 1) * lg);
#pragma unroll
      for (int i = 0; i < 16; ++i) { O0[i] *= qd; O1[i] *= qd; }
    }
    __syncthreads();
    LAS unsigned char* va = lds + RV_OFF + (4 * h + q4) * RV_ROW + (64 * vh + 16 * blk + 4 * pp) * 2;
    for (int jt = 0; jt <= it; ++jt) {
      const bf16_t* kp = base + (size_t)(32 * jt + r) * NW + OFF_KR + hh * 64 + 8 * h;
      f32x16 S;
#pragma unroll
      for (int i = 0; i < 16; ++i) S[i] = 0.f;
#pragma unroll
      for (int ks = 0; ks < 4; ++ks) { const bf16x8 Kf = *(const bf16x8*)(kp + 16 * ks); S = MFMA32(Kf, Qf[ks], S); }
#pragma unroll
      for (int i = 0; i < 16; ++i) {
        const int dj = qi - (32 * jt + (i & 3) + 8 * (i >> 2) + 4 * h);
        S[i] = dj >= 0 ? S[i] * fexp2((float)dj * lg) : 0.f;
      }
#pragma unroll
      for (int s = 0; s < 2; ++s) {
        const bf16x8 Pb = pack8(S, s);
        const bf16x8 V0 = tr_frag(va + (32 * jt + 16 * s) * RV_ROW, 8 * RV_ROW), V1 = tr_frag(va + (32 * jt + 16 * s) * RV_ROW + 64, 8 * RV_ROW);
        O0 = MFMA32(V0, Pb, O0);
        O1 = MFMA32(V1, Pb, O1);
      }
    }
    float s1 = 0.f, s2 = 0.f;
#pragma unroll
    for (int i = 0; i < 16; ++i) { s1 += O0[i] + O1[i]; s2 += O0[i] * O0[i] + O1[i] * O1[i]; }
    s1 += __shfl_xor(s1, 32); s2 += __shfl_xor(s2, 32);
    if (h == 0) { red[(vh * 128 + qi) * 2] = s1; red[(vh * 128 + qi) * 2 + 1] = s2; }
    __syncthreads();
    s1 += red[((vh ^ 1) * 128 + qi) * 2]; s2 += red[((vh ^ 1) * 128 + qi) * 2 + 1];
    const float mu = s1 * (1.0f / 128.0f), var = fmaxf(s2 * (1.0f / 128.0f) - mu * mu, 0.f), rs = rsqrtf(var + 1e-5f);
    const size_t tok = (size_t)(tok0 + qi);
    const bf16_t* gr = p.proj + tok * NW + OFF_GR + hh * 128 + 64 * vh + 4 * h;
    bf16_t* mo = p.mixed + tok * DM + 512 + hh * 128 + 64 * vh + 4 * h;
    const float* gnp = p.gn + hh * 128 + 64 * vh + 4 * h;
#pragma unroll
    for (int dt = 0; dt < 2; ++dt)
#pragma unroll
      for (int g = 0; g < 4; ++g) {
        const int vo = 32 * dt + 8 * g;
        const u32x2 gw = *(const u32x2*)(gr + vo);
        const f32x4 gnv = *(const f32x4*)(gnp + vo);
        float f0, f1, f2, f3;
        if (dt == 0) { f0 = O0[4 * g]; f1 = O0[4 * g + 1]; f2 = O0[4 * g + 2]; f3 = O0[4 * g + 3]; }
        else { f0 = O1[4 * g]; f1 = O1[4 * g + 1]; f2 = O1[4 * g + 2]; f3 = O1[4 * g + 3]; }
        f0 = (f0 - mu) * rs * gnv[0] * silu(bflo(gw.x)); f1 = (f1 - mu) * rs * gnv[1] * silu(bfhi(gw.x));
        f2 = (f2 - mu) * rs * gnv[2] * silu(bflo(gw.y)); f3 = (f3 - mu) * rs * gnv[3] * silu(bfhi(gw.y));
        u32x2 wv; wv.x = pack2(f0, f1); wv.y = pack2(f2, f3);
        *(u32x2*)(mo + vo) = wv;
      }
    __syncthreads();
  }
}

DI void phase_final(const Params& p, int bid, int nb) {
  const int tid = threadIdx.x, lane = tid & 63, wid = tid >> 6, nw = blockDim.x >> 6;
  for (int row = bid * nw + wid; row < T_TOK; row += nb * nw) {
    const float rs = rsqrtf(p.rowss[row] * (1.0f / DM) + 1e-6f);
    float* yr = p.out + (size_t)row * DM;
#pragma unroll
    for (int it = 0; it < 4; ++it) {
      const f32x4 v = *(const f32x4*)(yr + it * 256 + lane * 4), g = *(const f32x4*)(p.fg + it * 256 + lane * 4);
      *(f32x4*)(yr + it * 256 + lane * 4) = v * rs * g;
    }
  }
}

DI void grid_barrier(unsigned* ctr, unsigned target) {
  asm volatile("s_waitcnt vmcnt(0) lgkmcnt(0)" ::: "memory");
  __syncthreads();
  if (threadIdx.x == 0) {
    __builtin_amdgcn_fence(__ATOMIC_RELEASE, "agent");
    asm volatile("s_waitcnt vmcnt(0)" ::: "memory");
    __hip_atomic_fetch_add(ctr, 1u, __ATOMIC_RELAXED, __HIP_MEMORY_SCOPE_AGENT);
    unsigned spins = 0;
    while (__hip_atomic_load(ctr, __ATOMIC_RELAXED, __HIP_MEMORY_SCOPE_AGENT) < target && spins < (1u << 22)) { __builtin_amdgcn_s_sleep(2); ++spins; }
    __builtin_amdgcn_fence(__ATOMIC_ACQUIRE, "agent");
    asm volatile("s_waitcnt vmcnt(0)" ::: "memory");
  }
  __syncthreads();
}

__global__ void __launch_bounds__(512) k_mega(Params p) {
  extern __shared__ __attribute__((aligned(16))) unsigned char shm_[];
  LAS unsigned char* shm = (LAS unsigned char*)shm_;
  const int bid = blockIdx.x, nb = gridDim.x;
  unsigned bar_n = 0;
#define GRID_BAR() do { bar_n += (unsigned)nb; grid_barrier(p.bar, bar_n); } while (0)
  phase_prep(p, bid, nb);
  GRID_BAR();
  phase_gemm<1>(shm, p, bid, nb);
  GRID_BAR();
  phase_attn(shm, p, bid, nb);
  phase_retkv(shm, p, bid, nb);
  GRID_BAR();
  phase_retscan(p, bid, nb);
  GRID_BAR();
  phase_retout(shm, p, bid, nb);
  GRID_BAR();
  phase_gemm<2>(shm, p, bid, nb);
}

extern "C" void kernel_launch(void* const* d_in, const int* in_sizes, int n_in, void* d_out, int out_size, void* d_ws, size_t ws_size, hipStream_t stream) {
  Params p{};
  p.x = (const float*)d_in[0]; p.ng = (const float*)d_in[1]; p.w_in = (const float*)d_in[2]; p.gn = (const float*)d_in[3];
  p.w_out = (const float*)d_in[4]; p.fg = (const float*)d_in[5];
  p.out = (float*)d_out;
  char* w = (char*)d_ws; size_t o = 0;
  auto take = [&](size_t bytes) { char* r = w + o; o += (bytes + 255) & ~(size_t)255; return r; };
  p.xb = (bf16_t*)take((size_t)T_TOK * DM * 2);
  p.proj = (bf16_t*)take((size_t)T_TOK * NW * 2);
  p.mixed = (bf16_t*)take((size_t)T_TOK * DM * 2);
  p.winT = (bf16_t*)take((size_t)NW * DM * 2);
  p.woutT = (bf16_t*)take((size_t)DM * DM * 2);
  p.rstd = (float*)take((size_t)T_TOK * 4);
  p.rowss = (float*)take((size_t)T_TOK * 4);
  p.ropeT = (float2*)take((size_t)SEQ * 32 * 8);
  p.retT = (float2*)take((size_t)SEQ * 32 * 8);
  p.kvT = (float*)take((size_t)1024 * 8192 * 4);
  p.stT = (bf16_t*)take((size_t)1024 * 8192 * 2);
  p.bar = (unsigned*)take(1024);
  static int grid_blocks = 0;
  if (!grid_blocks) {
    (void)hipFuncSetAttribute((const void*)k_mega, hipFuncAttributeMaxDynamicSharedMemorySize, GEMM_LDS);
    int dev = 0, cus = 0, per_cu = 0;
    (void)hipGetDevice(&dev);
    (void)hipDeviceGetAttribute(&cus, hipDeviceAttributeMultiprocessorCount, dev);
    (void)hipOccupancyMaxActiveBlocksPerMultiprocessor(&per_cu, k_mega, 512, GEMM_LDS);
    if (per_cu < 1) per_cu = 1;
    grid_blocks = cus;
  }
  (void)hipMemsetAsync(p.bar, 0, 1024, stream);
  hipLaunchKernelGGL(k_mega, dim3(grid_blocks), dim3(512), GEMM_LDS, stream, p);
}
```

```cpp
#include <hip/hip_runtime.h>
#include <hip/hip_cooperative_groups.h>
#include <cstdint>
#include <cstdio>
namespace cg = cooperative_groups;

typedef unsigned short bf16_t;
typedef short bf16x8 __attribute__((ext_vector_type(8)));
typedef float f32x4 __attribute__((ext_vector_type(4)));
typedef unsigned u32x4 __attribute__((ext_vector_type(4)));
typedef unsigned u32x2 __attribute__((ext_vector_type(2)));

constexpr int T_TOK = 32768, DM = 1024, NW = 3584, SEQ = 4096;
constexpr int OFF_QA = 0, OFF_KA = 512, OFF_VA = 1024, OFF_GA = 1536, OFF_QR = 2048, OFF_KR = 2304, OFF_VR = 2560, OFF_GR = 3072;

struct Params {
  const float* x; const float* ng; const float* w_in; const float* gn; const float* w_out; const float* fg;
  float* out;
  bf16_t* xb; bf16_t* proj; bf16_t* mixed; bf16_t* winT; bf16_t* woutT;
  float* rstd; float* rowss; float2* ropeT; float2* retT; float* kvT; bf16_t* stT; unsigned* bar; bf16_t* ob; float* lseg;
};

#define DI __device__ __forceinline__
DI unsigned short f2bf(float x) { unsigned u = __float_as_uint(x); u += 0x7fffu + ((u >> 16) & 1u); return (unsigned short)(u >> 16); }
DI float bf2f(unsigned short b) { return __uint_as_float(((unsigned)b) << 16); }
typedef float f32x2_t __attribute__((ext_vector_type(2)));
typedef __bf16 bf16x2_t __attribute__((ext_vector_type(2)));
DI unsigned pack2(float lo, float hi) { const f32x2_t v = {lo, hi}; return __builtin_bit_cast(unsigned, __builtin_convertvector(v, bf16x2_t)); }
DI float bflo(unsigned w) { return __uint_as_float(w << 16); }
DI float bfhi(unsigned w) { return __uint_as_float(w & 0xffff0000u); }
DI int perm32(int rho) { const int n = rho >> 4, i = rho & 15; return 8 * (i >> 2) + 4 * n + (i & 3); }
DI int cmap(int p) { return (p & ~31) + perm32(p & 31); }
DI int cmapA(int p) { return (p & ~127) + ((p >> 6) & 1) * 64 + ((p >> 4) & 1) * 32 + ((p >> 5) & 1) * 16 + (p & 15); }

DI void phase_prep(const Params& p, int bid, int nb) {
  const int tid = threadIdx.x, lane = tid & 63, wid = tid >> 6, nw = blockDim.x >> 6;
  for (int row0 = (bid * nw + wid) * 4; row0 < T_TOK; row0 += nb * nw * 4) {
    f32x4 v[4][4];
#pragma unroll
    for (int rr = 0; rr < 4; ++rr)
#pragma unroll
      for (int it = 0; it < 4; ++it) v[rr][it] = *(const f32x4*)(p.x + (size_t)(row0 + rr) * DM + it * 256 + lane * 4);
#pragma unroll
    for (int rr = 0; rr < 4; ++rr) {
      float ss = 0.f;
#pragma unroll
      for (int it = 0; it < 4; ++it) ss += v[rr][it][0] * v[rr][it][0] + v[rr][it][1] * v[rr][it][1] + v[rr][it][2] * v[rr][it][2] + v[rr][it][3] * v[rr][it][3];
#pragma unroll
      for (int o = 32; o >= 1; o >>= 1) ss += __shfl_xor(ss, o);
#pragma unroll
      for (int it = 0; it < 4; ++it) { u32x2 w; w.x = pack2(v[rr][it][0], v[rr][it][1]); w.y = pack2(v[rr][it][2], v[rr][it][3]); *(u32x2*)(p.xb + (size_t)(row0 + rr) * DM + it * 256 + lane * 4) = w; }
      if (lane == 0) p.rstd[row0 + rr] = rsqrtf(ss * (1.0f / DM) + 1e-6f);
    }
  }
  const int gt = bid * blockDim.x + tid, gn = nb * blockDim.x;
  for (int idx = gt; idx < NW * 128; idx += gn) {
    const int pp = idx % NW, kc = idx / NW, c = pp < 1024 ? cmapA(pp) : cmap(pp);
    float f[8];
#pragma unroll
    for (int j = 0; j < 8; ++j) { const int k = kc * 8 + j; f[j] = p.ng[k] * p.w_in[(size_t)k * NW + c]; }
    u32x4 w; w.x = pack2(f[0], f[1]); w.y = pack2(f[2], f[3]); w.z = pack2(f[4], f[5]); w.w = pack2(f[6], f[7]);
    *(u32x4*)(p.winT + (size_t)pp * DM + kc * 8) = w;
  }
  for (int idx = gt; idx < DM * 128; idx += gn) {
    const int pp = idx % DM, kc = idx / DM, c = cmap(pp);
    float f[8];
#pragma unroll
    for (int j = 0; j < 8; ++j) { const int k = kc * 8 + j; f[j] = p.w_out[(size_t)k * DM + c]; }
    u32x4 w; w.x = pack2(f[0], f[1]); w.y = pack2(f[2], f[3]); w.z = pack2(f[4], f[5]); w.w = pack2(f[6], f[7]);
    *(u32x4*)(p.woutT + (size_t)pp * DM + kc * 8) = w;
  }
  for (int idx = gt; idx < SEQ * 32; idx += gn) {
    const int pos = idx >> 5, i = idx & 31;
    const float inv1 = powf(10000.0f, -(float)i / 32.0f);
    const float inv2 = 1.0f / powf(10000.0f, (float)i / 31.0f);
    const float a1 = (float)pos * inv1, a2 = (float)pos * inv2;
    p.ropeT[idx] = make_float2(cosf(a1), sinf(a1));
    p.retT[idx] = make_float2(cosf(a2), sinf(a2));
  }
}

constexpr int BM = 256, BK = 64, HALF = 128, HT = HALF * BK;
constexpr int GEMM_LDS = 8 * HT * 2;
DI int lds_byte(int r, int c) { int st = (r >> 4) * 2 + (c >> 5), rr = r & 15, cc = c & 31, ob = rr * 64 + cc * 2; return st * 1024 + (ob ^ (((ob >> 9) & 1) << 5)); }
DI void stage_rc(int b, int& R, int& C) { int st = b / 1024, sb = b % 1024, swz = sb ^ (((sb >> 9) & 1) << 5); R = (st >> 1) * 16 + swz / 64; C = (st & 1) * 32 + (swz % 64) / 2; }

#define LAS __attribute__((address_space(3)))
template <int EPI>
DI void gemm_tile(LAS unsigned char* lds, const bf16_t* __restrict__ A, const bf16_t* __restrict__ Bt, const int brow, const int bcol, const Params& p) {
  constexpr int K = 1024, nt = K / BK, HTB = HALF * BK * 2;
  const int tid = threadIdx.x, wid = __builtin_amdgcn_readfirstlane(tid >> 6), lane = tid & 63, wr = wid >> 2, wc = wid & 3, fr = lane & 15, fq = lane >> 4;
  unsigned voff[2];
#pragma unroll
  for (int i = 0; i < 2; ++i) { int R, C; stage_rc(tid * 16 + i * 8192, R, C); voff[i] = (unsigned)(R * K + C) * 2u; }
  const unsigned ldsw = (unsigned)wid * 1024u;
  const int aoff = lds_byte(wr * 64 + fr, fq * 8), boff = lds_byte(wc * 32 + fr, fq * 8);
  const char* cA0 = (const char*)A + (size_t)brow * K * 2; const char* cA1 = cA0 + (size_t)HALF * K * 2;
  const char* cB0 = (const char*)Bt + (size_t)bcol * K * 2; const char* cB1 = cB0 + (size_t)HALF * K * 2;
#define SAo(b, h) (((b) * 2 + (h)) * HTB)
#define SBo(b, h) ((4 + (b) * 2 + (h)) * HTB)
#define STAGE(bufoff, gb, kt) do { _Pragma("unroll") for (int _i = 0; _i < 2; ++_i) \
    __builtin_amdgcn_global_load_lds((const unsigned*)((gb) + (size_t)(kt) * (BK * 2) + voff[_i]), (LAS unsigned*)(lds + (bufoff) + ldsw + _i * 8192), 16, 0, 0); } while (0)
#define LDA(dst, b, h) do { _Pragma("unroll") for (int m = 0; m < 4; ++m) _Pragma("unroll") for (int k = 0; k < 2; ++k) \
    dst[m][k] = *(const LAS bf16x8*)(lds + SAo(b, h) + aoff + m * 2048 + k * 1024); } while (0)
#define LDB(dst, b, h) do { _Pragma("unroll") for (int n = 0; n < 2; ++n) _Pragma("unroll") for (int k = 0; k < 2; ++k) \
    dst[n][k] = *(const LAS bf16x8*)(lds + SBo(b, h) + boff + n * 2048 + k * 1024); } while (0)
#define MMA(ai, bj, At, Bt_) do { __builtin_amdgcn_s_setprio(1); \
    _Pragma("unroll") for (int m = 0; m < 4; ++m) _Pragma("unroll") for (int n = 0; n < 2; ++n) _Pragma("unroll") for (int k = 0; k < 2; ++k) \
      acc[ai][bj][m][n] = __builtin_amdgcn_mfma_f32_16x16x32_bf16(Bt_[n][k], At[m][k], acc[ai][bj][m][n], 0, 0, 0); \
    __builtin_amdgcn_s_setprio(0); } while (0)
#define WAIT_V(n) asm volatile("s_waitcnt vmcnt(" #n ")" ::: "memory")
#define WAIT_L(n) asm volatile("s_waitcnt lgkmcnt(" #n ")" ::: "memory")
#define BAR __builtin_amdgcn_s_barrier()
#define SCHED __builtin_amdgcn_sched_barrier(0)
  f32x4 acc[2][2][4][2];
#pragma unroll
  for (int a = 0; a < 2; ++a)
#pragma unroll
    for (int b = 0; b < 2; ++b)
#pragma unroll
      for (int m = 0; m < 4; ++m)
#pragma unroll
        for (int n = 0; n < 2; ++n) acc[a][b][m][n] = (f32x4){0.f, 0.f, 0.f, 0.f};
  bf16x8 At[4][2], B0[2][2], B1[2][2];
  WAIT_V(0);
  STAGE(SBo(0, 0), cB0, 0); STAGE(SAo(0, 0), cA0, 0);
  STAGE(SBo(0, 1), cB1, 0); STAGE(SAo(0, 1), cA1, 0);
  if (wr == 1) BAR;
  WAIT_V(4); BAR;
  STAGE(SBo(1, 0), cB0, 1); STAGE(SAo(1, 0), cA0, 1); STAGE(SBo(1, 1), cB1, 1);
  WAIT_V(6); BAR;
  for (int t = 0; t < nt - 2; t += 2) {
    LDB(B0, 0, 0); SCHED; LDA(At, 0, 0); STAGE(SAo(1, 1), cA1, t + 1);
    WAIT_L(8); BAR; WAIT_L(0); MMA(0, 0, At, B0); BAR; SCHED;
    LDB(B1, 0, 1); STAGE(SBo(0, 0), cB0, t + 2);
    BAR; WAIT_L(0); MMA(0, 1, At, B1); BAR;
    LDA(At, 0, 1); STAGE(SAo(0, 0), cA0, t + 2);
    BAR; WAIT_L(0); MMA(1, 0, At, B0); BAR; SCHED;
    STAGE(SBo(0, 1), cB1, t + 2);
    WAIT_V(6); BAR; MMA(1, 1, At, B1); BAR;
    LDB(B0, 1, 0); SCHED; LDA(At, 1, 0); STAGE(SAo(0, 1), cA1, t + 2);
    WAIT_L(8); BAR; WAIT_L(0); MMA(0, 0, At, B0); BAR; SCHED;
    LDB(B1, 1, 1); STAGE(SBo(1, 0), cB0, t + 3);
    BAR; WAIT_L(0); MMA(0, 1, At, B1); BAR;
    LDA(At, 1, 1); STAGE(SAo(1, 0), cA0, t + 3);
    BAR; WAIT_L(0); MMA(1, 0, At, B0); BAR; SCHED;
    STAGE(SBo(1, 1), cB1, t + 3);
    WAIT_V(6); BAR; MMA(1, 1, At, B1); BAR;
  }
  { LDB(B0, 0, 0); LDA(At, 0, 0); STAGE(SAo(1, 1), cA1, nt - 1);
    BAR; WAIT_L(0); MMA(0, 0, At, B0); BAR;
    LDB(B1, 0, 1); BAR; WAIT_L(0); MMA(0, 1, At, B1); BAR;
    LDA(At, 0, 1); WAIT_V(4); BAR; WAIT_L(0); MMA(1, 0, At, B0); MMA(1, 1, At, B1); BAR; }
  { LDB(B0, 1, 0); LDA(At, 1, 0); WAIT_V(2); BAR; WAIT_L(0); MMA(0, 0, At, B0); BAR;
    LDB(B1, 1, 1); WAIT_V(0); BAR; WAIT_L(0); MMA(0, 1, At, B1); BAR;
    LDA(At, 1, 1); BAR; WAIT_L(0); MMA(1, 0, At, B0); MMA(1, 1, At, B1); BAR; }
  if (wr == 0) BAR;
  if (EPI == 1) {
    const int pn = bcol >> 8;
    if (pn < 4) {
      const float sc = pn < 2 ? 0.125f * 1.4426950408889634f : 1.0f;
      const int i0 = 16 * (wc & 1) + 4 * fq;
#pragma unroll
      for (int ai = 0; ai < 2; ++ai)
#pragma unroll
        for (int m = 0; m < 4; ++m) {
          const int row = brow + ai * HALF + wr * 64 + m * 16 + fr;
          const float rs = p.rstd[row] * sc;
          const float* tb = (const float*)(p.ropeT + (row & (SEQ - 1)) * 32 + i0);
          const f32x4 t0 = *(const f32x4*)tb, t1 = *(const f32x4*)(tb + 4);
#pragma unroll
          for (int bj = 0; bj < 2; ++bj) {
            const f32x4 x1 = acc[ai][bj][m][0] * rs, x2 = acc[ai][bj][m][1] * rs;
            u32x2 wa, wb;
            wa.x = pack2(x1[0] * t0[0] - x2[0] * t0[1], x1[1] * t0[2] - x2[1] * t0[3]);
            wa.y = pack2(x1[2] * t1[0] - x2[2] * t1[1], x1[3] * t1[2] - x2[3] * t1[3]);
            wb.x = pack2(x2[0] * t0[0] + x1[0] * t0[1], x2[1] * t0[2] + x1[1] * t0[3]);
            wb.y = pack2(x2[2] * t1[0] + x1[2] * t1[1], x2[3] * t1[2] + x1[3] * t1[3]);
            bf16_t* o = p.proj + (size_t)row * NW + bcol + bj * HALF + (wc >> 1) * 64 + i0;
            *(u32x2*)o = wa; *(u32x2*)(o + 32) = wb;
          }
        }
    } else if (pn == 8 || pn == 9) {
      const float sc = pn == 9 ? 0.125f : 1.0f;
      const int i0 = 16 * (wc & 1) + 4 * fq;
#pragma unroll
      for (int ai = 0; ai < 2; ++ai)
#pragma unroll
        for (int m = 0; m < 4; ++m) {
          const int row = brow + ai * HALF + wr * 64 + m * 16 + fr;
          const float rs = p.rstd[row] * sc;
          const float* tb = (const float*)(p.retT + (row & (SEQ - 1)) * 32 + i0);
          const f32x4 t0 = *(const f32x4*)tb, t1 = *(const f32x4*)(tb + 4);
#pragma unroll
          for (int bj = 0; bj < 2; ++bj) {
            const f32x4 v0 = acc[ai][bj][m][0] * rs, v1 = acc[ai][bj][m][1] * rs;
            u32x4 w;
            w.x = pack2(v0[0] * t0[0] - v0[1] * t0[1], v0[1] * t0[0] + v0[0] * t0[1]);
            w.y = pack2(v0[2] * t0[2] - v0[3] * t0[3], v0[3] * t0[2] + v0[2] * t0[3]);
            w.z = pack2(v1[0] * t1[0] - v1[1] * t1[1], v1[1] * t1[0] + v1[0] * t1[1]);
            w.w = pack2(v1[2] * t1[2] - v1[3] * t1[3], v1[3] * t1[2] + v1[2] * t1[3]);
            *(u32x4*)(p.proj + (size_t)row * NW + bcol + bj * HALF + wc * 32 + 8 * fq) = w;
          }
        }
    } else {
#pragma unroll
    for (int ai = 0; ai < 2; ++ai)
#pragma unroll
      for (int m = 0; m < 4; ++m) {
        const int row = brow + ai * HALF + wr * 64 + m * 16 + fr;
        const float rs = p.rstd[row];
#pragma unroll
        for (int bj = 0; bj < 2; ++bj) {
          const f32x4 v0 = acc[ai][bj][m][0] * rs, v1 = acc[ai][bj][m][1] * rs;
          u32x4 w; w.x = pack2(v0[0], v0[1]); w.y = pack2(v0[2], v0[3]); w.z = pack2(v1[0], v1[1]); w.w = pack2(v1[2], v1[3]);
          *(u32x4*)(p.proj + (size_t)row * NW + bcol + bj * HALF + wc * 32 + 8 * fq) = w;
        }
      }
    }
  } else {
    const int pm = brow >> 8, pn = bcol >> 8;
    LAS float* part = (LAS float*)lds;
    LAS float* rsl = (LAS float*)(lds + 4096);
#pragma unroll
    for (int ai = 0; ai < 2; ++ai)
#pragma unroll
      for (int m = 0; m < 4; ++m) {
        const int rl = ai * HALF + wr * 64 + m * 16 + fr;
        float ss = 0.f;
#pragma unroll
        for (int bj = 0; bj < 2; ++bj) {
          const size_t off = (size_t)(brow + rl) * DM + bcol + bj * HALF + wc * 32 + 8 * fq;
          const f32x4 x0 = *(const f32x4*)(p.x + off), x1 = *(const f32x4*)(p.x + off + 4);
          const f32x4 y0 = acc[ai][bj][m][0] + x0, y1 = acc[ai][bj][m][1] + x1;
          acc[ai][bj][m][0] = y0; acc[ai][bj][m][1] = y1;
          ss += y0[0] * y0[0] + y0[1] * y0[1] + y0[2] * y0[2] + y0[3] * y0[3] + y1[0] * y1[0] + y1[1] * y1[1] + y1[2] * y1[2] + y1[3] * y1[3];
        }
        ss += __shfl_xor(ss, 16); ss += __shfl_xor(ss, 32);
        if (fq == 0) part[wc * 256 + rl] = ss;
      }
    __syncthreads();
    float* xs = p.rowss + (size_t)(pm * 4) * 256;
    if (tid < 256) {
      const float tot = part[tid] + part[256 + tid] + part[512 + tid] + part[768 + tid];
      __hip_atomic_store(xs + pn * 256 + tid, tot, __ATOMIC_RELAXED, __HIP_MEMORY_SCOPE_AGENT);
    }
    asm volatile("s_waitcnt vmcnt(0)" ::: "memory");
    __syncthreads();
    unsigned* cnt = p.bar + 64 + pm;
    if (tid == 0) __hip_atomic_fetch_add(cnt, 1u, __ATOMIC_RELAXED, __HIP_MEMORY_SCOPE_AGENT);
    if (wid == 0) {
      unsigned spins = 0;
      while (__hip_atomic_load(cnt, __ATOMIC_RELAXED, __HIP_MEMORY_SCOPE_AGENT) < 4u && spins < (1u << 20)) { __builtin_amdgcn_s_sleep(1); ++spins; }
      __builtin_amdgcn_fence(__ATOMIC_ACQUIRE, "agent");
      asm volatile("s_waitcnt vmcnt(0)" ::: "memory");
    }
    __syncthreads();
    if (tid < 256) {
      float t = 0.f;
#pragma unroll
      for (int q = 0; q < 4; ++q) t += __hip_atomic_load(xs + q * 256 + tid, __ATOMIC_RELAXED, __HIP_MEMORY_SCOPE_AGENT);
      rsl[tid] = rsqrtf(t * (1.0f / DM) + 1e-6f);
    }
    __syncthreads();
#pragma unroll
    for (int ai = 0; ai < 2; ++ai)
#pragma unroll
      for (int m = 0; m < 4; ++m) {
        const int rl = ai * HALF + wr * 64 + m * 16 + fr;
        const float rs = rsl[rl];
#pragma unroll
        for (int bj = 0; bj < 2; ++bj) {
          const int col = bcol + bj * HALF + wc * 32 + 8 * fq;
          const f32x4 g0 = *(const f32x4*)(p.fg + col), g1 = *(const f32x4*)(p.fg + col + 4);
          float* o = p.out + (size_t)(brow + rl) * DM + col;
          *(f32x4*)o = acc[ai][bj][m][0] * rs * g0; *(f32x4*)(o + 4) = acc[ai][bj][m][1] * rs * g1;
        }
      }
    __syncthreads();
  }
}

DI void tile_of(int L, int nM, int nN, int& pm, int& pn) {
  const int nwg = nM * nN, NX = 8, WGM = 8;
  int wgid = L; { const int q = nwg / NX, r = nwg % NX, xcd = wgid % NX, off = wgid / NX; wgid = (xcd < r ? xcd * (q + 1) : r * (q + 1) + (xcd - r) * q) + off; }
  const int nig = WGM * nN, gid = wgid / nig, fm = gid * WGM, gsz = (nM - fm) < WGM ? (nM - fm) : WGM;
  pm = fm + ((wgid % nig) % gsz); pn = (wgid % nig) / gsz;
}

template <int EPI>
DI void phase_gemm(LAS unsigned char* shm, const Params& p, int bid, int nb) {
  const int nM = T_TOK / BM, nN = (EPI == 1 ? NW : DM) / BM;
  for (int L = bid; L < nM * nN; L += nb) {
    int pm, pn; tile_of(L, nM, nN, pm, pn);
    if (EPI == 1) gemm_tile<1>(shm, p.xb, p.winT, pm * BM, pn * BM, p);
    else gemm_tile<2>(shm, p.mixed, p.woutT, pm * BM, pn * BM, p);
  }
}

DI void phase_rotary(const Params& p, int bid, int nb) {
  const long total = (long)T_TOK * 768;
  for (long idx = (long)bid * blockDim.x + threadIdx.x; idx < total; idx += (long)nb * blockDim.x) {
    const int tok = (int)(idx / 768); int j = (int)(idx % 768);
    const int pos = tok & (SEQ - 1);
    int a, b; float sc; const float2* tab;
    if (j < 256) { const int h = j >> 5, i = j & 31; a = OFF_QA + h * 64 + i; b = a + 32; sc = 0.125f; tab = p.ropeT + pos * 32 + i; }
    else if (j < 512) { j -= 256; const int h = j >> 5, i = j & 31; a = OFF_KA + h * 64 + i; b = a + 32; sc = 1.f; tab = p.ropeT + pos * 32 + i; }
    else if (j < 640) { j -= 512; const int h = j >> 5, i = j & 31; a = OFF_QR + h * 64 + 2 * i; b = a + 1; sc = 1.f; tab = p.retT + pos * 32 + i; }
    else { j -= 640; const int h = j >> 5, i = j & 31; a = OFF_KR + h * 64 + 2 * i; b = a + 1; sc = 0.125f; tab = p.retT + pos * 32 + i; }
    const float2 cs = *tab;
    bf16_t* row = p.proj + (size_t)tok * NW;
    const float x1 = bf2f(row[a]), x2 = bf2f(row[b]);
    row[a] = f2bf((x1 * cs.x - x2 * cs.y) * sc);
    row[b] = f2bf((x2 * cs.x + x1 * cs.y) * sc);
  }
}

DI void load_row64(const bf16_t* src, float* dst) {
#pragma unroll
  for (int c = 0; c < 8; ++c) {
    const u32x4 w = *(const u32x4*)(src + c * 8);
    dst[c * 8 + 0] = bflo(w.x); dst[c * 8 + 1] = bfhi(w.x); dst[c * 8 + 2] = bflo(w.y); dst[c * 8 + 3] = bfhi(w.y);
    dst[c * 8 + 4] = bflo(w.z); dst[c * 8 + 5] = bfhi(w.z); dst[c * 8 + 6] = bflo(w.w); dst[c * 8 + 7] = bfhi(w.w);
  }
}

DI void phase_attn_naive(const Params& p, int bid, int nb) {
  const long total = (long)T_TOK * 8;
  for (long idx = (long)bid * blockDim.x + threadIdx.x; idx < total; idx += (long)nb * blockDim.x) {
    const int h = (int)(idx & 7), tok = (int)(idx >> 3);
    const int pos = tok & (SEQ - 1), tb = tok - pos;
    float q[64], o[64];
    load_row64(p.proj + (size_t)tok * NW + OFF_QA + h * 64, q);
#pragma unroll
    for (int d = 0; d < 64; ++d) o[d] = 0.f;
    float m = -1e30f, l = 0.f;
    for (int br = 0; br < 3; ++br) {
      const int dl = br == 0 ? 1 : (br == 1 ? 4 : 16);
      for (int j = 0; j <= 128; ++j) {
        const int pk = pos - j * dl; if (pk < 0) break;
        const bf16_t* kr = p.proj + (size_t)(tb + pk) * NW + OFF_KA + h * 64;
        float s = 0.f;
#pragma unroll
        for (int c = 0; c < 8; ++c) {
          const u32x4 w = *(const u32x4*)(kr + c * 8);
          s += q[c * 8 + 0] * bflo(w.x) + q[c * 8 + 1] * bfhi(w.x) + q[c * 8 + 2] * bflo(w.y) + q[c * 8 + 3] * bfhi(w.y)
             + q[c * 8 + 4] * bflo(w.z) + q[c * 8 + 5] * bfhi(w.z) + q[c * 8 + 6] * bflo(w.w) + q[c * 8 + 7] * bfhi(w.w);
        }
        const float mn = fmaxf(m, s), al = __expf(m - mn), pe = __expf(s - mn);
        m = mn; l = l * al + pe;
        const bf16_t* vr = kr + (OFF_VA - OFF_KA);
#pragma unroll
        for (int c = 0; c < 8; ++c) {
          const u32x4 w = *(const u32x4*)(vr + c * 8);
          o[c * 8 + 0] = o[c * 8 + 0] * al + pe * bflo(w.x); o[c * 8 + 1] = o[c * 8 + 1] * al + pe * bfhi(w.x);
          o[c * 8 + 2] = o[c * 8 + 2] * al + pe * bflo(w.y); o[c * 8 + 3] = o[c * 8 + 3] * al + pe * bfhi(w.y);
          o[c * 8 + 4] = o[c * 8 + 4] * al + pe * bflo(w.z); o[c * 8 + 5] = o[c * 8 + 5] * al + pe * bfhi(w.z);
          o[c * 8 + 6] = o[c * 8 + 6] * al + pe * bflo(w.w); o[c * 8 + 7] = o[c * 8 + 7] * al + pe * bfhi(w.w);
        }
      }
    }
    const float il = 1.0f / l;
    const bf16_t* gr = p.proj + (size_t)tok * NW + OFF_GA + h * 64;
    bf16_t* mo = p.mixed + (size_t)tok * DM + h * 64;
#pragma unroll
    for (int c = 0; c < 8; ++c) {
      const u32x4 w = *(const u32x4*)(gr + c * 8);
      float g[8] = {bflo(w.x), bfhi(w.x), bflo(w.y), bfhi(w.y), bflo(w.z), bfhi(w.z), bflo(w.w), bfhi(w.w)};
      float r[8];
#pragma unroll
      for (int e = 0; e < 8; ++e) r[e] = o[c * 8 + e] * il * (g[e] / (1.0f + __expf(-g[e])));
      u32x4 ww; ww.x = pack2(r[0], r[1]); ww.y = pack2(r[2], r[3]); ww.z = pack2(r[4], r[5]); ww.w = pack2(r[6], r[7]);
      *(u32x4*)(mo + c * 8) = ww;
    }
  }
}

DI float ret_log2g(int h) { return log2f(1.0f - exp2f(-5.0f - (float)h)); }

DI void phase_retkv_naive(const Params& p, int bid, int nb) {
  const long total = 1024L * 8192;
  for (long idx = (long)bid * blockDim.x + threadIdx.x; idx < total; idx += (long)nb * blockDim.x) {
    const int d = (int)(idx & 63), v = (int)((idx >> 6) & 127), u = (int)(idx >> 13);
    const int n = u & 31, h = (u >> 5) & 3, b = u >> 7;
    const float lg = ret_log2g(h);
    const bf16_t* base = p.proj + (size_t)(b * SEQ + n * 128) * NW;
    float s = 0.f;
    for (int j = 0; j < 128; ++j) {
      const float kk = bf2f(base[(size_t)j * NW + OFF_KR + h * 64 + d]), vv = bf2f(base[(size_t)j * NW + OFF_VR + h * 128 + v]);
      s += kk * exp2f((float)(127 - j) * lg) * vv;
    }
    p.kvT[idx] = s;
  }
}
DI void phase_retscan(const Params& p, int bid, int nb) {
  const long total = 32L * 4096;
  typedef float f32x2 __attribute__((ext_vector_type(2)));
  const float* __restrict__ kv = p.kvT; bf16_t* __restrict__ stp = p.stT;
  for (long idx = (long)bid * blockDim.x + threadIdx.x; idx < total; idx += (long)nb * blockDim.x) {
    const int e = (int)(idx & 4095) * 2, bh = (int)(idx >> 12), h = bh & 3;
    const float cd = exp2f(128.0f * ret_log2g(h));
    f32x2 kr[31];
#pragma unroll
    for (int n = 0; n < 31; ++n) kr[n] = *(const f32x2*)(kv + ((size_t)(bh * 32 + n) << 13) + e);
    float s0 = 0.f, s1 = 0.f;
#pragma unroll
    for (int n = 0; n < 32; ++n) {
      *(unsigned*)(stp + ((size_t)(bh * 32 + n) << 13) + e) = pack2(s0, s1);
      if (n < 31) { s0 = s0 * cd + kr[n][0]; s1 = s1 * cd + kr[n][1]; }
    }
  }
}
DI void phase_retout_naive(const Params& p, int bid, int nb) {
  const long total = 1024L * 256;
  for (long idx = (long)bid * blockDim.x + threadIdx.x; idx < total; idx += (long)nb * blockDim.x) {
    const int vh = (int)(idx & 1), i = (int)((idx >> 1) & 127), u = (int)(idx >> 8);
    const int n = u & 31, h = (u >> 5) & 3, b = u >> 7;
    const float lg = ret_log2g(h);
    const int tok0 = b * SEQ + n * 128, tok = tok0 + i;
    float o[64];
#pragma unroll
    for (int v = 0; v < 64; ++v) o[v] = 0.f;
    const bf16_t* qrow = p.proj + (size_t)tok * NW + OFF_QR + h * 64;
    for (int j = 0; j <= i; ++j) {
      const bf16_t* krow = p.proj + (size_t)(tok0 + j) * NW + OFF_KR + h * 64;
      float s = 0.f;
#pragma unroll
      for (int c = 0; c < 8; ++c) {
        const u32x4 a = *(const u32x4*)(qrow + c * 8), w = *(const u32x4*)(krow + c * 8);
        s += bflo(a.x) * bflo(w.x) + bfhi(a.x) * bfhi(w.x) + bflo(a.y) * bflo(w.y) + bfhi(a.y) * bfhi(w.y)
           + bflo(a.z) * bflo(w.z) + bfhi(a.z) * bfhi(w.z) + bflo(a.w) * bflo(w.w) + bfhi(a.w) * bfhi(w.w);
      }
      s *= exp2f((float)(i - j) * lg);
      const bf16_t* vrow = p.proj + (size_t)(tok0 + j) * NW + OFF_VR + h * 128 + vh * 64;
#pragma unroll
      for (int c = 0; c < 8; ++c) {
        const u32x4 w = *(const u32x4*)(vrow + c * 8);
        o[c * 8 + 0] += s * bflo(w.x); o[c * 8 + 1] += s * bfhi(w.x); o[c * 8 + 2] += s * bflo(w.y); o[c * 8 + 3] += s * bfhi(w.y);
        o[c * 8 + 4] += s * bflo(w.z); o[c * 8 + 5] += s * bfhi(w.z); o[c * 8 + 6] += s * bflo(w.w); o[c * 8 + 7] += s * bfhi(w.w);
      }
    }
    const float qd = exp2f((float)(i + 1) * lg);
    const bf16_t* st = p.stT + ((size_t)u << 13) + vh * 64 * 64;
    for (int d = 0; d < 64; ++d) {
      const float qq = bf2f(qrow[d]) * qd;
#pragma unroll
      for (int v = 0; v < 64; ++v) o[v] += qq * bf2f(st[v * 64 + d]);
    }
    float mu = 0.f;
#pragma unroll
    for (int v = 0; v < 64; ++v) mu += o[v];
    mu += __shfl_xor(mu, 1);
    mu *= (1.0f / 128.0f);
    float var = 0.f;
#pragma unroll
    for (int v = 0; v < 64; ++v) { const float dd = o[v] - mu; var += dd * dd; }
    var += __shfl_xor(var, 1);
    const float rs = rsqrtf(var * (1.0f / 128.0f) + 1e-5f);
    const bf16_t* gr = p.proj + (size_t)tok * NW + OFF_GR + h * 128 + vh * 64;
    bf16_t* mo = p.mixed + (size_t)tok * DM + 512 + h * 128 + vh * 64;
#pragma unroll
    for (int c = 0; c < 8; ++c) {
      const u32x4 w = *(const u32x4*)(gr + c * 8);
      float g[8] = {bflo(w.x), bfhi(w.x), bflo(w.y), bfhi(w.y), bflo(w.z), bfhi(w.z), bflo(w.w), bfhi(w.w)};
      float r[8];
#pragma unroll
      for (int e = 0; e < 8; ++e) r[e] = (o[c * 8 + e] - mu) * rs * p.gn[h * 128 + vh * 64 + c * 8 + e] * (g[e] / (1.0f + __expf(-g[e])));
      u32x4 ww; ww.x = pack2(r[0], r[1]); ww.y = pack2(r[2], r[3]); ww.z = pack2(r[4], r[5]); ww.w = pack2(r[6], r[7]);
      *(u32x4*)(mo + c * 8) = ww;
    }
  }
}

typedef float f32x16 __attribute__((ext_vector_type(16)));
typedef short s16x4 __attribute__((ext_vector_type(4)));
#define MFMA32(a, b, c) __builtin_amdgcn_mfma_f32_32x32x16_bf16((a), (b), (c), 0, 0, 0)
DI s16x4 tr_read(LAS unsigned char* a) { return __builtin_amdgcn_ds_read_tr16_b64_v4i16((LAS s16x4*)a); }
DI bf16x8 tr_frag(LAS unsigned char* a, int rowstride8) {
  const s16x4 lo = tr_read(a), hi = tr_read(a + rowstride8);
  return __builtin_shufflevector(lo, hi, 0, 1, 2, 3, 4, 5, 6, 7);
}
DI bf16x8 pack8(const f32x16& x, int s) {
  u32x4 w;
  w.x = pack2(x[8 * s + 0], x[8 * s + 1]); w.y = pack2(x[8 * s + 2], x[8 * s + 3]); w.z = pack2(x[8 * s + 4], x[8 * s + 5]); w.w = pack2(x[8 * s + 6], x[8 * s + 7]);
  return __builtin_bit_cast(bf16x8, w);
}
DI float fexp2(float x) { return __builtin_amdgcn_exp2f(x); }
DI float silu(float g) { return g / (1.0f + __expf(-g)); }

constexpr int AT_ROWB = 136, AT_LS = 512 * AT_ROWB, AT_VST = AT_LS + 2048, VROW = 192, KROW = 144, KST_W = 32 * KROW, VST_W = KST_W + 32 * VROW;
constexpr int ATTN_LDS = AT_VST + 8 * VST_W;
constexpr float LOG2E = 1.4426950408889634f;

constexpr int PT_ROW = 136;

DI void softmax_pv(f32x16& S, f32x16& O0, f32x16& O1, float& m, float& l, const bf16x8 (&Vf)[2][2], const bool mlow, const bool mhigh, const int r, const int h) {
  if (mlow || mhigh) {
#pragma unroll
    for (int i = 0; i < 16; ++i) {
      const int keyrow = (i & 3) + 8 * (i >> 2) + 4 * h;
      const bool bad = (mlow && keyrow < r) || (mhigh && keyrow > r);
      S[i] = bad ? -1e30f : S[i];
    }
  }
  float mx = fmaxf(S[0], S[1]);
#pragma unroll
  for (int i = 2; i < 16; ++i) mx = fmaxf(mx, S[i]);
  mx = fmaxf(mx, __shfl_xor(mx, 32));
  const float mn = fmaxf(m, mx), al = fexp2(m - mn);
  m = mn;
  float ps = 0.f;
#pragma unroll
  for (int i = 0; i < 16; ++i) { S[i] = fexp2(S[i] - mn); ps += S[i]; }
  ps += __shfl_xor(ps, 32);
  l = l * al + ps;
#pragma unroll
  for (int i = 0; i < 16; ++i) { O0[i] *= al; O1[i] *= al; }
#pragma unroll
  for (int s = 0; s < 2; ++s) {
    const bf16x8 Pb = pack8(S, s);
    O0 = MFMA32(Vf[s][0], Pb, O0);
    O1 = MFMA32(Vf[s][1], Pb, O1);
  }
}

DI void attn_tile2(const u32x4 (&Kc)[4], const u32x4 (&Vc)[4], const bf16x8 (&QA)[4], const bf16x8 (&QB)[4],
                   f32x16& A0, f32x16& A1, float& mA, float& lA, f32x16& B0, f32x16& B1, float& mB, float& lB,
                   LAS unsigned char* kst, LAS unsigned char* vst, LAS unsigned char* trp, const int lane, const int kt) {
  const int r = lane & 31, h = lane >> 5;
#pragma unroll
  for (int c = 0; c < 4; ++c) {
    *(LAS u32x4*)(kst + ((lane >> 3) + 8 * c) * KROW + (lane & 7) * 16) = Kc[c];
    *(LAS u32x4*)(vst + ((lane >> 3) + 8 * c) * VROW + (lane & 7) * 16) = Vc[c];
  }
  bf16x8 Kf[4], Vf[2][2];
#pragma unroll
  for (int ks = 0; ks < 4; ++ks) Kf[ks] = *(const LAS bf16x8*)(kst + r * KROW + (2 * ks + h) * 16);
#pragma unroll
  for (int s = 0; s < 2; ++s) { Vf[s][0] = tr_frag(trp + 16 * s * VROW, 8 * VROW); Vf[s][1] = tr_frag(trp + 16 * s * VROW + 64, 8 * VROW); }
  if (kt <= 4) {
    f32x16 S;
#pragma unroll
    for (int i = 0; i < 16; ++i) S[i] = 0.f;
#pragma unroll
    for (int ks = 0; ks < 4; ++ks) S = MFMA32(Kf[ks], QA[ks], S);
    softmax_pv(S, A0, A1, mA, lA, Vf, kt == 0, kt == 4, r, h);
  }
  if (kt >= 1) {
    f32x16 S;
#pragma unroll
    for (int i = 0; i < 16; ++i) S[i] = 0.f;
#pragma unroll
    for (int ks = 0; ks < 4; ++ks) S = MFMA32(Kf[ks], QB[ks], S);
    softmax_pv(S, B0, B1, mB, lB, Vf, kt == 1, kt == 5, r, h);
  }
}

DI void attn_merge(const Params& p, LAS unsigned char* T, const f32x16& O0, const f32x16& O1, const float m, const float l, const int lane,
                   const int tokq0  , const int sh, const int hh, const bool first, const bool last) {
  const int r = lane & 31, h = lane >> 5;
  const int rowc = lane >> 3, ch = lane & 7;
  float lse = m + __log2f(l);
  float w1 = 1.0f / l, w0 = 0.f;
  if (!first) {
#pragma unroll
    for (int c = 0; c < 4; ++c) {
      const size_t tk = (size_t)(tokq0 + ((rowc + 8 * c) << sh));
      *(LAS u32x4*)(T + (rowc + 8 * c) * PT_ROW + ch * 16) = *(const u32x4*)(p.ob + (tk * 8 + hh) * 64 + ch * 8);
    }
    const float lp = p.lseg[(size_t)(tokq0 + (r << sh)) * 8 + hh];
    const float M = fmaxf(lse, lp), e1 = fexp2(lse - M), e0 = fexp2(lp - M), den = e0 + e1, id = 1.0f / den;
    w1 *= e1 * id; w0 = e0 * id; lse = M + __log2f(den);
  }
  LAS unsigned char* ob = T + r * PT_ROW + 8 * h;
#pragma unroll
  for (int dt = 0; dt < 2; ++dt)
#pragma unroll
    for (int g = 0; g < 4; ++g) {
      float f0, f1, f2, f3;
      if (dt == 0) { f0 = O0[4 * g] * w1; f1 = O0[4 * g + 1] * w1; f2 = O0[4 * g + 2] * w1; f3 = O0[4 * g + 3] * w1; }
      else { f0 = O1[4 * g] * w1; f1 = O1[4 * g + 1] * w1; f2 = O1[4 * g + 2] * w1; f3 = O1[4 * g + 3] * w1; }
      LAS u32x2* a = (LAS u32x2*)(ob + 64 * dt + 16 * g);
      if (!first) { const u32x2 pv = *a; f0 += w0 * bflo(pv.x); f1 += w0 * bfhi(pv.x); f2 += w0 * bflo(pv.y); f3 += w0 * bfhi(pv.y); }
      u32x2 wv; wv.x = pack2(f0, f1); wv.y = pack2(f2, f3);
      *a = wv;
    }
  if (!last) {
    if (h == 0) p.lseg[(size_t)(tokq0 + (r << sh)) * 8 + hh] = lse;
#pragma unroll
    for (int c = 0; c < 4; ++c) {
      const size_t tk = (size_t)(tokq0 + ((rowc + 8 * c) << sh));
      *(u32x4*)(p.ob + (tk * 8 + hh) * 64 + ch * 8) = *(const LAS u32x4*)(T + (rowc + 8 * c) * PT_ROW + ch * 16);
    }
  } else {
#pragma unroll
    for (int c = 0; c < 4; ++c) {
      const size_t tk = (size_t)(tokq0 + ((rowc + 8 * c) << sh));
      const u32x4 a = *(const LAS u32x4*)(T + (rowc + 8 * c) * PT_ROW + ch * 16);
      const u32x4 g = *(const u32x4*)(p.proj + tk * NW + OFF_GA + hh * 64 + ch * 8);
      u32x4 w;
      w.x = pack2(bflo(a.x) * silu(bflo(g.x)), bfhi(a.x) * silu(bfhi(g.x)));
      w.y = pack2(bflo(a.y) * silu(bflo(g.y)), bfhi(a.y) * silu(bfhi(g.y)));
      w.z = pack2(bflo(a.z) * silu(bflo(g.z)), bfhi(a.z) * silu(bfhi(g.z)));
      w.w = pack2(bflo(a.w) * silu(bflo(g.w)), bfhi(a.w) * silu(bfhi(g.w)));
      *(u32x4*)(p.mixed + tk * DM + hh * 64 + ch * 8) = w;
    }
  }
}

DI void attn_task2(const Params& p, LAS unsigned char* kst, const int lane, const int tokbase, const int hh,
                   const int sh, const int r_res, const int l0, const bool first, const bool last) {
  const int r = lane & 31, h = lane >> 5;
  const int i16 = lane & 15, q4 = i16 >> 2, pp = i16 & 3, blk = (lane >> 4) & 1;
  LAS unsigned char* vst = kst + KST_W;
  LAS unsigned char* trp = vst + (4 * h + q4) * VROW + 32 * blk + 8 * pp;
  const bf16_t* qpA = p.proj + (size_t)(tokbase + r_res + ((l0 + r) << sh)) * NW + OFF_QA + hh * 64 + 8 * h;
  const bf16_t* qpB = qpA + (size_t)(32 << sh) * NW;
  bf16x8 QA[4], QB[4];
#pragma unroll
  for (int ks = 0; ks < 4; ++ks) { QA[ks] = *(const bf16x8*)(qpA + 16 * ks); QB[ks] = *(const bf16x8*)(qpB + 16 * ks); }
  f32x16 A0, A1, B0, B1;
#pragma unroll
  for (int i = 0; i < 16; ++i) { A0[i] = 0.f; A1[i] = 0.f; B0[i] = 0.f; B1[i] = 0.f; }
  float mA = -1e30f, lA = 0.f, mB = -1e30f, lB = 0.f;
  const int kt0 = (l0 >= 128) ? 0 : (4 - (l0 >> 5));
#define LOAD_KV(Kd, Vd, kt_) do { const int lk0_ = l0 - 128 + 32 * (kt_) + (lane >> 3); \
    _Pragma("unroll") for (int c_ = 0; c_ < 4; ++c_) { \
      const bf16_t* kp_ = p.proj + (size_t)(tokbase + r_res + ((lk0_ + 8 * c_) << sh)) * NW + OFF_KA + hh * 64 + 8 * (lane & 7); \
      Kd[c_] = *(const u32x4*)kp_; Vd[c_] = *(const u32x4*)(kp_ + (OFF_VA - OFF_KA)); } } while (0)
  for (int kt = kt0; kt < 6; kt += 2) {
    u32x4 K0[4], K1[4], V0[4], V1[4];
    LOAD_KV(K0, V0, kt);
    LOAD_KV(K1, V1, kt + 1);
    attn_tile2(K0, V0, QA, QB, A0, A1, mA, lA, B0, B1, mB, lB, kst, vst, trp, lane, kt);
    attn_tile2(K1, V1, QA, QB, A0, A1, mA, lA, B0, B1, mB, lB, kst, vst, trp, lane, kt + 1);
  }
#undef LOAD_KV
  const int tokA = tokbase + r_res + (l0 << sh);
  attn_merge(p, kst, A0, A1, mA, lA, lane, tokA, sh, hh, first, last);
  attn_merge(p, kst, B0, B1, mB, lB, lane, tokA + (32 << sh), sh, hh, first, last);
}

DI void phase_attn(LAS unsigned char* lds, const Params& p, int bid, int nb) {
  const int tid = threadIdx.x, wid = __builtin_amdgcn_readfirstlane(tid >> 6), lane = tid & 63;
  LAS unsigned char* kst = lds + wid * VST_W;
  for (int unit = bid; unit < 256; unit += nb) {
    const int sp = unit & 3, hh = (unit >> 2) & 7, b = unit >> 5;
    const int tokbase = b * SEQ;
    for (int stage = 0; stage < 3; ++stage) {
      const int sh = stage == 0 ? 4 : (stage == 1 ? 2 : 0);
      for (int tk = 0; tk < 2; ++tk) {
        const int idx = wid + 8 * tk;
        int r_res, l0;
        if (stage == 0) { r_res = idx; l0 = 64 * sp; }
        else if (stage == 1) { r_res = idx >> 2; l0 = 256 * sp + 64 * (idx & 3); }
        else { r_res = 0; l0 = 1024 * sp + 64 * idx; }
        attn_task2(p, kst, lane, tokbase, hh, sh, r_res, l0, stage == 0, stage == 2);
      }
      __syncthreads();
    }
  }
}

constexpr int RV_ROW = 320, RK_ROW = 192, RV_OFF = 0, RK_OFF = 128 * RV_ROW  , RRED_OFF = RK_OFF + 128 * RK_ROW  ;

DI void phase_retkv(LAS unsigned char* lds, const Params& p, int bid, int nb) {
  const int tid = threadIdx.x, wid = __builtin_amdgcn_readfirstlane(tid >> 6), lane = tid & 63;
  const int r = lane & 31, h = lane >> 5, i16 = lane & 15, q4 = i16 >> 2, pp = i16 & 3, blk = (lane >> 4) & 1;
  const int vt = wid >> 1, dt = wid & 1;
  for (int u = bid; u < 1024; u += nb) {
    const int n = u & 31, hh = (u >> 5) & 3, b = u >> 7;
    const float lg = ret_log2g(hh);
    const bf16_t* base = p.proj + (size_t)(b * SEQ + n * 128) * NW;
#pragma unroll
    for (int it = 0; it < 4; ++it) {
      const int c = tid + 512 * it, j = c >> 4, cc = c & 15;
      *(LAS u32x4*)(lds + RV_OFF + j * RV_ROW + cc * 16) = *(const u32x4*)(base + (size_t)j * NW + OFF_VR + hh * 128 + cc * 8);
    }
#pragma unroll
    for (int it = 0; it < 2; ++it) {
      const int c = tid + 512 * it, j = c >> 3, cc = c & 7;
      const u32x4 w = *(const u32x4*)(base + (size_t)j * NW + OFF_KR + hh * 64 + cc * 8);
      const float dk = exp2f((float)(127 - j) * lg);
      u32x4 o;
      o.x = pack2(bflo(w.x) * dk, bfhi(w.x) * dk); o.y = pack2(bflo(w.y) * dk, bfhi(w.y) * dk);
      o.z = pack2(bflo(w.z) * dk, bfhi(w.z) * dk); o.w = pack2(bflo(w.w) * dk, bfhi(w.w) * dk);
      *(LAS u32x4*)(lds + RK_OFF + j * RK_ROW + cc * 16) = o;
    }
    __syncthreads();
    f32x16 acc;
#pragma unroll
    for (int i = 0; i < 16; ++i) acc[i] = 0.f;
    LAS unsigned char* va = lds + RV_OFF + (4 * h + q4) * RV_ROW + (32 * vt + 16 * blk + 4 * pp) * 2;
    LAS unsigned char* ka = lds + RK_OFF + (4 * h + q4) * RK_ROW + (32 * dt + 16 * blk + 4 * pp) * 2;
#pragma unroll
    for (int s = 0; s < 8; ++s) {
      const bf16x8 A = tr_frag(va + 16 * s * RV_ROW, 8 * RV_ROW), B = tr_frag(ka + 16 * s * RK_ROW, 8 * RK_ROW);
      acc = MFMA32(A, B, acc);
    }
    float* o = p.kvT + ((size_t)u << 13) + (32 * vt + 4 * h) * 64 + 32 * dt + r;
#pragma unroll
    for (int i = 0; i < 16; ++i) o[((i & 3) + 8 * (i >> 2)) * 64] = acc[i];
    __syncthreads();
  }
}

DI void phase_retout(LAS unsigned char* lds, const Params& p, int bid, int nb) {
  const int tid = threadIdx.x, wid = __builtin_amdgcn_readfirstlane(tid >> 6), lane = tid & 63;
  const int r = lane & 31, h = lane >> 5, i16 = lane & 15, q4 = i16 >> 2, pp = i16 & 3, blk = (lane >> 4) & 1;
  const int it = wid & 3, vh = wid >> 2;
  LAS float* red = (LAS float*)(lds + RRED_OFF);
  for (int u = bid; u < 1024; u += nb) {
    const int n = u & 31, hh = (u >> 5) & 3, b = u >> 7;
    const float lg = ret_log2g(hh);
    const int tok0 = b * SEQ + n * 128;
    const bf16_t* base = p.proj + (size_t)tok0 * NW;
#pragma unroll
    for (int k = 0; k < 4; ++k) {
      const int c = tid + 512 * k, j = c >> 4, cc = c & 15;
      *(LAS u32x4*)(lds + RV_OFF + j * RV_ROW + cc * 16) = *(const u32x4*)(base + (size_t)j * NW + OFF_VR + hh * 128 + cc * 8);
    }
    const int qi = 32 * it + r;
    const bf16_t* qp = base + (size_t)qi * NW + OFF_QR + hh * 64 + 8 * h;
    bf16x8 Qf[4], St0[4], St1[4];
    const bf16_t* st = p.stT + ((size_t)u << 13) + (size_t)(64 * vh + r) * 64 + 8 * h;
#pragma unroll
    for (int ks = 0; ks < 4; ++ks) { Qf[ks] = *(const bf16x8*)(qp + 16 * ks); St0[ks] = *(const bf16x8*)(st + 16 * ks); St1[ks] = *(const bf16x8*)(st + 32 * 64 + 16 * ks); }
    const size_t tok = (size_t)(tok0 + qi);
    const bf16_t* gr = p.proj + tok * NW + OFF_GR + hh * 128 + 64 * vh + 4 * h;
    u32x2 gw[8];
#pragma unroll
    for (int k = 0; k < 8; ++k) gw[k] = *(const u32x2*)(gr + 32 * (k >> 2) + 8 * (k & 3));
    f32x16 O0, O1;
#pragma unroll
    for (int i = 0; i < 16; ++i) { O0[i] = 0.f; O1[i] = 0.f; }
    {
#pragma unroll
      for (int ks = 0; ks < 4; ++ks) { O0 = MFMA32(St0[ks], Qf[ks], O0); O1 = MFMA32(St1[ks], Qf[ks], O1); }
      const float qd = exp2f((float)(qi + 1) * lg);
#pragma unroll
      for (int i = 0; i < 16; ++i) { O0[i] *= qd; O1[i] *= qd; }
    }
    __syncthreads();
    LAS unsigned char* va = lds + RV_OFF + (4 * h + q4) * RV_ROW + (64 * vh + 16 * blk + 4 * pp) * 2;
#pragma unroll
    for (int jt = 0; jt < 4; ++jt)
      if (jt <= it) {
        const bf16_t* kp = base + (size_t)(32 * jt + r) * NW + OFF_KR + hh * 64 + 8 * h;
        bf16x8 Kf[4];
#pragma unroll
        for (int ks = 0; ks < 4; ++ks) Kf[ks] = *(const bf16x8*)(kp + 16 * ks);
        f32x16 S;
#pragma unroll
        for (int i = 0; i < 16; ++i) S[i] = 0.f;
#pragma unroll
        for (int ks = 0; ks < 4; ++ks) S = MFMA32(Kf[ks], Qf[ks], S);
#pragma unroll
        for (int i = 0; i < 16; ++i) {
          const int dj = qi - (32 * jt + (i & 3) + 8 * (i >> 2) + 4 * h);
          S[i] = dj >= 0 ? S[i] * fexp2((float)dj * lg) : 0.f;
        }
#pragma unroll
        for (int s2 = 0; s2 < 2; ++s2) {
          const bf16x8 Pb = pack8(S, s2);
          const bf16x8 V0 = tr_frag(va + (32 * jt + 16 * s2) * RV_ROW, 8 * RV_ROW), V1 = tr_frag(va + (32 * jt + 16 * s2) * RV_ROW + 64, 8 * RV_ROW);
          O0 = MFMA32(V0, Pb, O0);
          O1 = MFMA32(V1, Pb, O1);
        }
      }
    float s1 = 0.f, s2 = 0.f;
#pragma unroll
    for (int i = 0; i < 16; ++i) { s1 += O0[i] + O1[i]; s2 += O0[i] * O0[i] + O1[i] * O1[i]; }
    s1 += __shfl_xor(s1, 32); s2 += __shfl_xor(s2, 32);
    if (h == 0) { red[(vh * 128 + qi) * 2] = s1; red[(vh * 128 + qi) * 2 + 1] = s2; }
    __syncthreads();
    s1 += red[((vh ^ 1) * 128 + qi) * 2]; s2 += red[((vh ^ 1) * 128 + qi) * 2 + 1];
    const float mu = s1 * (1.0f / 128.0f), var = fmaxf(s2 * (1.0f / 128.0f) - mu * mu, 0.f), rs = rsqrtf(var + 1e-5f);
    bf16_t* mo = p.mixed + tok * DM + 512 + hh * 128 + 64 * vh + 4 * h;
    const float* gnp = p.gn + hh * 128 + 64 * vh + 4 * h;
#pragma unroll
    for (int dt = 0; dt < 2; ++dt)
#pragma unroll
      for (int g = 0; g < 4; ++g) {
        const int vo = 32 * dt + 8 * g;
        const u32x2 gwv = gw[dt * 4 + g];
        const f32x4 gnv = *(const f32x4*)(gnp + vo);
        float f0, f1, f2, f3;
        if (dt == 0) { f0 = O0[4 * g]; f1 = O0[4 * g + 1]; f2 = O0[4 * g + 2]; f3 = O0[4 * g + 3]; }
        else { f0 = O1[4 * g]; f1 = O1[4 * g + 1]; f2 = O1[4 * g + 2]; f3 = O1[4 * g + 3]; }
        f0 = (f0 - mu) * rs * gnv[0] * silu(bflo(gwv.x)); f1 = (f1 - mu) * rs * gnv[1] * silu(bfhi(gwv.x));
        f2 = (f2 - mu) * rs * gnv[2] * silu(bflo(gwv.y)); f3 = (f3 - mu) * rs * gnv[3] * silu(bfhi(gwv.y));
        u32x2 wv; wv.x = pack2(f0, f1); wv.y = pack2(f2, f3);
        *(u32x2*)(mo + vo) = wv;
      }
    __syncthreads();
  }
}

DI void phase_final(const Params& p, int bid, int nb) {
  const int tid = threadIdx.x, lane = tid & 63, wid = tid >> 6, nw = blockDim.x >> 6;
  for (int row = bid * nw + wid; row < T_TOK; row += nb * nw) {
    const float rs = rsqrtf(p.rowss[row] * (1.0f / DM) + 1e-6f);
    float* yr = p.out + (size_t)row * DM;
#pragma unroll
    for (int it = 0; it < 4; ++it) {
      const f32x4 v = *(const f32x4*)(yr + it * 256 + lane * 4), g = *(const f32x4*)(p.fg + it * 256 + lane * 4);
      *(f32x4*)(yr + it * 256 + lane * 4) = v * rs * g;
    }
  }
}

DI void grid_barrier(unsigned* ctr, unsigned target) {
  asm volatile("s_waitcnt vmcnt(0) lgkmcnt(0)" ::: "memory");
  __syncthreads();
  if (threadIdx.x == 0) {
    __builtin_amdgcn_fence(__ATOMIC_RELEASE, "agent");
    asm volatile("s_waitcnt vmcnt(0)" ::: "memory");
    __hip_atomic_fetch_add(ctr, 1u, __ATOMIC_RELAXED, __HIP_MEMORY_SCOPE_AGENT);
    unsigned spins = 0;
    while (__hip_atomic_load(ctr, __ATOMIC_RELAXED, __HIP_MEMORY_SCOPE_AGENT) < target && spins < (1u << 22)) { __builtin_amdgcn_s_sleep(2); ++spins; }
    __builtin_amdgcn_fence(__ATOMIC_ACQUIRE, "agent");
    asm volatile("s_waitcnt vmcnt(0)" ::: "memory");
  }
  __syncthreads();
}

__global__ void __launch_bounds__(512) k_mega(Params p) {
  extern __shared__ __attribute__((aligned(16))) unsigned char shm_[];
  LAS unsigned char* shm = (LAS unsigned char*)shm_;
  const int bid = blockIdx.x, nb = gridDim.x;
  unsigned bar_n = 0;
#ifdef PROBE_PHASE
  unsigned long long ts_a = 0, ts_b = 0; int ph_i = 0;
  if (PROBE_PHASE == 0) ts_a = __builtin_amdgcn_s_memrealtime();
#define GRID_BAR() do { bar_n += (unsigned)nb; grid_barrier(p.bar, bar_n); ++ph_i; if (ph_i == PROBE_PHASE) ts_a = __builtin_amdgcn_s_memrealtime(); if (ph_i == PROBE_PHASE + 1) ts_b = __builtin_amdgcn_s_memrealtime(); } while (0)
#else
#define GRID_BAR() do { bar_n += (unsigned)nb; grid_barrier(p.bar, bar_n); } while (0)
#endif
  phase_prep(p, bid, nb);
  GRID_BAR();
  phase_gemm<1>(shm, p, bid, nb);
  GRID_BAR();
  phase_attn(shm, p, bid, nb);
  phase_retkv(shm, p, bid, nb);
  GRID_BAR();
  phase_retscan(p, bid, nb);
  GRID_BAR();
  phase_retout(shm, p, bid, nb);
  GRID_BAR();
  phase_gemm<2>(shm, p, bid, nb);
#ifdef PROBE_PHASE
  if (PROBE_PHASE == 5) ts_b = __builtin_amdgcn_s_memrealtime();
  if (bid == 0 && threadIdx.x == 0) {
    const unsigned long long until = __builtin_amdgcn_s_memrealtime() + 9ull * (ts_b - ts_a);
    while (__builtin_amdgcn_s_memrealtime() < until) __builtin_amdgcn_s_sleep(8);
  }
#endif
}

extern "C" void kernel_launch(void* const* d_in, const int* in_sizes, int n_in, void* d_out, int out_size, void* d_ws, size_t ws_size, hipStream_t stream) {
  Params p{};
  p.x = (const float*)d_in[0]; p.ng = (const float*)d_in[1]; p.w_in = (const float*)d_in[2]; p.gn = (const float*)d_in[3];
  p.w_out = (const float*)d_in[4]; p.fg = (const float*)d_in[5];
  p.out = (float*)d_out;
  char* w = (char*)d_ws; size_t o = 0;
  auto take = [&](size_t bytes) { char* r = w + o; o += (bytes + 255) & ~(size_t)255; return r; };
  p.xb = (bf16_t*)take((size_t)T_TOK * DM * 2);
  p.proj = (bf16_t*)take((size_t)T_TOK * NW * 2);
  p.mixed = (bf16_t*)take((size_t)T_TOK * DM * 2);
  p.winT = (bf16_t*)take((size_t)NW * DM * 2);
  p.woutT = (bf16_t*)take((size_t)DM * DM * 2);
  p.rstd = (float*)take((size_t)T_TOK * 4);
  p.rowss = (float*)take((size_t)T_TOK * 4);
  p.ropeT = (float2*)take((size_t)SEQ * 32 * 8);
  p.retT = (float2*)take((size_t)SEQ * 32 * 8);
  p.kvT = (float*)take((size_t)1024 * 8192 * 4);
  p.stT = (bf16_t*)take((size_t)1024 * 8192 * 2);
  p.bar = (unsigned*)take(1024);
  p.ob = (bf16_t*)take((size_t)T_TOK * 512 * 2);
  p.lseg = (float*)take((size_t)T_TOK * 8 * 4);
  static int grid_blocks = 0;
  if (!grid_blocks) {
    (void)hipFuncSetAttribute((const void*)k_mega, hipFuncAttributeMaxDynamicSharedMemorySize, ATTN_LDS);
    int dev = 0, cus = 0, per_cu = 0;
    (void)hipGetDevice(&dev);
    (void)hipDeviceGetAttribute(&cus, hipDeviceAttributeMultiprocessorCount, dev);
    (void)hipOccupancyMaxActiveBlocksPerMultiprocessor(&per_cu, k_mega, 512, ATTN_LDS);
    if (per_cu < 1) per_cu = 1;
    grid_blocks = cus;
  }
  (void)hipMemsetAsync(p.bar, 0, 1024, stream);
  hipLaunchKernelGGL(k_mega, dim3(grid_blocks), dim3(512), ATTN_LDS, stream, p);
}
```

```cpp
#include <hip/hip_runtime.h>
#include <hip/hip_cooperative_groups.h>
#include <cstdint>
#include <cstdio>
namespace cg = cooperative_groups;

typedef unsigned short bf16_t;
typedef short bf16x8 __attribute__((ext_vector_type(8)));
typedef float f32x4 __attribute__((ext_vector_type(4)));
typedef unsigned u32x4 __attribute__((ext_vector_type(4)));
typedef unsigned u32x2 __attribute__((ext_vector_type(2)));

constexpr int T_TOK = 32768, DM = 1024, NW = 3584, SEQ = 4096;
constexpr int OFF_QA = 0, OFF_KA = 512, OFF_VA = 1024, OFF_GA = 1536, OFF_QR = 2048, OFF_KR = 2304, OFF_VR = 2560, OFF_GR = 3072;

struct Params {
  const float* x; const float* ng; const float* w_in; const float* gn; const float* w_out; const float* fg;
  float* out;
  bf16_t* xb; bf16_t* proj; bf16_t* mixed; bf16_t* winT; bf16_t* woutT;
  float* rstd; float* rowss; float2* ropeT; float2* retT; float* kvT; bf16_t* stT; unsigned* bar; bf16_t* ob; float* lseg;
};

#define DI __device__ __forceinline__
DI unsigned short f2bf(float x) { unsigned u = __float_as_uint(x); u += 0x7fffu + ((u >> 16) & 1u); return (unsigned short)(u >> 16); }
DI float bf2f(unsigned short b) { return __uint_as_float(((unsigned)b) << 16); }
typedef float f32x2_t __attribute__((ext_vector_type(2)));
typedef __bf16 bf16x2_t __attribute__((ext_vector_type(2)));
DI unsigned pack2(float lo, float hi) { const f32x2_t v = {lo, hi}; return __builtin_bit_cast(unsigned, __builtin_convertvector(v, bf16x2_t)); }
DI float bflo(unsigned w) { return __uint_as_float(w << 16); }
DI float bfhi(unsigned w) { return __uint_as_float(w & 0xffff0000u); }
DI int perm32(int rho) { const int n = rho >> 4, i = rho & 15; return 8 * (i >> 2) + 4 * n + (i & 3); }
DI int cmap(int p) { return (p & ~31) + perm32(p & 31); }
DI int cmapA(int p) { return (p & ~127) + ((p >> 6) & 1) * 64 + ((p >> 4) & 1) * 32 + ((p >> 5) & 1) * 16 + (p & 15); }

DI void phase_prep(const Params& p, int bid, int nb) {
  const int tid = threadIdx.x, lane = tid & 63, wid = tid >> 6, nw = blockDim.x >> 6;
  if (wid < 6)
  for (int row0 = (bid * 6 + wid) * 4; row0 < T_TOK; row0 += nb * 6 * 4) {
    f32x4 v[4][4];
#pragma unroll
    for (int rr = 0; rr < 4; ++rr)
#pragma unroll
      for (int it = 0; it < 4; ++it) v[rr][it] = *(const f32x4*)(p.x + (size_t)(row0 + rr) * DM + it * 256 + lane * 4);
#pragma unroll
    for (int rr = 0; rr < 4; ++rr) {
      float ss = 0.f;
#pragma unroll
      for (int it = 0; it < 4; ++it) ss += v[rr][it][0] * v[rr][it][0] + v[rr][it][1] * v[rr][it][1] + v[rr][it][2] * v[rr][it][2] + v[rr][it][3] * v[rr][it][3];
#pragma unroll
      for (int o = 32; o >= 1; o >>= 1) ss += __shfl_xor(ss, o);
#pragma unroll
      for (int it = 0; it < 4; ++it) { u32x2 w; w.x = pack2(v[rr][it][0], v[rr][it][1]); w.y = pack2(v[rr][it][2], v[rr][it][3]); *(u32x2*)(p.xb + (size_t)(row0 + rr) * DM + it * 256 + lane * 4) = w; }
      if (lane == 0) p.rstd[row0 + rr] = rsqrtf(ss * (1.0f / DM) + 1e-6f);
    }
  }
  if (wid < 6) return;
  const int gt = bid * 128 + (tid - 384), gn = nb * 128;
  for (int idx = gt; idx < (NW / 4) * 128; idx += gn) {
    const int p4 = idx % (NW / 4), kc = idx / (NW / 4), pp = p4 * 4, c = pp < 1024 ? cmapA(pp) : cmap(pp);
    f32x4 f[8];
#pragma unroll
    for (int j = 0; j < 8; ++j) { const int k = kc * 8 + j; f[j] = *(const f32x4*)(p.w_in + (size_t)k * NW + c) * p.ng[k]; }
#pragma unroll
    for (int e = 0; e < 4; ++e) {
      u32x4 w; w.x = pack2(f[0][e], f[1][e]); w.y = pack2(f[2][e], f[3][e]); w.z = pack2(f[4][e], f[5][e]); w.w = pack2(f[6][e], f[7][e]);
      *(u32x4*)(p.winT + (size_t)(pp + e) * DM + kc * 8) = w;
    }
  }
  for (int idx = gt; idx < (DM / 4) * 128; idx += gn) {
    const int p4 = idx % (DM / 4), kc = idx / (DM / 4), pp = p4 * 4, c = cmap(pp);
    f32x4 f[8];
#pragma unroll
    for (int j = 0; j < 8; ++j) { const int k = kc * 8 + j; f[j] = *(const f32x4*)(p.w_out + (size_t)k * DM + c); }
#pragma unroll
    for (int e = 0; e < 4; ++e) {
      u32x4 w; w.x = pack2(f[0][e], f[1][e]); w.y = pack2(f[2][e], f[3][e]); w.z = pack2(f[4][e], f[5][e]); w.w = pack2(f[6][e], f[7][e]);
      *(u32x4*)(p.woutT + (size_t)(pp + e) * DM + kc * 8) = w;
    }
  }
  for (int idx = gt; idx < SEQ * 32; idx += gn) {
    const int pos = idx >> 5, i = idx & 31;
    const float inv1 = powf(10000.0f, -(float)i / 32.0f);
    const float inv2 = 1.0f / powf(10000.0f, (float)i / 31.0f);
    const float a1 = (float)pos * inv1, a2 = (float)pos * inv2;
    p.ropeT[idx] = make_float2(cosf(a1), sinf(a1));
    p.retT[idx] = make_float2(cosf(a2), sinf(a2));
  }
}

constexpr int BM = 256, BK = 64, HALF = 128, HT = HALF * BK;
constexpr int GEMM_LDS = 8 * HT * 2;
DI int lds_byte(int r, int c) { int st = (r >> 4) * 2 + (c >> 5), rr = r & 15, cc = c & 31, ob = rr * 64 + cc * 2; return st * 1024 + (ob ^ (((ob >> 9) & 1) << 5)); }
DI void stage_rc(int b, int& R, int& C) { int st = b / 1024, sb = b % 1024, swz = sb ^ (((sb >> 9) & 1) << 5); R = (st >> 1) * 16 + swz / 64; C = (st & 1) * 32 + (swz % 64) / 2; }

#define LAS __attribute__((address_space(3)))
template <int EPI>
DI void gemm_tile(LAS unsigned char* lds, const bf16_t* __restrict__ A, const bf16_t* __restrict__ Bt, const int brow, const int bcol, const bool primed, const int nbrow, const int nbcol, const Params& p) {
  constexpr int K = 1024, nt = K / BK, HTB = HALF * BK * 2;
  const int tid = threadIdx.x, wid = __builtin_amdgcn_readfirstlane(tid >> 6), lane = tid & 63, wr = wid >> 2, wc = wid & 3, fr = lane & 15, fq = lane >> 4;
  unsigned voff[2];
#pragma unroll
  for (int i = 0; i < 2; ++i) { int R, C; stage_rc(tid * 16 + i * 8192, R, C); voff[i] = (unsigned)(R * K + C) * 2u; }
  const unsigned ldsw = (unsigned)wid * 1024u;
  const int aoff = lds_byte(wr * 64 + fr, fq * 8), boff = lds_byte(wc * 32 + fr, fq * 8);
  const char* cA0 = (const char*)A + (size_t)brow * K * 2; const char* cA1 = cA0 + (size_t)HALF * K * 2;
  const char* cB0 = (const char*)Bt + (size_t)bcol * K * 2; const char* cB1 = cB0 + (size_t)HALF * K * 2;
#define SAo(b, h) (((b) * 2 + (h)) * HTB)
#define SBo(b, h) ((4 + (b) * 2 + (h)) * HTB)
#define STAGE(bufoff, gb, kt) do { _Pragma("unroll") for (int _i = 0; _i < 2; ++_i) \
    __builtin_amdgcn_global_load_lds((const unsigned*)((gb) + (size_t)(kt) * (BK * 2) + voff[_i]), (LAS unsigned*)(lds + (bufoff) + ldsw + _i * 8192), 16, 0, 0); } while (0)
#define LDA(dst, b, h) do { _Pragma("unroll") for (int m = 0; m < 4; ++m) _Pragma("unroll") for (int k = 0; k < 2; ++k) \
    dst[m][k] = *(const LAS bf16x8*)(lds + SAo(b, h) + aoff + m * 2048 + k * 1024); } while (0)
#define LDB(dst, b, h) do { _Pragma("unroll") for (int n = 0; n < 2; ++n) _Pragma("unroll") for (int k = 0; k < 2; ++k) \
    dst[n][k] = *(const LAS bf16x8*)(lds + SBo(b, h) + boff + n * 2048 + k * 1024); } while (0)
#define MMA(ai, bj, At, Bt_) do { __builtin_amdgcn_s_setprio(1); \
    _Pragma("unroll") for (int m = 0; m < 4; ++m) _Pragma("unroll") for (int n = 0; n < 2; ++n) _Pragma("unroll") for (int k = 0; k < 2; ++k) \
      acc[ai][bj][m][n] = __builtin_amdgcn_mfma_f32_16x16x32_bf16(Bt_[n][k], At[m][k], acc[ai][bj][m][n], 0, 0, 0); \
    __builtin_amdgcn_s_setprio(0); } while (0)
#define WAIT_V(n) asm volatile("s_waitcnt vmcnt(" #n ")" ::: "memory")
#define WAIT_L(n) asm volatile("s_waitcnt lgkmcnt(" #n ")" ::: "memory")
#define BAR __builtin_amdgcn_s_barrier()
#define SCHED __builtin_amdgcn_sched_barrier(0)
  f32x4 acc[2][2][4][2];
#pragma unroll
  for (int a = 0; a < 2; ++a)
#pragma unroll
    for (int b = 0; b < 2; ++b)
#pragma unroll
      for (int m = 0; m < 4; ++m)
#pragma unroll
        for (int n = 0; n < 2; ++n) acc[a][b][m][n] = (f32x4){0.f, 0.f, 0.f, 0.f};
  bf16x8 At[4][2], B0[2][2], B1[2][2];
  if (!primed) {
    WAIT_V(0);
    STAGE(SBo(0, 0), cB0, 0); STAGE(SAo(0, 0), cA0, 0);
    STAGE(SBo(0, 1), cB1, 0); STAGE(SAo(0, 1), cA1, 0);
  }
  if (wr == 1) BAR;
  if (primed) WAIT_V(0); else WAIT_V(4);
  BAR;
  STAGE(SBo(1, 0), cB0, 1); STAGE(SAo(1, 0), cA0, 1); STAGE(SBo(1, 1), cB1, 1);
  WAIT_V(6); BAR;
  for (int t = 0; t < nt - 2; t += 2) {
    LDB(B0, 0, 0); SCHED; LDA(At, 0, 0); STAGE(SAo(1, 1), cA1, t + 1);
    WAIT_L(8); BAR; WAIT_L(0); MMA(0, 0, At, B0); BAR; SCHED;
    LDB(B1, 0, 1); STAGE(SBo(0, 0), cB0, t + 2);
    BAR; WAIT_L(0); MMA(0, 1, At, B1); BAR;
    LDA(At, 0, 1); STAGE(SAo(0, 0), cA0, t + 2);
    BAR; WAIT_L(0); MMA(1, 0, At, B0); BAR; SCHED;
    STAGE(SBo(0, 1), cB1, t + 2);
    WAIT_V(6); BAR; MMA(1, 1, At, B1); BAR;
    LDB(B0, 1, 0); SCHED; LDA(At, 1, 0); STAGE(SAo(0, 1), cA1, t + 2);
    WAIT_L(8); BAR; WAIT_L(0); MMA(0, 0, At, B0); BAR; SCHED;
    LDB(B1, 1, 1); STAGE(SBo(1, 0), cB0, t + 3);
    BAR; WAIT_L(0); MMA(0, 1, At, B1); BAR;
    LDA(At, 1, 1); STAGE(SAo(1, 0), cA0, t + 3);
    BAR; WAIT_L(0); MMA(1, 0, At, B0); BAR; SCHED;
    STAGE(SBo(1, 1), cB1, t + 3);
    WAIT_V(6); BAR; MMA(1, 1, At, B1); BAR;
  }
  { LDB(B0, 0, 0); LDA(At, 0, 0); STAGE(SAo(1, 1), cA1, nt - 1);
    BAR; WAIT_L(0); MMA(0, 0, At, B0); BAR;
    LDB(B1, 0, 1); BAR; WAIT_L(0); MMA(0, 1, At, B1); BAR;
    LDA(At, 0, 1); WAIT_V(4); BAR; WAIT_L(0); MMA(1, 0, At, B0); MMA(1, 1, At, B1); BAR; }
  { LDB(B0, 1, 0); LDA(At, 1, 0); WAIT_V(2); BAR; WAIT_L(0); MMA(0, 0, At, B0); BAR;
    LDB(B1, 1, 1); WAIT_V(0); BAR; WAIT_L(0); MMA(0, 1, At, B1); BAR;
    LDA(At, 1, 1); BAR; WAIT_L(0); MMA(1, 0, At, B0); MMA(1, 1, At, B1); BAR; }
  if (wr == 0) BAR;
  if (nbrow >= 0) {
    const char* nA0 = (const char*)A + (size_t)nbrow * K * 2; const char* nB0 = (const char*)Bt + (size_t)nbcol * K * 2;
    STAGE(SBo(0, 0), nB0, 0); STAGE(SAo(0, 0), nA0, 0);
    STAGE(SBo(0, 1), nB0 + (size_t)HALF * K * 2, 0); STAGE(SAo(0, 1), nA0 + (size_t)HALF * K * 2, 0);
  }
  if (EPI == 1) {
    const int pn = bcol >> 8;
    if (pn < 4) {
      const float sc = pn < 2 ? 0.125f * 1.4426950408889634f : 1.0f;
      const int i0 = 16 * (wc & 1) + 4 * fq;
#pragma unroll
      for (int ai = 0; ai < 2; ++ai)
#pragma unroll
        for (int m = 0; m < 4; ++m) {
          const int row = brow + ai * HALF + wr * 64 + m * 16 + fr;
          const float rs = p.rstd[row] * sc;
          const float* tb = (const float*)(p.ropeT + (row & (SEQ - 1)) * 32 + i0);
          const f32x4 t0 = *(const f32x4*)tb, t1 = *(const f32x4*)(tb + 4);
#pragma unroll
          for (int bj = 0; bj < 2; ++bj) {
            const f32x4 x1 = acc[ai][bj][m][0] * rs, x2 = acc[ai][bj][m][1] * rs;
            u32x2 wa, wb;
            wa.x = pack2(x1[0] * t0[0] - x2[0] * t0[1], x1[1] * t0[2] - x2[1] * t0[3]);
            wa.y = pack2(x1[2] * t1[0] - x2[2] * t1[1], x1[3] * t1[2] - x2[3] * t1[3]);
            wb.x = pack2(x2[0] * t0[0] + x1[0] * t0[1], x2[1] * t0[2] + x1[1] * t0[3]);
            wb.y = pack2(x2[2] * t1[0] + x1[2] * t1[1], x2[3] * t1[2] + x1[3] * t1[3]);
            bf16_t* o = p.proj + (size_t)row * NW + bcol + bj * HALF + (wc >> 1) * 64 + i0;
            *(u32x2*)o = wa; *(u32x2*)(o + 32) = wb;
          }
        }
    } else if (pn == 8 || pn == 9) {
      const float sc = pn == 9 ? 0.125f : 1.0f;
      const int i0 = 16 * (wc & 1) + 4 * fq;
#pragma unroll
      for (int ai = 0; ai < 2; ++ai)
#pragma unroll
        for (int m = 0; m < 4; ++m) {
          const int row = brow + ai * HALF + wr * 64 + m * 16 + fr;
          const float rs = p.rstd[row] * sc;
          const float* tb = (const float*)(p.retT + (row & (SEQ - 1)) * 32 + i0);
          const f32x4 t0 = *(const f32x4*)tb, t1 = *(const f32x4*)(tb + 4);
#pragma unroll
          for (int bj = 0; bj < 2; ++bj) {
            const f32x4 v0 = acc[ai][bj][m][0] * rs, v1 = acc[ai][bj][m][1] * rs;
            u32x4 w;
            w.x = pack2(v0[0] * t0[0] - v0[1] * t0[1], v0[1] * t0[0] + v0[0] * t0[1]);
            w.y = pack2(v0[2] * t0[2] - v0[3] * t0[3], v0[3] * t0[2] + v0[2] * t0[3]);
            w.z = pack2(v1[0] * t1[0] - v1[1] * t1[1], v1[1] * t1[0] + v1[0] * t1[1]);
            w.w = pack2(v1[2] * t1[2] - v1[3] * t1[3], v1[3] * t1[2] + v1[2] * t1[3]);
            *(u32x4*)(p.proj + (size_t)row * NW + bcol + bj * HALF + wc * 32 + 8 * fq) = w;
          }
        }
    } else {
#pragma unroll
    for (int ai = 0; ai < 2; ++ai)
#pragma unroll
      for (int m = 0; m < 4; ++m) {
        const int row = brow + ai * HALF + wr * 64 + m * 16 + fr;
        const float rs = p.rstd[row];
#pragma unroll
        for (int bj = 0; bj < 2; ++bj) {
          const f32x4 v0 = acc[ai][bj][m][0] * rs, v1 = acc[ai][bj][m][1] * rs;
          u32x4 w; w.x = pack2(v0[0], v0[1]); w.y = pack2(v0[2], v0[3]); w.z = pack2(v1[0], v1[1]); w.w = pack2(v1[2], v1[3]);
          *(u32x4*)(p.proj + (size_t)row * NW + bcol + bj * HALF + wc * 32 + 8 * fq) = w;
        }
      }
    }
  } else {
    const int pm = brow >> 8, pn = bcol >> 8;
    LAS float* part = (LAS float*)(lds + GEMM_LDS);
    LAS float* rsl = (LAS float*)(lds + GEMM_LDS + 4096);
#pragma unroll
    for (int ai = 0; ai < 2; ++ai)
#pragma unroll
      for (int m = 0; m < 4; ++m) {
        const int rl = ai * HALF + wr * 64 + m * 16 + fr;
        float ss = 0.f;
#pragma unroll
        for (int bj = 0; bj < 2; ++bj) {
          const size_t off = (size_t)(brow + rl) * DM + bcol + bj * HALF + wc * 32 + 8 * fq;
          const f32x4 x0 = *(const f32x4*)(p.x + off), x1 = *(const f32x4*)(p.x + off + 4);
          const f32x4 y0 = acc[ai][bj][m][0] + x0, y1 = acc[ai][bj][m][1] + x1;
          acc[ai][bj][m][0] = y0; acc[ai][bj][m][1] = y1;
          ss += y0[0] * y0[0] + y0[1] * y0[1] + y0[2] * y0[2] + y0[3] * y0[3] + y1[0] * y1[0] + y1[1] * y1[1] + y1[2] * y1[2] + y1[3] * y1[3];
        }
        ss += __shfl_xor(ss, 16); ss += __shfl_xor(ss, 32);
        if (fq == 0) part[wc * 256 + rl] = ss;
      }
    __syncthreads();
    float* xs = p.rowss + (size_t)(pm * 4) * 256;
    if (tid < 256) {
      const float tot = part[tid] + part[256 + tid] + part[512 + tid] + part[768 + tid];
      __hip_atomic_store(xs + pn * 256 + tid, tot, __ATOMIC_RELAXED, __HIP_MEMORY_SCOPE_AGENT);
    }
    asm volatile("s_waitcnt vmcnt(0)" ::: "memory");
    __syncthreads();
    unsigned* cnt = p.bar + 64 + pm;
    if (tid == 0) __hip_atomic_fetch_add(cnt, 1u, __ATOMIC_RELAXED, __HIP_MEMORY_SCOPE_AGENT);
    if (wid == 0) {
      unsigned spins = 0;
      while (__hip_atomic_load(cnt, __ATOMIC_RELAXED, __HIP_MEMORY_SCOPE_AGENT) < 4u && spins < (1u << 20)) { __builtin_amdgcn_s_sleep(1); ++spins; }
      __builtin_amdgcn_fence(__ATOMIC_ACQUIRE, "agent");
      asm volatile("s_waitcnt vmcnt(0)" ::: "memory");
    }
    __syncthreads();
    if (tid < 256) {
      float t = 0.f;
#pragma unroll
      for (int q = 0; q < 4; ++q) t += __hip_atomic_load(xs + q * 256 + tid, __ATOMIC_RELAXED, __HIP_MEMORY_SCOPE_AGENT);
      rsl[tid] = rsqrtf(t * (1.0f / DM) + 1e-6f);
    }
    __syncthreads();
#pragma unroll
    for (int ai = 0; ai < 2; ++ai)
#pragma unroll
      for (int m = 0; m < 4; ++m) {
        const int rl = ai * HALF + wr * 64 + m * 16 + fr;
        const float rs = rsl[rl];
#pragma unroll
        for (int bj = 0; bj < 2; ++bj) {
          const int col = bcol + bj * HALF + wc * 32 + 8 * fq;
          const f32x4 g0 = *(const f32x4*)(p.fg + col), g1 = *(const f32x4*)(p.fg + col + 4);
          float* o = p.out + (size_t)(brow + rl) * DM + col;
          *(f32x4*)o = acc[ai][bj][m][0] * rs * g0; *(f32x4*)(o + 4) = acc[ai][bj][m][1] * rs * g1;
        }
      }
    __syncthreads();
  }
}

DI void tile_of(int L, int nM, int nN, int& pm, int& pn) {
  const int nwg = nM * nN, NX = 8, WGM = 8;
  int wgid = L; { const int q = nwg / NX, r = nwg % NX, xcd = wgid % NX, off = wgid / NX; wgid = (xcd < r ? xcd * (q + 1) : r * (q + 1) + (xcd - r) * q) + off; }
  const int nig = WGM * nN, gid = wgid / nig, fm = gid * WGM, gsz = (nM - fm) < WGM ? (nM - fm) : WGM;
  pm = fm + ((wgid % nig) % gsz); pn = (wgid % nig) / gsz;
}

template <int EPI>
DI void phase_gemm(LAS unsigned char* shm, const Params& p, int bid, int nb) {
  const int nM = T_TOK / BM, nN = (EPI == 1 ? NW : DM) / BM, nT = nM * nN;
  bool primed = false;
  for (int L = bid; L < nT; L += nb) {
    int pm, pn; tile_of(L, nM, nN, pm, pn);
    int npm = -1, npn = 0;
    if (L + nb < nT) tile_of(L + nb, nM, nN, npm, npn);
    const int nbrow = npm < 0 ? -1 : npm * BM;
    if (EPI == 1) gemm_tile<1>(shm, p.xb, p.winT, pm * BM, pn * BM, primed, nbrow, npn * BM, p);
    else gemm_tile<2>(shm, p.mixed, p.woutT, pm * BM, pn * BM, primed, nbrow, npn * BM, p);
    primed = true;
  }
  asm volatile("s_waitcnt vmcnt(0)" ::: "memory");
}

DI void phase_rotary(const Params& p, int bid, int nb) {
  const long total = (long)T_TOK * 768;
  for (long idx = (long)bid * blockDim.x + threadIdx.x; idx < total; idx += (long)nb * blockDim.x) {
    const int tok = (int)(idx / 768); int j = (int)(idx % 768);
    const int pos = tok & (SEQ - 1);
    int a, b; float sc; const float2* tab;
    if (j < 256) { const int h = j >> 5, i = j & 31; a = OFF_QA + h * 64 + i; b = a + 32; sc = 0.125f; tab = p.ropeT + pos * 32 + i; }
    else if (j < 512) { j -= 256; const int h = j >> 5, i = j & 31; a = OFF_KA + h * 64 + i; b = a + 32; sc = 1.f; tab = p.ropeT + pos * 32 + i; }
    else if (j < 640) { j -= 512; const int h = j >> 5, i = j & 31; a = OFF_QR + h * 64 + 2 * i; b = a + 1; sc = 1.f; tab = p.retT + pos * 32 + i; }
    else { j -= 640; const int h = j >> 5, i = j & 31; a = OFF_KR + h * 64 + 2 * i; b = a + 1; sc = 0.125f; tab = p.retT + pos * 32 + i; }
    const float2 cs = *tab;
    bf16_t* row = p.proj + (size_t)tok * NW;
    const float x1 = bf2f(row[a]), x2 = bf2f(row[b]);
    row[a] = f2bf((x1 * cs.x - x2 * cs.y) * sc);
    row[b] = f2bf((x2 * cs.x + x1 * cs.y) * sc);
  }
}

DI void load_row64(const bf16_t* src, float* dst) {
#pragma unroll
  for (int c = 0; c < 8; ++c) {
    const u32x4 w = *(const u32x4*)(src + c * 8);
    dst[c * 8 + 0] = bflo(w.x); dst[c * 8 + 1] = bfhi(w.x); dst[c * 8 + 2] = bflo(w.y); dst[c * 8 + 3] = bfhi(w.y);
    dst[c * 8 + 4] = bflo(w.z); dst[c * 8 + 5] = bfhi(w.z); dst[c * 8 + 6] = bflo(w.w); dst[c * 8 + 7] = bfhi(w.w);
  }
}

DI void phase_attn_naive(const Params& p, int bid, int nb) {
  const long total = (long)T_TOK * 8;
  for (long idx = (long)bid * blockDim.x + threadIdx.x; idx < total; idx += (long)nb * blockDim.x) {
    const int h = (int)(idx & 7), tok = (int)(idx >> 3);
    const int pos = tok & (SEQ - 1), tb = tok - pos;
    float q[64], o[64];
    load_row64(p.proj + (size_t)tok * NW + OFF_QA + h * 64, q);
#pragma unroll
    for (int d = 0; d < 64; ++d) o[d] = 0.f;
    float m = -1e30f, l = 0.f;
    for (int br = 0; br < 3; ++br) {
      const int dl = br == 0 ? 1 : (br == 1 ? 4 : 16);
      for (int j = 0; j <= 128; ++j) {
        const int pk = pos - j * dl; if (pk < 0) break;
        const bf16_t* kr = p.proj + (size_t)(tb + pk) * NW + OFF_KA + h * 64;
        float s = 0.f;
#pragma unroll
        for (int c = 0; c < 8; ++c) {
          const u32x4 w = *(const u32x4*)(kr + c * 8);
          s += q[c * 8 + 0] * bflo(w.x) + q[c * 8 + 1] * bfhi(w.x) + q[c * 8 + 2] * bflo(w.y) + q[c * 8 + 3] * bfhi(w.y)
             + q[c * 8 + 4] * bflo(w.z) + q[c * 8 + 5] * bfhi(w.z) + q[c * 8 + 6] * bflo(w.w) + q[c * 8 + 7] * bfhi(w.w);
        }
        const float mn = fmaxf(m, s), al = __expf(m - mn), pe = __expf(s - mn);
        m = mn; l = l * al + pe;
        const bf16_t* vr = kr + (OFF_VA - OFF_KA);
#pragma unroll
        for (int c = 0; c < 8; ++c) {
          const u32x4 w = *(const u32x4*)(vr + c * 8);
          o[c * 8 + 0] = o[c * 8 + 0] * al + pe * bflo(w.x); o[c * 8 + 1] = o[c * 8 + 1] * al + pe * bfhi(w.x);
          o[c * 8 + 2] = o[c * 8 + 2] * al + pe * bflo(w.y); o[c * 8 + 3] = o[c * 8 + 3] * al + pe * bfhi(w.y);
          o[c * 8 + 4] = o[c * 8 + 4] * al + pe * bflo(w.z); o[c * 8 + 5] = o[c * 8 + 5] * al + pe * bfhi(w.z);
          o[c * 8 + 6] = o[c * 8 + 6] * al + pe * bflo(w.w); o[c * 8 + 7] = o[c * 8 + 7] * al + pe * bfhi(w.w);
        }
      }
    }
    const float il = 1.0f / l;
    const bf16_t* gr = p.proj + (size_t)tok * NW + OFF_GA + h * 64;
    bf16_t* mo = p.mixed + (size_t)tok * DM + h * 64;
#pragma unroll
    for (int c = 0; c < 8; ++c) {
      const u32x4 w = *(const u32x4*)(gr + c * 8);
      float g[8] = {bflo(w.x), bfhi(w.x), bflo(w.y), bfhi(w.y), bflo(w.z), bfhi(w.z), bflo(w.w), bfhi(w.w)};
      float r[8];
#pragma unroll
      for (int e = 0; e < 8; ++e) r[e] = o[c * 8 + e] * il * (g[e] / (1.0f + __expf(-g[e])));
      u32x4 ww; ww.x = pack2(r[0], r[1]); ww.y = pack2(r[2], r[3]); ww.z = pack2(r[4], r[5]); ww.w = pack2(r[6], r[7]);
      *(u32x4*)(mo + c * 8) = ww;
    }
  }
}

DI float ret_log2g(int h) { return log2f(1.0f - exp2f(-5.0f - (float)h)); }

DI void phase_retkv_naive(const Params& p, int bid, int nb) {
  const long total = 1024L * 8192;
  for (long idx = (long)bid * blockDim.x + threadIdx.x; idx < total; idx += (long)nb * blockDim.x) {
    const int d = (int)(idx & 63), v = (int)((idx >> 6) & 127), u = (int)(idx >> 13);
    const int n = u & 31, h = (u >> 5) & 3, b = u >> 7;
    const float lg = ret_log2g(h);
    const bf16_t* base = p.proj + (size_t)(b * SEQ + n * 128) * NW;
    float s = 0.f;
    for (int j = 0; j < 128; ++j) {
      const float kk = bf2f(base[(size_t)j * NW + OFF_KR + h * 64 + d]), vv = bf2f(base[(size_t)j * NW + OFF_VR + h * 128 + v]);
      s += kk * exp2f((float)(127 - j) * lg) * vv;
    }
    p.kvT[idx] = s;
  }
}
DI void phase_retscan(const Params& p, int bid, int nb) {
  const long total = 32L * 4096;
  typedef float f32x2 __attribute__((ext_vector_type(2)));
  const float* __restrict__ kv = p.kvT; bf16_t* __restrict__ stp = p.stT;
  for (long idx = (long)bid * blockDim.x + threadIdx.x; idx < total; idx += (long)nb * blockDim.x) {
    const int e = (int)(idx & 4095) * 2, bh = (int)(idx >> 12), h = bh & 3;
    const float cd = exp2f(128.0f * ret_log2g(h));
    f32x2 kr[31];
#pragma unroll
    for (int n = 0; n < 31; ++n) kr[n] = *(const f32x2*)(kv + ((size_t)(bh * 32 + n) << 13) + e);
    float s0 = 0.f, s1 = 0.f;
#pragma unroll
    for (int n = 0; n < 32; ++n) {
      *(unsigned*)(stp + ((size_t)(bh * 32 + n) << 13) + e) = pack2(s0, s1);
      if (n < 31) { s0 = s0 * cd + kr[n][0]; s1 = s1 * cd + kr[n][1]; }
    }
  }
}
DI void phase_retout_naive(const Params& p, int bid, int nb) {
  const long total = 1024L * 256;
  for (long idx = (long)bid * blockDim.x + threadIdx.x; idx < total; idx += (long)nb * blockDim.x) {
    const int vh = (int)(idx & 1), i = (int)((idx >> 1) & 127), u = (int)(idx >> 8);
    const int n = u & 31, h = (u >> 5) & 3, b = u >> 7;
    const float lg = ret_log2g(h);
    const int tok0 = b * SEQ + n * 128, tok = tok0 + i;
    float o[64];
#pragma unroll
    for (int v = 0; v < 64; ++v) o[v] = 0.f;
    const bf16_t* qrow = p.proj + (size_t)tok * NW + OFF_QR + h * 64;
    for (int j = 0; j <= i; ++j) {
      const bf16_t* krow = p.proj + (size_t)(tok0 + j) * NW + OFF_KR + h * 64;
      float s = 0.f;
#pragma unroll
      for (int c = 0; c < 8; ++c) {
        const u32x4 a = *(const u32x4*)(qrow + c * 8), w = *(const u32x4*)(krow + c * 8);
        s += bflo(a.x) * bflo(w.x) + bfhi(a.x) * bfhi(w.x) + bflo(a.y) * bflo(w.y) + bfhi(a.y) * bfhi(w.y)
           + bflo(a.z) * bflo(w.z) + bfhi(a.z) * bfhi(w.z) + bflo(a.w) * bflo(w.w) + bfhi(a.w) * bfhi(w.w);
      }
      s *= exp2f((float)(i - j) * lg);
      const bf16_t* vrow = p.proj + (size_t)(tok0 + j) * NW + OFF_VR + h * 128 + vh * 64;
#pragma unroll
      for (int c = 0; c < 8; ++c) {
        const u32x4 w = *(const u32x4*)(vrow + c * 8);
        o[c * 8 + 0] += s * bflo(w.x); o[c * 8 + 1] += s * bfhi(w.x); o[c * 8 + 2] += s * bflo(w.y); o[c * 8 + 3] += s * bfhi(w.y);
        o[c * 8 + 4] += s * bflo(w.z); o[c * 8 + 5] += s * bfhi(w.z); o[c * 8 + 6] += s * bflo(w.w); o[c * 8 + 7] += s * bfhi(w.w);
      }
    }
    const float qd = exp2f((float)(i + 1) * lg);
    const bf16_t* st = p.stT + ((size_t)u << 13) + vh * 64 * 64;
    for (int d = 0; d < 64; ++d) {
      const float qq = bf2f(qrow[d]) * qd;
#pragma unroll
      for (int v = 0; v < 64; ++v) o[v] += qq * bf2f(st[v * 64 + d]);
    }
    float mu = 0.f;
#pragma unroll
    for (int v = 0; v < 64; ++v) mu += o[v];
    mu += __shfl_xor(mu, 1);
    mu *= (1.0f / 128.0f);
    float var = 0.f;
#pragma unroll
    for (int v = 0; v < 64; ++v) { const float dd = o[v] - mu; var += dd * dd; }
    var += __shfl_xor(var, 1);
    const float rs = rsqrtf(var * (1.0f / 128.0f) + 1e-5f);
    const bf16_t* gr = p.proj + (size_t)tok * NW + OFF_GR + h * 128 + vh * 64;
    bf16_t* mo = p.mixed + (size_t)tok * DM + 512 + h * 128 + vh * 64;
#pragma unroll
    for (int c = 0; c < 8; ++c) {
      const u32x4 w = *(const u32x4*)(gr + c * 8);
      float g[8] = {bflo(w.x), bfhi(w.x), bflo(w.y), bfhi(w.y), bflo(w.z), bfhi(w.z), bflo(w.w), bfhi(w.w)};
      float r[8];
#pragma unroll
      for (int e = 0; e < 8; ++e) r[e] = (o[c * 8 + e] - mu) * rs * p.gn[h * 128 + vh * 64 + c * 8 + e] * (g[e] / (1.0f + __expf(-g[e])));
      u32x4 ww; ww.x = pack2(r[0], r[1]); ww.y = pack2(r[2], r[3]); ww.z = pack2(r[4], r[5]); ww.w = pack2(r[6], r[7]);
      *(u32x4*)(mo + c * 8) = ww;
    }
  }
}

typedef float f32x16 __attribute__((ext_vector_type(16)));
typedef short s16x4 __attribute__((ext_vector_type(4)));
#define MFMA32(a, b, c) __builtin_amdgcn_mfma_f32_32x32x16_bf16((a), (b), (c), 0, 0, 0)
DI s16x4 tr_read(LAS unsigned char* a) { return __builtin_amdgcn_ds_read_tr16_b64_v4i16((LAS s16x4*)a); }
DI bf16x8 tr_frag(LAS unsigned char* a, int rowstride8) {
  const s16x4 lo = tr_read(a), hi = tr_read(a + rowstride8);
  return __builtin_shufflevector(lo, hi, 0, 1, 2, 3, 4, 5, 6, 7);
}
DI bf16x8 pack8(const f32x16& x, int s) {
  u32x4 w;
  w.x = pack2(x[8 * s + 0], x[8 * s + 1]); w.y = pack2(x[8 * s + 2], x[8 * s + 3]); w.z = pack2(x[8 * s + 4], x[8 * s + 5]); w.w = pack2(x[8 * s + 6], x[8 * s + 7]);
  return __builtin_bit_cast(bf16x8, w);
}
DI float fexp2(float x) { return __builtin_amdgcn_exp2f(x); }
DI float half_max(float x) { const u32x2 r = __builtin_amdgcn_permlane32_swap(__float_as_uint(x), __float_as_uint(x), false, false); return fmaxf(__uint_as_float(r[0]), __uint_as_float(r[1])); }
DI float half_sum(float x) { const u32x2 r = __builtin_amdgcn_permlane32_swap(__float_as_uint(x), __float_as_uint(x), false, false); return __uint_as_float(r[0]) + __uint_as_float(r[1]); }
DI float silu(float g) { return g / (1.0f + __expf(-g)); }

constexpr int AT_ROWB = 136, AT_LS = 512 * AT_ROWB, AT_VST = AT_LS + 2048, VROW = 192, KROW = 144, KST_W = 32 * KROW, VST_W = KST_W + 32 * VROW;
constexpr int ATTN_LDS = AT_VST + 8 * VST_W;
constexpr float LOG2E = 1.4426950408889634f;

constexpr int PT_ROW = 136;

DI void softmax_pv(f32x16& S, f32x16& O0, f32x16& O1, float& m, float& l, const bf16x8 (&Vf)[2][2], const bool mlow, const bool mhigh, const int r, const int h) {
  if (mlow || mhigh) {
#pragma unroll
    for (int i = 0; i < 16; ++i) {
      const int keyrow = (i & 3) + 8 * (i >> 2) + 4 * h;
      const bool bad = (mlow && keyrow < r) || (mhigh && keyrow > r);
      S[i] = bad ? -1e30f : S[i];
    }
  }
  float mx = fmaxf(S[0], S[1]);
#pragma unroll
  for (int i = 2; i < 16; ++i) mx = fmaxf(mx, S[i]);
  mx = half_max(mx);
  const float mn = fmaxf(m, mx);
  if (__builtin_amdgcn_ballot_w64(mn > m) != 0ull) {
    const float al = fexp2(m - mn);
    l *= al;
#pragma unroll
    for (int i = 0; i < 16; ++i) { O0[i] *= al; O1[i] *= al; }
    m = mn;
  }
  float ps = 0.f;
#pragma unroll
  for (int i = 0; i < 16; ++i) { S[i] = fexp2(S[i] - mn); ps += S[i]; }
  l += half_sum(ps);
#pragma unroll
  for (int s = 0; s < 2; ++s) {
    const bf16x8 Pb = pack8(S, s);
    O0 = MFMA32(Vf[s][0], Pb, O0);
    O1 = MFMA32(Vf[s][1], Pb, O1);
  }
}

DI void attn_tile2(const u32x4 (&Kc)[4], const u32x4 (&Vc)[4], const bf16x8 (&QA)[4], const bf16x8 (&QB)[4],
                   f32x16& A0, f32x16& A1, float& mA, float& lA, f32x16& B0, f32x16& B1, float& mB, float& lB,
                   LAS unsigned char* kst, LAS unsigned char* vst, LAS unsigned char* trp, const int lane, const int kt) {
  const int r = lane & 31, h = lane >> 5;
#pragma unroll
  for (int c = 0; c < 4; ++c) {
    *(LAS u32x4*)(kst + ((lane >> 3) + 8 * c) * KROW + (lane & 7) * 16) = Kc[c];
    *(LAS u32x4*)(vst + ((lane >> 3) + 8 * c) * VROW + (lane & 7) * 16) = Vc[c];
  }
  bf16x8 Kf[4], Vf[2][2];
#pragma unroll
  for (int ks = 0; ks < 4; ++ks) Kf[ks] = *(const LAS bf16x8*)(kst + r * KROW + (2 * ks + h) * 16);
#pragma unroll
  for (int s = 0; s < 2; ++s) { Vf[s][0] = tr_frag(trp + 16 * s * VROW, 8 * VROW); Vf[s][1] = tr_frag(trp + 16 * s * VROW + 64, 8 * VROW); }
  if (kt <= 4) {
    f32x16 S;
#pragma unroll
    for (int i = 0; i < 16; ++i) S[i] = 0.f;
#pragma unroll
    for (int ks = 0; ks < 4; ++ks) S = MFMA32(Kf[ks], QA[ks], S);
    softmax_pv(S, A0, A1, mA, lA, Vf, kt == 0, kt == 4, r, h);
  }
  if (kt >= 1) {
    f32x16 S;
#pragma unroll
    for (int i = 0; i < 16; ++i) S[i] = 0.f;
#pragma unroll
    for (int ks = 0; ks < 4; ++ks) S = MFMA32(Kf[ks], QB[ks], S);
    softmax_pv(S, B0, B1, mB, lB, Vf, kt == 1, kt == 5, r, h);
  }
}

DI void attn_merge(const Params& p, LAS unsigned char* T, const f32x16& O0, const f32x16& O1, const float m, const float l, const int lane,
                   const int tokq0  , const int sh, const int hh, const bool first, const bool last) {
  const int r = lane & 31, h = lane >> 5;
  const int rowc = lane >> 3, ch = lane & 7;
  float lse = m + __log2f(l);
  float w1 = 1.0f / l, w0 = 0.f;
  if (!first) {
#pragma unroll
    for (int c = 0; c < 4; ++c) {
      const size_t tk = (size_t)(tokq0 + ((rowc + 8 * c) << sh));
      *(LAS u32x4*)(T + (rowc + 8 * c) * PT_ROW + ch * 16) = *(const u32x4*)(p.ob + (tk * 8 + hh) * 64 + ch * 8);
    }
    const float lp = p.lseg[(size_t)(tokq0 + (r << sh)) * 8 + hh];
    const float M = fmaxf(lse, lp), e1 = fexp2(lse - M), e0 = fexp2(lp - M), den = e0 + e1, id = 1.0f / den;
    w1 *= e1 * id; w0 = e0 * id; lse = M + __log2f(den);
  }
  LAS unsigned char* ob = T + r * PT_ROW + 8 * h;
#pragma unroll
  for (int dt = 0; dt < 2; ++dt)
#pragma unroll
    for (int g = 0; g < 4; ++g) {
      float f0, f1, f2, f3;
      if (dt == 0) { f0 = O0[4 * g] * w1; f1 = O0[4 * g + 1] * w1; f2 = O0[4 * g + 2] * w1; f3 = O0[4 * g + 3] * w1; }
      else { f0 = O1[4 * g] * w1; f1 = O1[4 * g + 1] * w1; f2 = O1[4 * g + 2] * w1; f3 = O1[4 * g + 3] * w1; }
      LAS u32x2* a = (LAS u32x2*)(ob + 64 * dt + 16 * g);
      if (!first) { const u32x2 pv = *a; f0 += w0 * bflo(pv.x); f1 += w0 * bfhi(pv.x); f2 += w0 * bflo(pv.y); f3 += w0 * bfhi(pv.y); }
      u32x2 wv; wv.x = pack2(f0, f1); wv.y = pack2(f2, f3);
      *a = wv;
    }
  if (!last) {
    if (h == 0) p.lseg[(size_t)(tokq0 + (r << sh)) * 8 + hh] = lse;
#pragma unroll
    for (int c = 0; c < 4; ++c) {
      const size_t tk = (size_t)(tokq0 + ((rowc + 8 * c) << sh));
      *(u32x4*)(p.ob + (tk * 8 + hh) * 64 + ch * 8) = *(const LAS u32x4*)(T + (rowc + 8 * c) * PT_ROW + ch * 16);
    }
  } else {
#pragma unroll
    for (int c = 0; c < 4; ++c) {
      const size_t tk = (size_t)(tokq0 + ((rowc + 8 * c) << sh));
      const u32x4 a = *(const LAS u32x4*)(T + (rowc + 8 * c) * PT_ROW + ch * 16);
      const u32x4 g = *(const u32x4*)(p.proj + tk * NW + OFF_GA + hh * 64 + ch * 8);
      u32x4 w;
      w.x = pack2(bflo(a.x) * silu(bflo(g.x)), bfhi(a.x) * silu(bfhi(g.x)));
      w.y = pack2(bflo(a.y) * silu(bflo(g.y)), bfhi(a.y) * silu(bfhi(g.y)));
      w.z = pack2(bflo(a.z) * silu(bflo(g.z)), bfhi(a.z) * silu(bfhi(g.z)));
      w.w = pack2(bflo(a.w) * silu(bflo(g.w)), bfhi(a.w) * silu(bfhi(g.w)));
      *(u32x4*)(p.mixed + tk * DM + hh * 64 + ch * 8) = w;
    }
  }
}

DI void attn_task2(const Params& p, LAS unsigned char* kst, const int lane, const int tokbase, const int hh,
                   const int sh, const int r_res, const int l0, const bool first, const bool last) {
  const int r = lane & 31, h = lane >> 5;
  const int i16 = lane & 15, q4 = i16 >> 2, pp = i16 & 3, blk = (lane >> 4) & 1;
  LAS unsigned char* vst = kst + KST_W;
  LAS unsigned char* trp = vst + (4 * h + q4) * VROW + 32 * blk + 8 * pp;
  const bf16_t* qpA = p.proj + (size_t)(tokbase + r_res + ((l0 + r) << sh)) * NW + OFF_QA + hh * 64 + 8 * h;
  const bf16_t* qpB = qpA + (size_t)(32 << sh) * NW;
  bf16x8 QA[4], QB[4];
#pragma unroll
  for (int ks = 0; ks < 4; ++ks) { QA[ks] = *(const bf16x8*)(qpA + 16 * ks); QB[ks] = *(const bf16x8*)(qpB + 16 * ks); }
  f32x16 A0, A1, B0, B1;
#pragma unroll
  for (int i = 0; i < 16; ++i) { A0[i] = 0.f; A1[i] = 0.f; B0[i] = 0.f; B1[i] = 0.f; }
  float mA = -1e30f, lA = 0.f, mB = -1e30f, lB = 0.f;
  const int kt0 = (l0 >= 128) ? 0 : (4 - (l0 >> 5));
#define LOAD_KV(Kd, Vd, kt_) do { const int lk0_ = l0 - 128 + 32 * (kt_) + (lane >> 3); \
    _Pragma("unroll") for (int c_ = 0; c_ < 4; ++c_) { \
      const bf16_t* kp_ = p.proj + (size_t)(tokbase + r_res + ((lk0_ + 8 * c_) << sh)) * NW + OFF_KA + hh * 64 + 8 * (lane & 7); \
      Kd[c_] = *(const u32x4*)kp_; Vd[c_] = *(const u32x4*)(kp_ + (OFF_VA - OFF_KA)); } } while (0)
  for (int kt = kt0; kt < 6; kt += 2) {
    u32x4 K0[4], K1[4], V0[4], V1[4];
    LOAD_KV(K0, V0, kt);
    LOAD_KV(K1, V1, kt + 1);
    attn_tile2(K0, V0, QA, QB, A0, A1, mA, lA, B0, B1, mB, lB, kst, vst, trp, lane, kt);
    attn_tile2(K1, V1, QA, QB, A0, A1, mA, lA, B0, B1, mB, lB, kst, vst, trp, lane, kt + 1);
  }
#undef LOAD_KV
  const int tokA = tokbase + r_res + (l0 << sh);
  attn_merge(p, kst, A0, A1, mA, lA, lane, tokA, sh, hh, first, last);
  attn_merge(p, kst, B0, B1, mB, lB, lane, tokA + (32 << sh), sh, hh, first, last);
}

DI void phase_attn(LAS unsigned char* lds, const Params& p, int bid, int nb) {
  const int tid = threadIdx.x, wid = __builtin_amdgcn_readfirstlane(tid >> 6), lane = tid & 63;
  LAS unsigned char* kst = lds + wid * VST_W;
  for (int unit = bid; unit < 256; unit += nb) {
    const int sp = unit & 3, hh = (unit >> 2) & 7, b = unit >> 5;
    const int tokbase = b * SEQ;
    for (int stage = 0; stage < 3; ++stage) {
      const int sh = stage == 0 ? 4 : (stage == 1 ? 2 : 0);
      for (int tk = 0; tk < 2; ++tk) {
        const int idx = wid + 8 * tk;
        int r_res, l0;
        if (stage == 0) { r_res = idx; l0 = 64 * sp; }
        else if (stage == 1) { r_res = idx >> 2; l0 = 256 * sp + 64 * (idx & 3); }
        else { r_res = 0; l0 = 1024 * sp + 64 * idx; }
        attn_task2(p, kst, lane, tokbase, hh, sh, r_res, l0, stage == 0, stage == 2);
      }
      __syncthreads();
    }
  }
}

constexpr int RV_ROW = 320, RK_ROW = 192, RV_OFF = 0, RK_OFF = 128 * RV_ROW  , RRED_OFF = RK_OFF + 128 * RK_ROW  ;

DI void phase_retkv(LAS unsigned char* lds, const Params& p, int bid, int nb) {
  const int tid = threadIdx.x, wid = __builtin_amdgcn_readfirstlane(tid >> 6), lane = tid & 63;
  const int r = lane & 31, h = lane >> 5, i16 = lane & 15, q4 = i16 >> 2, pp = i16 & 3, blk = (lane >> 4) & 1;
  const int vt = wid >> 1, dt = wid & 1;
  LAS int* uslot = (LAS int*)(lds + RRED_OFF);
  for (;;) {
    if (tid == 0) *uslot = (int)__hip_atomic_fetch_add(p.bar + 200, 1u, __ATOMIC_RELAXED, __HIP_MEMORY_SCOPE_AGENT);
    __syncthreads();
    const int u = __builtin_amdgcn_readfirstlane(*uslot);
    if (u >= 1024) break;
    const int n = u & 31, hh = (u >> 5) & 3, b = u >> 7;
    const float lg = ret_log2g(hh);
    const bf16_t* base = p.proj + (size_t)(b * SEQ + n * 128) * NW;
#pragma unroll
    for (int it = 0; it < 4; ++it) {
      const int c = tid + 512 * it, j = c >> 4, cc = c & 15;
      *(LAS u32x4*)(lds + RV_OFF + j * RV_ROW + cc * 16) = *(const u32x4*)(base + (size_t)j * NW + OFF_VR + hh * 128 + cc * 8);
    }
#pragma unroll
    for (int it = 0; it < 2; ++it) {
      const int c = tid + 512 * it, j = c >> 3, cc = c & 7;
      const u32x4 w = *(const u32x4*)(base + (size_t)j * NW + OFF_KR + hh * 64 + cc * 8);
      const float dk = exp2f((float)(127 - j) * lg);
      u32x4 o;
      o.x = pack2(bflo(w.x) * dk, bfhi(w.x) * dk); o.y = pack2(bflo(w.y) * dk, bfhi(w.y) * dk);
      o.z = pack2(bflo(w.z) * dk, bfhi(w.z) * dk); o.w = pack2(bflo(w.w) * dk, bfhi(w.w) * dk);
      *(LAS u32x4*)(lds + RK_OFF + j * RK_ROW + cc * 16) = o;
    }
    __syncthreads();
    f32x16 acc;
#pragma unroll
    for (int i = 0; i < 16; ++i) acc[i] = 0.f;
    LAS unsigned char* va = lds + RV_OFF + (4 * h + q4) * RV_ROW + (32 * vt + 16 * blk + 4 * pp) * 2;
    LAS unsigned char* ka = lds + RK_OFF + (4 * h + q4) * RK_ROW + (32 * dt + 16 * blk + 4 * pp) * 2;
#pragma unroll
    for (int s = 0; s < 8; ++s) {
      const bf16x8 A = tr_frag(va + 16 * s * RV_ROW, 8 * RV_ROW), B = tr_frag(ka + 16 * s * RK_ROW, 8 * RK_ROW);
      acc = MFMA32(A, B, acc);
    }
    float* o = p.kvT + ((size_t)u << 13) + (32 * vt + 4 * h) * 64 + 32 * dt + r;
#pragma unroll
    for (int i = 0; i < 16; ++i) __hip_atomic_store(o + ((i & 3) + 8 * (i >> 2)) * 64, acc[i], __ATOMIC_RELAXED, __HIP_MEMORY_SCOPE_AGENT);
    asm volatile("s_waitcnt vmcnt(0)" ::: "memory");
    __syncthreads();
    const int bh = u >> 5;
    if (tid == 0) uslot[1] = (__hip_atomic_fetch_add(p.bar + 208 + bh, 1u, __ATOMIC_RELAXED, __HIP_MEMORY_SCOPE_AGENT) == 31u) ? 1 : 0;
    __syncthreads();
    if (__builtin_amdgcn_readfirstlane(uslot[1]) != 0) {
      if (tid == 0) { __builtin_amdgcn_fence(__ATOMIC_ACQUIRE, "agent"); asm volatile("s_waitcnt vmcnt(0)" ::: "memory"); }
      __syncthreads();
      typedef float f32x2 __attribute__((ext_vector_type(2)));
      const float cd = exp2f(128.0f * lg);
      for (int e2 = tid; e2 < 4096; e2 += 512) {
        const int e = e2 * 2;
        f32x2 kr[31];
#pragma unroll
        for (int nn = 0; nn < 31; ++nn) {
          const float* a = p.kvT + ((size_t)(bh * 32 + nn) << 13) + e;
          kr[nn][0] = __hip_atomic_load(a, __ATOMIC_RELAXED, __HIP_MEMORY_SCOPE_AGENT); kr[nn][1] = __hip_atomic_load(a + 1, __ATOMIC_RELAXED, __HIP_MEMORY_SCOPE_AGENT);
        }
        float s0 = 0.f, s1 = 0.f;
#pragma unroll
        for (int nn = 0; nn < 32; ++nn) {
          *(unsigned*)(p.stT + ((size_t)(bh * 32 + nn) << 13) + e) = pack2(s0, s1);
          if (nn < 31) { s0 = s0 * cd + kr[nn][0]; s1 = s1 * cd + kr[nn][1]; }
        }
      }
    }
    __syncthreads();
  }
}

constexpr int RKO = 40960, RQO = RKO + 128 * 144, RSO = RQO + 128 * 144, RGO = RSO + 128 * 144, RG_ROW = 272, RRED2 = RGO + 128 * RG_ROW;
DI void phase_retout(LAS unsigned char* lds, const Params& p, int bid, int nb) {
  const int tid = threadIdx.x, wid = __builtin_amdgcn_readfirstlane(tid >> 6), lane = tid & 63;
  const int r = lane & 31, h = lane >> 5, i16 = lane & 15, q4 = i16 >> 2, pp = i16 & 3, blk = (lane >> 4) & 1;
  const int it = wid & 3, vh = wid >> 2;
  LAS float* red = (LAS float*)(lds + RRED2);
  for (int u = bid; u < 1024; u += nb) {
    const int n = u & 31, hh = (u >> 5) & 3, b = u >> 7;
    const float lg = ret_log2g(hh);
    const int tok0 = b * SEQ + n * 128;
    const bf16_t* base = p.proj + (size_t)tok0 * NW;
    {
      u32x4 tv[4], tg[4], tk[2], tq[2], ts[2];
#pragma unroll
      for (int k = 0; k < 4; ++k) {
        const int c = tid + 512 * k, j = c >> 4, cc = c & 15;
        tv[k] = *(const u32x4*)(base + (size_t)j * NW + OFF_VR + hh * 128 + cc * 8);
        tg[k] = *(const u32x4*)(base + (size_t)j * NW + OFF_GR + hh * 128 + cc * 8);
      }
#pragma unroll
      for (int k = 0; k < 2; ++k) {
        const int c = tid + 512 * k, j = c >> 3, cc = c & 7;
        tk[k] = *(const u32x4*)(base + (size_t)j * NW + OFF_KR + hh * 64 + cc * 8);
        tq[k] = *(const u32x4*)(base + (size_t)j * NW + OFF_QR + hh * 64 + cc * 8);
        ts[k] = *(const u32x4*)(p.stT + ((size_t)u << 13) + (size_t)c * 8);
      }
#pragma unroll
      for (int k = 0; k < 4; ++k) {
        const int c = tid + 512 * k, j = c >> 4, cc = c & 15;
        *(LAS u32x4*)(lds + RV_OFF + j * RV_ROW + cc * 16) = tv[k];
        *(LAS u32x4*)(lds + RGO + j * RG_ROW + cc * 16) = tg[k];
      }
#pragma unroll
      for (int k = 0; k < 2; ++k) {
        const int c = tid + 512 * k, j = c >> 3, cc = c & 7;
        *(LAS u32x4*)(lds + RKO + j * 144 + cc * 16) = tk[k];
        *(LAS u32x4*)(lds + RQO + j * 144 + cc * 16) = tq[k];
        *(LAS u32x4*)(lds + RSO + j * 144 + cc * 16) = ts[k];
      }
    }
    __syncthreads();
    const int qi = 32 * it + r;
    bf16x8 Qf[4];
#pragma unroll
    for (int ks = 0; ks < 4; ++ks) Qf[ks] = *(const LAS bf16x8*)(lds + RQO + qi * 144 + (2 * ks + h) * 16);
    f32x16 O0, O1;
#pragma unroll
    for (int i = 0; i < 16; ++i) { O0[i] = 0.f; O1[i] = 0.f; }
    {
#pragma unroll
      for (int ks = 0; ks < 4; ++ks) {
        const bf16x8 S0 = *(const LAS bf16x8*)(lds + RSO + (64 * vh + r) * 144 + (2 * ks + h) * 16);
        const bf16x8 S1 = *(const LAS bf16x8*)(lds + RSO + (64 * vh + 32 + r) * 144 + (2 * ks + h) * 16);
        O0 = MFMA32(S0, Qf[ks], O0); O1 = MFMA32(S1, Qf[ks], O1);
      }
      const float qd = exp2f((float)(qi + 1) * lg);
#pragma unroll
      for (int i = 0; i < 16; ++i) { O0[i] *= qd; O1[i] *= qd; }
    }
    LAS unsigned char* va = lds + RV_OFF + (4 * h + q4) * RV_ROW + (64 * vh + 16 * blk + 4 * pp) * 2;
    for (int jt = 0; jt <= it; ++jt) {
      f32x16 S;
#pragma unroll
      for (int i = 0; i < 16; ++i) S[i] = 0.f;
#pragma unroll
      for (int ks = 0; ks < 4; ++ks) { const bf16x8 Kf = *(const LAS bf16x8*)(lds + RKO + (32 * jt + r) * 144 + (2 * ks + h) * 16); S = MFMA32(Kf, Qf[ks], S); }
#pragma unroll
      for (int i = 0; i < 16; ++i) {
        const int dj = qi - (32 * jt + (i & 3) + 8 * (i >> 2) + 4 * h);
        S[i] = dj >= 0 ? S[i] * fexp2((float)dj * lg) : 0.f;
      }
#pragma unroll
      for (int s2 = 0; s2 < 2; ++s2) {
        const bf16x8 Pb = pack8(S, s2);
        const bf16x8 V0 = tr_frag(va + (32 * jt + 16 * s2) * RV_ROW, 8 * RV_ROW), V1 = tr_frag(va + (32 * jt + 16 * s2) * RV_ROW + 64, 8 * RV_ROW);
        O0 = MFMA32(V0, Pb, O0);
        O1 = MFMA32(V1, Pb, O1);
      }
    }
    float s1 = 0.f, s2 = 0.f;
#pragma unroll
    for (int i = 0; i < 16; ++i) { s1 += O0[i] + O1[i]; s2 += O0[i] * O0[i] + O1[i] * O1[i]; }
    s1 += __shfl_xor(s1, 32); s2 += __shfl_xor(s2, 32);
    if (h == 0) { red[(vh * 128 + qi) * 2] = s1; red[(vh * 128 + qi) * 2 + 1] = s2; }
    __syncthreads();
    s1 += red[((vh ^ 1) * 128 + qi) * 2]; s2 += red[((vh ^ 1) * 128 + qi) * 2 + 1];
    const float mu = s1 * (1.0f / 128.0f), var = fmaxf(s2 * (1.0f / 128.0f) - mu * mu, 0.f), rs = rsqrtf(var + 1e-5f);
    const float* gnp = p.gn + hh * 128 + 64 * vh + 4 * h;
    LAS unsigned char* gt = lds + RGO + qi * RG_ROW + (64 * vh + 4 * h) * 2;
#pragma unroll
    for (int dt = 0; dt < 2; ++dt)
#pragma unroll
      for (int g = 0; g < 4; ++g) {
        const int vo = 32 * dt + 8 * g;
        LAS u32x2* ga = (LAS u32x2*)(gt + vo * 2);
        const u32x2 gwv = *ga;
        const f32x4 gnv = *(const f32x4*)(gnp + vo);
        float f0, f1, f2, f3;
        if (dt == 0) { f0 = O0[4 * g]; f1 = O0[4 * g + 1]; f2 = O0[4 * g + 2]; f3 = O0[4 * g + 3]; }
        else { f0 = O1[4 * g]; f1 = O1[4 * g + 1]; f2 = O1[4 * g + 2]; f3 = O1[4 * g + 3]; }
        f0 = (f0 - mu) * rs * gnv[0] * silu(bflo(gwv.x)); f1 = (f1 - mu) * rs * gnv[1] * silu(bfhi(gwv.x));
        f2 = (f2 - mu) * rs * gnv[2] * silu(bflo(gwv.y)); f3 = (f3 - mu) * rs * gnv[3] * silu(bfhi(gwv.y));
        u32x2 wv; wv.x = pack2(f0, f1); wv.y = pack2(f2, f3);
        *ga = wv;
      }
    __syncthreads();
#pragma unroll
    for (int k = 0; k < 4; ++k) {
      const int c = tid + 512 * k, j = c >> 4, cc = c & 15;
      *(u32x4*)(p.mixed + (size_t)(tok0 + j) * DM + 512 + hh * 128 + cc * 8) = *(const LAS u32x4*)(lds + RGO + j * RG_ROW + cc * 16);
    }
    __syncthreads();
  }
}

DI void phase_final(const Params& p, int bid, int nb) {
  const int tid = threadIdx.x, lane = tid & 63, wid = tid >> 6, nw = blockDim.x >> 6;
  for (int row = bid * nw + wid; row < T_TOK; row += nb * nw) {
    const float rs = rsqrtf(p.rowss[row] * (1.0f / DM) + 1e-6f);
    float* yr = p.out + (size_t)row * DM;
#pragma unroll
    for (int it = 0; it < 4; ++it) {
      const f32x4 v = *(const f32x4*)(yr + it * 256 + lane * 4), g = *(const f32x4*)(p.fg + it * 256 + lane * 4);
      *(f32x4*)(yr + it * 256 + lane * 4) = v * rs * g;
    }
  }
}

DI void grid_barrier(unsigned* ctr, unsigned target) {
  asm volatile("s_waitcnt vmcnt(0) lgkmcnt(0)" ::: "memory");
  __syncthreads();
  if (threadIdx.x == 0) {
    __builtin_amdgcn_fence(__ATOMIC_RELEASE, "agent");
    asm volatile("s_waitcnt vmcnt(0)" ::: "memory");
    __hip_atomic_fetch_add(ctr, 1u, __ATOMIC_RELAXED, __HIP_MEMORY_SCOPE_AGENT);
    unsigned spins = 0;
    while (__hip_atomic_load(ctr, __ATOMIC_RELAXED, __HIP_MEMORY_SCOPE_AGENT) < target && spins < (1u << 22)) { __builtin_amdgcn_s_sleep(2); ++spins; }
    __builtin_amdgcn_fence(__ATOMIC_ACQUIRE, "agent");
    asm volatile("s_waitcnt vmcnt(0)" ::: "memory");
  }
  __syncthreads();
}

__global__ void __launch_bounds__(512) k_mega(Params p) {
  extern __shared__ __attribute__((aligned(16))) unsigned char shm_[];
  LAS unsigned char* shm = (LAS unsigned char*)shm_;
  const int bid = blockIdx.x, nb = gridDim.x;
  unsigned bar_n = 0;
#ifdef PROBE_PHASE
  unsigned long long ts_a = 0, ts_b = 0; int ph_i = 0;
  if (PROBE_PHASE == 0) ts_a = __builtin_amdgcn_s_memrealtime();
#define GRID_BAR() do { bar_n += (unsigned)nb; grid_barrier(p.bar, bar_n); ++ph_i; if (ph_i == PROBE_PHASE) ts_a = __builtin_amdgcn_s_memrealtime(); if (ph_i == PROBE_PHASE + 1) ts_b = __builtin_amdgcn_s_memrealtime(); } while (0)
#else
#define GRID_BAR() do { bar_n += (unsigned)nb; grid_barrier(p.bar, bar_n); } while (0)
#endif
  phase_prep(p, bid, nb);
  GRID_BAR();
  phase_gemm<1>(shm, p, bid, nb);
  GRID_BAR();
  phase_attn(shm, p, bid, nb);
  phase_retkv(shm, p, bid, nb);
  GRID_BAR();
  phase_retout(shm, p, bid, nb);
  GRID_BAR();
  phase_gemm<2>(shm, p, bid, nb);
#ifdef PROBE_PHASE
  if (PROBE_PHASE == 5) ts_b = __builtin_amdgcn_s_memrealtime();
  if (bid == 0 && threadIdx.x == 0) {
    const unsigned long long until = __builtin_amdgcn_s_memrealtime() + 9ull * (ts_b - ts_a);
    while (__builtin_amdgcn_s_memrealtime() < until) __builtin_amdgcn_s_sleep(8);
  }
#endif
}

extern "C" void kernel_launch(void* const* d_in, const int* in_sizes, int n_in, void* d_out, int out_size, void* d_ws, size_t ws_size, hipStream_t stream) {
  Params p{};
  p.x = (const float*)d_in[0]; p.ng = (const float*)d_in[1]; p.w_in = (const float*)d_in[2]; p.gn = (const float*)d_in[3];
  p.w_out = (const float*)d_in[4]; p.fg = (const float*)d_in[5];
  p.out = (float*)d_out;
  char* w = (char*)d_ws; size_t o = 0;
  auto take = [&](size_t bytes) { char* r = w + o; o += (bytes + 255) & ~(size_t)255; return r; };
  p.xb = (bf16_t*)take((size_t)T_TOK * DM * 2);
  p.proj = (bf16_t*)take((size_t)T_TOK * NW * 2);
  p.mixed = (bf16_t*)take((size_t)T_TOK * DM * 2);
  p.winT = (bf16_t*)take((size_t)NW * DM * 2);
  p.woutT = (bf16_t*)take((size_t)DM * DM * 2);
  p.rstd = (float*)take((size_t)T_TOK * 4);
  p.rowss = (float*)take((size_t)T_TOK * 4);
  p.ropeT = (float2*)take((size_t)SEQ * 32 * 8);
  p.retT = (float2*)take((size_t)SEQ * 32 * 8);
  p.kvT = (float*)take((size_t)1024 * 8192 * 4);
  p.stT = (bf16_t*)take((size_t)1024 * 8192 * 2);
  p.bar = (unsigned*)take(1024);
  p.ob = (bf16_t*)take((size_t)T_TOK * 512 * 2);
  p.lseg = (float*)take((size_t)T_TOK * 8 * 4);
  static int grid_blocks = 0;
  if (!grid_blocks) {
    (void)hipFuncSetAttribute((const void*)k_mega, hipFuncAttributeMaxDynamicSharedMemorySize, ATTN_LDS);
    int dev = 0, cus = 0, per_cu = 0;
    (void)hipGetDevice(&dev);
    (void)hipDeviceGetAttribute(&cus, hipDeviceAttributeMultiprocessorCount, dev);
    (void)hipOccupancyMaxActiveBlocksPerMultiprocessor(&per_cu, k_mega, 512, ATTN_LDS);
    if (per_cu < 1) per_cu = 1;
    grid_blocks = cus;
  }
  (void)hipMemsetAsync(p.bar, 0, 1024, stream);
  hipLaunchKernelGGL(k_mega, dim3(grid_blocks), dim3(512), ATTN_LDS, stream, p);
}
```

```cpp
#include <hip/hip_runtime.h>
#include <hip/hip_cooperative_groups.h>
#include <cstdint>
#include <cstdio>
namespace cg = cooperative_groups;

typedef unsigned short bf16_t;
typedef short bf16x8 __attribute__((ext_vector_type(8)));
typedef float f32x4 __attribute__((ext_vector_type(4)));
typedef unsigned u32x4 __attribute__((ext_vector_type(4)));
typedef unsigned u32x2 __attribute__((ext_vector_type(2)));

constexpr int T_TOK = 32768, DM = 1024, NW = 3584, SEQ = 4096;
constexpr int OFF_QA = 0, OFF_KA = 512, OFF_VA = 1024, OFF_GA = 1536, OFF_QR = 2048, OFF_KR = 2304, OFF_VR = 2560, OFF_GR = 3072;

struct Params {
  const float* x; const float* ng; const float* w_in; const float* gn; const float* w_out; const float* fg;
  float* out;
  bf16_t* xb; bf16_t* proj; bf16_t* mixed; bf16_t* winT; bf16_t* woutT;
  float* rstd; float* rowss; float2* ropeT; float2* retT; float* kvT; bf16_t* stT; unsigned* bar; bf16_t* ob; float* lseg;
};

#define DI __device__ __forceinline__
DI unsigned short f2bf(float x) { unsigned u = __float_as_uint(x); u += 0x7fffu + ((u >> 16) & 1u); return (unsigned short)(u >> 16); }
DI float bf2f(unsigned short b) { return __uint_as_float(((unsigned)b) << 16); }
typedef float f32x2_t __attribute__((ext_vector_type(2)));
typedef __bf16 bf16x2_t __attribute__((ext_vector_type(2)));
DI unsigned pack2(float lo, float hi) { const f32x2_t v = {lo, hi}; return __builtin_bit_cast(unsigned, __builtin_convertvector(v, bf16x2_t)); }
DI float bflo(unsigned w) { return __uint_as_float(w << 16); }
DI float bfhi(unsigned w) { return __uint_as_float(w & 0xffff0000u); }
DI int perm32(int rho) { const int n = rho >> 4, i = rho & 15; return 8 * (i >> 2) + 4 * n + (i & 3); }
DI int cmap(int p) { return (p & ~31) + perm32(p & 31); }
DI int cmapA(int p) { return (p & ~127) + ((p >> 6) & 1) * 64 + ((p >> 4) & 1) * 32 + ((p >> 5) & 1) * 16 + (p & 15); }

DI void phase_prep(const Params& p, int bid, int nb) {
  const int tid = threadIdx.x, lane = tid & 63, wid = tid >> 6, nw = blockDim.x >> 6;
  if (wid < 6)
  for (int row0 = (bid * 6 + wid) * 4; row0 < T_TOK; row0 += nb * 6 * 4) {
    f32x4 v[4][4];
#pragma unroll
    for (int rr = 0; rr < 4; ++rr)
#pragma unroll
      for (int it = 0; it < 4; ++it) v[rr][it] = *(const f32x4*)(p.x + (size_t)(row0 + rr) * DM + it * 256 + lane * 4);
#pragma unroll
    for (int rr = 0; rr < 4; ++rr) {
      float ss = 0.f;
#pragma unroll
      for (int it = 0; it < 4; ++it) ss += v[rr][it][0] * v[rr][it][0] + v[rr][it][1] * v[rr][it][1] + v[rr][it][2] * v[rr][it][2] + v[rr][it][3] * v[rr][it][3];
#pragma unroll
      for (int o = 32; o >= 1; o >>= 1) ss += __shfl_xor(ss, o);
#pragma unroll
      for (int it = 0; it < 4; ++it) { u32x2 w; w.x = pack2(v[rr][it][0], v[rr][it][1]); w.y = pack2(v[rr][it][2], v[rr][it][3]); *(u32x2*)(p.xb + (size_t)(row0 + rr) * DM + it * 256 + lane * 4) = w; }
      if (lane == 0) p.rstd[row0 + rr] = rsqrtf(ss * (1.0f / DM) + 1e-6f);
    }
  }
  if (wid < 6) return;
  const int gt = bid * 128 + (tid - 384), gn = nb * 128;
  for (int idx = gt; idx < (NW / 4) * 128; idx += gn) {
    const int p4 = idx % (NW / 4), kc = idx / (NW / 4), pp = p4 * 4, c = pp < 1024 ? cmapA(pp) : cmap(pp);
    f32x4 f[8];
#pragma unroll
    for (int j = 0; j < 8; ++j) { const int k = kc * 8 + j; f[j] = *(const f32x4*)(p.w_in + (size_t)k * NW + c) * p.ng[k]; }
#pragma unroll
    for (int e = 0; e < 4; ++e) {
      u32x4 w; w.x = pack2(f[0][e], f[1][e]); w.y = pack2(f[2][e], f[3][e]); w.z = pack2(f[4][e], f[5][e]); w.w = pack2(f[6][e], f[7][e]);
      *(u32x4*)(p.winT + (size_t)(pp + e) * DM + kc * 8) = w;
    }
  }
  for (int idx = gt; idx < (DM / 4) * 128; idx += gn) {
    const int p4 = idx % (DM / 4), kc = idx / (DM / 4), pp = p4 * 4, c = cmap(pp);
    f32x4 f[8];
#pragma unroll
    for (int j = 0; j < 8; ++j) { const int k = kc * 8 + j; f[j] = *(const f32x4*)(p.w_out + (size_t)k * DM + c); }
#pragma unroll
    for (int e = 0; e < 4; ++e) {
      u32x4 w; w.x = pack2(f[0][e], f[1][e]); w.y = pack2(f[2][e], f[3][e]); w.z = pack2(f[4][e], f[5][e]); w.w = pack2(f[6][e], f[7][e]);
      *(u32x4*)(p.woutT + (size_t)(pp + e) * DM + kc * 8) = w;
    }
  }
  for (int idx = gt; idx < SEQ * 32; idx += gn) {
    const int pos = idx >> 5, i = idx & 31;
    const float inv1 = powf(10000.0f, -(float)i / 32.0f);
    const float inv2 = 1.0f / powf(10000.0f, (float)i / 31.0f);
    const float a1 = (float)pos * inv1, a2 = (float)pos * inv2;
    p.ropeT[idx] = make_float2(cosf(a1), sinf(a1));
    p.retT[idx] = make_float2(cosf(a2), sinf(a2));
  }
}

constexpr int BM = 256, BK = 64, HALF = 128, HT = HALF * BK;
constexpr int GEMM_LDS = 8 * HT * 2;
DI int lds_byte(int r, int c) { int st = (r >> 4) * 2 + (c >> 5), rr = r & 15, cc = c & 31, ob = rr * 64 + cc * 2; return st * 1024 + (ob ^ (((ob >> 9) & 1) << 5)); }
DI void stage_rc(int b, int& R, int& C) { int st = b / 1024, sb = b % 1024, swz = sb ^ (((sb >> 9) & 1) << 5); R = (st >> 1) * 16 + swz / 64; C = (st & 1) * 32 + (swz % 64) / 2; }

#define LAS __attribute__((address_space(3)))
template <int EPI>
DI void gemm_tile(LAS unsigned char* lds, const bf16_t* __restrict__ A, const bf16_t* __restrict__ Bt, const int brow, const int bcol, const bool primed, const int nbrow, const int nbcol, const Params& p) {
  constexpr int K = 1024, nt = K / BK, HTB = HALF * BK * 2;
  const int tid = threadIdx.x, wid = __builtin_amdgcn_readfirstlane(tid >> 6), lane = tid & 63, wr = wid >> 2, wc = wid & 3, fr = lane & 15, fq = lane >> 4;
  unsigned voff[2];
#pragma unroll
  for (int i = 0; i < 2; ++i) { int R, C; stage_rc(tid * 16 + i * 8192, R, C); voff[i] = (unsigned)(R * K + C) * 2u; }
  const unsigned ldsw = (unsigned)wid * 1024u;
  const int aoff = lds_byte(wr * 64 + fr, fq * 8), boff = lds_byte(wc * 32 + fr, fq * 8);
  const char* cA0 = (const char*)A + (size_t)brow * K * 2; const char* cA1 = cA0 + (size_t)HALF * K * 2;
  const char* cB0 = (const char*)Bt + (size_t)bcol * K * 2; const char* cB1 = cB0 + (size_t)HALF * K * 2;
#define SAo(b, h) (((b) * 2 + (h)) * HTB)
#define SBo(b, h) ((4 + (b) * 2 + (h)) * HTB)
#define STAGE(bufoff, gb, kt) do { _Pragma("unroll") for (int _i = 0; _i < 2; ++_i) \
    __builtin_amdgcn_global_load_lds((const unsigned*)((gb) + (size_t)(kt) * (BK * 2) + voff[_i]), (LAS unsigned*)(lds + (bufoff) + ldsw + _i * 8192), 16, 0, 0); } while (0)
#define LDA(dst, b, h) do { _Pragma("unroll") for (int m = 0; m < 4; ++m) _Pragma("unroll") for (int k = 0; k < 2; ++k) \
    dst[m][k] = *(const LAS bf16x8*)(lds + SAo(b, h) + aoff + m * 2048 + k * 1024); } while (0)
#define LDB(dst, b, h) do { _Pragma("unroll") for (int n = 0; n < 2; ++n) _Pragma("unroll") for (int k = 0; k < 2; ++k) \
    dst[n][k] = *(const LAS bf16x8*)(lds + SBo(b, h) + boff + n * 2048 + k * 1024); } while (0)
#define MMA(ai, bj, At, Bt_) do { __builtin_amdgcn_s_setprio(1); \
    _Pragma("unroll") for (int m = 0; m < 4; ++m) _Pragma("unroll") for (int n = 0; n < 2; ++n) _Pragma("unroll") for (int k = 0; k < 2; ++k) \
      acc[ai][bj][m][n] = __builtin_amdgcn_mfma_f32_16x16x32_bf16(Bt_[n][k], At[m][k], acc[ai][bj][m][n], 0, 0, 0); \
    __builtin_amdgcn_s_setprio(0); } while (0)
#define WAIT_V(n) asm volatile("s_waitcnt vmcnt(" #n ")" ::: "memory")
#define WAIT_L(n) asm volatile("s_waitcnt lgkmcnt(" #n ")" ::: "memory")
#define BAR __builtin_amdgcn_s_barrier()
#define SCHED __builtin_amdgcn_sched_barrier(0)
  f32x4 acc[2][2][4][2];
#pragma unroll
  for (int a = 0; a < 2; ++a)
#pragma unroll
    for (int b = 0; b < 2; ++b)
#pragma unroll
      for (int m = 0; m < 4; ++m)
#pragma unroll
        for (int n = 0; n < 2; ++n) acc[a][b][m][n] = (f32x4){0.f, 0.f, 0.f, 0.f};
  bf16x8 At[4][2], B0[2][2], B1[2][2];
  if (!primed) {
    WAIT_V(0);
    STAGE(SBo(0, 0), cB0, 0); STAGE(SAo(0, 0), cA0, 0);
    STAGE(SBo(0, 1), cB1, 0); STAGE(SAo(0, 1), cA1, 0);
  }
  if (wr == 1) BAR;
  if (primed) WAIT_V(0); else WAIT_V(4);
  BAR;
  STAGE(SBo(1, 0), cB0, 1); STAGE(SAo(1, 0), cA0, 1); STAGE(SBo(1, 1), cB1, 1);
  WAIT_V(6); BAR;
  for (int t = 0; t < nt - 2; t += 2) {
    LDB(B0, 0, 0); SCHED; LDA(At, 0, 0); STAGE(SAo(1, 1), cA1, t + 1);
    WAIT_L(8); BAR; WAIT_L(0); MMA(0, 0, At, B0); BAR; SCHED;
    LDB(B1, 0, 1); STAGE(SBo(0, 0), cB0, t + 2);
    BAR; WAIT_L(0); MMA(0, 1, At, B1); BAR;
    LDA(At, 0, 1); STAGE(SAo(0, 0), cA0, t + 2);
    BAR; WAIT_L(0); MMA(1, 0, At, B0); BAR; SCHED;
    STAGE(SBo(0, 1), cB1, t + 2);
    WAIT_V(6); BAR; MMA(1, 1, At, B1); BAR;
    LDB(B0, 1, 0); SCHED; LDA(At, 1, 0); STAGE(SAo(0, 1), cA1, t + 2);
    WAIT_L(8); BAR; WAIT_L(0); MMA(0, 0, At, B0); BAR; SCHED;
    LDB(B1, 1, 1); STAGE(SBo(1, 0), cB0, t + 3);
    BAR; WAIT_L(0); MMA(0, 1, At, B1); BAR;
    LDA(At, 1, 1); STAGE(SAo(1, 0), cA0, t + 3);
    BAR; WAIT_L(0); MMA(1, 0, At, B0); BAR; SCHED;
    STAGE(SBo(1, 1), cB1, t + 3);
    WAIT_V(6); BAR; MMA(1, 1, At, B1); BAR;
  }
  { LDB(B0, 0, 0); LDA(At, 0, 0); STAGE(SAo(1, 1), cA1, nt - 1);
    BAR; WAIT_L(0); MMA(0, 0, At, B0); BAR;
    LDB(B1, 0, 1); BAR; WAIT_L(0); MMA(0, 1, At, B1); BAR;
    LDA(At, 0, 1); WAIT_V(4); BAR; WAIT_L(0); MMA(1, 0, At, B0); MMA(1, 1, At, B1); BAR; }
  { LDB(B0, 1, 0); LDA(At, 1, 0); WAIT_V(2); BAR; WAIT_L(0); MMA(0, 0, At, B0); BAR;
    LDB(B1, 1, 1); WAIT_V(0); BAR; WAIT_L(0); MMA(0, 1, At, B1); BAR;
    LDA(At, 1, 1); BAR; WAIT_L(0); MMA(1, 0, At, B0); MMA(1, 1, At, B1); BAR; }
  if (wr == 0) BAR;
  if (nbrow >= 0) {
    const char* nA0 = (const char*)A + (size_t)nbrow * K * 2; const char* nB0 = (const char*)Bt + (size_t)nbcol * K * 2;
    STAGE(SBo(0, 0), nB0, 0); STAGE(SAo(0, 0), nA0, 0);
    STAGE(SBo(0, 1), nB0 + (size_t)HALF * K * 2, 0); STAGE(SAo(0, 1), nA0 + (size_t)HALF * K * 2, 0);
  }
  if (EPI == 1) {
    const int pn = bcol >> 8;
    if (pn < 4) {
      const float sc = pn < 2 ? 0.125f * 1.4426950408889634f : 1.0f;
      const int i0 = 16 * (wc & 1) + 4 * fq;
#pragma unroll
      for (int ai = 0; ai < 2; ++ai)
#pragma unroll
        for (int m = 0; m < 4; ++m) {
          const int row = brow + ai * HALF + wr * 64 + m * 16 + fr;
          const float rs = p.rstd[row] * sc;
          const float* tb = (const float*)(p.ropeT + (row & (SEQ - 1)) * 32 + i0);
          const f32x4 t0 = *(const f32x4*)tb, t1 = *(const f32x4*)(tb + 4);
#pragma unroll
          for (int bj = 0; bj < 2; ++bj) {
            const f32x4 x1 = acc[ai][bj][m][0] * rs, x2 = acc[ai][bj][m][1] * rs;
            u32x2 wa, wb;
            wa.x = pack2(x1[0] * t0[0] - x2[0] * t0[1], x1[1] * t0[2] - x2[1] * t0[3]);
            wa.y = pack2(x1[2] * t1[0] - x2[2] * t1[1], x1[3] * t1[2] - x2[3] * t1[3]);
            wb.x = pack2(x2[0] * t0[0] + x1[0] * t0[1], x2[1] * t0[2] + x1[1] * t0[3]);
            wb.y = pack2(x2[2] * t1[0] + x1[2] * t1[1], x2[3] * t1[2] + x1[3] * t1[3]);
            bf16_t* o = p.proj + (size_t)row * NW + bcol + bj * HALF + (wc >> 1) * 64 + i0;
            *(u32x2*)o = wa; *(u32x2*)(o + 32) = wb;
          }
        }
    } else if (pn == 8 || pn == 9) {
      const float sc = pn == 9 ? 0.125f : 1.0f;
      const int i0 = 16 * (wc & 1) + 4 * fq;
#pragma unroll
      for (int ai = 0; ai < 2; ++ai)
#pragma unroll
        for (int m = 0; m < 4; ++m) {
          const int row = brow + ai * HALF + wr * 64 + m * 16 + fr;
          const float rs = p.rstd[row] * sc;
          const float* tb = (const float*)(p.retT + (row & (SEQ - 1)) * 32 + i0);
          const f32x4 t0 = *(const f32x4*)tb, t1 = *(const f32x4*)(tb + 4);
#pragma unroll
          for (int bj = 0; bj < 2; ++bj) {
            const f32x4 v0 = acc[ai][bj][m][0] * rs, v1 = acc[ai][bj][m][1] * rs;
            u32x4 w;
            w.x = pack2(v0[0] * t0[0] - v0[1] * t0[1], v0[1] * t0[0] + v0[0] * t0[1]);
            w.y = pack2(v0[2] * t0[2] - v0[3] * t0[3], v0[3] * t0[2] + v0[2] * t0[3]);
            w.z = pack2(v1[0] * t1[0] - v1[1] * t1[1], v1[1] * t1[0] + v1[0] * t1[1]);
            w.w = pack2(v1[2] * t1[2] - v1[3] * t1[3], v1[3] * t1[2] + v1[2] * t1[3]);
            *(u32x4*)(p.proj + (size_t)row * NW + bcol + bj * HALF + wc * 32 + 8 * fq) = w;
          }
        }
    } else {
#pragma unroll
    for (int ai = 0; ai < 2; ++ai)
#pragma unroll
      for (int m = 0; m < 4; ++m) {
        const int row = brow + ai * HALF + wr * 64 + m * 16 + fr;
        const float rs = p.rstd[row];
#pragma unroll
        for (int bj = 0; bj < 2; ++bj) {
          const f32x4 v0 = acc[ai][bj][m][0] * rs, v1 = acc[ai][bj][m][1] * rs;
          u32x4 w; w.x = pack2(v0[0], v0[1]); w.y = pack2(v0[2], v0[3]); w.z = pack2(v1[0], v1[1]); w.w = pack2(v1[2], v1[3]);
          *(u32x4*)(p.proj + (size_t)row * NW + bcol + bj * HALF + wc * 32 + 8 * fq) = w;
        }
      }
    }
  } else {
    const int pm = brow >> 8, pn = bcol >> 8;
    LAS float* part = (LAS float*)(lds + GEMM_LDS);
    LAS float* rsl = (LAS float*)(lds + GEMM_LDS + 4096);
#pragma unroll
    for (int ai = 0; ai < 2; ++ai)
#pragma unroll
      for (int m = 0; m < 4; ++m) {
        const int rl = ai * HALF + wr * 64 + m * 16 + fr;
        float ss = 0.f;
#pragma unroll
        for (int bj = 0; bj < 2; ++bj) {
          const size_t off = (size_t)(brow + rl) * DM + bcol + bj * HALF + wc * 32 + 8 * fq;
          const f32x4 x0 = *(const f32x4*)(p.x + off), x1 = *(const f32x4*)(p.x + off + 4);
          const f32x4 y0 = acc[ai][bj][m][0] + x0, y1 = acc[ai][bj][m][1] + x1;
          acc[ai][bj][m][0] = y0; acc[ai][bj][m][1] = y1;
          ss += y0[0] * y0[0] + y0[1] * y0[1] + y0[2] * y0[2] + y0[3] * y0[3] + y1[0] * y1[0] + y1[1] * y1[1] + y1[2] * y1[2] + y1[3] * y1[3];
        }
        ss += __shfl_xor(ss, 16); ss += __shfl_xor(ss, 32);
        if (fq == 0) part[wc * 256 + rl] = ss;
      }
    __syncthreads();
    float* xs = p.rowss + (size_t)(pm * 4) * 256;
    if (tid < 256) {
      const float tot = part[tid] + part[256 + tid] + part[512 + tid] + part[768 + tid];
      __hip_atomic_store(xs + pn * 256 + tid, tot, __ATOMIC_RELAXED, __HIP_MEMORY_SCOPE_AGENT);
    }
    asm volatile("s_waitcnt vmcnt(0)" ::: "memory");
    __syncthreads();
    unsigned* cnt = p.bar + 64 + pm;
    if (tid == 0) __hip_atomic_fetch_add(cnt, 1u, __ATOMIC_RELAXED, __HIP_MEMORY_SCOPE_AGENT);
    if (wid == 0) {
      unsigned spins = 0;
      while (__hip_atomic_load(cnt, __ATOMIC_RELAXED, __HIP_MEMORY_SCOPE_AGENT) < 4u && spins < (1u << 20)) { __builtin_amdgcn_s_sleep(1); ++spins; }
      __builtin_amdgcn_fence(__ATOMIC_ACQUIRE, "agent");
      asm volatile("s_waitcnt vmcnt(0)" ::: "memory");
    }
    __syncthreads();
    if (tid < 256) {
      float t = 0.f;
#pragma unroll
      for (int q = 0; q < 4; ++q) t += __hip_atomic_load(xs + q * 256 + tid, __ATOMIC_RELAXED, __HIP_MEMORY_SCOPE_AGENT);
      rsl[tid] = rsqrtf(t * (1.0f / DM) + 1e-6f);
    }
    __syncthreads();
#pragma unroll
    for (int ai = 0; ai < 2; ++ai)
#pragma unroll
      for (int m = 0; m < 4; ++m) {
        const int rl = ai * HALF + wr * 64 + m * 16 + fr;
        const float rs = rsl[rl];
#pragma unroll
        for (int bj = 0; bj < 2; ++bj) {
          const int col = bcol + bj * HALF + wc * 32 + 8 * fq;
          const f32x4 g0 = *(const f32x4*)(p.fg + col), g1 = *(const f32x4*)(p.fg + col + 4);
          float* o = p.out + (size_t)(brow + rl) * DM + col;
          *(f32x4*)o = acc[ai][bj][m][0] * rs * g0; *(f32x4*)(o + 4) = acc[ai][bj][m][1] * rs * g1;
        }
      }
    __syncthreads();
  }
}

DI void tile_of(int L, int nM, int nN, int& pm, int& pn) {
  const int nwg = nM * nN, NX = 8, WGM = 8;
  int wgid = L; { const int q = nwg / NX, r = nwg % NX, xcd = wgid % NX, off = wgid / NX; wgid = (xcd < r ? xcd * (q + 1) : r * (q + 1) + (xcd - r) * q) + off; }
  const int nig = WGM * nN, gid = wgid / nig, fm = gid * WGM, gsz = (nM - fm) < WGM ? (nM - fm) : WGM;
  pm = fm + ((wgid % nig) % gsz); pn = (wgid % nig) / gsz;
}

template <int EPI>
DI void phase_gemm(LAS unsigned char* shm, const Params& p, int bid, int nb) {
  const int nM = T_TOK / BM, nN = (EPI == 1 ? NW : DM) / BM, nT = nM * nN;
  bool primed = false;
  for (int L = bid; L < nT; L += nb) {
    int pm, pn; tile_of(L, nM, nN, pm, pn);
    int npm = -1, npn = 0;
    if (L + nb < nT) tile_of(L + nb, nM, nN, npm, npn);
    const int nbrow = npm < 0 ? -1 : npm * BM;
    if (EPI == 1) gemm_tile<1>(shm, p.xb, p.winT, pm * BM, pn * BM, primed, nbrow, npn * BM, p);
    else gemm_tile<2>(shm, p.mixed, p.woutT, pm * BM, pn * BM, primed, nbrow, npn * BM, p);
    primed = true;
  }
  asm volatile("s_waitcnt vmcnt(0)" ::: "memory");
}

DI void phase_rotary(const Params& p, int bid, int nb) {
  const long total = (long)T_TOK * 768;
  for (long idx = (long)bid * blockDim.x + threadIdx.x; idx < total; idx += (long)nb * blockDim.x) {
    const int tok = (int)(idx / 768); int j = (int)(idx % 768);
    const int pos = tok & (SEQ - 1);
    int a, b; float sc; const float2* tab;
    if (j < 256) { const int h = j >> 5, i = j & 31; a = OFF_QA + h * 64 + i; b = a + 32; sc = 0.125f; tab = p.ropeT + pos * 32 + i; }
    else if (j < 512) { j -= 256; const int h = j >> 5, i = j & 31; a = OFF_KA + h * 64 + i; b = a + 32; sc = 1.f; tab = p.ropeT + pos * 32 + i; }
    else if (j < 640) { j -= 512; const int h = j >> 5, i = j & 31; a = OFF_QR + h * 64 + 2 * i; b = a + 1; sc = 1.f; tab = p.retT + pos * 32 + i; }
    else { j -= 640; const int h = j >> 5, i = j & 31; a = OFF_KR + h * 64 + 2 * i; b = a + 1; sc = 0.125f; tab = p.retT + pos * 32 + i; }
    const float2 cs = *tab;
    bf16_t* row = p.proj + (size_t)tok * NW;
    const float x1 = bf2f(row[a]), x2 = bf2f(row[b]);
    row[a] = f2bf((x1 * cs.x - x2 * cs.y) * sc);
    row[b] = f2bf((x2 * cs.x + x1 * cs.y) * sc);
  }
}

DI void load_row64(const bf16_t* src, float* dst) {
#pragma unroll
  for (int c = 0; c < 8; ++c) {
    const u32x4 w = *(const u32x4*)(src + c * 8);
    dst[c * 8 + 0] = bflo(w.x); dst[c * 8 + 1] = bfhi(w.x); dst[c * 8 + 2] = bflo(w.y); dst[c * 8 + 3] = bfhi(w.y);
    dst[c * 8 + 4] = bflo(w.z); dst[c * 8 + 5] = bfhi(w.z); dst[c * 8 + 6] = bflo(w.w); dst[c * 8 + 7] = bfhi(w.w);
  }
}

DI void phase_attn_naive(const Params& p, int bid, int nb) {
  const long total = (long)T_TOK * 8;
  for (long idx = (long)bid * blockDim.x + threadIdx.x; idx < total; idx += (long)nb * blockDim.x) {
    const int h = (int)(idx & 7), tok = (int)(idx >> 3);
    const int pos = tok & (SEQ - 1), tb = tok - pos;
    float q[64], o[64];
    load_row64(p.proj + (size_t)tok * NW + OFF_QA + h * 64, q);
#pragma unroll
    for (int d = 0; d < 64; ++d) o[d] = 0.f;
    float m = -1e30f, l = 0.f;
    for (int br = 0; br < 3; ++br) {
      const int dl = br == 0 ? 1 : (br == 1 ? 4 : 16);
      for (int j = 0; j <= 128; ++j) {
        const int pk = pos - j * dl; if (pk < 0) break;
        const bf16_t* kr = p.proj + (size_t)(tb + pk) * NW + OFF_KA + h * 64;
        float s = 0.f;
#pragma unroll
        for (int c = 0; c < 8; ++c) {
          const u32x4 w = *(const u32x4*)(kr + c * 8);
          s += q[c * 8 + 0] * bflo(w.x) + q[c * 8 + 1] * bfhi(w.x) + q[c * 8 + 2] * bflo(w.y) + q[c * 8 + 3] * bfhi(w.y)
             + q[c * 8 + 4] * bflo(w.z) + q[c * 8 + 5] * bfhi(w.z) + q[c * 8 + 6] * bflo(w.w) + q[c * 8 + 7] * bfhi(w.w);
        }
        const float mn = fmaxf(m, s), al = __expf(m - mn), pe = __expf(s - mn);
        m = mn; l = l * al + pe;
        const bf16_t* vr = kr + (OFF_VA - OFF_KA);
#pragma unroll
        for (int c = 0; c < 8; ++c) {
          const u32x4 w = *(const u32x4*)(vr + c * 8);
          o[c * 8 + 0] = o[c * 8 + 0] * al + pe * bflo(w.x); o[c * 8 + 1] = o[c * 8 + 1] * al + pe * bfhi(w.x);
          o[c * 8 + 2] = o[c * 8 + 2] * al + pe * bflo(w.y); o[c * 8 + 3] = o[c * 8 + 3] * al + pe * bfhi(w.y);
          o[c * 8 + 4] = o[c * 8 + 4] * al + pe * bflo(w.z); o[c * 8 + 5] = o[c * 8 + 5] * al + pe * bfhi(w.z);
          o[c * 8 + 6] = o[c * 8 + 6] * al + pe * bflo(w.w); o[c * 8 + 7] = o[c * 8 + 7] * al + pe * bfhi(w.w);
        }
      }
    }
    const float il = 1.0f / l;
    const bf16_t* gr = p.proj + (size_t)tok * NW + OFF_GA + h * 64;
    bf16_t* mo = p.mixed + (size_t)tok * DM + h * 64;
#pragma unroll
    for (int c = 0; c < 8; ++c) {
      const u32x4 w = *(const u32x4*)(gr + c * 8);
      float g[8] = {bflo(w.x), bfhi(w.x), bflo(w.y), bfhi(w.y), bflo(w.z), bfhi(w.z), bflo(w.w), bfhi(w.w)};
      float r[8];
#pragma unroll
      for (int e = 0; e < 8; ++e) r[e] = o[c * 8 + e] * il * (g[e] / (1.0f + __expf(-g[e])));
      u32x4 ww; ww.x = pack2(r[0], r[1]); ww.y = pack2(r[2], r[3]); ww.z = pack2(r[4], r[5]); ww.w = pack2(r[6], r[7]);
      *(u32x4*)(mo + c * 8) = ww;
    }
  }
}

DI float ret_log2g(int h) { return log2f(1.0f - exp2f(-5.0f - (float)h)); }

DI void phase_retkv_naive(const Params& p, int bid, int nb) {
  const long total = 1024L * 8192;
  for (long idx = (long)bid * blockDim.x + threadIdx.x; idx < total; idx += (long)nb * blockDim.x) {
    const int d = (int)(idx & 63), v = (int)((idx >> 6) & 127), u = (int)(idx >> 13);
    const int n = u & 31, h = (u >> 5) & 3, b = u >> 7;
    const float lg = ret_log2g(h);
    const bf16_t* base = p.proj + (size_t)(b * SEQ + n * 128) * NW;
    float s = 0.f;
    for (int j = 0; j < 128; ++j) {
      const float kk = bf2f(base[(size_t)j * NW + OFF_KR + h * 64 + d]), vv = bf2f(base[(size_t)j * NW + OFF_VR + h * 128 + v]);
      s += kk * exp2f((float)(127 - j) * lg) * vv;
    }
    p.kvT[idx] = s;
  }
}
DI void phase_retscan(const Params& p, int bid, int nb) {
  const long total = 32L * 4096;
  typedef float f32x2 __attribute__((ext_vector_type(2)));
  const float* __restrict__ kv = p.kvT; bf16_t* __restrict__ stp = p.stT;
  for (long idx = (long)bid * blockDim.x + threadIdx.x; idx < total; idx += (long)nb * blockDim.x) {
    const int e = (int)(idx & 4095) * 2, bh = (int)(idx >> 12), h = bh & 3;
    const float cd = exp2f(128.0f * ret_log2g(h));
    f32x2 kr[31];
#pragma unroll
    for (int n = 0; n < 31; ++n) kr[n] = *(const f32x2*)(kv + ((size_t)(bh * 32 + n) << 13) + e);
    float s0 = 0.f, s1 = 0.f;
#pragma unroll
    for (int n = 0; n < 32; ++n) {
      *(unsigned*)(stp + ((size_t)(bh * 32 + n) << 13) + e) = pack2(s0, s1);
      if (n < 31) { s0 = s0 * cd + kr[n][0]; s1 = s1 * cd + kr[n][1]; }
    }
  }
}
DI void phase_retout_naive(const Params& p, int bid, int nb) {
  const long total = 1024L * 256;
  for (long idx = (long)bid * blockDim.x + threadIdx.x; idx < total; idx += (long)nb * blockDim.x) {
    const int vh = (int)(idx & 1), i = (int)((idx >> 1) & 127), u = (int)(idx >> 8);
    const int n = u & 31, h = (u >> 5) & 3, b = u >> 7;
    const float lg = ret_log2g(h);
    const int tok0 = b * SEQ + n * 128, tok = tok0 + i;
    float o[64];
#pragma unroll
    for (int v = 0; v < 64; ++v) o[v] = 0.f;
    const bf16_t* qrow = p.proj + (size_t)tok * NW + OFF_QR + h * 64;
    for (int j = 0; j <= i; ++j) {
      const bf16_t* krow = p.proj + (size_t)(tok0 + j) * NW + OFF_KR + h * 64;
      float s = 0.f;
#pragma unroll
      for (int c = 0; c < 8; ++c) {
        const u32x4 a = *(const u32x4*)(qrow + c * 8), w = *(const u32x4*)(krow + c * 8);
        s += bflo(a.x) * bflo(w.x) + bfhi(a.x) * bfhi(w.x) + bflo(a.y) * bflo(w.y) + bfhi(a.y) * bfhi(w.y)
           + bflo(a.z) * bflo(w.z) + bfhi(a.z) * bfhi(w.z) + bflo(a.w) * bflo(w.w) + bfhi(a.w) * bfhi(w.w);
      }
      s *= exp2f((float)(i - j) * lg);
      const bf16_t* vrow = p.proj + (size_t)(tok0 + j) * NW + OFF_VR + h * 128 + vh * 64;
#pragma unroll
      for (int c = 0; c < 8; ++c) {
        const u32x4 w = *(const u32x4*)(vrow + c * 8);
        o[c * 8 + 0] += s * bflo(w.x); o[c * 8 + 1] += s * bfhi(w.x); o[c * 8 + 2] += s * bflo(w.y); o[c * 8 + 3] += s * bfhi(w.y);
        o[c * 8 + 4] += s * bflo(w.z); o[c * 8 + 5] += s * bfhi(w.z); o[c * 8 + 6] += s * bflo(w.w); o[c * 8 + 7] += s * bfhi(w.w);
      }
    }
    const float qd = exp2f((float)(i + 1) * lg);
    const bf16_t* st = p.stT + ((size_t)u << 13) + vh * 64 * 64;
    for (int d = 0; d < 64; ++d) {
      const float qq = bf2f(qrow[d]) * qd;
#pragma unroll
      for (int v = 0; v < 64; ++v) o[v] += qq * bf2f(st[v * 64 + d]);
    }
    float mu = 0.f;
#pragma unroll
    for (int v = 0; v < 64; ++v) mu += o[v];
    mu += __shfl_xor(mu, 1);
    mu *= (1.0f / 128.0f);
    float var = 0.f;
#pragma unroll
    for (int v = 0; v < 64; ++v) { const float dd = o[v] - mu; var += dd * dd; }
    var += __shfl_xor(var, 1);
    const float rs = rsqrtf(var * (1.0f / 128.0f) + 1e-5f);
    const bf16_t* gr = p.proj + (size_t)tok * NW + OFF_GR + h * 128 + vh * 64;
    bf16_t* mo = p.mixed + (size_t)tok * DM + 512 + h * 128 + vh * 64;
#pragma unroll
    for (int c = 0; c < 8; ++c) {
      const u32x4 w = *(const u32x4*)(gr + c * 8);
      float g[8] = {bflo(w.x), bfhi(w.x), bflo(w.y), bfhi(w.y), bflo(w.z), bfhi(w.z), bflo(w.w), bfhi(w.w)};
      float r[8];
#pragma unroll
      for (int e = 0; e < 8; ++e) r[e] = (o[c * 8 + e] - mu) * rs * p.gn[h * 128 + vh * 64 + c * 8 + e] * (g[e] / (1.0f + __expf(-g[e])));
      u32x4 ww; ww.x = pack2(r[0], r[1]); ww.y = pack2(r[2], r[3]); ww.z = pack2(r[4], r[5]); ww.w = pack2(r[6], r[7]);
      *(u32x4*)(mo + c * 8) = ww;
    }
  }
}

typedef float f32x16 __attribute__((ext_vector_type(16)));
typedef short s16x4 __attribute__((ext_vector_type(4)));
#define MFMA32(a, b, c) __builtin_amdgcn_mfma_f32_32x32x16_bf16((a), (b), (c), 0, 0, 0)
DI s16x4 tr_read(LAS unsigned char* a) { return __builtin_amdgcn_ds_read_tr16_b64_v4i16((LAS s16x4*)a); }
DI bf16x8 tr_frag(LAS unsigned char* a, int rowstride8) {
  const s16x4 lo = tr_read(a), hi = tr_read(a + rowstride8);
  return __builtin_shufflevector(lo, hi, 0, 1, 2, 3, 4, 5, 6, 7);
}
DI bf16x8 pack8(const f32x16& x, int s) {
  u32x4 w;
  w.x = pack2(x[8 * s + 0], x[8 * s + 1]); w.y = pack2(x[8 * s + 2], x[8 * s + 3]); w.z = pack2(x[8 * s + 4], x[8 * s + 5]); w.w = pack2(x[8 * s + 6], x[8 * s + 7]);
  return __builtin_bit_cast(bf16x8, w);
}
DI float fexp2(float x) { return __builtin_amdgcn_exp2f(x); }
DI float half_max(float x) { const u32x2 r = __builtin_amdgcn_permlane32_swap(__float_as_uint(x), __float_as_uint(x), false, false); return fmaxf(__uint_as_float(r[0]), __uint_as_float(r[1])); }
DI float half_sum(float x) { const u32x2 r = __builtin_amdgcn_permlane32_swap(__float_as_uint(x), __float_as_uint(x), false, false); return __uint_as_float(r[0]) + __uint_as_float(r[1]); }
DI float silu(float g) { return g / (1.0f + __expf(-g)); }

constexpr int AT_ROWB = 136, AT_LS = 512 * AT_ROWB, AT_VST = AT_LS + 2048, VROW = 192, KROW = 144, KST_W = 32 * KROW, VST_W = KST_W + 32 * VROW;
constexpr int ATTN_LDS = AT_VST + 8 * VST_W;
constexpr float LOG2E = 1.4426950408889634f;

constexpr int PT_ROW = 136;

DI void softmax_pv(f32x16& S, f32x16& O0, f32x16& O1, float& m, float& l, const bf16x8 (&Vf)[2][2], const bool mlow, const bool mhigh, const int r, const int h) {
  if (mlow || mhigh) {
#pragma unroll
    for (int i = 0; i < 16; ++i) {
      const int keyrow = (i & 3) + 8 * (i >> 2) + 4 * h;
      const bool bad = (mlow && keyrow < r) || (mhigh && keyrow > r);
      S[i] = bad ? -1e30f : S[i];
    }
  }
  float mx = fmaxf(S[0], S[1]);
#pragma unroll
  for (int i = 2; i < 16; ++i) mx = fmaxf(mx, S[i]);
  mx = half_max(mx);
  const float mn = fmaxf(m, mx);
  if (__builtin_amdgcn_ballot_w64(mn > m) != 0ull) {
    const float al = fexp2(m - mn);
    l *= al;
#pragma unroll
    for (int i = 0; i < 16; ++i) { O0[i] *= al; O1[i] *= al; }
    m = mn;
  }
  float ps = 0.f;
#pragma unroll
  for (int i = 0; i < 16; ++i) { S[i] = fexp2(S[i] - mn); ps += S[i]; }
  l += half_sum(ps);
#pragma unroll
  for (int s = 0; s < 2; ++s) {
    const bf16x8 Pb = pack8(S, s);
    O0 = MFMA32(Vf[s][0], Pb, O0);
    O1 = MFMA32(Vf[s][1], Pb, O1);
  }
}

DI void attn_tile2(const u32x4 (&Kc)[4], const u32x4 (&Vc)[4], const bf16x8 (&QA)[4], const bf16x8 (&QB)[4],
                   f32x16& A0, f32x16& A1, float& mA, float& lA, f32x16& B0, f32x16& B1, float& mB, float& lB,
                   LAS unsigned char* kst, LAS unsigned char* vst, LAS unsigned char* trp, const int lane, const int kt) {
  const int r = lane & 31, h = lane >> 5;
#pragma unroll
  for (int c = 0; c < 4; ++c) {
    *(LAS u32x4*)(kst + ((lane >> 3) + 8 * c) * KROW + (lane & 7) * 16) = Kc[c];
    *(LAS u32x4*)(vst + ((lane >> 3) + 8 * c) * VROW + (lane & 7) * 16) = Vc[c];
  }
  bf16x8 Kf[4], Vf[2][2];
#pragma unroll
  for (int ks = 0; ks < 4; ++ks) Kf[ks] = *(const LAS bf16x8*)(kst + r * KROW + (2 * ks + h) * 16);
#pragma unroll
  for (int s = 0; s < 2; ++s) { Vf[s][0] = tr_frag(trp + 16 * s * VROW, 8 * VROW); Vf[s][1] = tr_frag(trp + 16 * s * VROW + 64, 8 * VROW); }
  if (kt <= 4) {
    f32x16 S;
#pragma unroll
    for (int i = 0; i < 16; ++i) S[i] = 0.f;
#pragma unroll
    for (int ks = 0; ks < 4; ++ks) S = MFMA32(Kf[ks], QA[ks], S);
    softmax_pv(S, A0, A1, mA, lA, Vf, kt == 0, kt == 4, r, h);
  }
  if (kt >= 1) {
    f32x16 S;
#pragma unroll
    for (int i = 0; i < 16; ++i) S[i] = 0.f;
#pragma unroll
    for (int ks = 0; ks < 4; ++ks) S = MFMA32(Kf[ks], QB[ks], S);
    softmax_pv(S, B0, B1, mB, lB, Vf, kt == 1, kt == 5, r, h);
  }
}

DI void attn_merge(const Params& p, LAS unsigned char* T, const f32x16& O0, const f32x16& O1, const float m, const float l, const int lane,
                   const int tokq0  , const int sh, const int hh, const bool first, const bool last) {
  const int r = lane & 31, h = lane >> 5;
  const int rowc = lane >> 3, ch = lane & 7;
  float lse = m + __log2f(l);
  float w1 = 1.0f / l, w0 = 0.f;
  if (!first) {
#pragma unroll
    for (int c = 0; c < 4; ++c) {
      const size_t tk = (size_t)(tokq0 + ((rowc + 8 * c) << sh));
      *(LAS u32x4*)(T + (rowc + 8 * c) * PT_ROW + ch * 16) = *(const u32x4*)(p.ob + (tk * 8 + hh) * 64 + ch * 8);
    }
    const float lp = p.lseg[(size_t)(tokq0 + (r << sh)) * 8 + hh];
    const float M = fmaxf(lse, lp), e1 = fexp2(lse - M), e0 = fexp2(lp - M), den = e0 + e1, id = 1.0f / den;
    w1 *= e1 * id; w0 = e0 * id; lse = M + __log2f(den);
  }
  LAS unsigned char* ob = T + r * PT_ROW + 8 * h;
#pragma unroll
  for (int dt = 0; dt < 2; ++dt)
#pragma unroll
    for (int g = 0; g < 4; ++g) {
      float f0, f1, f2, f3;
      if (dt == 0) { f0 = O0[4 * g] * w1; f1 = O0[4 * g + 1] * w1; f2 = O0[4 * g + 2] * w1; f3 = O0[4 * g + 3] * w1; }
      else { f0 = O1[4 * g] * w1; f1 = O1[4 * g + 1] * w1; f2 = O1[4 * g + 2] * w1; f3 = O1[4 * g + 3] * w1; }
      LAS u32x2* a = (LAS u32x2*)(ob + 64 * dt + 16 * g);
      if (!first) { const u32x2 pv = *a; f0 += w0 * bflo(pv.x); f1 += w0 * bfhi(pv.x); f2 += w0 * bflo(pv.y); f3 += w0 * bfhi(pv.y); }
      u32x2 wv; wv.x = pack2(f0, f1); wv.y = pack2(f2, f3);
      *a = wv;
    }
  if (!last) {
    if (h == 0) p.lseg[(size_t)(tokq0 + (r << sh)) * 8 + hh] = lse;
#pragma unroll
    for (int c = 0; c < 4; ++c) {
      const size_t tk = (size_t)(tokq0 + ((rowc + 8 * c) << sh));
      *(u32x4*)(p.ob + (tk * 8 + hh) * 64 + ch * 8) = *(const LAS u32x4*)(T + (rowc + 8 * c) * PT_ROW + ch * 16);
    }
  } else {
#pragma unroll
    for (int c = 0; c < 4; ++c) {
      const size_t tk = (size_t)(tokq0 + ((rowc + 8 * c) << sh));
      const u32x4 a = *(const LAS u32x4*)(T + (rowc + 8 * c) * PT_ROW + ch * 16);
      const u32x4 g = *(const u32x4*)(p.proj + tk * NW + OFF_GA + hh * 64 + ch * 8);
      u32x4 w;
      w.x = pack2(bflo(a.x) * silu(bflo(g.x)), bfhi(a.x) * silu(bfhi(g.x)));
      w.y = pack2(bflo(a.y) * silu(bflo(g.y)), bfhi(a.y) * silu(bfhi(g.y)));
      w.z = pack2(bflo(a.z) * silu(bflo(g.z)), bfhi(a.z) * silu(bfhi(g.z)));
      w.w = pack2(bflo(a.w) * silu(bflo(g.w)), bfhi(a.w) * silu(bfhi(g.w)));
      *(u32x4*)(p.mixed + tk * DM + hh * 64 + ch * 8) = w;
    }
  }
}

DI void attn_task2(const Params& p, LAS unsigned char* kst, const int lane, const int tokbase, const int hh,
                   const int sh, const int r_res, const int l0, const bool first, const bool last) {
  const int r = lane & 31, h = lane >> 5;
  const int i16 = lane & 15, q4 = i16 >> 2, pp = i16 & 3, blk = (lane >> 4) & 1;
  LAS unsigned char* vst = kst + KST_W;
  LAS unsigned char* trp = vst + (4 * h + q4) * VROW + 32 * blk + 8 * pp;
  const bf16_t* qpA = p.proj + (size_t)(tokbase + r_res + ((l0 + r) << sh)) * NW + OFF_QA + hh * 64 + 8 * h;
  const bf16_t* qpB = qpA + (size_t)(32 << sh) * NW;
  bf16x8 QA[4], QB[4];
#pragma unroll
  for (int ks = 0; ks < 4; ++ks) { QA[ks] = *(const bf16x8*)(qpA + 16 * ks); QB[ks] = *(const bf16x8*)(qpB + 16 * ks); }
  f32x16 A0, A1, B0, B1;
#pragma unroll
  for (int i = 0; i < 16; ++i) { A0[i] = 0.f; A1[i] = 0.f; B0[i] = 0.f; B1[i] = 0.f; }
  float mA = -1e30f, lA = 0.f, mB = -1e30f, lB = 0.f;
  const int kt0 = (l0 >= 128) ? 0 : (4 - (l0 >> 5));
#define LOAD_KV(Kd, Vd, kt_) do { const int lk0_ = l0 - 128 + 32 * (kt_) + (lane >> 3); \
    _Pragma("unroll") for (int c_ = 0; c_ < 4; ++c_) { \
      const bf16_t* kp_ = p.proj + (size_t)(tokbase + r_res + ((lk0_ + 8 * c_) << sh)) * NW + OFF_KA + hh * 64 + 8 * (lane & 7); \
      Kd[c_] = *(const u32x4*)kp_; Vd[c_] = *(const u32x4*)(kp_ + (OFF_VA - OFF_KA)); } } while (0)
  for (int kt = kt0; kt < 6; kt += 2) {
    u32x4 K0[4], K1[4], V0[4], V1[4];
    LOAD_KV(K0, V0, kt);
    LOAD_KV(K1, V1, kt + 1);
    attn_tile2(K0, V0, QA, QB, A0, A1, mA, lA, B0, B1, mB, lB, kst, vst, trp, lane, kt);
    attn_tile2(K1, V1, QA, QB, A0, A1, mA, lA, B0, B1, mB, lB, kst, vst, trp, lane, kt + 1);
  }
#undef LOAD_KV
  const int tokA = tokbase + r_res + (l0 << sh);
  attn_merge(p, kst, A0, A1, mA, lA, lane, tokA, sh, hh, first, last);
  attn_merge(p, kst, B0, B1, mB, lB, lane, tokA + (32 << sh), sh, hh, first, last);
}

DI void phase_attn(LAS unsigned char* lds, const Params& p, int bid, int nb) {
  const int tid = threadIdx.x, wid = __builtin_amdgcn_readfirstlane(tid >> 6), lane = tid & 63;
  LAS unsigned char* kst = lds + wid * VST_W;
  for (int unit = bid; unit < 256; unit += nb) {
    const int sp = unit & 3, hh = (unit >> 2) & 7, b = unit >> 5;
    const int tokbase = b * SEQ;
    for (int stage = 0; stage < 3; ++stage) {
      const int sh = stage == 0 ? 4 : (stage == 1 ? 2 : 0);
      for (int tk = 0; tk < 2; ++tk) {
        const int idx = wid + 8 * tk;
        int r_res, l0;
        if (stage == 0) { r_res = idx; l0 = 64 * sp; }
        else if (stage == 1) { r_res = idx >> 2; l0 = 256 * sp + 64 * (idx & 3); }
        else { r_res = 0; l0 = 1024 * sp + 64 * idx; }
        attn_task2(p, kst, lane, tokbase, hh, sh, r_res, l0, stage == 0, stage == 2);
      }
      __syncthreads();
    }
  }
}

constexpr int RV_ROW = 320, RK_ROW = 192, RV_OFF = 0, RK_OFF = 128 * RV_ROW  , RRED_OFF = RK_OFF + 128 * RK_ROW  ;

DI void retout_unit(LAS unsigned char* lds, const Params& p, const int u);
DI void phase_retkv(LAS unsigned char* lds, const Params& p, int bid, int nb) {
  const int tid = threadIdx.x, wid = __builtin_amdgcn_readfirstlane(tid >> 6), lane = tid & 63;
  const int r = lane & 31, h = lane >> 5, i16 = lane & 15, q4 = i16 >> 2, pp = i16 & 3, blk = (lane >> 4) & 1;
  const int vt = wid >> 1, dt = wid & 1;
  LAS int* uslot = (LAS int*)(lds + RRED_OFF);
  for (;;) {
    if (tid == 0) *uslot = (int)__hip_atomic_fetch_add(p.bar + 200, 1u, __ATOMIC_RELAXED, __HIP_MEMORY_SCOPE_AGENT);
    __syncthreads();
    const int u = __builtin_amdgcn_readfirstlane(*uslot);
    if (u >= 2048) break;
    if (u >= 1024) { __syncthreads(); retout_unit(lds, p, u - 1024); continue; }
    const int n = u & 31, hh = (u >> 5) & 3, b = u >> 7;
    const float lg = ret_log2g(hh);
    const bf16_t* base = p.proj + (size_t)(b * SEQ + n * 128) * NW;
#pragma unroll
    for (int it = 0; it < 4; ++it) {
      const int c = tid + 512 * it, j = c >> 4, cc = c & 15;
      *(LAS u32x4*)(lds + RV_OFF + j * RV_ROW + cc * 16) = *(const u32x4*)(base + (size_t)j * NW + OFF_VR + hh * 128 + cc * 8);
    }
#pragma unroll
    for (int it = 0; it < 2; ++it) {
      const int c = tid + 512 * it, j = c >> 3, cc = c & 7;
      const u32x4 w = *(const u32x4*)(base + (size_t)j * NW + OFF_KR + hh * 64 + cc * 8);
      const float dk = exp2f((float)(127 - j) * lg);
      u32x4 o;
      o.x = pack2(bflo(w.x) * dk, bfhi(w.x) * dk); o.y = pack2(bflo(w.y) * dk, bfhi(w.y) * dk);
      o.z = pack2(bflo(w.z) * dk, bfhi(w.z) * dk); o.w = pack2(bflo(w.w) * dk, bfhi(w.w) * dk);
      *(LAS u32x4*)(lds + RK_OFF + j * RK_ROW + cc * 16) = o;
    }
    __syncthreads();
    f32x16 acc;
#pragma unroll
    for (int i = 0; i < 16; ++i) acc[i] = 0.f;
    LAS unsigned char* va = lds + RV_OFF + (4 * h + q4) * RV_ROW + (32 * vt + 16 * blk + 4 * pp) * 2;
    LAS unsigned char* ka = lds + RK_OFF + (4 * h + q4) * RK_ROW + (32 * dt + 16 * blk + 4 * pp) * 2;
#pragma unroll
    for (int s = 0; s < 8; ++s) {
      const bf16x8 A = tr_frag(va + 16 * s * RV_ROW, 8 * RV_ROW), B = tr_frag(ka + 16 * s * RK_ROW, 8 * RK_ROW);
      acc = MFMA32(A, B, acc);
    }
    float* o = p.kvT + ((size_t)u << 13) + (32 * vt + 4 * h) * 64 + 32 * dt + r;
#pragma unroll
    for (int i = 0; i < 16; ++i) __hip_atomic_store(o + ((i & 3) + 8 * (i >> 2)) * 64, acc[i], __ATOMIC_RELAXED, __HIP_MEMORY_SCOPE_AGENT);
    asm volatile("s_waitcnt vmcnt(0)" ::: "memory");
    __syncthreads();
    const int bh = u >> 5;
    if (tid == 0) uslot[1] = (__hip_atomic_fetch_add(p.bar + 208 + bh, 1u, __ATOMIC_RELAXED, __HIP_MEMORY_SCOPE_AGENT) == 31u) ? 1 : 0;
    __syncthreads();
    if (__builtin_amdgcn_readfirstlane(uslot[1]) != 0) {
      if (tid == 0) { __builtin_amdgcn_fence(__ATOMIC_ACQUIRE, "agent"); asm volatile("s_waitcnt vmcnt(0)" ::: "memory"); }
      __syncthreads();
      typedef float f32x2 __attribute__((ext_vector_type(2)));
      const float cd = exp2f(128.0f * lg);
      for (int e2 = tid; e2 < 4096; e2 += 512) {
        const int e = e2 * 2;
        f32x2 kr[31];
#pragma unroll
        for (int nn = 0; nn < 31; ++nn) {
          const float* a = p.kvT + ((size_t)(bh * 32 + nn) << 13) + e;
          kr[nn][0] = __hip_atomic_load(a, __ATOMIC_RELAXED, __HIP_MEMORY_SCOPE_AGENT); kr[nn][1] = __hip_atomic_load(a + 1, __ATOMIC_RELAXED, __HIP_MEMORY_SCOPE_AGENT);
        }
        float s0 = 0.f, s1 = 0.f;
#pragma unroll
        for (int nn = 0; nn < 32; ++nn) {
          __hip_atomic_store((unsigned*)(p.stT + ((size_t)(bh * 32 + nn) << 13) + e), pack2(s0, s1), __ATOMIC_RELAXED, __HIP_MEMORY_SCOPE_AGENT);
          if (nn < 31) { s0 = s0 * cd + kr[nn][0]; s1 = s1 * cd + kr[nn][1]; }
        }
      }
      asm volatile("s_waitcnt vmcnt(0)" ::: "memory");
      __syncthreads();
      if (tid == 0) __hip_atomic_store(p.bar + 16 + bh, 1u, __ATOMIC_RELAXED, __HIP_MEMORY_SCOPE_AGENT);
    }
    __syncthreads();
  }
}

constexpr int RKO = 40960, RQO = RKO + 128 * 144, RSO = RQO + 128 * 144, RGO = RSO + 128 * 144, RG_ROW = 272, RRED2 = RGO + 128 * RG_ROW;
DI void retout_unit(LAS unsigned char* lds, const Params& p, const int u) {
  const int tid = threadIdx.x, wid = __builtin_amdgcn_readfirstlane(tid >> 6), lane = tid & 63;
  const int r = lane & 31, h = lane >> 5, i16 = lane & 15, q4 = i16 >> 2, pp = i16 & 3, blk = (lane >> 4) & 1;
  const int it = wid & 3, vh = wid >> 2;
  LAS float* red = (LAS float*)(lds + RRED2);
  {
    if (tid == 0) {
      unsigned spins = 0;
      while (__hip_atomic_load(p.bar + 16 + (u >> 5), __ATOMIC_RELAXED, __HIP_MEMORY_SCOPE_AGENT) == 0u && spins < (1u << 22)) { __builtin_amdgcn_s_sleep(2); ++spins; }
      __builtin_amdgcn_fence(__ATOMIC_ACQUIRE, "agent");
      asm volatile("s_waitcnt vmcnt(0)" ::: "memory");
    }
    __syncthreads();
    const int n = u & 31, hh = (u >> 5) & 3, b = u >> 7;
    const float lg = ret_log2g(hh);
    const int tok0 = b * SEQ + n * 128;
    const bf16_t* base = p.proj + (size_t)tok0 * NW;
    {
      u32x4 tv[4], tg[4], tk[2], tq[2], ts[2];
#pragma unroll
      for (int k = 0; k < 4; ++k) {
        const int c = tid + 512 * k, j = c >> 4, cc = c & 15;
        tv[k] = *(const u32x4*)(base + (size_t)j * NW + OFF_VR + hh * 128 + cc * 8);
        tg[k] = *(const u32x4*)(base + (size_t)j * NW + OFF_GR + hh * 128 + cc * 8);
      }
#pragma unroll
      for (int k = 0; k < 2; ++k) {
        const int c = tid + 512 * k, j = c >> 3, cc = c & 7;
        tk[k] = *(const u32x4*)(base + (size_t)j * NW + OFF_KR + hh * 64 + cc * 8);
        tq[k] = *(const u32x4*)(base + (size_t)j * NW + OFF_QR + hh * 64 + cc * 8);
        ts[k] = *(const u32x4*)(p.stT + ((size_t)u << 13) + (size_t)c * 8);
      }
#pragma unroll
      for (int k = 0; k < 4; ++k) {
        const int c = tid + 512 * k, j = c >> 4, cc = c & 15;
        *(LAS u32x4*)(lds + RV_OFF + j * RV_ROW + cc * 16) = tv[k];
        *(LAS u32x4*)(lds + RGO + j * RG_ROW + cc * 16) = tg[k];
      }
#pragma unroll
      for (int k = 0; k < 2; ++k) {
        const int c = tid + 512 * k, j = c >> 3, cc = c & 7;
        *(LAS u32x4*)(lds + RKO + j * 144 + cc * 16) = tk[k];
        *(LAS u32x4*)(lds + RQO + j * 144 + cc * 16) = tq[k];
        *(LAS u32x4*)(lds + RSO + j * 144 + cc * 16) = ts[k];
      }
    }
    __syncthreads();
    const int qi = 32 * it + r;
    bf16x8 Qf[4];
#pragma unroll
    for (int ks = 0; ks < 4; ++ks) Qf[ks] = *(const LAS bf16x8*)(lds + RQO + qi * 144 + (2 * ks + h) * 16);
    f32x16 O0, O1;
#pragma unroll
    for (int i = 0; i < 16; ++i) { O0[i] = 0.f; O1[i] = 0.f; }
    {
#pragma unroll
      for (int ks = 0; ks < 4; ++ks) {
        const bf16x8 S0 = *(const LAS bf16x8*)(lds + RSO + (64 * vh + r) * 144 + (2 * ks + h) * 16);
        const bf16x8 S1 = *(const LAS bf16x8*)(lds + RSO + (64 * vh + 32 + r) * 144 + (2 * ks + h) * 16);
        O0 = MFMA32(S0, Qf[ks], O0); O1 = MFMA32(S1, Qf[ks], O1);
      }
      const float qd = exp2f((float)(qi + 1) * lg);
#pragma unroll
      for (int i = 0; i < 16; ++i) { O0[i] *= qd; O1[i] *= qd; }
    }
    LAS unsigned char* va = lds + RV_OFF + (4 * h + q4) * RV_ROW + (64 * vh + 16 * blk + 4 * pp) * 2;
    for (int jt = 0; jt <= it; ++jt) {
      f32x16 S;
#pragma unroll
      for (int i = 0; i < 16; ++i) S[i] = 0.f;
#pragma unroll
      for (int ks = 0; ks < 4; ++ks) { const bf16x8 Kf = *(const LAS bf16x8*)(lds + RKO + (32 * jt + r) * 144 + (2 * ks + h) * 16); S = MFMA32(Kf, Qf[ks], S); }
#pragma unroll
      for (int i = 0; i < 16; ++i) {
        const int dj = qi - (32 * jt + (i & 3) + 8 * (i >> 2) + 4 * h);
        S[i] = dj >= 0 ? S[i] * fexp2((float)dj * lg) : 0.f;
      }
#pragma unroll
      for (int s2 = 0; s2 < 2; ++s2) {
        const bf16x8 Pb = pack8(S, s2);
        const bf16x8 V0 = tr_frag(va + (32 * jt + 16 * s2) * RV_ROW, 8 * RV_ROW), V1 = tr_frag(va + (32 * jt + 16 * s2) * RV_ROW + 64, 8 * RV_ROW);
        O0 = MFMA32(V0, Pb, O0);
        O1 = MFMA32(V1, Pb, O1);
      }
    }
    float s1 = 0.f, s2 = 0.f;
#pragma unroll
    for (int i = 0; i < 16; ++i) { s1 += O0[i] + O1[i]; s2 += O0[i] * O0[i] + O1[i] * O1[i]; }
    s1 += __shfl_xor(s1, 32); s2 += __shfl_xor(s2, 32);
    if (h == 0) { red[(vh * 128 + qi) * 2] = s1; red[(vh * 128 + qi) * 2 + 1] = s2; }
    __syncthreads();
    s1 += red[((vh ^ 1) * 128 + qi) * 2]; s2 += red[((vh ^ 1) * 128 + qi) * 2 + 1];
    const float mu = s1 * (1.0f / 128.0f), var = fmaxf(s2 * (1.0f / 128.0f) - mu * mu, 0.f), rs = rsqrtf(var + 1e-5f);
    const float* gnp = p.gn + hh * 128 + 64 * vh + 4 * h;
    LAS unsigned char* gt = lds + RGO + qi * RG_ROW + (64 * vh + 4 * h) * 2;
#pragma unroll
    for (int dt = 0; dt < 2; ++dt)
#pragma unroll
      for (int g = 0; g < 4; ++g) {
        const int vo = 32 * dt + 8 * g;
        LAS u32x2* ga = (LAS u32x2*)(gt + vo * 2);
        const u32x2 gwv = *ga;
        const f32x4 gnv = *(const f32x4*)(gnp + vo);
        float f0, f1, f2, f3;
        if (dt == 0) { f0 = O0[4 * g]; f1 = O0[4 * g + 1]; f2 = O0[4 * g + 2]; f3 = O0[4 * g + 3]; }
        else { f0 = O1[4 * g]; f1 = O1[4 * g + 1]; f2 = O1[4 * g + 2]; f3 = O1[4 * g + 3]; }
        f0 = (f0 - mu) * rs * gnv[0] * silu(bflo(gwv.x)); f1 = (f1 - mu) * rs * gnv[1] * silu(bfhi(gwv.x));
        f2 = (f2 - mu) * rs * gnv[2] * silu(bflo(gwv.y)); f3 = (f3 - mu) * rs * gnv[3] * silu(bfhi(gwv.y));
        u32x2 wv; wv.x = pack2(f0, f1); wv.y = pack2(f2, f3);
        *ga = wv;
      }
    __syncthreads();
#pragma unroll
    for (int k = 0; k < 4; ++k) {
      const int c = tid + 512 * k, j = c >> 4, cc = c & 15;
      *(u32x4*)(p.mixed + (size_t)(tok0 + j) * DM + 512 + hh * 128 + cc * 8) = *(const LAS u32x4*)(lds + RGO + j * RG_ROW + cc * 16);
    }
    __syncthreads();
  }
}

DI void phase_final(const Params& p, int bid, int nb) {
  const int tid = threadIdx.x, lane = tid & 63, wid = tid >> 6, nw = blockDim.x >> 6;
  for (int row = bid * nw + wid; row < T_TOK; row += nb * nw) {
    const float rs = rsqrtf(p.rowss[row] * (1.0f / DM) + 1e-6f);
    float* yr = p.out + (size_t)row * DM;
#pragma unroll
    for (int it = 0; it < 4; ++it) {
      const f32x4 v = *(const f32x4*)(yr + it * 256 + lane * 4), g = *(const f32x4*)(p.fg + it * 256 + lane * 4);
      *(f32x4*)(yr + it * 256 + lane * 4) = v * rs * g;
    }
  }
}

DI void grid_barrier(unsigned* ctr, unsigned target) {
  asm volatile("s_waitcnt vmcnt(0) lgkmcnt(0)" ::: "memory");
  __syncthreads();
  if (threadIdx.x == 0) {
    __builtin_amdgcn_fence(__ATOMIC_RELEASE, "agent");
    asm volatile("s_waitcnt vmcnt(0)" ::: "memory");
    __hip_atomic_fetch_add(ctr, 1u, __ATOMIC_RELAXED, __HIP_MEMORY_SCOPE_AGENT);
    unsigned spins = 0;
    while (__hip_atomic_load(ctr, __ATOMIC_RELAXED, __HIP_MEMORY_SCOPE_AGENT) < target && spins < (1u << 22)) { __builtin_amdgcn_s_sleep(2); ++spins; }
    __builtin_amdgcn_fence(__ATOMIC_ACQUIRE, "agent");
    asm volatile("s_waitcnt vmcnt(0)" ::: "memory");
  }
  __syncthreads();
}

__global__ void __launch_bounds__(512) k_mega(Params p) {
  extern __shared__ __attribute__((aligned(16))) unsigned char shm_[];
  LAS unsigned char* shm = (LAS unsigned char*)shm_;
  const int bid = blockIdx.x, nb = gridDim.x;
  unsigned bar_n = 0;
#ifdef PROBE_PHASE
  unsigned long long ts_a = 0, ts_b = 0; int ph_i = 0;
  if (PROBE_PHASE == 0) ts_a = __builtin_amdgcn_s_memrealtime();
#define GRID_BAR() do { bar_n += (unsigned)nb; grid_barrier(p.bar, bar_n); ++ph_i; if (ph_i == PROBE_PHASE) ts_a = __builtin_amdgcn_s_memrealtime(); if (ph_i == PROBE_PHASE + 1) ts_b = __builtin_amdgcn_s_memrealtime(); } while (0)
#else
#define GRID_BAR() do { bar_n += (unsigned)nb; grid_barrier(p.bar, bar_n); } while (0)
#endif
  phase_prep(p, bid, nb);
  GRID_BAR();
  phase_gemm<1>(shm, p, bid, nb);
  GRID_BAR();
  phase_attn(shm, p, bid, nb);
  phase_retkv(shm, p, bid, nb);
  GRID_BAR();
  phase_gemm<2>(shm, p, bid, nb);
#ifdef PROBE_PHASE
  if (PROBE_PHASE == 5) ts_b = __builtin_amdgcn_s_memrealtime();
  if (bid == 0 && threadIdx.x == 0) {
    const unsigned long long until = __builtin_amdgcn_s_memrealtime() + 9ull * (ts_b - ts_a);
    while (__builtin_amdgcn_s_memrealtime() < until) __builtin_amdgcn_s_sleep(8);
  }
#endif
}

extern "C" void kernel_launch(void* const* d_in, const int* in_sizes, int n_in, void* d_out, int out_size, void* d_ws, size_t ws_size, hipStream_t stream) {
  Params p{};
  p.x = (const float*)d_in[0]; p.ng = (const float*)d_in[1]; p.w_in = (const float*)d_in[2]; p.gn = (const float*)d_in[3];
  p.w_out = (const float*)d_in[4]; p.fg = (const float*)d_in[5];
  p.out = (float*)d_out;
  char* w = (char*)d_ws; size_t o = 0;
  auto take = [&](size_t bytes) { char* r = w + o; o += (bytes + 255) & ~(size_t)255; return r; };
  p.xb = (bf16_t*)take((size_t)T_TOK * DM * 2);
  p.proj = (bf16_t*)take((size_t)T_TOK * NW * 2);
  p.mixed = (bf16_t*)take((size_t)T_TOK * DM * 2);
  p.winT = (bf16_t*)take((size_t)NW * DM * 2);
  p.woutT = (bf16_t*)take((size_t)DM * DM * 2);
  p.rstd = (float*)take((size_t)T_TOK * 4);
  p.rowss = (float*)take((size_t)T_TOK * 4);
  p.ropeT = (float2*)take((size_t)SEQ * 32 * 8);
  p.retT = (float2*)take((size_t)SEQ * 32 * 8);
  p.kvT = (float*)take((size_t)1024 * 8192 * 4);
  p.stT = (bf16_t*)take((size_t)1024 * 8192 * 2);
  p.bar = (unsigned*)take(1024);
  p.ob = (bf16_t*)take((size_t)T_TOK * 512 * 2);
  p.lseg = (float*)take((size_t)T_TOK * 8 * 4);
  static int grid_blocks = 0;
  if (!grid_blocks) {
    (void)hipFuncSetAttribute((const void*)k_mega, hipFuncAttributeMaxDynamicSharedMemorySize, ATTN_LDS);
    int dev = 0, cus = 0, per_cu = 0;
    (void)hipGetDevice(&dev);
    (void)hipDeviceGetAttribute(&cus, hipDeviceAttributeMultiprocessorCount, dev);
    (void)hipOccupancyMaxActiveBlocksPerMultiprocessor(&per_cu, k_mega, 512, ATTN_LDS);
    if (per_cu < 1) per_cu = 1;
    grid_blocks = cus;
  }
  (void)hipMemsetAsync(p.bar, 0, 1024, stream);
  hipLaunchKernelGGL(k_mega, dim3(grid_blocks), dim3(512), ATTN_LDS, stream, p);
}
```

```cpp
#include <hip/hip_runtime.h>
#include <hip/hip_cooperative_groups.h>
#include <cstdint>
#include <cstdio>
namespace cg = cooperative_groups;

typedef unsigned short bf16_t;
typedef short bf16x8 __attribute__((ext_vector_type(8)));
typedef float f32x4 __attribute__((ext_vector_type(4)));
typedef unsigned u32x4 __attribute__((ext_vector_type(4)));
typedef unsigned u32x2 __attribute__((ext_vector_type(2)));

constexpr int T_TOK = 32768, DM = 1024, NW = 3584, SEQ = 4096;
constexpr int OFF_QA = 0, OFF_KA = 512, OFF_VA = 1024, OFF_GA = 1536, OFF_QR = 2048, OFF_KR = 2304, OFF_VR = 2560, OFF_GR = 3072;

struct Params {
  const float* x; const float* ng; const float* w_in; const float* gn; const float* w_out; const float* fg;
  float* out;
  bf16_t* xb; bf16_t* proj; bf16_t* mixed; bf16_t* winT; bf16_t* woutT;
  float* rstd; float* rowss; float2* ropeT; float2* retT; float* kvT; bf16_t* stT; unsigned* bar; bf16_t* ob; float* lseg;
};

#define DI __device__ __forceinline__
DI unsigned short f2bf(float x) { unsigned u = __float_as_uint(x); u += 0x7fffu + ((u >> 16) & 1u); return (unsigned short)(u >> 16); }
DI float bf2f(unsigned short b) { return __uint_as_float(((unsigned)b) << 16); }
typedef float f32x2_t __attribute__((ext_vector_type(2)));
typedef __bf16 bf16x2_t __attribute__((ext_vector_type(2)));
DI unsigned pack2(float lo, float hi) { const f32x2_t v = {lo, hi}; return __builtin_bit_cast(unsigned, __builtin_convertvector(v, bf16x2_t)); }
DI float bflo(unsigned w) { return __uint_as_float(w << 16); }
DI float bfhi(unsigned w) { return __uint_as_float(w & 0xffff0000u); }
DI int perm32(int rho) { const int n = rho >> 4, i = rho & 15; return 8 * (i >> 2) + 4 * n + (i & 3); }
DI int cmap(int p) { return (p & ~31) + perm32(p & 31); }
DI int cmapA(int p) { return (p & ~127) + ((p >> 6) & 1) * 64 + ((p >> 4) & 1) * 32 + ((p >> 5) & 1) * 16 + (p & 15); }

DI void phase_prep(const Params& p, int bid, int nb) {
  const int tid = threadIdx.x, lane = tid & 63, wid = tid >> 6, nw = blockDim.x >> 6;
  if (wid < 6)
  for (int row0 = (bid * 6 + wid) * 4; row0 < T_TOK; row0 += nb * 6 * 4) {
    f32x4 v[4][4];
#pragma unroll
    for (int rr = 0; rr < 4; ++rr)
#pragma unroll
      for (int it = 0; it < 4; ++it) v[rr][it] = *(const f32x4*)(p.x + (size_t)(row0 + rr) * DM + it * 256 + lane * 4);
#pragma unroll
    for (int rr = 0; rr < 4; ++rr) {
      float ss = 0.f;
#pragma unroll
      for (int it = 0; it < 4; ++it) ss += v[rr][it][0] * v[rr][it][0] + v[rr][it][1] * v[rr][it][1] + v[rr][it][2] * v[rr][it][2] + v[rr][it][3] * v[rr][it][3];
#pragma unroll
      for (int o = 32; o >= 1; o >>= 1) ss += __shfl_xor(ss, o);
#pragma unroll
      for (int it = 0; it < 4; ++it) { u32x2 w; w.x = pack2(v[rr][it][0], v[rr][it][1]); w.y = pack2(v[rr][it][2], v[rr][it][3]); *(u32x2*)(p.xb + (size_t)(row0 + rr) * DM + it * 256 + lane * 4) = w; }
      if (lane == 0) p.rstd[row0 + rr] = rsqrtf(ss * (1.0f / DM) + 1e-6f);
    }
  }
  if (wid < 6) return;
  const int gt = bid * 128 + (tid - 384), gn = nb * 128;
  for (int idx = gt; idx < (NW / 4) * 128; idx += gn) {
    const int p4 = idx % (NW / 4), kc = idx / (NW / 4), pp = p4 * 4, c = pp < 1024 ? cmapA(pp) : cmap(pp);
    f32x4 f[8];
#pragma unroll
    for (int j = 0; j < 8; ++j) { const int k = kc * 8 + j; f[j] = *(const f32x4*)(p.w_in + (size_t)k * NW + c) * p.ng[k]; }
#pragma unroll
    for (int e = 0; e < 4; ++e) {
      u32x4 w; w.x = pack2(f[0][e], f[1][e]); w.y = pack2(f[2][e], f[3][e]); w.z = pack2(f[4][e], f[5][e]); w.w = pack2(f[6][e], f[7][e]);
      *(u32x4*)(p.winT + (size_t)(pp + e) * DM + kc * 8) = w;
    }
  }
  for (int idx = gt; idx < (DM / 4) * 128; idx += gn) {
    const int p4 = idx % (DM / 4), kc = idx / (DM / 4), pp = p4 * 4, c = cmap(pp);
    f32x4 f[8];
#pragma unroll
    for (int j = 0; j < 8; ++j) { const int k = kc * 8 + j; f[j] = *(const f32x4*)(p.w_out + (size_t)k * DM + c); }
#pragma unroll
    for (int e = 0; e < 4; ++e) {
      u32x4 w; w.x = pack2(f[0][e], f[1][e]); w.y = pack2(f[2][e], f[3][e]); w.z = pack2(f[4][e], f[5][e]); w.w = pack2(f[6][e], f[7][e]);
      *(u32x4*)(p.woutT + (size_t)(pp + e) * DM + kc * 8) = w;
    }
  }
  for (int idx = gt; idx < SEQ * 32; idx += gn) {
    const int pos = idx >> 5, i = idx & 31;
    const float inv1 = powf(10000.0f, -(float)i / 32.0f);
    const float inv2 = 1.0f / powf(10000.0f, (float)i / 31.0f);
    const float a1 = (float)pos * inv1, a2 = (float)pos * inv2;
    p.ropeT[idx] = make_float2(cosf(a1), sinf(a1));
    p.retT[idx] = make_float2(cosf(a2), sinf(a2));
  }
}

constexpr int BM = 256, BK = 64, HALF = 128, HT = HALF * BK;
constexpr int GEMM_LDS = 8 * HT * 2;
DI int lds_byte(int r, int c) { int st = (r >> 4) * 2 + (c >> 5), rr = r & 15, cc = c & 31, ob = rr * 64 + cc * 2; return st * 1024 + (ob ^ (((ob >> 9) & 1) << 5)); }
DI void stage_rc(int b, int& R, int& C) { int st = b / 1024, sb = b % 1024, swz = sb ^ (((sb >> 9) & 1) << 5); R = (st >> 1) * 16 + swz / 64; C = (st & 1) * 32 + (swz % 64) / 2; }

#define LAS __attribute__((address_space(3)))
template <int EPI>
DI void gemm_tile(LAS unsigned char* lds, const bf16_t* __restrict__ A, const bf16_t* __restrict__ Bt, const int brow, const int bcol, const bool primed, const int nbrow, const int nbcol, const Params& p) {
  constexpr int K = 1024, nt = K / BK, HTB = HALF * BK * 2;
  const int tid = threadIdx.x, wid = __builtin_amdgcn_readfirstlane(tid >> 6), lane = tid & 63, wr = wid >> 2, wc = wid & 3, fr = lane & 15, fq = lane >> 4;
  unsigned voff[2];
#pragma unroll
  for (int i = 0; i < 2; ++i) { int R, C; stage_rc(tid * 16 + i * 8192, R, C); voff[i] = (unsigned)(R * K + C) * 2u; }
  const unsigned ldsw = (unsigned)wid * 1024u;
  const int aoff = lds_byte(wr * 64 + fr, fq * 8), boff = lds_byte(wc * 32 + fr, fq * 8);
  const char* cA0 = (const char*)A + (size_t)brow * K * 2; const char* cA1 = cA0 + (size_t)HALF * K * 2;
  const char* cB0 = (const char*)Bt + (size_t)bcol * K * 2; const char* cB1 = cB0 + (size_t)HALF * K * 2;
#define SAo(b, h) (((b) * 2 + (h)) * HTB)
#define SBo(b, h) ((4 + (b) * 2 + (h)) * HTB)
#define STAGE(bufoff, gb, kt) do { _Pragma("unroll") for (int _i = 0; _i < 2; ++_i) \
    __builtin_amdgcn_global_load_lds((const unsigned*)((gb) + (size_t)(kt) * (BK * 2) + voff[_i]), (LAS unsigned*)(lds + (bufoff) + ldsw + _i * 8192), 16, 0, 0); } while (0)
#define LDA(dst, b, h) do { _Pragma("unroll") for (int m = 0; m < 4; ++m) _Pragma("unroll") for (int k = 0; k < 2; ++k) \
    dst[m][k] = *(const LAS bf16x8*)(lds + SAo(b, h) + aoff + m * 2048 + k * 1024); } while (0)
#define LDB(dst, b, h) do { _Pragma("unroll") for (int n = 0; n < 2; ++n) _Pragma("unroll") for (int k = 0; k < 2; ++k) \
    dst[n][k] = *(const LAS bf16x8*)(lds + SBo(b, h) + boff + n * 2048 + k * 1024); } while (0)
#define MMA(ai, bj, At, Bt_) do { __builtin_amdgcn_s_setprio(1); \
    _Pragma("unroll") for (int m = 0; m < 4; ++m) _Pragma("unroll") for (int n = 0; n < 2; ++n) _Pragma("unroll") for (int k = 0; k < 2; ++k) \
      acc[ai][bj][m][n] = __builtin_amdgcn_mfma_f32_16x16x32_bf16(Bt_[n][k], At[m][k], acc[ai][bj][m][n], 0, 0, 0); \
    __builtin_amdgcn_s_setprio(0); } while (0)
#define WAIT_V(n) asm volatile("s_waitcnt vmcnt(" #n ")" ::: "memory")
#define WAIT_L(n) asm volatile("s_waitcnt lgkmcnt(" #n ")" ::: "memory")
#define BAR __builtin_amdgcn_s_barrier()
#define SCHED __builtin_amdgcn_sched_barrier(0)
  f32x4 acc[2][2][4][2];
#pragma unroll
  for (int a = 0; a < 2; ++a)
#pragma unroll
    for (int b = 0; b < 2; ++b)
#pragma unroll
      for (int m = 0; m < 4; ++m)
#pragma unroll
        for (int n = 0; n < 2; ++n) acc[a][b][m][n] = (f32x4){0.f, 0.f, 0.f, 0.f};
  bf16x8 At[4][2], B0[2][2], B1[2][2];
  if (!primed) {
    WAIT_V(0);
    STAGE(SBo(0, 0), cB0, 0); STAGE(SAo(0, 0), cA0, 0);
    STAGE(SBo(0, 1), cB1, 0); STAGE(SAo(0, 1), cA1, 0);
  }
  if (wr == 1) BAR;
  if (primed) WAIT_V(0); else WAIT_V(4);
  BAR;
  STAGE(SBo(1, 0), cB0, 1); STAGE(SAo(1, 0), cA0, 1); STAGE(SBo(1, 1), cB1, 1);
  WAIT_V(6); BAR;
  for (int t = 0; t < nt - 2; t += 2) {
    LDB(B0, 0, 0); SCHED; LDA(At, 0, 0); STAGE(SAo(1, 1), cA1, t + 1);
    WAIT_L(8); BAR; WAIT_L(0); MMA(0, 0, At, B0); BAR; SCHED;
    LDB(B1, 0, 1); STAGE(SBo(0, 0), cB0, t + 2);
    BAR; WAIT_L(0); MMA(0, 1, At, B1); BAR;
    LDA(At, 0, 1); STAGE(SAo(0, 0), cA0, t + 2);
    BAR; WAIT_L(0); MMA(1, 0, At, B0); BAR; SCHED;
    STAGE(SBo(0, 1), cB1, t + 2);
    WAIT_V(6); BAR; MMA(1, 1, At, B1); BAR;
    LDB(B0, 1, 0); SCHED; LDA(At, 1, 0); STAGE(SAo(0, 1), cA1, t + 2);
    WAIT_L(8); BAR; WAIT_L(0); MMA(0, 0, At, B0); BAR; SCHED;
    LDB(B1, 1, 1); STAGE(SBo(1, 0), cB0, t + 3);
    BAR; WAIT_L(0); MMA(0, 1, At, B1); BAR;
    LDA(At, 1, 1); STAGE(SAo(1, 0), cA0, t + 3);
    BAR; WAIT_L(0); MMA(1, 0, At, B0); BAR; SCHED;
    STAGE(SBo(1, 1), cB1, t + 3);
    WAIT_V(6); BAR; MMA(1, 1, At, B1); BAR;
  }
  { LDB(B0, 0, 0); LDA(At, 0, 0); STAGE(SAo(1, 1), cA1, nt - 1);
    BAR; WAIT_L(0); MMA(0, 0, At, B0); BAR;
    LDB(B1, 0, 1); BAR; WAIT_L(0); MMA(0, 1, At, B1); BAR;
    LDA(At, 0, 1); WAIT_V(4); BAR; WAIT_L(0); MMA(1, 0, At, B0); MMA(1, 1, At, B1); BAR; }
  { LDB(B0, 1, 0); LDA(At, 1, 0); WAIT_V(2); BAR; WAIT_L(0); MMA(0, 0, At, B0); BAR;
    LDB(B1, 1, 1); WAIT_V(0); BAR; WAIT_L(0); MMA(0, 1, At, B1); BAR;
    LDA(At, 1, 1); BAR; WAIT_L(0); MMA(1, 0, At, B0); MMA(1, 1, At, B1); BAR; }
  if (wr == 0) BAR;
  if (nbrow >= 0) {
    const char* nA0 = (const char*)A + (size_t)nbrow * K * 2; const char* nB0 = (const char*)Bt + (size_t)nbcol * K * 2;
    STAGE(SBo(0, 0), nB0, 0); STAGE(SAo(0, 0), nA0, 0);
    STAGE(SBo(0, 1), nB0 + (size_t)HALF * K * 2, 0); STAGE(SAo(0, 1), nA0 + (size_t)HALF * K * 2, 0);
  }
  if (EPI == 1) {
    const int pn = bcol >> 8;
    if (pn < 4) {
      const float sc = pn < 2 ? 0.125f * 1.4426950408889634f : 1.0f;
      const int i0 = 16 * (wc & 1) + 4 * fq;
#pragma unroll
      for (int ai = 0; ai < 2; ++ai)
#pragma unroll
        for (int m = 0; m < 4; ++m) {
          const int row = brow + ai * HALF + wr * 64 + m * 16 + fr;
          const float rs = p.rstd[row] * sc;
          const float* tb = (const float*)(p.ropeT + (row & (SEQ - 1)) * 32 + i0);
          const f32x4 t0 = *(const f32x4*)tb, t1 = *(const f32x4*)(tb + 4);
#pragma unroll
          for (int bj = 0; bj < 2; ++bj) {
            const f32x4 x1 = acc[ai][bj][m][0] * rs, x2 = acc[ai][bj][m][1] * rs;
            u32x2 wa, wb;
            wa.x = pack2(x1[0] * t0[0] - x2[0] * t0[1], x1[1] * t0[2] - x2[1] * t0[3]);
            wa.y = pack2(x1[2] * t1[0] - x2[2] * t1[1], x1[3] * t1[2] - x2[3] * t1[3]);
            wb.x = pack2(x2[0] * t0[0] + x1[0] * t0[1], x2[1] * t0[2] + x1[1] * t0[3]);
            wb.y = pack2(x2[2] * t1[0] + x1[2] * t1[1], x2[3] * t1[2] + x1[3] * t1[3]);
            bf16_t* o = p.proj + (size_t)row * NW + bcol + bj * HALF + (wc >> 1) * 64 + i0;
            *(u32x2*)o = wa; *(u32x2*)(o + 32) = wb;
          }
        }
    } else if (pn == 8 || pn == 9) {
      const float sc = pn == 9 ? 0.125f : 1.0f;
      const int i0 = 16 * (wc & 1) + 4 * fq;
#pragma unroll
      for (int ai = 0; ai < 2; ++ai)
#pragma unroll
        for (int m = 0; m < 4; ++m) {
          const int row = brow + ai * HALF + wr * 64 + m * 16 + fr;
          const float rs = p.rstd[row] * sc;
          const float* tb = (const float*)(p.retT + (row & (SEQ - 1)) * 32 + i0);
          const f32x4 t0 = *(const f32x4*)tb, t1 = *(const f32x4*)(tb + 4);
#pragma unroll
          for (int bj = 0; bj < 2; ++bj) {
            const f32x4 v0 = acc[ai][bj][m][0] * rs, v1 = acc[ai][bj][m][1] * rs;
            u32x4 w;
            w.x = pack2(v0[0] * t0[0] - v0[1] * t0[1], v0[1] * t0[0] + v0[0] * t0[1]);
            w.y = pack2(v0[2] * t0[2] - v0[3] * t0[3], v0[3] * t0[2] + v0[2] * t0[3]);
            w.z = pack2(v1[0] * t1[0] - v1[1] * t1[1], v1[1] * t1[0] + v1[0] * t1[1]);
            w.w = pack2(v1[2] * t1[2] - v1[3] * t1[3], v1[3] * t1[2] + v1[2] * t1[3]);
            *(u32x4*)(p.proj + (size_t)row * NW + bcol + bj * HALF + wc * 32 + 8 * fq) = w;
          }
        }
    } else {
#pragma unroll
    for (int ai = 0; ai < 2; ++ai)
#pragma unroll
      for (int m = 0; m < 4; ++m) {
        const int row = brow + ai * HALF + wr * 64 + m * 16 + fr;
        const float rs = p.rstd[row];
#pragma unroll
        for (int bj = 0; bj < 2; ++bj) {
          const f32x4 v0 = acc[ai][bj][m][0] * rs, v1 = acc[ai][bj][m][1] * rs;
          u32x4 w; w.x = pack2(v0[0], v0[1]); w.y = pack2(v0[2], v0[3]); w.z = pack2(v1[0], v1[1]); w.w = pack2(v1[2], v1[3]);
          *(u32x4*)(p.proj + (size_t)row * NW + bcol + bj * HALF + wc * 32 + 8 * fq) = w;
        }
      }
    }
  } else {
    const int pm = brow >> 8, pn = bcol >> 8;
    LAS float* part = (LAS float*)(lds + GEMM_LDS);
    LAS float* rsl = (LAS float*)(lds + GEMM_LDS + 4096);
#pragma unroll
    for (int ai = 0; ai < 2; ++ai)
#pragma unroll
      for (int m = 0; m < 4; ++m) {
        const int rl = ai * HALF + wr * 64 + m * 16 + fr;
        float ss = 0.f;
#pragma unroll
        for (int bj = 0; bj < 2; ++bj) {
          const size_t off = (size_t)(brow + rl) * DM + bcol + bj * HALF + wc * 32 + 8 * fq;
          const f32x4 x0 = *(const f32x4*)(p.x + off), x1 = *(const f32x4*)(p.x + off + 4);
          const f32x4 y0 = acc[ai][bj][m][0] + x0, y1 = acc[ai][bj][m][1] + x1;
          acc[ai][bj][m][0] = y0; acc[ai][bj][m][1] = y1;
          ss += y0[0] * y0[0] + y0[1] * y0[1] + y0[2] * y0[2] + y0[3] * y0[3] + y1[0] * y1[0] + y1[1] * y1[1] + y1[2] * y1[2] + y1[3] * y1[3];
        }
        ss += __shfl_xor(ss, 16); ss += __shfl_xor(ss, 32);
        if (fq == 0) part[wc * 256 + rl] = ss;
      }
    __syncthreads();
    float* xs = p.rowss + (size_t)(pm * 4) * 256;
    if (tid < 256) {
      const float tot = part[tid] + part[256 + tid] + part[512 + tid] + part[768 + tid];
      __hip_atomic_store(xs + pn * 256 + tid, tot, __ATOMIC_RELAXED, __HIP_MEMORY_SCOPE_AGENT);
    }
    asm volatile("s_waitcnt vmcnt(0)" ::: "memory");
    __syncthreads();
    unsigned* cnt = p.bar + 64 + pm;
    if (tid == 0) __hip_atomic_fetch_add(cnt, 1u, __ATOMIC_RELAXED, __HIP_MEMORY_SCOPE_AGENT);
    if (wid == 0) {
      unsigned spins = 0;
      while (__hip_atomic_load(cnt, __ATOMIC_RELAXED, __HIP_MEMORY_SCOPE_AGENT) < 4u && spins < (1u << 20)) { __builtin_amdgcn_s_sleep(1); ++spins; }
      __builtin_amdgcn_fence(__ATOMIC_ACQUIRE, "agent");
      asm volatile("s_waitcnt vmcnt(0)" ::: "memory");
    }
    __syncthreads();
    if (tid < 256) {
      float t = 0.f;
#pragma unroll
      for (int q = 0; q < 4; ++q) t += __hip_atomic_load(xs + q * 256 + tid, __ATOMIC_RELAXED, __HIP_MEMORY_SCOPE_AGENT);
      rsl[tid] = rsqrtf(t * (1.0f / DM) + 1e-6f);
    }
    __syncthreads();
#pragma unroll
    for (int ai = 0; ai < 2; ++ai)
#pragma unroll
      for (int m = 0; m < 4; ++m) {
        const int rl = ai * HALF + wr * 64 + m * 16 + fr;
        const float rs = rsl[rl];
#pragma unroll
        for (int bj = 0; bj < 2; ++bj) {
          const int col = bcol + bj * HALF + wc * 32 + 8 * fq;
          const f32x4 g0 = *(const f32x4*)(p.fg + col), g1 = *(const f32x4*)(p.fg + col + 4);
          float* o = p.out + (size_t)(brow + rl) * DM + col;
          *(f32x4*)o = acc[ai][bj][m][0] * rs * g0; *(f32x4*)(o + 4) = acc[ai][bj][m][1] * rs * g1;
        }
      }
    __syncthreads();
  }
}

DI void tile_of(int L, int nM, int nN, int& pm, int& pn) {
  const int nwg = nM * nN, NX = 8, WGM = 8;
  int wgid = L; { const int q = nwg / NX, r = nwg % NX, xcd = wgid % NX, off = wgid / NX; wgid = (xcd < r ? xcd * (q + 1) : r * (q + 1) + (xcd - r) * q) + off; }
  const int nig = WGM * nN, gid = wgid / nig, fm = gid * WGM, gsz = (nM - fm) < WGM ? (nM - fm) : WGM;
  pm = fm + ((wgid % nig) % gsz); pn = (wgid % nig) / gsz;
}

template <int EPI>
DI void phase_gemm(LAS unsigned char* shm, const Params& p, int bid, int nb) {
  const int nM = T_TOK / BM, nN = (EPI == 1 ? NW : DM) / BM, nT = nM * nN;
  bool primed = false;
  for (int L = bid; L < nT; L += nb) {
    int pm, pn; tile_of(L, nM, nN, pm, pn);
    int npm = -1, npn = 0;
    if (L + nb < nT) tile_of(L + nb, nM, nN, npm, npn);
    const int nbrow = npm < 0 ? -1 : npm * BM;
    if (EPI == 1) gemm_tile<1>(shm, p.xb, p.winT, pm * BM, pn * BM, primed, nbrow, npn * BM, p);
    else gemm_tile<2>(shm, p.mixed, p.woutT, pm * BM, pn * BM, primed, nbrow, npn * BM, p);
    primed = true;
  }
  asm volatile("s_waitcnt vmcnt(0)" ::: "memory");
}

DI float ret_log2g(int h) { return log2f(1.0f - exp2f(-5.0f - (float)h)); }

typedef float f32x16 __attribute__((ext_vector_type(16)));
typedef short s16x4 __attribute__((ext_vector_type(4)));
#define MFMA32(a, b, c) __builtin_amdgcn_mfma_f32_32x32x16_bf16((a), (b), (c), 0, 0, 0)
DI s16x4 tr_read(LAS unsigned char* a) { return __builtin_amdgcn_ds_read_tr16_b64_v4i16((LAS s16x4*)a); }
DI bf16x8 tr_frag(LAS unsigned char* a, int rowstride8) {
  const s16x4 lo = tr_read(a), hi = tr_read(a + rowstride8);
  return __builtin_shufflevector(lo, hi, 0, 1, 2, 3, 4, 5, 6, 7);
}
DI bf16x8 pack8(const f32x16& x, int s) {
  u32x4 w;
  w.x = pack2(x[8 * s + 0], x[8 * s + 1]); w.y = pack2(x[8 * s + 2], x[8 * s + 3]); w.z = pack2(x[8 * s + 4], x[8 * s + 5]); w.w = pack2(x[8 * s + 6], x[8 * s + 7]);
  return __builtin_bit_cast(bf16x8, w);
}
DI float fexp2(float x) { return __builtin_amdgcn_exp2f(x); }
DI float half_max(float x) { const u32x2 r = __builtin_amdgcn_permlane32_swap(__float_as_uint(x), __float_as_uint(x), false, false); return fmaxf(__uint_as_float(r[0]), __uint_as_float(r[1])); }
DI float half_sum(float x) { const u32x2 r = __builtin_amdgcn_permlane32_swap(__float_as_uint(x), __float_as_uint(x), false, false); return __uint_as_float(r[0]) + __uint_as_float(r[1]); }
DI float silu(float g) { return g / (1.0f + __expf(-g)); }

constexpr int AT_ROWB = 136, AT_LS = 512 * AT_ROWB, AT_VST = AT_LS + 2048, VROW = 192, KROW = 144, KST_W = 32 * KROW, VST_W = KST_W + 32 * VROW;
constexpr int ATTN_LDS = AT_VST + 8 * VST_W;
constexpr float LOG2E = 1.4426950408889634f;

constexpr int PT_ROW = 136;

DI void softmax_pv(f32x16& S, f32x16& O0, f32x16& O1, float& m, float& l, const bf16x8 (&Vf)[2][2], const bool mlow, const bool mhigh, const int r, const int h) {
  if (mlow || mhigh) {
#pragma unroll
    for (int i = 0; i < 16; ++i) {
      const int keyrow = (i & 3) + 8 * (i >> 2) + 4 * h;
      const bool bad = (mlow && keyrow < r) || (mhigh && keyrow > r);
      S[i] = bad ? -1e30f : S[i];
    }
  }
  float mx = fmaxf(S[0], S[1]);
#pragma unroll
  for (int i = 2; i < 16; ++i) mx = fmaxf(mx, S[i]);
  mx = half_max(mx);
  const float mn = fmaxf(m, mx);
  if (__builtin_amdgcn_ballot_w64(mn > m) != 0ull) {
    const float al = fexp2(m - mn);
    l *= al;
#pragma unroll
    for (int i = 0; i < 16; ++i) { O0[i] *= al; O1[i] *= al; }
    m = mn;
  }
  float ps = 0.f;
#pragma unroll
  for (int i = 0; i < 16; ++i) { S[i] = fexp2(S[i] - mn); ps += S[i]; }
  l += half_sum(ps);
#pragma unroll
  for (int s = 0; s < 2; ++s) {
    const bf16x8 Pb = pack8(S, s);
    O0 = MFMA32(Vf[s][0], Pb, O0);
    O1 = MFMA32(Vf[s][1], Pb, O1);
  }
}

DI void attn_tile2(const u32x4 (&Kc)[4], const u32x4 (&Vc)[4], const bf16x8 (&QA)[4], const bf16x8 (&QB)[4],
                   f32x16& A0, f32x16& A1, float& mA, float& lA, f32x16& B0, f32x16& B1, float& mB, float& lB,
                   LAS unsigned char* kst, LAS unsigned char* vst, LAS unsigned char* trp, const int lane, const int kt) {
  const int r = lane & 31, h = lane >> 5;
#pragma unroll
  for (int c = 0; c < 4; ++c) {
    *(LAS u32x4*)(kst + ((lane >> 3) + 8 * c) * KROW + (lane & 7) * 16) = Kc[c];
    *(LAS u32x4*)(vst + ((lane >> 3) + 8 * c) * VROW + (lane & 7) * 16) = Vc[c];
  }
  bf16x8 Kf[4], Vf[2][2];
#pragma unroll
  for (int ks = 0; ks < 4; ++ks) Kf[ks] = *(const LAS bf16x8*)(kst + r * KROW + (2 * ks + h) * 16);
#pragma unroll
  for (int s = 0; s < 2; ++s) { Vf[s][0] = tr_frag(trp + 16 * s * VROW, 8 * VROW); Vf[s][1] = tr_frag(trp + 16 * s * VROW + 64, 8 * VROW); }
  if (kt <= 4) {
    f32x16 S;
#pragma unroll
    for (int i = 0; i < 16; ++i) S[i] = 0.f;
#pragma unroll
    for (int ks = 0; ks < 4; ++ks) S = MFMA32(Kf[ks], QA[ks], S);
    softmax_pv(S, A0, A1, mA, lA, Vf, kt == 0, kt == 4, r, h);
  }
  if (kt >= 1) {
    f32x16 S;
#pragma unroll
    for (int i = 0; i < 16; ++i) S[i] = 0.f;
#pragma unroll
    for (int ks = 0; ks < 4; ++ks) S = MFMA32(Kf[ks], QB[ks], S);
    softmax_pv(S, B0, B1, mB, lB, Vf, kt == 1, kt == 5, r, h);
  }
}

DI void attn_merge(const Params& p, LAS unsigned char* T, const f32x16& O0, const f32x16& O1, const float m, const float l, const int lane,
                   const int tokq0  , const int sh, const int hh, const bool first, const bool last) {
  const int r = lane & 31, h = lane >> 5;
  const int rowc = lane >> 3, ch = lane & 7;
  float lse = m + __log2f(l);
  float w1 = 1.0f / l, w0 = 0.f;
  if (!first) {
#pragma unroll
    for (int c = 0; c < 4; ++c) {
      const size_t tk = (size_t)(tokq0 + ((rowc + 8 * c) << sh));
      *(LAS u32x4*)(T + (rowc + 8 * c) * PT_ROW + ch * 16) = *(const u32x4*)(p.ob + (tk * 8 + hh) * 64 + ch * 8);
    }
    const float lp = p.lseg[(size_t)(tokq0 + (r << sh)) * 8 + hh];
    const float M = fmaxf(lse, lp), e1 = fexp2(lse - M), e0 = fexp2(lp - M), den = e0 + e1, id = 1.0f / den;
    w1 *= e1 * id; w0 = e0 * id; lse = M + __log2f(den);
  }
  LAS unsigned char* ob = T + r * PT_ROW + 8 * h;
#pragma unroll
  for (int dt = 0; dt < 2; ++dt)
#pragma unroll
    for (int g = 0; g < 4; ++g) {
      float f0, f1, f2, f3;
      if (dt == 0) { f0 = O0[4 * g] * w1; f1 = O0[4 * g + 1] * w1; f2 = O0[4 * g + 2] * w1; f3 = O0[4 * g + 3] * w1; }
      else { f0 = O1[4 * g] * w1; f1 = O1[4 * g + 1] * w1; f2 = O1[4 * g + 2] * w1; f3 = O1[4 * g + 3] * w1; }
      LAS u32x2* a = (LAS u32x2*)(ob + 64 * dt + 16 * g);
      if (!first) { const u32x2 pv = *a; f0 += w0 * bflo(pv.x); f1 += w0 * bfhi(pv.x); f2 += w0 * bflo(pv.y); f3 += w0 * bfhi(pv.y); }
      u32x2 wv; wv.x = pack2(f0, f1); wv.y = pack2(f2, f3);
      *a = wv;
    }
  if (!last) {
    if (h == 0) p.lseg[(size_t)(tokq0 + (r << sh)) * 8 + hh] = lse;
#pragma unroll
    for (int c = 0; c < 4; ++c) {
      const size_t tk = (size_t)(tokq0 + ((rowc + 8 * c) << sh));
      *(u32x4*)(p.ob + (tk * 8 + hh) * 64 + ch * 8) = *(const LAS u32x4*)(T + (rowc + 8 * c) * PT_ROW + ch * 16);
    }
  } else {
#pragma unroll
    for (int c = 0; c < 4; ++c) {
      const size_t tk = (size_t)(tokq0 + ((rowc + 8 * c) << sh));
      const u32x4 a = *(const LAS u32x4*)(T + (rowc + 8 * c) * PT_ROW + ch * 16);
      const u32x4 g = *(const u32x4*)(p.proj + tk * NW + OFF_GA + hh * 64 + ch * 8);
      u32x4 w;
      w.x = pack2(bflo(a.x) * silu(bflo(g.x)), bfhi(a.x) * silu(bfhi(g.x)));
      w.y = pack2(bflo(a.y) * silu(bflo(g.y)), bfhi(a.y) * silu(bfhi(g.y)));
      w.z = pack2(bflo(a.z) * silu(bflo(g.z)), bfhi(a.z) * silu(bfhi(g.z)));
      w.w = pack2(bflo(a.w) * silu(bflo(g.w)), bfhi(a.w) * silu(bfhi(g.w)));
      *(u32x4*)(p.mixed + tk * DM + hh * 64 + ch * 8) = w;
    }
  }
}

DI void attn_task2(const Params& p, LAS unsigned char* kst, const int lane, const int tokbase, const int hh,
                   const int sh, const int r_res, const int l0, const bool first, const bool last) {
  const int r = lane & 31, h = lane >> 5;
  const int i16 = lane & 15, q4 = i16 >> 2, pp = i16 & 3, blk = (lane >> 4) & 1;
  LAS unsigned char* vst = kst + KST_W;
  LAS unsigned char* trp = vst + (4 * h + q4) * VROW + 32 * blk + 8 * pp;
  const bf16_t* qpA = p.proj + (size_t)(tokbase + r_res + ((l0 + r) << sh)) * NW + OFF_QA + hh * 64 + 8 * h;
  const bf16_t* qpB = qpA + (size_t)(32 << sh) * NW;
  bf16x8 QA[4], QB[4];
#pragma unroll
  for (int ks = 0; ks < 4; ++ks) { QA[ks] = *(const bf16x8*)(qpA + 16 * ks); QB[ks] = *(const bf16x8*)(qpB + 16 * ks); }
  f32x16 A0, A1, B0, B1;
#pragma unroll
  for (int i = 0; i < 16; ++i) { A0[i] = 0.f; A1[i] = 0.f; B0[i] = 0.f; B1[i] = 0.f; }
  float mA = -1e30f, lA = 0.f, mB = -1e30f, lB = 0.f;
  const int kt0 = (l0 >= 128) ? 0 : (4 - (l0 >> 5));
#define LOAD_KV(Kd, Vd, kt_) do { const int lk0_ = l0 - 128 + 32 * (kt_) + (lane >> 3); \
    _Pragma("unroll") for (int c_ = 0; c_ < 4; ++c_) { \
      const bf16_t* kp_ = p.proj + (size_t)(tokbase + r_res + ((lk0_ + 8 * c_) << sh)) * NW + OFF_KA + hh * 64 + 8 * (lane & 7); \
      Kd[c_] = *(const u32x4*)kp_; Vd[c_] = *(const u32x4*)(kp_ + (OFF_VA - OFF_KA)); } } while (0)
  for (int kt = kt0; kt < 6; kt += 2) {
    u32x4 K0[4], K1[4], V0[4], V1[4];
    LOAD_KV(K0, V0, kt);
    LOAD_KV(K1, V1, kt + 1);
    attn_tile2(K0, V0, QA, QB, A0, A1, mA, lA, B0, B1, mB, lB, kst, vst, trp, lane, kt);
    attn_tile2(K1, V1, QA, QB, A0, A1, mA, lA, B0, B1, mB, lB, kst, vst, trp, lane, kt + 1);
  }
#undef LOAD_KV
  const int tokA = tokbase + r_res + (l0 << sh);
  attn_merge(p, kst, A0, A1, mA, lA, lane, tokA, sh, hh, first, last);
  attn_merge(p, kst, B0, B1, mB, lB, lane, tokA + (32 << sh), sh, hh, first, last);
}

DI void phase_attn(LAS unsigned char* lds, const Params& p, int bid, int nb) {
  const int tid = threadIdx.x, wid = __builtin_amdgcn_readfirstlane(tid >> 6), lane = tid & 63;
  LAS unsigned char* kst = lds + wid * VST_W;
  for (int unit = bid; unit < 256; unit += nb) {
    const int sp = unit & 3, hh = (unit >> 2) & 7, b = unit >> 5;
    const int tokbase = b * SEQ;
    for (int stage = 0; stage < 3; ++stage) {
      const int sh = stage == 0 ? 4 : (stage == 1 ? 2 : 0);
      for (int tk = 0; tk < 2; ++tk) {
        const int idx = wid + 8 * tk;
        int r_res, l0;
        if (stage == 0) { r_res = idx; l0 = 64 * sp; }
        else if (stage == 1) { r_res = idx >> 2; l0 = 256 * sp + 64 * (idx & 3); }
        else { r_res = 0; l0 = 1024 * sp + 64 * idx; }
        attn_task2(p, kst, lane, tokbase, hh, sh, r_res, l0, stage == 0, stage == 2);
      }
      __syncthreads();
    }
  }
}

constexpr int RV_ROW = 320, RK_ROW = 192, RV_OFF = 0, RK_OFF = 128 * RV_ROW  , RRED_OFF = RK_OFF + 128 * RK_ROW  ;

DI void retout_unit(LAS unsigned char* lds, const Params& p, const int u);
DI void phase_retkv(LAS unsigned char* lds, const Params& p, int bid, int nb) {
  const int tid = threadIdx.x, wid = __builtin_amdgcn_readfirstlane(tid >> 6), lane = tid & 63;
  const int r = lane & 31, h = lane >> 5, i16 = lane & 15, q4 = i16 >> 2, pp = i16 & 3, blk = (lane >> 4) & 1;
  const int vt = wid >> 1, dt = wid & 1;
  LAS int* uslot = (LAS int*)(lds + RRED_OFF);
  for (;;) {
    if (tid == 0) *uslot = (int)__hip_atomic_fetch_add(p.bar + 200, 1u, __ATOMIC_RELAXED, __HIP_MEMORY_SCOPE_AGENT);
    __syncthreads();
    const int u = __builtin_amdgcn_readfirstlane(*uslot);
    if (u >= 2048) break;
    if (u >= 1024) { __syncthreads(); retout_unit(lds, p, u - 1024); continue; }
    const int n = u & 31, hh = (u >> 5) & 3, b = u >> 7;
    const float lg = ret_log2g(hh);
    const bf16_t* base = p.proj + (size_t)(b * SEQ + n * 128) * NW;
#pragma unroll
    for (int it = 0; it < 4; ++it) {
      const int c = tid + 512 * it, j = c >> 4, cc = c & 15;
      *(LAS u32x4*)(lds + RV_OFF + j * RV_ROW + cc * 16) = *(const u32x4*)(base + (size_t)j * NW + OFF_VR + hh * 128 + cc * 8);
    }
#pragma unroll
    for (int it = 0; it < 2; ++it) {
      const int c = tid + 512 * it, j = c >> 3, cc = c & 7;
      const u32x4 w = *(const u32x4*)(base + (size_t)j * NW + OFF_KR + hh * 64 + cc * 8);
      const float dk = exp2f((float)(127 - j) * lg);
      u32x4 o;
      o.x = pack2(bflo(w.x) * dk, bfhi(w.x) * dk); o.y = pack2(bflo(w.y) * dk, bfhi(w.y) * dk);
      o.z = pack2(bflo(w.z) * dk, bfhi(w.z) * dk); o.w = pack2(bflo(w.w) * dk, bfhi(w.w) * dk);
      *(LAS u32x4*)(lds + RK_OFF + j * RK_ROW + cc * 16) = o;
    }
    __syncthreads();
    f32x16 acc;
#pragma unroll
    for (int i = 0; i < 16; ++i) acc[i] = 0.f;
    LAS unsigned char* va = lds + RV_OFF + (4 * h + q4) * RV_ROW + (32 * vt + 16 * blk + 4 * pp) * 2;
    LAS unsigned char* ka = lds + RK_OFF + (4 * h + q4) * RK_ROW + (32 * dt + 16 * blk + 4 * pp) * 2;
#pragma unroll
    for (int s = 0; s < 8; ++s) {
      const bf16x8 A = tr_frag(va + 16 * s * RV_ROW, 8 * RV_ROW), B = tr_frag(ka + 16 * s * RK_ROW, 8 * RK_ROW);
      acc = MFMA32(A, B, acc);
    }
    float* o = p.kvT + ((size_t)u << 13) + (32 * vt + 4 * h) * 64 + 32 * dt + r;
#pragma unroll
    for (int i = 0; i < 16; ++i) __hip_atomic_store(o + ((i & 3) + 8 * (i >> 2)) * 64, acc[i], __ATOMIC_RELAXED, __HIP_MEMORY_SCOPE_AGENT);
    asm volatile("s_waitcnt vmcnt(0)" ::: "memory");
    __syncthreads();
    const int bh = u >> 5;
    if (tid == 0) uslot[1] = (__hip_atomic_fetch_add(p.bar + 208 + bh, 1u, __ATOMIC_RELAXED, __HIP_MEMORY_SCOPE_AGENT) == 31u) ? 1 : 0;
    __syncthreads();
    if (__builtin_amdgcn_readfirstlane(uslot[1]) != 0) {
      if (tid == 0) { __builtin_amdgcn_fence(__ATOMIC_ACQUIRE, "agent"); asm volatile("s_waitcnt vmcnt(0)" ::: "memory"); }
      __syncthreads();
      typedef float f32x2 __attribute__((ext_vector_type(2)));
      const float cd = exp2f(128.0f * lg);
      for (int e2 = tid; e2 < 4096; e2 += 512) {
        const int e = e2 * 2;
        f32x2 kr[31];
#pragma unroll
        for (int nn = 0; nn < 31; ++nn) {
          const float* a = p.kvT + ((size_t)(bh * 32 + nn) << 13) + e;
          kr[nn][0] = __hip_atomic_load(a, __ATOMIC_RELAXED, __HIP_MEMORY_SCOPE_AGENT); kr[nn][1] = __hip_atomic_load(a + 1, __ATOMIC_RELAXED, __HIP_MEMORY_SCOPE_AGENT);
        }
        float s0 = 0.f, s1 = 0.f;
#pragma unroll
        for (int nn = 0; nn < 32; ++nn) {
          __hip_atomic_store((unsigned*)(p.stT + ((size_t)(bh * 32 + nn) << 13) + e), pack2(s0, s1), __ATOMIC_RELAXED, __HIP_MEMORY_SCOPE_AGENT);
          if (nn < 31) { s0 = s0 * cd + kr[nn][0]; s1 = s1 * cd + kr[nn][1]; }
        }
      }
      asm volatile("s_waitcnt vmcnt(0)" ::: "memory");
      __syncthreads();
      if (tid == 0) __hip_atomic_store(p.bar + 16 + bh, 1u, __ATOMIC_RELAXED, __HIP_MEMORY_SCOPE_AGENT);
    }
    __syncthreads();
  }
}

constexpr int RKO = 40960, RQO = RKO + 128 * 144, RSO = RQO + 128 * 144, RGO = RSO + 128 * 144, RG_ROW = 272, RRED2 = RGO + 128 * RG_ROW;
DI void retout_unit(LAS unsigned char* lds, const Params& p, const int u) {
  const int tid = threadIdx.x, wid = __builtin_amdgcn_readfirstlane(tid >> 6), lane = tid & 63;
  const int r = lane & 31, h = lane >> 5, i16 = lane & 15, q4 = i16 >> 2, pp = i16 & 3, blk = (lane >> 4) & 1;
  const int it = wid & 3, vh = wid >> 2;
  LAS float* red = (LAS float*)(lds + RRED2);
  {
    if (tid == 0) {
      unsigned spins = 0;
      while (__hip_atomic_load(p.bar + 16 + (u >> 5), __ATOMIC_RELAXED, __HIP_MEMORY_SCOPE_AGENT) == 0u && spins < (1u << 22)) { __builtin_amdgcn_s_sleep(2); ++spins; }
      __builtin_amdgcn_fence(__ATOMIC_ACQUIRE, "agent");
      asm volatile("s_waitcnt vmcnt(0)" ::: "memory");
    }
    __syncthreads();
    const int n = u & 31, hh = (u >> 5) & 3, b = u >> 7;
    const float lg = ret_log2g(hh);
    const int tok0 = b * SEQ + n * 128;
    const bf16_t* base = p.proj + (size_t)tok0 * NW;
    {
      u32x4 tv[4], tg[4], tk[2], tq[2], ts[2];
#pragma unroll
      for (int k = 0; k < 4; ++k) {
        const int c = tid + 512 * k, j = c >> 4, cc = c & 15;
        tv[k] = *(const u32x4*)(base + (size_t)j * NW + OFF_VR + hh * 128 + cc * 8);
        tg[k] = *(const u32x4*)(base + (size_t)j * NW + OFF_GR + hh * 128 + cc * 8);
      }
#pragma unroll
      for (int k = 0; k < 2; ++k) {
        const int c = tid + 512 * k, j = c >> 3, cc = c & 7;
        tk[k] = *(const u32x4*)(base + (size_t)j * NW + OFF_KR + hh * 64 + cc * 8);
        tq[k] = *(const u32x4*)(base + (size_t)j * NW + OFF_QR + hh * 64 + cc * 8);
        ts[k] = *(const u32x4*)(p.stT + ((size_t)u << 13) + (size_t)c * 8);
      }
#pragma unroll
      for (int k = 0; k < 4; ++k) {
        const int c = tid + 512 * k, j = c >> 4, cc = c & 15;
        *(LAS u32x4*)(lds + RV_OFF + j * RV_ROW + cc * 16) = tv[k];
        *(LAS u32x4*)(lds + RGO + j * RG_ROW + cc * 16) = tg[k];
      }
#pragma unroll
      for (int k = 0; k < 2; ++k) {
        const int c = tid + 512 * k, j = c >> 3, cc = c & 7;
        *(LAS u32x4*)(lds + RKO + j * 144 + cc * 16) = tk[k];
        *(LAS u32x4*)(lds + RQO + j * 144 + cc * 16) = tq[k];
        *(LAS u32x4*)(lds + RSO + j * 144 + cc * 16) = ts[k];
      }
    }
    __syncthreads();
    const int qi = 32 * it + r;
    bf16x8 Qf[4];
#pragma unroll
    for (int ks = 0; ks < 4; ++ks) Qf[ks] = *(const LAS bf16x8*)(lds + RQO + qi * 144 + (2 * ks + h) * 16);
    f32x16 O0, O1;
#pragma unroll
    for (int i = 0; i < 16; ++i) { O0[i] = 0.f; O1[i] = 0.f; }
    {
#pragma unroll
      for (int ks = 0; ks < 4; ++ks) {
        const bf16x8 S0 = *(const LAS bf16x8*)(lds + RSO + (64 * vh + r) * 144 + (2 * ks + h) * 16);
        const bf16x8 S1 = *(const LAS bf16x8*)(lds + RSO + (64 * vh + 32 + r) * 144 + (2 * ks + h) * 16);
        O0 = MFMA32(S0, Qf[ks], O0); O1 = MFMA32(S1, Qf[ks], O1);
      }
      const float qd = exp2f((float)(qi + 1) * lg);
#pragma unroll
      for (int i = 0; i < 16; ++i) { O0[i] *= qd; O1[i] *= qd; }
    }
    LAS unsigned char* va = lds + RV_OFF + (4 * h + q4) * RV_ROW + (64 * vh + 16 * blk + 4 * pp) * 2;
    for (int jt = 0; jt <= it; ++jt) {
      f32x16 S;
#pragma unroll
      for (int i = 0; i < 16; ++i) S[i] = 0.f;
#pragma unroll
      for (int ks = 0; ks < 4; ++ks) { const bf16x8 Kf = *(const LAS bf16x8*)(lds + RKO + (32 * jt + r) * 144 + (2 * ks + h) * 16); S = MFMA32(Kf, Qf[ks], S); }
#pragma unroll
      for (int i = 0; i < 16; ++i) {
        const int dj = qi - (32 * jt + (i & 3) + 8 * (i >> 2) + 4 * h);
        S[i] = dj >= 0 ? S[i] * fexp2((float)dj * lg) : 0.f;
      }
#pragma unroll
      for (int s2 = 0; s2 < 2; ++s2) {
        const bf16x8 Pb = pack8(S, s2);
        const bf16x8 V0 = tr_frag(va + (32 * jt + 16 * s2) * RV_ROW, 8 * RV_ROW), V1 = tr_frag(va + (32 * jt + 16 * s2) * RV_ROW + 64, 8 * RV_ROW);
        O0 = MFMA32(V0, Pb, O0);
        O1 = MFMA32(V1, Pb, O1);
      }
    }
    float s1 = 0.f, s2 = 0.f;
#pragma unroll
    for (int i = 0; i < 16; ++i) { s1 += O0[i] + O1[i]; s2 += O0[i] * O0[i] + O1[i] * O1[i]; }
    s1 += __shfl_xor(s1, 32); s2 += __shfl_xor(s2, 32);
    if (h == 0) { red[(vh * 128 + qi) * 2] = s1; red[(vh * 128 + qi) * 2 + 1] = s2; }
    __syncthreads();
    s1 += red[((vh ^ 1) * 128 + qi) * 2]; s2 += red[((vh ^ 1) * 128 + qi) * 2 + 1];
    const float mu = s1 * (1.0f / 128.0f), var = fmaxf(s2 * (1.0f / 128.0f) - mu * mu, 0.f), rs = rsqrtf(var + 1e-5f);
    const float* gnp = p.gn + hh * 128 + 64 * vh + 4 * h;
    LAS unsigned char* gt = lds + RGO + qi * RG_ROW + (64 * vh + 4 * h) * 2;
#pragma unroll
    for (int dt = 0; dt < 2; ++dt)
#pragma unroll
      for (int g = 0; g < 4; ++g) {
        const int vo = 32 * dt + 8 * g;
        LAS u32x2* ga = (LAS u32x2*)(gt + vo * 2);
        const u32x2 gwv = *ga;
        const f32x4 gnv = *(const f32x4*)(gnp + vo);
        float f0, f1, f2, f3;
        if (dt == 0) { f0 = O0[4 * g]; f1 = O0[4 * g + 1]; f2 = O0[4 * g + 2]; f3 = O0[4 * g + 3]; }
        else { f0 = O1[4 * g]; f1 = O1[4 * g + 1]; f2 = O1[4 * g + 2]; f3 = O1[4 * g + 3]; }
        f0 = (f0 - mu) * rs * gnv[0] * silu(bflo(gwv.x)); f1 = (f1 - mu) * rs * gnv[1] * silu(bfhi(gwv.x));
        f2 = (f2 - mu) * rs * gnv[2] * silu(bflo(gwv.y)); f3 = (f3 - mu) * rs * gnv[3] * silu(bfhi(gwv.y));
        u32x2 wv; wv.x = pack2(f0, f1); wv.y = pack2(f2, f3);
        *ga = wv;
      }
    __syncthreads();
#pragma unroll
    for (int k = 0; k < 4; ++k) {
      const int c = tid + 512 * k, j = c >> 4, cc = c & 15;
      *(u32x4*)(p.mixed + (size_t)(tok0 + j) * DM + 512 + hh * 128 + cc * 8) = *(const LAS u32x4*)(lds + RGO + j * RG_ROW + cc * 16);
    }
    __syncthreads();
  }
}

DI void grid_barrier(unsigned* ctr, unsigned target) {
  asm volatile("s_waitcnt vmcnt(0) lgkmcnt(0)" ::: "memory");
  __syncthreads();
  if (threadIdx.x == 0) {
    __builtin_amdgcn_fence(__ATOMIC_RELEASE, "agent");
    asm volatile("s_waitcnt vmcnt(0)" ::: "memory");
    __hip_atomic_fetch_add(ctr, 1u, __ATOMIC_RELAXED, __HIP_MEMORY_SCOPE_AGENT);
    unsigned spins = 0;
    while (__hip_atomic_load(ctr, __ATOMIC_RELAXED, __HIP_MEMORY_SCOPE_AGENT) < target && spins < (1u << 22)) { __builtin_amdgcn_s_sleep(2); ++spins; }
    __builtin_amdgcn_fence(__ATOMIC_ACQUIRE, "agent");
    asm volatile("s_waitcnt vmcnt(0)" ::: "memory");
  }
  __syncthreads();
}

__global__ void __launch_bounds__(512) k_mega(Params p) {
  extern __shared__ __attribute__((aligned(16))) unsigned char shm_[];
  LAS unsigned char* shm = (LAS unsigned char*)shm_;
  const int bid = blockIdx.x, nb = gridDim.x;
  unsigned bar_n = 0;
#ifdef PROBE_PHASE
  unsigned long long ts_a = 0, ts_b = 0; int ph_i = 0;
  if (PROBE_PHASE == 0) ts_a = __builtin_amdgcn_s_memrealtime();
#define GRID_BAR() do { bar_n += (unsigned)nb; grid_barrier(p.bar, bar_n); ++ph_i; if (ph_i == PROBE_PHASE) ts_a = __builtin_amdgcn_s_memrealtime(); if (ph_i == PROBE_PHASE + 1) ts_b = __builtin_amdgcn_s_memrealtime(); } while (0)
#else
#define GRID_BAR() do { bar_n += (unsigned)nb; grid_barrier(p.bar, bar_n); } while (0)
#endif
  phase_prep(p, bid, nb);
  GRID_BAR();
  phase_gemm<1>(shm, p, bid, nb);
  GRID_BAR();
  phase_attn(shm, p, bid, nb);
  phase_retkv(shm, p, bid, nb);
  GRID_BAR();
  phase_gemm<2>(shm, p, bid, nb);
#ifdef PROBE_PHASE
  if (PROBE_PHASE == 5) ts_b = __builtin_amdgcn_s_memrealtime();
  if (bid == 0 && threadIdx.x == 0) {
    const unsigned long long until = __builtin_amdgcn_s_memrealtime() + 9ull * (ts_b - ts_a);
    while (__builtin_amdgcn_s_memrealtime() < until) __builtin_amdgcn_s_sleep(8);
  }
#endif
}

extern "C" void kernel_launch(void* const* d_in, const int* in_sizes, int n_in, void* d_out, int out_size, void* d_ws, size_t ws_size, hipStream_t stream) {
  Params p{};
  p.x = (const float*)d_in[0]; p.ng = (const float*)d_in[1]; p.w_in = (const float*)d_in[2]; p.gn = (const float*)d_in[3];
  p.w_out = (const float*)d_in[4]; p.fg = (const float*)d_in[5];
  p.out = (float*)d_out;
  char* w = (char*)d_ws; size_t o = 0;
  auto take = [&](size_t bytes) { char* r = w + o; o += (bytes + 255) & ~(size_t)255; return r; };
  p.xb = (bf16_t*)take((size_t)T_TOK * DM * 2);
  p.proj = (bf16_t*)take((size_t)T_TOK * NW * 2);
  p.mixed = (bf16_t*)take((size_t)T_TOK * DM * 2);
  p.winT = (bf16_t*)take((size_t)NW * DM * 2);
  p.woutT = (bf16_t*)take((size_t)DM * DM * 2);
  p.rstd = (float*)take((size_t)T_TOK * 4);
  p.rowss = (float*)take((size_t)T_TOK * 4);
  p.ropeT = (float2*)take((size_t)SEQ * 32 * 8);
  p.retT = (float2*)take((size_t)SEQ * 32 * 8);
  p.kvT = (float*)take((size_t)1024 * 8192 * 4);
  p.stT = (bf16_t*)take((size_t)1024 * 8192 * 2);
  p.bar = (unsigned*)take(1024);
  p.ob = (bf16_t*)take((size_t)T_TOK * 512 * 2);
  p.lseg = (float*)take((size_t)T_TOK * 8 * 4);
  static int grid_blocks = 0;
  if (!grid_blocks) {
    (void)hipFuncSetAttribute((const void*)k_mega, hipFuncAttributeMaxDynamicSharedMemorySize, ATTN_LDS);
    int dev = 0, cus = 0, per_cu = 0;
    (void)hipGetDevice(&dev);
    (void)hipDeviceGetAttribute(&cus, hipDeviceAttributeMultiprocessorCount, dev);
    (void)hipOccupancyMaxActiveBlocksPerMultiprocessor(&per_cu, k_mega, 512, ATTN_LDS);
    if (per_cu < 1) per_cu = 1;
    grid_blocks = cus;
  }
  (void)hipMemsetAsync(p.bar, 0, 1024, stream);
  hipLaunchKernelGGL(k_mega, dim3(grid_blocks), dim3(512), ATTN_LDS, stream, p);
}
```

```cpp
#include <hip/hip_runtime.h>
#include <hip/hip_cooperative_groups.h>
#include <cstdint>
#include <cstdio>
namespace cg = cooperative_groups;

typedef unsigned short bf16_t;
typedef short bf16x8 __attribute__((ext_vector_type(8)));
typedef float f32x4 __attribute__((ext_vector_type(4)));
typedef unsigned u32x4 __attribute__((ext_vector_type(4)));
typedef unsigned u32x2 __attribute__((ext_vector_type(2)));

constexpr int T_TOK = 32768, DM = 1024, NW = 3584, SEQ = 4096;
constexpr int OFF_QA = 0, OFF_KA = 512, OFF_VA = 1024, OFF_GA = 1536, OFF_QR = 2048, OFF_KR = 2304, OFF_VR = 2560, OFF_GR = 3072;

struct Params {
  const float* x; const float* ng; const float* w_in; const float* gn; const float* w_out; const float* fg;
  float* out;
  bf16_t* xb; bf16_t* proj; bf16_t* mixed; bf16_t* winT; bf16_t* woutT;
  float* rstd; float* rowss; float2* ropeT; float2* retT; float* kvT; bf16_t* stT; unsigned* bar; bf16_t* ob; float* lseg;
};

#define DI __device__ __forceinline__
DI unsigned short f2bf(float x) { unsigned u = __float_as_uint(x); u += 0x7fffu + ((u >> 16) & 1u); return (unsigned short)(u >> 16); }
DI float bf2f(unsigned short b) { return __uint_as_float(((unsigned)b) << 16); }
typedef float f32x2_t __attribute__((ext_vector_type(2)));
typedef __bf16 bf16x2_t __attribute__((ext_vector_type(2)));
DI unsigned pack2(float lo, float hi) { const f32x2_t v = {lo, hi}; return __builtin_bit_cast(unsigned, __builtin_convertvector(v, bf16x2_t)); }
DI float bflo(unsigned w) { return __uint_as_float(w << 16); }
DI float bfhi(unsigned w) { return __uint_as_float(w & 0xffff0000u); }
DI int perm32(int rho) { const int n = rho >> 4, i = rho & 15; return 8 * (i >> 2) + 4 * n + (i & 3); }
DI int cmap(int p) { return (p & ~31) + perm32(p & 31); }
DI int cmapA(int p) { return (p & ~127) + ((p >> 6) & 1) * 64 + ((p >> 4) & 1) * 32 + ((p >> 5) & 1) * 16 + (p & 15); }

DI void phase_prep(const Params& p, int bid, int nb) {
  const int tid = threadIdx.x, lane = tid & 63, wid = tid >> 6, nw = blockDim.x >> 6;
  if (wid < 6)
  for (int row0 = (bid * 6 + wid) * 4; row0 < T_TOK; row0 += nb * 6 * 4) {
    f32x4 v[4][4];
#pragma unroll
    for (int rr = 0; rr < 4; ++rr)
#pragma unroll
      for (int it = 0; it < 4; ++it) v[rr][it] = *(const f32x4*)(p.x + (size_t)(row0 + rr) * DM + it * 256 + lane * 4);
#pragma unroll
    for (int rr = 0; rr < 4; ++rr) {
      float ss = 0.f;
#pragma unroll
      for (int it = 0; it < 4; ++it) ss += v[rr][it][0] * v[rr][it][0] + v[rr][it][1] * v[rr][it][1] + v[rr][it][2] * v[rr][it][2] + v[rr][it][3] * v[rr][it][3];
#pragma unroll
      for (int o = 32; o >= 1; o >>= 1) ss += __shfl_xor(ss, o);
#pragma unroll
      for (int it = 0; it < 4; ++it) { u32x2 w; w.x = pack2(v[rr][it][0], v[rr][it][1]); w.y = pack2(v[rr][it][2], v[rr][it][3]); *(u32x2*)(p.xb + (size_t)(row0 + rr) * DM + it * 256 + lane * 4) = w; }
      if (lane == 0) p.rstd[row0 + rr] = rsqrtf(ss * (1.0f / DM) + 1e-6f);
    }
  }
  if (wid < 6) return;
  const int gt = bid * 128 + (tid - 384), gn = nb * 128;
  for (int idx = gt; idx < (NW / 4) * 128; idx += gn) {
    const int p4 = idx % (NW / 4), kc = idx / (NW / 4), pp = p4 * 4, c = pp < 1024 ? cmapA(pp) : cmap(pp);
    f32x4 f[8];
#pragma unroll
    for (int j = 0; j < 8; ++j) { const int k = kc * 8 + j; f[j] = *(const f32x4*)(p.w_in + (size_t)k * NW + c) * p.ng[k]; }
#pragma unroll
    for (int e = 0; e < 4; ++e) {
      u32x4 w; w.x = pack2(f[0][e], f[1][e]); w.y = pack2(f[2][e], f[3][e]); w.z = pack2(f[4][e], f[5][e]); w.w = pack2(f[6][e], f[7][e]);
      *(u32x4*)(p.winT + (size_t)(pp + e) * DM + kc * 8) = w;
    }
  }
  for (int idx = gt; idx < (DM / 4) * 128; idx += gn) {
    const int p4 = idx % (DM / 4), kc = idx / (DM / 4), pp = p4 * 4, c = cmap(pp);
    f32x4 f[8];
#pragma unroll
    for (int j = 0; j < 8; ++j) { const int k = kc * 8 + j; f[j] = *(const f32x4*)(p.w_out + (size_t)k * DM + c); }
#pragma unroll
    for (int e = 0; e < 4; ++e) {
      u32x4 w; w.x = pack2(f[0][e], f[1][e]); w.y = pack2(f[2][e], f[3][e]); w.z = pack2(f[4][e], f[5][e]); w.w = pack2(f[6][e], f[7][e]);
      *(u32x4*)(p.woutT + (size_t)(pp + e) * DM + kc * 8) = w;
    }
  }
  for (int idx = gt; idx < SEQ * 32; idx += gn) {
    const int pos = idx >> 5, i = idx & 31;
    const float inv1 = powf(10000.0f, -(float)i / 32.0f);
    const float inv2 = 1.0f / powf(10000.0f, (float)i / 31.0f);
    const float a1 = (float)pos * inv1, a2 = (float)pos * inv2;
    p.ropeT[idx] = make_float2(cosf(a1), sinf(a1));
    p.retT[idx] = make_float2(cosf(a2), sinf(a2));
  }
}

constexpr int BM = 256, BK = 64, HALF = 128, HT = HALF * BK;
constexpr int GEMM_LDS = 8 * HT * 2;
DI int lds_byte(int r, int c) { int st = (r >> 4) * 2 + (c >> 5), rr = r & 15, cc = c & 31, ob = rr * 64 + cc * 2; return st * 1024 + (ob ^ (((ob >> 9) & 1) << 5)); }
DI void stage_rc(int b, int& R, int& C) { int st = b / 1024, sb = b % 1024, swz = sb ^ (((sb >> 9) & 1) << 5); R = (st >> 1) * 16 + swz / 64; C = (st & 1) * 32 + (swz % 64) / 2; }

#define LAS __attribute__((address_space(3)))
template <int EPI>
DI void gemm_epi(LAS unsigned char* lds, f32x4 (&acc)[2][2][4][2], const int brow, const int bcol, const Params& p) {
  const int tid = threadIdx.x, wid = __builtin_amdgcn_readfirstlane(tid >> 6), lane = tid & 63, wr = wid >> 2, wc = wid & 3, fr = lane & 15, fq = lane >> 4;
  if (EPI == 1) {
    const int pn = bcol >> 8;
    if (pn < 4) {
      const float sc = pn < 2 ? 0.125f * 1.4426950408889634f : 1.0f;
      const int i0 = 16 * (wc & 1) + 4 * fq;
#pragma unroll
      for (int ai = 0; ai < 2; ++ai)
#pragma unroll
        for (int m = 0; m < 4; ++m) {
          const int row = brow + ai * HALF + wr * 64 + m * 16 + fr;
          const float rs = p.rstd[row] * sc;
          const float* tb = (const float*)(p.ropeT + (row & (SEQ - 1)) * 32 + i0);
          const f32x4 t0 = *(const f32x4*)tb, t1 = *(const f32x4*)(tb + 4);
#pragma unroll
          for (int bj = 0; bj < 2; ++bj) {
            const f32x4 x1 = acc[ai][bj][m][0] * rs, x2 = acc[ai][bj][m][1] * rs;
            u32x2 wa, wb;
            wa.x = pack2(x1[0] * t0[0] - x2[0] * t0[1], x1[1] * t0[2] - x2[1] * t0[3]);
            wa.y = pack2(x1[2] * t1[0] - x2[2] * t1[1], x1[3] * t1[2] - x2[3] * t1[3]);
            wb.x = pack2(x2[0] * t0[0] + x1[0] * t0[1], x2[1] * t0[2] + x1[1] * t0[3]);
            wb.y = pack2(x2[2] * t1[0] + x1[2] * t1[1], x2[3] * t1[2] + x1[3] * t1[3]);
            bf16_t* o = p.proj + (size_t)row * NW + bcol + bj * HALF + (wc >> 1) * 64 + i0;
            *(u32x2*)o = wa; *(u32x2*)(o + 32) = wb;
          }
        }
    } else if (pn == 8 || pn == 9) {
      const float sc = pn == 9 ? 0.125f : 1.0f;
      const int i0 = 16 * (wc & 1) + 4 * fq;
#pragma unroll
      for (int ai = 0; ai < 2; ++ai)
#pragma unroll
        for (int m = 0; m < 4; ++m) {
          const int row = brow + ai * HALF + wr * 64 + m * 16 + fr;
          const float rs = p.rstd[row] * sc;
          const float* tb = (const float*)(p.retT + (row & (SEQ - 1)) * 32 + i0);
          const f32x4 t0 = *(const f32x4*)tb, t1 = *(const f32x4*)(tb + 4);
#pragma unroll
          for (int bj = 0; bj < 2; ++bj) {
            const f32x4 v0 = acc[ai][bj][m][0] * rs, v1 = acc[ai][bj][m][1] * rs;
            u32x4 w;
            w.x = pack2(v0[0] * t0[0] - v0[1] * t0[1], v0[1] * t0[0] + v0[0] * t0[1]);
            w.y = pack2(v0[2] * t0[2] - v0[3] * t0[3], v0[3] * t0[2] + v0[2] * t0[3]);
            w.z = pack2(v1[0] * t1[0] - v1[1] * t1[1], v1[1] * t1[0] + v1[0] * t1[1]);
            w.w = pack2(v1[2] * t1[2] - v1[3] * t1[3], v1[3] * t1[2] + v1[2] * t1[3]);
            *(u32x4*)(p.proj + (size_t)row * NW + bcol + bj * HALF + wc * 32 + 8 * fq) = w;
          }
        }
    } else {
#pragma unroll
    for (int ai = 0; ai < 2; ++ai)
#pragma unroll
      for (int m = 0; m < 4; ++m) {
        const int row = brow + ai * HALF + wr * 64 + m * 16 + fr;
        const float rs = p.rstd[row];
#pragma unroll
        for (int bj = 0; bj < 2; ++bj) {
          const f32x4 v0 = acc[ai][bj][m][0] * rs, v1 = acc[ai][bj][m][1] * rs;
          u32x4 w; w.x = pack2(v0[0], v0[1]); w.y = pack2(v0[2], v0[3]); w.z = pack2(v1[0], v1[1]); w.w = pack2(v1[2], v1[3]);
          *(u32x4*)(p.proj + (size_t)row * NW + bcol + bj * HALF + wc * 32 + 8 * fq) = w;
        }
      }
    }
  } else {
    const int pm = brow >> 8, pn = bcol >> 8;
    LAS float* part = (LAS float*)(lds + GEMM_LDS);
    LAS float* rsl = (LAS float*)(lds + GEMM_LDS + 4096);
#pragma unroll
    for (int ai = 0; ai < 2; ++ai)
#pragma unroll
      for (int m = 0; m < 4; ++m) {
        const int rl = ai * HALF + wr * 64 + m * 16 + fr;
        float ss = 0.f;
#pragma unroll
        for (int bj = 0; bj < 2; ++bj) {
          const size_t off = (size_t)(brow + rl) * DM + bcol + bj * HALF + wc * 32 + 8 * fq;
          const f32x4 x0 = *(const f32x4*)(p.x + off), x1 = *(const f32x4*)(p.x + off + 4);
          const f32x4 y0 = acc[ai][bj][m][0] + x0, y1 = acc[ai][bj][m][1] + x1;
          acc[ai][bj][m][0] = y0; acc[ai][bj][m][1] = y1;
          ss += y0[0] * y0[0] + y0[1] * y0[1] + y0[2] * y0[2] + y0[3] * y0[3] + y1[0] * y1[0] + y1[1] * y1[1] + y1[2] * y1[2] + y1[3] * y1[3];
        }
        ss += __shfl_xor(ss, 16); ss += __shfl_xor(ss, 32);
        if (fq == 0) part[wc * 256 + rl] = ss;
      }
    __syncthreads();
    float* xs = p.rowss + (size_t)(pm * 4) * 256;
    if (tid < 256) {
      const float tot = part[tid] + part[256 + tid] + part[512 + tid] + part[768 + tid];
      __hip_atomic_store(xs + pn * 256 + tid, tot, __ATOMIC_RELAXED, __HIP_MEMORY_SCOPE_AGENT);
    }
    asm volatile("s_waitcnt vmcnt(0)" ::: "memory");
    __syncthreads();
    unsigned* cnt = p.bar + 64 + pm;
    if (tid == 0) __hip_atomic_fetch_add(cnt, 1u, __ATOMIC_RELAXED, __HIP_MEMORY_SCOPE_AGENT);
    if (wid == 0) {
      unsigned spins = 0;
      while (__hip_atomic_load(cnt, __ATOMIC_RELAXED, __HIP_MEMORY_SCOPE_AGENT) < 4u && spins < (1u << 20)) { __builtin_amdgcn_s_sleep(1); ++spins; }
      __builtin_amdgcn_fence(__ATOMIC_ACQUIRE, "agent");
      asm volatile("s_waitcnt vmcnt(0)" ::: "memory");
    }
    __syncthreads();
    if (tid < 256) {
      float t = 0.f;
#pragma unroll
      for (int q = 0; q < 4; ++q) t += __hip_atomic_load(xs + q * 256 + tid, __ATOMIC_RELAXED, __HIP_MEMORY_SCOPE_AGENT);
      rsl[tid] = rsqrtf(t * (1.0f / DM) + 1e-6f);
    }
    __syncthreads();
#pragma unroll
    for (int ai = 0; ai < 2; ++ai)
#pragma unroll
      for (int m = 0; m < 4; ++m) {
        const int rl = ai * HALF + wr * 64 + m * 16 + fr;
        const float rs = rsl[rl];
#pragma unroll
        for (int bj = 0; bj < 2; ++bj) {
          const int col = bcol + bj * HALF + wc * 32 + 8 * fq;
          const f32x4 g0 = *(const f32x4*)(p.fg + col), g1 = *(const f32x4*)(p.fg + col + 4);
          float* o = p.out + (size_t)(brow + rl) * DM + col;
          *(f32x4*)o = acc[ai][bj][m][0] * rs * g0; *(f32x4*)(o + 4) = acc[ai][bj][m][1] * rs * g1;
        }
      }
    __syncthreads();
  }
}

DI void tile_of(int L, int nM, int nN, int& pm, int& pn) {
  const int nwg = nM * nN, NX = 8, WGM = 8;
  int wgid = L; { const int q = nwg / NX, r = nwg % NX, xcd = wgid % NX, off = wgid / NX; wgid = (xcd < r ? xcd * (q + 1) : r * (q + 1) + (xcd - r) * q) + off; }
  const int nig = WGM * nN, gid = wgid / nig, fm = gid * WGM, gsz = (nM - fm) < WGM ? (nM - fm) : WGM;
  pm = fm + ((wgid % nig) % gsz); pn = (wgid % nig) / gsz;
}


template <int EPI>
DI void phase_gemm(LAS unsigned char* lds, const Params& p, int bid, int nb) {
  constexpr int K = 1024, nt = K / BK, HTB = HALF * BK * 2;
  const bf16_t* A = EPI == 1 ? p.xb : p.mixed; const bf16_t* Bt = EPI == 1 ? p.winT : p.woutT;
  const int nM = T_TOK / BM, nN = (EPI == 1 ? NW : DM) / BM, nT = nM * nN;
  const int tid = threadIdx.x, wid = __builtin_amdgcn_readfirstlane(tid >> 6), lane = tid & 63, wr = wid >> 2, wc = wid & 3, fr = lane & 15, fq = lane >> 4;
  unsigned voff[2];
#pragma unroll
  for (int i = 0; i < 2; ++i) { int R, C; stage_rc(tid * 16 + i * 8192, R, C); voff[i] = (unsigned)(R * K + C) * 2u; }
  const unsigned ldsw = (unsigned)wid * 1024u;
  const int aoff = lds_byte(wr * 64 + fr, fq * 8), boff = lds_byte(wc * 32 + fr, fq * 8);
  const size_t kstep = (size_t)(BK * 2), hstep = (size_t)HALF * K * 2, tstep = 2 * hstep;
#define SAo(b, h) (((b) * 2 + (h)) * HTB)
#define SBo(b, h) ((4 + (b) * 2 + (h)) * HTB)
#define STAGEP(bufoff, gptr) do { _Pragma("unroll") for (int _i = 0; _i < 2; ++_i) \
    __builtin_amdgcn_global_load_lds((const unsigned*)((gptr) + voff[_i]), (LAS unsigned*)(lds + (bufoff) + ldsw + _i * 8192), 16, 0, 0); } while (0)
#define LDA(dst, b, h) do { _Pragma("unroll") for (int m = 0; m < 4; ++m) _Pragma("unroll") for (int k = 0; k < 2; ++k) \
    dst[m][k] = *(const LAS bf16x8*)(lds + SAo(b, h) + aoff + m * 2048 + k * 1024); } while (0)
#define LDB(dst, b, h) do { _Pragma("unroll") for (int n = 0; n < 2; ++n) _Pragma("unroll") for (int k = 0; k < 2; ++k) \
    dst[n][k] = *(const LAS bf16x8*)(lds + SBo(b, h) + boff + n * 2048 + k * 1024); } while (0)
#define MMA(ai, bj, At, Bt_) do { __builtin_amdgcn_s_setprio(1); \
    _Pragma("unroll") for (int m = 0; m < 4; ++m) _Pragma("unroll") for (int n = 0; n < 2; ++n) _Pragma("unroll") for (int k = 0; k < 2; ++k) \
      acc[ai][bj][m][n] = __builtin_amdgcn_mfma_f32_16x16x32_bf16(Bt_[n][k], At[m][k], acc[ai][bj][m][n], 0, 0, 0); \
    __builtin_amdgcn_s_setprio(0); } while (0)
#define WAIT_V(n) asm volatile("s_waitcnt vmcnt(" #n ")" ::: "memory")
#define WAIT_L(n) asm volatile("s_waitcnt lgkmcnt(" #n ")" ::: "memory")
#define BAR __builtin_amdgcn_s_barrier()
#define SCHED __builtin_amdgcn_sched_barrier(0)
  int L = bid;
  if (L >= nT) return;
  int pm, pn; tile_of(L, nM, nN, pm, pn);
  f32x4 acc[2][2][4][2];
#pragma unroll
  for (int a = 0; a < 2; ++a)
#pragma unroll
    for (int b = 0; b < 2; ++b)
#pragma unroll
      for (int m = 0; m < 4; ++m)
#pragma unroll
        for (int n = 0; n < 2; ++n) acc[a][b][m][n] = (f32x4){0.f, 0.f, 0.f, 0.f};
  bf16x8 At[4][2], B0[2][2], B1[2][2];
  const char* cA = (const char*)A + (size_t)pm * tstep; const char* cB = (const char*)Bt + (size_t)pn * tstep;
  WAIT_V(0);
  STAGEP(SBo(0, 0), cB); STAGEP(SBo(0, 1), cB + hstep); STAGEP(SAo(0, 0), cA); STAGEP(SAo(0, 1), cA + hstep);
  if (wr == 1) BAR;
  WAIT_V(2); BAR;
  STAGEP(SBo(1, 0), cB + kstep); STAGEP(SAo(1, 0), cA + kstep); STAGEP(SBo(1, 1), cB + hstep + kstep);
  WAIT_V(6); BAR;
  for (;;) {
    const bool has_next = (L + nb < nT);
    int npm = pm, npn = pn;
    if (has_next) tile_of(L + nb, nM, nN, npm, npn);
    const char* nA = (const char*)A + (size_t)npm * tstep; const char* nB = (const char*)Bt + (size_t)npn * tstep;
    for (int t = 0; t < nt; t += 2) {
      const bool last = (t == nt - 2);
      const char* a1 = cA + (size_t)(t + 1) * kstep;
      const char* a2 = last ? nA : cA + (size_t)(t + 2) * kstep; const char* b2 = last ? nB : cB + (size_t)(t + 2) * kstep;
      const char* a3 = a2 + kstep; const char* b3 = b2 + kstep;
      LDB(B0, 0, 0); LDB(B1, 0, 1); SCHED; LDA(At, 0, 0); STAGEP(SAo(1, 1), a1 + hstep);
      WAIT_V(8); WAIT_L(0); BAR; MMA(0, 0, At, B0); MMA(0, 1, At, B1); BAR; SCHED;
      LDA(At, 0, 1); STAGEP(SBo(0, 0), b2); STAGEP(SBo(0, 1), b2 + hstep); STAGEP(SAo(0, 0), a2);
      WAIT_V(8); WAIT_L(0); BAR; MMA(1, 0, At, B0); MMA(1, 1, At, B1); BAR; SCHED;
      LDB(B0, 1, 0); LDB(B1, 1, 1); SCHED; LDA(At, 1, 0); STAGEP(SAo(0, 1), a2 + hstep);
      WAIT_V(8); WAIT_L(0); BAR; MMA(0, 0, At, B0); MMA(0, 1, At, B1); BAR; SCHED;
      LDA(At, 1, 1); STAGEP(SBo(1, 0), b3); STAGEP(SBo(1, 1), b3 + hstep); STAGEP(SAo(1, 0), a3);
      WAIT_V(8); WAIT_L(0); BAR; MMA(1, 0, At, B0); MMA(1, 1, At, B1); BAR; SCHED;
    }
    if (wr == 0) BAR;
    gemm_epi<EPI>(lds, acc, pm * BM, pn * BM, p);
    if (!has_next) break;
#pragma unroll
    for (int a = 0; a < 2; ++a)
#pragma unroll
      for (int b = 0; b < 2; ++b)
#pragma unroll
        for (int m = 0; m < 4; ++m)
#pragma unroll
          for (int n = 0; n < 2; ++n) acc[a][b][m][n] = (f32x4){0.f, 0.f, 0.f, 0.f};
    pm = npm; pn = npn; cA = nA; cB = nB; L += nb;
    if (wr == 1) BAR;
  }
  WAIT_V(0);
  BAR;
}

DI float ret_log2g(int h) { return log2f(1.0f - exp2f(-5.0f - (float)h)); }

typedef float f32x16 __attribute__((ext_vector_type(16)));
typedef short s16x4 __attribute__((ext_vector_type(4)));
#define MFMA32(a, b, c) __builtin_amdgcn_mfma_f32_32x32x16_bf16((a), (b), (c), 0, 0, 0)
DI s16x4 tr_read(LAS unsigned char* a) { return __builtin_amdgcn_ds_read_tr16_b64_v4i16((LAS s16x4*)a); }
DI bf16x8 tr_frag(LAS unsigned char* a, int rowstride8) {
  const s16x4 lo = tr_read(a), hi = tr_read(a + rowstride8);
  return __builtin_shufflevector(lo, hi, 0, 1, 2, 3, 4, 5, 6, 7);
}
DI bf16x8 pack8(const f32x16& x, int s) {
  u32x4 w;
  w.x = pack2(x[8 * s + 0], x[8 * s + 1]); w.y = pack2(x[8 * s + 2], x[8 * s + 3]); w.z = pack2(x[8 * s + 4], x[8 * s + 5]); w.w = pack2(x[8 * s + 6], x[8 * s + 7]);
  return __builtin_bit_cast(bf16x8, w);
}
DI float fexp2(float x) { return __builtin_amdgcn_exp2f(x); }
DI float half_max(float x) { const u32x2 r = __builtin_amdgcn_permlane32_swap(__float_as_uint(x), __float_as_uint(x), false, false); return fmaxf(__uint_as_float(r[0]), __uint_as_float(r[1])); }
DI float half_sum(float x) { const u32x2 r = __builtin_amdgcn_permlane32_swap(__float_as_uint(x), __float_as_uint(x), false, false); return __uint_as_float(r[0]) + __uint_as_float(r[1]); }
DI float silu(float g) { return g / (1.0f + __expf(-g)); }

constexpr int AT_ROWB = 136, AT_LS = 512 * AT_ROWB, AT_VST = AT_LS + 2048, VROW = 192, KROW = 144, KST_W = 32 * KROW, VST_W = KST_W + 32 * VROW;
constexpr int ATTN_LDS = AT_VST + 8 * VST_W;
constexpr float LOG2E = 1.4426950408889634f;

constexpr int PT_ROW = 136;

DI void softmax_pv(f32x16& S, f32x16& O0, f32x16& O1, float& m, float& l, const bf16x8 (&Vf)[2][2], const bool mlow, const bool mhigh, const int r, const int h) {
  if (mlow || mhigh) {
#pragma unroll
    for (int i = 0; i < 16; ++i) {
      const int keyrow = (i & 3) + 8 * (i >> 2) + 4 * h;
      const bool bad = (mlow && keyrow < r) || (mhigh && keyrow > r);
      S[i] = bad ? -1e30f : S[i];
    }
  }
  float mx = fmaxf(S[0], S[1]);
#pragma unroll
  for (int i = 2; i < 16; ++i) mx = fmaxf(mx, S[i]);
  mx = half_max(mx);
  const float mn = fmaxf(m, mx);
  if (__builtin_amdgcn_ballot_w64(mn > m) != 0ull) {
    const float al = fexp2(m - mn);
    l *= al;
#pragma unroll
    for (int i = 0; i < 16; ++i) { O0[i] *= al; O1[i] *= al; }
    m = mn;
  }
  float ps = 0.f;
#pragma unroll
  for (int i = 0; i < 16; ++i) { S[i] = fexp2(S[i] - mn); ps += S[i]; }
  l += half_sum(ps);
#pragma unroll
  for (int s = 0; s < 2; ++s) {
    const bf16x8 Pb = pack8(S, s);
    O0 = MFMA32(Vf[s][0], Pb, O0);
    O1 = MFMA32(Vf[s][1], Pb, O1);
  }
}

DI void attn_tile2(const u32x4 (&Kc)[4], const u32x4 (&Vc)[4], const bf16x8 (&QA)[4], const bf16x8 (&QB)[4],
                   f32x16& A0, f32x16& A1, float& mA, float& lA, f32x16& B0, f32x16& B1, float& mB, float& lB,
                   LAS unsigned char* kst, LAS unsigned char* vst, LAS unsigned char* trp, const int lane, const int kt) {
  const int r = lane & 31, h = lane >> 5;
#pragma unroll
  for (int c = 0; c < 4; ++c) {
    *(LAS u32x4*)(kst + ((lane >> 3) + 8 * c) * KROW + (lane & 7) * 16) = Kc[c];
    *(LAS u32x4*)(vst + ((lane >> 3) + 8 * c) * VROW + (lane & 7) * 16) = Vc[c];
  }
  bf16x8 Kf[4], Vf[2][2];
#pragma unroll
  for (int ks = 0; ks < 4; ++ks) Kf[ks] = *(const LAS bf16x8*)(kst + r * KROW + (2 * ks + h) * 16);
#pragma unroll
  for (int s = 0; s < 2; ++s) { Vf[s][0] = tr_frag(trp + 16 * s * VROW, 8 * VROW); Vf[s][1] = tr_frag(trp + 16 * s * VROW + 64, 8 * VROW); }
  if (kt <= 4) {
    f32x16 S;
#pragma unroll
    for (int i = 0; i < 16; ++i) S[i] = 0.f;
#pragma unroll
    for (int ks = 0; ks < 4; ++ks) S = MFMA32(Kf[ks], QA[ks], S);
    softmax_pv(S, A0, A1, mA, lA, Vf, kt == 0, kt == 4, r, h);
  }
  if (kt >= 1) {
    f32x16 S;
#pragma unroll
    for (int i = 0; i < 16; ++i) S[i] = 0.f;
#pragma unroll
    for (int ks = 0; ks < 4; ++ks) S = MFMA32(Kf[ks], QB[ks], S);
    softmax_pv(S, B0, B1, mB, lB, Vf, kt == 1, kt == 5, r, h);
  }
}

DI void attn_merge(const Params& p, LAS unsigned char* T, const f32x16& O0, const f32x16& O1, const float m, const float l, const int lane,
                   const int tokq0  , const int sh, const int hh, const bool first, const bool last) {
  const int r = lane & 31, h = lane >> 5;
  const int rowc = lane >> 3, ch = lane & 7;
  float lse = m + __log2f(l);
  float w1 = 1.0f / l, w0 = 0.f;
  if (!first) {
#pragma unroll
    for (int c = 0; c < 4; ++c) {
      const size_t tk = (size_t)(tokq0 + ((rowc + 8 * c) << sh));
      *(LAS u32x4*)(T + (rowc + 8 * c) * PT_ROW + ch * 16) = *(const u32x4*)(p.ob + (tk * 8 + hh) * 64 + ch * 8);
    }
    const float lp = p.lseg[(size_t)(tokq0 + (r << sh)) * 8 + hh];
    const float M = fmaxf(lse, lp), e1 = fexp2(lse - M), e0 = fexp2(lp - M), den = e0 + e1, id = 1.0f / den;
    w1 *= e1 * id; w0 = e0 * id; lse = M + __log2f(den);
  }
  LAS unsigned char* ob = T + r * PT_ROW + 8 * h;
#pragma unroll
  for (int dt = 0; dt < 2; ++dt)
#pragma unroll
    for (int g = 0; g < 4; ++g) {
      float f0, f1, f2, f3;
      if (dt == 0) { f0 = O0[4 * g] * w1; f1 = O0[4 * g + 1] * w1; f2 = O0[4 * g + 2] * w1; f3 = O0[4 * g + 3] * w1; }
      else { f0 = O1[4 * g] * w1; f1 = O1[4 * g + 1] * w1; f2 = O1[4 * g + 2] * w1; f3 = O1[4 * g + 3] * w1; }
      LAS u32x2* a = (LAS u32x2*)(ob + 64 * dt + 16 * g);
      if (!first) { const u32x2 pv = *a; f0 += w0 * bflo(pv.x); f1 += w0 * bfhi(pv.x); f2 += w0 * bflo(pv.y); f3 += w0 * bfhi(pv.y); }
      u32x2 wv; wv.x = pack2(f0, f1); wv.y = pack2(f2, f3);
      *a = wv;
    }
  if (!last) {
    if (h == 0) p.lseg[(size_t)(tokq0 + (r << sh)) * 8 + hh] = lse;
#pragma unroll
    for (int c = 0; c < 4; ++c) {
      const size_t tk = (size_t)(tokq0 + ((rowc + 8 * c) << sh));
      *(u32x4*)(p.ob + (tk * 8 + hh) * 64 + ch * 8) = *(const LAS u32x4*)(T + (rowc + 8 * c) * PT_ROW + ch * 16);
    }
  } else {
#pragma unroll
    for (int c = 0; c < 4; ++c) {
      const size_t tk = (size_t)(tokq0 + ((rowc + 8 * c) << sh));
      const u32x4 a = *(const LAS u32x4*)(T + (rowc + 8 * c) * PT_ROW + ch * 16);
      const u32x4 g = *(const u32x4*)(p.proj + tk * NW + OFF_GA + hh * 64 + ch * 8);
      u32x4 w;
      w.x = pack2(bflo(a.x) * silu(bflo(g.x)), bfhi(a.x) * silu(bfhi(g.x)));
      w.y = pack2(bflo(a.y) * silu(bflo(g.y)), bfhi(a.y) * silu(bfhi(g.y)));
      w.z = pack2(bflo(a.z) * silu(bflo(g.z)), bfhi(a.z) * silu(bfhi(g.z)));
      w.w = pack2(bflo(a.w) * silu(bflo(g.w)), bfhi(a.w) * silu(bfhi(g.w)));
      *(u32x4*)(p.mixed + tk * DM + hh * 64 + ch * 8) = w;
    }
  }
}

DI void attn_task2(const Params& p, LAS unsigned char* kst, const int lane, const int tokbase, const int hh,
                   const int sh, const int r_res, const int l0, const bool first, const bool last) {
  const int r = lane & 31, h = lane >> 5;
  const int i16 = lane & 15, q4 = i16 >> 2, pp = i16 & 3, blk = (lane >> 4) & 1;
  LAS unsigned char* vst = kst + KST_W;
  LAS unsigned char* trp = vst + (4 * h + q4) * VROW + 32 * blk + 8 * pp;
  const bf16_t* qpA = p.proj + (size_t)(tokbase + r_res + ((l0 + r) << sh)) * NW + OFF_QA + hh * 64 + 8 * h;
  const bf16_t* qpB = qpA + (size_t)(32 << sh) * NW;
  bf16x8 QA[4], QB[4];
#pragma unroll
  for (int ks = 0; ks < 4; ++ks) { QA[ks] = *(const bf16x8*)(qpA + 16 * ks); QB[ks] = *(const bf16x8*)(qpB + 16 * ks); }
  f32x16 A0, A1, B0, B1;
#pragma unroll
  for (int i = 0; i < 16; ++i) { A0[i] = 0.f; A1[i] = 0.f; B0[i] = 0.f; B1[i] = 0.f; }
  float mA = -1e30f, lA = 0.f, mB = -1e30f, lB = 0.f;
  const int kt0 = (l0 >= 128) ? 0 : (4 - (l0 >> 5));
#define LOAD_KV(Kd, Vd, kt_) do { const int lk0_ = l0 - 128 + 32 * (kt_) + (lane >> 3); \
    _Pragma("unroll") for (int c_ = 0; c_ < 4; ++c_) { \
      const bf16_t* kp_ = p.proj + (size_t)(tokbase + r_res + ((lk0_ + 8 * c_) << sh)) * NW + OFF_KA + hh * 64 + 8 * (lane & 7); \
      Kd[c_] = *(const u32x4*)kp_; Vd[c_] = *(const u32x4*)(kp_ + (OFF_VA - OFF_KA)); } } while (0)
  for (int kt = kt0; kt < 6; kt += 2) {
    u32x4 K0[4], K1[4], V0[4], V1[4];
    LOAD_KV(K0, V0, kt);
    LOAD_KV(K1, V1, kt + 1);
    attn_tile2(K0, V0, QA, QB, A0, A1, mA, lA, B0, B1, mB, lB, kst, vst, trp, lane, kt);
    attn_tile2(K1, V1, QA, QB, A0, A1, mA, lA, B0, B1, mB, lB, kst, vst, trp, lane, kt + 1);
  }
#undef LOAD_KV
  const int tokA = tokbase + r_res + (l0 << sh);
  attn_merge(p, kst, A0, A1, mA, lA, lane, tokA, sh, hh, first, last);
  attn_merge(p, kst, B0, B1, mB, lB, lane, tokA + (32 << sh), sh, hh, first, last);
}

DI void phase_attn(LAS unsigned char* lds, const Params& p, int bid, int nb) {
  const int tid = threadIdx.x, wid = __builtin_amdgcn_readfirstlane(tid >> 6), lane = tid & 63;
  LAS unsigned char* kst = lds + wid * VST_W;
  for (int unit = bid; unit < 256; unit += nb) {
    const int xj = unit >> 3, bhh = (unit & 7) * 8 + (xj >> 2), sp = xj & 3, hh = bhh & 7, b = bhh >> 3;
    const int tokbase = b * SEQ;
    for (int stage = 0; stage < 3; ++stage) {
      const int sh = stage == 0 ? 4 : (stage == 1 ? 2 : 0);
      for (int tk = 0; tk < 2; ++tk) {
        const int idx = wid + 8 * tk;
        int r_res, l0;
        if (stage == 0) { r_res = idx; l0 = 64 * sp; }
        else if (stage == 1) { r_res = idx >> 2; l0 = 256 * sp + 64 * (idx & 3); }
        else { r_res = 0; l0 = 1024 * sp + 64 * idx; }
        attn_task2(p, kst, lane, tokbase, hh, sh, r_res, l0, stage == 0, stage == 2);
      }
      __syncthreads();
    }
  }
}

constexpr int RV_ROW = 320, RK_ROW = 192, RV_OFF = 0, RK_OFF = 128 * RV_ROW  , RRED_OFF = RK_OFF + 128 * RK_ROW  ;

DI void retout_unit(LAS unsigned char* lds, const Params& p, const int u);
DI void phase_retkv(LAS unsigned char* lds, const Params& p, int bid, int nb) {
  const int tid = threadIdx.x, wid = __builtin_amdgcn_readfirstlane(tid >> 6), lane = tid & 63;
  const int r = lane & 31, h = lane >> 5, i16 = lane & 15, q4 = i16 >> 2, pp = i16 & 3, blk = (lane >> 4) & 1;
  const int vt = wid >> 1, dt = wid & 1;
  LAS int* uslot = (LAS int*)(lds + RRED_OFF);
  for (;;) {
    if (tid == 0) *uslot = (int)__hip_atomic_fetch_add(p.bar + 200, 1u, __ATOMIC_RELAXED, __HIP_MEMORY_SCOPE_AGENT);
    __syncthreads();
    const int u = __builtin_amdgcn_readfirstlane(*uslot);
    if (u >= 2048) break;
    if (u >= 1024) { __syncthreads(); retout_unit(lds, p, u - 1024); continue; }
    const int n = u & 31, hh = (u >> 5) & 3, b = u >> 7;
    const float lg = ret_log2g(hh);
    const bf16_t* base = p.proj + (size_t)(b * SEQ + n * 128) * NW;
#pragma unroll
    for (int it = 0; it < 4; ++it) {
      const int c = tid + 512 * it, j = c >> 4, cc = c & 15;
      *(LAS u32x4*)(lds + RV_OFF + j * RV_ROW + cc * 16) = *(const u32x4*)(base + (size_t)j * NW + OFF_VR + hh * 128 + cc * 8);
    }
#pragma unroll
    for (int it = 0; it < 2; ++it) {
      const int c = tid + 512 * it, j = c >> 3, cc = c & 7;
      const u32x4 w = *(const u32x4*)(base + (size_t)j * NW + OFF_KR + hh * 64 + cc * 8);
      const float dk = exp2f((float)(127 - j) * lg);
      u32x4 o;
      o.x = pack2(bflo(w.x) * dk, bfhi(w.x) * dk); o.y = pack2(bflo(w.y) * dk, bfhi(w.y) * dk);
      o.z = pack2(bflo(w.z) * dk, bfhi(w.z) * dk); o.w = pack2(bflo(w.w) * dk, bfhi(w.w) * dk);
      *(LAS u32x4*)(lds + RK_OFF + j * RK_ROW + cc * 16) = o;
    }
    __syncthreads();
    f32x16 acc;
#pragma unroll
    for (int i = 0; i < 16; ++i) acc[i] = 0.f;
    LAS unsigned char* va = lds + RV_OFF + (4 * h + q4) * RV_ROW + (32 * vt + 16 * blk + 4 * pp) * 2;
    LAS unsigned char* ka = lds + RK_OFF + (4 * h + q4) * RK_ROW + (32 * dt + 16 * blk + 4 * pp) * 2;
#pragma unroll
    for (int s = 0; s < 8; ++s) {
      const bf16x8 A = tr_frag(va + 16 * s * RV_ROW, 8 * RV_ROW), B = tr_frag(ka + 16 * s * RK_ROW, 8 * RK_ROW);
      acc = MFMA32(A, B, acc);
    }
    float* o = p.kvT + ((size_t)u << 13) + (32 * vt + 4 * h) * 64 + 32 * dt + r;
#pragma unroll
    for (int i = 0; i < 16; ++i) __hip_atomic_store(o + ((i & 3) + 8 * (i >> 2)) * 64, acc[i], __ATOMIC_RELAXED, __HIP_MEMORY_SCOPE_AGENT);
    asm volatile("s_waitcnt vmcnt(0)" ::: "memory");
    __syncthreads();
    const int bh = u >> 5;
    if (tid == 0) uslot[1] = (__hip_atomic_fetch_add(p.bar + 208 + bh, 1u, __ATOMIC_RELAXED, __HIP_MEMORY_SCOPE_AGENT) == 31u) ? 1 : 0;
    __syncthreads();
    if (__builtin_amdgcn_readfirstlane(uslot[1]) != 0) {
      if (tid == 0) { __builtin_amdgcn_fence(__ATOMIC_ACQUIRE, "agent"); asm volatile("s_waitcnt vmcnt(0)" ::: "memory"); }
      __syncthreads();
      typedef float f32x2 __attribute__((ext_vector_type(2)));
      const float cd = exp2f(128.0f * lg);
      for (int e2 = tid; e2 < 4096; e2 += 512) {
        const int e = e2 * 2;
        f32x2 kr[31];
#pragma unroll
        for (int nn = 0; nn < 31; ++nn) {
          const float* a = p.kvT + ((size_t)(bh * 32 + nn) << 13) + e;
          kr[nn][0] = __hip_atomic_load(a, __ATOMIC_RELAXED, __HIP_MEMORY_SCOPE_AGENT); kr[nn][1] = __hip_atomic_load(a + 1, __ATOMIC_RELAXED, __HIP_MEMORY_SCOPE_AGENT);
        }
        float s0 = 0.f, s1 = 0.f;
#pragma unroll
        for (int nn = 0; nn < 32; ++nn) {
          __hip_atomic_store((unsigned*)(p.stT + ((size_t)(bh * 32 + nn) << 13) + e), pack2(s0, s1), __ATOMIC_RELAXED, __HIP_MEMORY_SCOPE_AGENT);
          if (nn < 31) { s0 = s0 * cd + kr[nn][0]; s1 = s1 * cd + kr[nn][1]; }
        }
      }
      asm volatile("s_waitcnt vmcnt(0)" ::: "memory");
      __syncthreads();
      if (tid == 0) __hip_atomic_store(p.bar + 16 + bh, 1u, __ATOMIC_RELAXED, __HIP_MEMORY_SCOPE_AGENT);
    }
    __syncthreads();
  }
}

constexpr int RKO = 40960, RQO = RKO + 128 * 144, RSO = RQO + 128 * 144, RGO = RSO + 128 * 144, RG_ROW = 272, RRED2 = RGO + 128 * RG_ROW;
DI void retout_unit(LAS unsigned char* lds, const Params& p, const int u) {
  const int tid = threadIdx.x, wid = __builtin_amdgcn_readfirstlane(tid >> 6), lane = tid & 63;
  const int r = lane & 31, h = lane >> 5, i16 = lane & 15, q4 = i16 >> 2, pp = i16 & 3, blk = (lane >> 4) & 1;
  const int it = wid & 3, vh = wid >> 2;
  LAS float* red = (LAS float*)(lds + RRED2);
  {
    if (tid == 0) {
      unsigned spins = 0;
      while (__hip_atomic_load(p.bar + 16 + (u >> 5), __ATOMIC_RELAXED, __HIP_MEMORY_SCOPE_AGENT) == 0u && spins < (1u << 22)) { __builtin_amdgcn_s_sleep(2); ++spins; }
      __builtin_amdgcn_fence(__ATOMIC_ACQUIRE, "agent");
      asm volatile("s_waitcnt vmcnt(0)" ::: "memory");
    }
    __syncthreads();
    const int n = u & 31, hh = (u >> 5) & 3, b = u >> 7;
    const float lg = ret_log2g(hh);
    const int tok0 = b * SEQ + n * 128;
    const bf16_t* base = p.proj + (size_t)tok0 * NW;
    {
      u32x4 tv[4], tg[4], tk[2], tq[2], ts[2];
#pragma unroll
      for (int k = 0; k < 4; ++k) {
        const int c = tid + 512 * k, j = c >> 4, cc = c & 15;
        tv[k] = *(const u32x4*)(base + (size_t)j * NW + OFF_VR + hh * 128 + cc * 8);
        tg[k] = *(const u32x4*)(base + (size_t)j * NW + OFF_GR + hh * 128 + cc * 8);
      }
#pragma unroll
      for (int k = 0; k < 2; ++k) {
        const int c = tid + 512 * k, j = c >> 3, cc = c & 7;
        tk[k] = *(const u32x4*)(base + (size_t)j * NW + OFF_KR + hh * 64 + cc * 8);
        tq[k] = *(const u32x4*)(base + (size_t)j * NW + OFF_QR + hh * 64 + cc * 8);
        ts[k] = *(const u32x4*)(p.stT + ((size_t)u << 13) + (size_t)c * 8);
      }
#pragma unroll
      for (int k = 0; k < 4; ++k) {
        const int c = tid + 512 * k, j = c >> 4, cc = c & 15;
        *(LAS u32x4*)(lds + RV_OFF + j * RV_ROW + cc * 16) = tv[k];
        *(LAS u32x4*)(lds + RGO + j * RG_ROW + cc * 16) = tg[k];
      }
#pragma unroll
      for (int k = 0; k < 2; ++k) {
        const int c = tid + 512 * k, j = c >> 3, cc = c & 7;
        *(LAS u32x4*)(lds + RKO + j * 144 + cc * 16) = tk[k];
        *(LAS u32x4*)(lds + RQO + j * 144 + cc * 16) = tq[k];
        *(LAS u32x4*)(lds + RSO + j * 144 + cc * 16) = ts[k];
      }
    }
    __syncthreads();
    const int qi = 32 * it + r;
    bf16x8 Qf[4];
#pragma unroll
    for (int ks = 0; ks < 4; ++ks) Qf[ks] = *(const LAS bf16x8*)(lds + RQO + qi * 144 + (2 * ks + h) * 16);
    f32x16 O0, O1;
#pragma unroll
    for (int i = 0; i < 16; ++i) { O0[i] = 0.f; O1[i] = 0.f; }
    {
#pragma unroll
      for (int ks = 0; ks < 4; ++ks) {
        const bf16x8 S0 = *(const LAS bf16x8*)(lds + RSO + (64 * vh + r) * 144 + (2 * ks + h) * 16);
        const bf16x8 S1 = *(const LAS bf16x8*)(lds + RSO + (64 * vh + 32 + r) * 144 + (2 * ks + h) * 16);
        O0 = MFMA32(S0, Qf[ks], O0); O1 = MFMA32(S1, Qf[ks], O1);
      }
      const float qd = exp2f((float)(qi + 1) * lg);
#pragma unroll
      for (int i = 0; i < 16; ++i) { O0[i] *= qd; O1[i] *= qd; }
    }
    LAS unsigned char* va = lds + RV_OFF + (4 * h + q4) * RV_ROW + (64 * vh + 16 * blk + 4 * pp) * 2;
    for (int jt = 0; jt <= it; ++jt) {
      f32x16 S;
#pragma unroll
      for (int i = 0; i < 16; ++i) S[i] = 0.f;
#pragma unroll
      for (int ks = 0; ks < 4; ++ks) { const bf16x8 Kf = *(const LAS bf16x8*)(lds + RKO + (32 * jt + r) * 144 + (2 * ks + h) * 16); S = MFMA32(Kf, Qf[ks], S); }
#pragma unroll
      for (int i = 0; i < 16; ++i) {
        const int dj = qi - (32 * jt + (i & 3) + 8 * (i >> 2) + 4 * h);
        S[i] = dj >= 0 ? S[i] * fexp2((float)dj * lg) : 0.f;
      }
#pragma unroll
      for (int s2 = 0; s2 < 2; ++s2) {
        const bf16x8 Pb = pack8(S, s2);
        const bf16x8 V0 = tr_frag(va + (32 * jt + 16 * s2) * RV_ROW, 8 * RV_ROW), V1 = tr_frag(va + (32 * jt + 16 * s2) * RV_ROW + 64, 8 * RV_ROW);
        O0 = MFMA32(V0, Pb, O0);
        O1 = MFMA32(V1, Pb, O1);
      }
    }
    float s1 = 0.f, s2 = 0.f;
#pragma unroll
    for (int i = 0; i < 16; ++i) { s1 += O0[i] + O1[i]; s2 += O0[i] * O0[i] + O1[i] * O1[i]; }
    s1 += __shfl_xor(s1, 32); s2 += __shfl_xor(s2, 32);
    if (h == 0) { red[(vh * 128 + qi) * 2] = s1; red[(vh * 128 + qi) * 2 + 1] = s2; }
    __syncthreads();
    s1 += red[((vh ^ 1) * 128 + qi) * 2]; s2 += red[((vh ^ 1) * 128 + qi) * 2 + 1];
    const float mu = s1 * (1.0f / 128.0f), var = fmaxf(s2 * (1.0f / 128.0f) - mu * mu, 0.f), rs = rsqrtf(var + 1e-5f);
    const float* gnp = p.gn + hh * 128 + 64 * vh + 4 * h;
    LAS unsigned char* gt = lds + RGO + qi * RG_ROW + (64 * vh + 4 * h) * 2;
#pragma unroll
    for (int dt = 0; dt < 2; ++dt)
#pragma unroll
      for (int g = 0; g < 4; ++g) {
        const int vo = 32 * dt + 8 * g;
        LAS u32x2* ga = (LAS u32x2*)(gt + vo * 2);
        const u32x2 gwv = *ga;
        const f32x4 gnv = *(const f32x4*)(gnp + vo);
        float f0, f1, f2, f3;
        if (dt == 0) { f0 = O0[4 * g]; f1 = O0[4 * g + 1]; f2 = O0[4 * g + 2]; f3 = O0[4 * g + 3]; }
        else { f0 = O1[4 * g]; f1 = O1[4 * g + 1]; f2 = O1[4 * g + 2]; f3 = O1[4 * g + 3]; }
        f0 = (f0 - mu) * rs * gnv[0] * silu(bflo(gwv.x)); f1 = (f1 - mu) * rs * gnv[1] * silu(bfhi(gwv.x));
        f2 = (f2 - mu) * rs * gnv[2] * silu(bflo(gwv.y)); f3 = (f3 - mu) * rs * gnv[3] * silu(bfhi(gwv.y));
        u32x2 wv; wv.x = pack2(f0, f1); wv.y = pack2(f2, f3);
        *ga = wv;
      }
    __syncthreads();
#pragma unroll
    for (int k = 0; k < 4; ++k) {
      const int c = tid + 512 * k, j = c >> 4, cc = c & 15;
      *(u32x4*)(p.mixed + (size_t)(tok0 + j) * DM + 512 + hh * 128 + cc * 8) = *(const LAS u32x4*)(lds + RGO + j * RG_ROW + cc * 16);
    }
    __syncthreads();
  }
}

DI void grid_barrier(unsigned* ctr, unsigned target) {
  asm volatile("s_waitcnt vmcnt(0) lgkmcnt(0)" ::: "memory");
  __syncthreads();
  if (threadIdx.x == 0) {
    __builtin_amdgcn_fence(__ATOMIC_RELEASE, "agent");
    asm volatile("s_waitcnt vmcnt(0)" ::: "memory");
    __hip_atomic_fetch_add(ctr, 1u, __ATOMIC_RELAXED, __HIP_MEMORY_SCOPE_AGENT);
    unsigned spins = 0;
    while (__hip_atomic_load(ctr, __ATOMIC_RELAXED, __HIP_MEMORY_SCOPE_AGENT) < target && spins < (1u << 22)) { __builtin_amdgcn_s_sleep(2); ++spins; }
    __builtin_amdgcn_fence(__ATOMIC_ACQUIRE, "agent");
    asm volatile("s_waitcnt vmcnt(0)" ::: "memory");
  }
  __syncthreads();
}

__global__ void __launch_bounds__(512) k_mega(Params p) {
  extern __shared__ __attribute__((aligned(16))) unsigned char shm_[];
  LAS unsigned char* shm = (LAS unsigned char*)shm_;
  const int bid = blockIdx.x, nb = gridDim.x;
  unsigned bar_n = 0;
#ifdef PROBE_PHASE
#ifndef PROBE_BLK
#define PROBE_BLK 0
#endif
  unsigned long long ts_a = 0, ts_b = 0; int ph_i = 0;
  if (PROBE_PHASE == 0) ts_a = __builtin_amdgcn_s_memrealtime();
#define GRID_BAR() do { bar_n += (unsigned)nb; grid_barrier(p.bar, bar_n); ++ph_i; if (ph_i == PROBE_PHASE) ts_a = __builtin_amdgcn_s_memrealtime(); if (ph_i == PROBE_PHASE + 1) ts_b = __builtin_amdgcn_s_memrealtime(); } while (0)
#else
#define GRID_BAR() do { bar_n += (unsigned)nb; grid_barrier(p.bar, bar_n); } while (0)
#endif
  phase_prep(p, bid, nb);
  GRID_BAR();
  phase_gemm<1>(shm, p, bid, nb);
  GRID_BAR();
  phase_attn(shm, p, bid, nb);
#ifdef PROBE_SUB
  ts_b = __builtin_amdgcn_s_memrealtime(); ph_i = 100;
#endif
  phase_retkv(shm, p, bid, nb);
  GRID_BAR();
  phase_gemm<2>(shm, p, bid, nb);
#ifdef PROBE_PHASE
  if (PROBE_PHASE == 3) ts_b = __builtin_amdgcn_s_memrealtime();
  if (bid == PROBE_BLK && threadIdx.x == 0) {
    const unsigned long long until = __builtin_amdgcn_s_memrealtime() + 9ull * (ts_b - ts_a);
    while (__builtin_amdgcn_s_memrealtime() < until) __builtin_amdgcn_s_sleep(8);
  }
#endif
}

extern "C" void kernel_launch(void* const* d_in, const int* in_sizes, int n_in, void* d_out, int out_size, void* d_ws, size_t ws_size, hipStream_t stream) {
  Params p{};
  p.x = (const float*)d_in[0]; p.ng = (const float*)d_in[1]; p.w_in = (const float*)d_in[2]; p.gn = (const float*)d_in[3];
  p.w_out = (const float*)d_in[4]; p.fg = (const float*)d_in[5];
  p.out = (float*)d_out;
  char* w = (char*)d_ws; size_t o = 0;
  auto take = [&](size_t bytes) { char* r = w + o; o += (bytes + 255) & ~(size_t)255; return r; };
  p.xb = (bf16_t*)take((size_t)T_TOK * DM * 2);
  p.proj = (bf16_t*)take((size_t)T_TOK * NW * 2);
  p.mixed = (bf16_t*)take((size_t)T_TOK * DM * 2);
  p.winT = (bf16_t*)take((size_t)NW * DM * 2);
  p.woutT = (bf16_t*)take((size_t)DM * DM * 2);
  p.rstd = (float*)take((size_t)T_TOK * 4);
  p.rowss = (float*)take((size_t)T_TOK * 4);
  p.ropeT = (float2*)take((size_t)SEQ * 32 * 8);
  p.retT = (float2*)take((size_t)SEQ * 32 * 8);
  p.kvT = (float*)take((size_t)1024 * 8192 * 4);
  p.stT = (bf16_t*)take((size_t)1024 * 8192 * 2);
  p.bar = (unsigned*)take(1024);
  p.ob = (bf16_t*)take((size_t)T_TOK * 512 * 2);
  p.lseg = (float*)take((size_t)T_TOK * 8 * 4);
  static int grid_blocks = 0;
  if (!grid_blocks) {
    (void)hipFuncSetAttribute((const void*)k_mega, hipFuncAttributeMaxDynamicSharedMemorySize, ATTN_LDS);
    int dev = 0, cus = 0, per_cu = 0;
    (void)hipGetDevice(&dev);
    (void)hipDeviceGetAttribute(&cus, hipDeviceAttributeMultiprocessorCount, dev);
    (void)hipOccupancyMaxActiveBlocksPerMultiprocessor(&per_cu, k_mega, 512, ATTN_LDS);
    if (per_cu < 1) per_cu = 1;
    grid_blocks = cus;
  }
  (void)hipMemsetAsync(p.bar, 0, 1024, stream);
  hipLaunchKernelGGL(k_mega, dim3(grid_blocks), dim3(512), ATTN_LDS, stream, p);
}
```

```cpp
#include <hip/hip_runtime.h>
#include <hip/hip_cooperative_groups.h>
#include <cstdint>
#include <cstdio>
namespace cg = cooperative_groups;

typedef unsigned short bf16_t;
typedef short bf16x8 __attribute__((ext_vector_type(8)));
typedef float f32x4 __attribute__((ext_vector_type(4)));
typedef unsigned u32x4 __attribute__((ext_vector_type(4)));
typedef unsigned u32x2 __attribute__((ext_vector_type(2)));

constexpr int T_TOK = 32768, DM = 1024, NW = 3584, SEQ = 4096;
constexpr int OFF_QA = 0, OFF_KA = 512, OFF_VA = 1024, OFF_GA = 1536, OFF_QR = 2048, OFF_KR = 2304, OFF_VR = 2560, OFF_GR = 3072;

struct Params {
  const float* x; const float* ng; const float* w_in; const float* gn; const float* w_out; const float* fg;
  float* out;
  bf16_t* xb; bf16_t* proj; bf16_t* mixed; bf16_t* winT; bf16_t* woutT;
  float* rstd; float* rowss; float2* ropeT; float2* retT; float* kvT; bf16_t* stT; unsigned* bar; bf16_t* ob; float* lseg;
};

#define DI __device__ __forceinline__
DI unsigned short f2bf(float x) { unsigned u = __float_as_uint(x); u += 0x7fffu + ((u >> 16) & 1u); return (unsigned short)(u >> 16); }
DI float bf2f(unsigned short b) { return __uint_as_float(((unsigned)b) << 16); }
typedef float f32x2_t __attribute__((ext_vector_type(2)));
typedef __bf16 bf16x2_t __attribute__((ext_vector_type(2)));
DI unsigned pack2(float lo, float hi) { const f32x2_t v = {lo, hi}; return __builtin_bit_cast(unsigned, __builtin_convertvector(v, bf16x2_t)); }
DI float bflo(unsigned w) { return __uint_as_float(w << 16); }
DI float bfhi(unsigned w) { return __uint_as_float(w & 0xffff0000u); }
DI int perm32(int rho) { const int n = rho >> 4, i = rho & 15; return 8 * (i >> 2) + 4 * n + (i & 3); }
DI int cmap(int p) { return (p & ~31) + perm32(p & 31); }
DI int cmapA(int p) { return (p & ~127) + ((p >> 6) & 1) * 64 + ((p >> 4) & 1) * 32 + ((p >> 5) & 1) * 16 + (p & 15); }

DI void phase_prep(const Params& p, int bid, int nb) {
  const int tid = threadIdx.x, lane = tid & 63, wid = tid >> 6, nw = blockDim.x >> 6;
  if (wid < 6)
  for (int row0 = (bid * 6 + wid) * 4; row0 < T_TOK; row0 += nb * 6 * 4) {
    f32x4 v[4][4];
#pragma unroll
    for (int rr = 0; rr < 4; ++rr)
#pragma unroll
      for (int it = 0; it < 4; ++it) v[rr][it] = __builtin_nontemporal_load((const f32x4*)(p.x + (size_t)(row0 + rr) * DM + it * 256 + lane * 4));
#pragma unroll
    for (int rr = 0; rr < 4; ++rr) {
      float ss = 0.f;
#pragma unroll
      for (int it = 0; it < 4; ++it) ss += v[rr][it][0] * v[rr][it][0] + v[rr][it][1] * v[rr][it][1] + v[rr][it][2] * v[rr][it][2] + v[rr][it][3] * v[rr][it][3];
#pragma unroll
      for (int o = 32; o >= 1; o >>= 1) ss += __shfl_xor(ss, o);
#pragma unroll
      for (int it = 0; it < 4; ++it) { u32x2 w; w.x = pack2(v[rr][it][0], v[rr][it][1]); w.y = pack2(v[rr][it][2], v[rr][it][3]); *(u32x2*)(p.xb + (size_t)(row0 + rr) * DM + it * 256 + lane * 4) = w; }
      if (lane == 0) p.rstd[row0 + rr] = rsqrtf(ss * (1.0f / DM) + 1e-6f);
    }
  }
  if (wid < 6) return;
  const int gt = bid * 128 + (tid - 384), gn = nb * 128;
  for (int idx = gt; idx < (NW / 4) * 128; idx += gn) {
    const int p4 = idx % (NW / 4), kc = idx / (NW / 4), pp = p4 * 4, c = pp < 1024 ? cmapA(pp) : cmap(pp);
    f32x4 f[8];
#pragma unroll
    for (int j = 0; j < 8; ++j) { const int k = kc * 8 + j; f[j] = *(const f32x4*)(p.w_in + (size_t)k * NW + c) * p.ng[k]; }
#pragma unroll
    for (int e = 0; e < 4; ++e) {
      u32x4 w; w.x = pack2(f[0][e], f[1][e]); w.y = pack2(f[2][e], f[3][e]); w.z = pack2(f[4][e], f[5][e]); w.w = pack2(f[6][e], f[7][e]);
      *(u32x4*)(p.winT + (size_t)(pp + e) * DM + kc * 8) = w;
    }
  }
  for (int idx = gt; idx < (DM / 4) * 128; idx += gn) {
    const int p4 = idx % (DM / 4), kc = idx / (DM / 4), pp = p4 * 4, c = cmap(pp);
    f32x4 f[8];
#pragma unroll
    for (int j = 0; j < 8; ++j) { const int k = kc * 8 + j; f[j] = *(const f32x4*)(p.w_out + (size_t)k * DM + c); }
#pragma unroll
    for (int e = 0; e < 4; ++e) {
      u32x4 w; w.x = pack2(f[0][e], f[1][e]); w.y = pack2(f[2][e], f[3][e]); w.z = pack2(f[4][e], f[5][e]); w.w = pack2(f[6][e], f[7][e]);
      *(u32x4*)(p.woutT + (size_t)(pp + e) * DM + kc * 8) = w;
    }
  }
  for (int idx = gt; idx < SEQ * 32; idx += gn) {
    const int pos = idx >> 5, i = idx & 31;
    const float inv1 = powf(10000.0f, -(float)i / 32.0f);
    const float inv2 = 1.0f / powf(10000.0f, (float)i / 31.0f);
    const float a1 = (float)pos * inv1, a2 = (float)pos * inv2;
    p.ropeT[idx] = make_float2(cosf(a1), sinf(a1));
    p.retT[idx] = make_float2(cosf(a2), sinf(a2));
  }
}

constexpr int BM = 256, BK = 64, HALF = 128, HT = HALF * BK;
constexpr int GEMM_LDS = 8 * HT * 2;
DI int lds_byte(int r, int c) { int st = (r >> 4) * 2 + (c >> 5), rr = r & 15, cc = c & 31, ob = rr * 64 + cc * 2; return st * 1024 + (ob ^ (((ob >> 9) & 1) << 5)); }
DI void stage_rc(int b, int& R, int& C) { int st = b / 1024, sb = b % 1024, swz = sb ^ (((sb >> 9) & 1) << 5); R = (st >> 1) * 16 + swz / 64; C = (st & 1) * 32 + (swz % 64) / 2; }

#define LAS __attribute__((address_space(3)))
template <int EPI>
DI void gemm_epi(LAS unsigned char* lds, f32x4 (&acc)[2][2][4][2], const int brow, const int bcol, const Params& p) {
  const int tid = threadIdx.x, wid = __builtin_amdgcn_readfirstlane(tid >> 6), lane = tid & 63, wr = wid >> 2, wc = wid & 3, fr = lane & 15, fq = lane >> 4;
  if (EPI == 1) {
    const int pn = bcol >> 8;
    if (pn < 4) {
      const float sc = pn < 2 ? 0.125f * 1.4426950408889634f : 1.0f;
      const int i0 = 16 * (wc & 1) + 4 * fq;
#pragma unroll
      for (int ai = 0; ai < 2; ++ai)
#pragma unroll
        for (int m = 0; m < 4; ++m) {
          const int row = brow + ai * HALF + wr * 64 + m * 16 + fr;
          const float rs = p.rstd[row] * sc;
          const float* tb = (const float*)(p.ropeT + (row & (SEQ - 1)) * 32 + i0);
          const f32x4 t0 = *(const f32x4*)tb, t1 = *(const f32x4*)(tb + 4);
#pragma unroll
          for (int bj = 0; bj < 2; ++bj) {
            const f32x4 x1 = acc[ai][bj][m][0] * rs, x2 = acc[ai][bj][m][1] * rs;
            u32x2 wa, wb;
            wa.x = pack2(x1[0] * t0[0] - x2[0] * t0[1], x1[1] * t0[2] - x2[1] * t0[3]);
            wa.y = pack2(x1[2] * t1[0] - x2[2] * t1[1], x1[3] * t1[2] - x2[3] * t1[3]);
            wb.x = pack2(x2[0] * t0[0] + x1[0] * t0[1], x2[1] * t0[2] + x1[1] * t0[3]);
            wb.y = pack2(x2[2] * t1[0] + x1[2] * t1[1], x2[3] * t1[2] + x1[3] * t1[3]);
            bf16_t* o = p.proj + (size_t)row * NW + bcol + bj * HALF + (wc >> 1) * 64 + i0;
            *(u32x2*)o = wa; *(u32x2*)(o + 32) = wb;
          }
        }
    } else if (pn == 8 || pn == 9) {
      const float sc = pn == 9 ? 0.125f : 1.0f;
      const int i0 = 16 * (wc & 1) + 4 * fq;
#pragma unroll
      for (int ai = 0; ai < 2; ++ai)
#pragma unroll
        for (int m = 0; m < 4; ++m) {
          const int row = brow + ai * HALF + wr * 64 + m * 16 + fr;
          const float rs = p.rstd[row] * sc;
          const float* tb = (const float*)(p.retT + (row & (SEQ - 1)) * 32 + i0);
          const f32x4 t0 = *(const f32x4*)tb, t1 = *(const f32x4*)(tb + 4);
#pragma unroll
          for (int bj = 0; bj < 2; ++bj) {
            const f32x4 v0 = acc[ai][bj][m][0] * rs, v1 = acc[ai][bj][m][1] * rs;
            u32x4 w;
            w.x = pack2(v0[0] * t0[0] - v0[1] * t0[1], v0[1] * t0[0] + v0[0] * t0[1]);
            w.y = pack2(v0[2] * t0[2] - v0[3] * t0[3], v0[3] * t0[2] + v0[2] * t0[3]);
            w.z = pack2(v1[0] * t1[0] - v1[1] * t1[1], v1[1] * t1[0] + v1[0] * t1[1]);
            w.w = pack2(v1[2] * t1[2] - v1[3] * t1[3], v1[3] * t1[2] + v1[2] * t1[3]);
            *(u32x4*)(p.proj + (size_t)row * NW + bcol + bj * HALF + wc * 32 + 8 * fq) = w;
          }
        }
    } else {
#pragma unroll
    for (int ai = 0; ai < 2; ++ai)
#pragma unroll
      for (int m = 0; m < 4; ++m) {
        const int row = brow + ai * HALF + wr * 64 + m * 16 + fr;
        const float rs = p.rstd[row];
#pragma unroll
        for (int bj = 0; bj < 2; ++bj) {
          const f32x4 v0 = acc[ai][bj][m][0] * rs, v1 = acc[ai][bj][m][1] * rs;
          u32x4 w; w.x = pack2(v0[0], v0[1]); w.y = pack2(v0[2], v0[3]); w.z = pack2(v1[0], v1[1]); w.w = pack2(v1[2], v1[3]);
          *(u32x4*)(p.proj + (size_t)row * NW + bcol + bj * HALF + wc * 32 + 8 * fq) = w;
        }
      }
    }
  } else {
    const int pm = brow >> 8, pn = bcol >> 8;
    LAS float* part = (LAS float*)(lds + GEMM_LDS);
    LAS float* rsl = (LAS float*)(lds + GEMM_LDS + 4096);
#pragma unroll
    for (int ai = 0; ai < 2; ++ai)
#pragma unroll
      for (int m = 0; m < 4; ++m) {
        const int rl = ai * HALF + wr * 64 + m * 16 + fr;
        float ss = 0.f;
#pragma unroll
        for (int bj = 0; bj < 2; ++bj) {
          const size_t off = (size_t)(brow + rl) * DM + bcol + bj * HALF + wc * 32 + 8 * fq;
          const f32x4 x0 = __builtin_nontemporal_load((const f32x4*)(p.x + off)), x1 = __builtin_nontemporal_load((const f32x4*)(p.x + off + 4));
          const f32x4 y0 = acc[ai][bj][m][0] + x0, y1 = acc[ai][bj][m][1] + x1;
          acc[ai][bj][m][0] = y0; acc[ai][bj][m][1] = y1;
          ss += y0[0] * y0[0] + y0[1] * y0[1] + y0[2] * y0[2] + y0[3] * y0[3] + y1[0] * y1[0] + y1[1] * y1[1] + y1[2] * y1[2] + y1[3] * y1[3];
        }
        ss += __shfl_xor(ss, 16); ss += __shfl_xor(ss, 32);
        if (fq == 0) part[wc * 256 + rl] = ss;
      }
    __syncthreads();
    float* xs = p.rowss + (size_t)(pm * 4) * 256;
    if (tid < 256) {
      const float tot = part[tid] + part[256 + tid] + part[512 + tid] + part[768 + tid];
      __hip_atomic_store(xs + pn * 256 + tid, tot, __ATOMIC_RELAXED, __HIP_MEMORY_SCOPE_AGENT);
    }
    asm volatile("s_waitcnt vmcnt(0)" ::: "memory");
    __syncthreads();
    unsigned* cnt = p.bar + 64 + pm;
    if (tid == 0) __hip_atomic_fetch_add(cnt, 1u, __ATOMIC_RELAXED, __HIP_MEMORY_SCOPE_AGENT);
    if (wid == 0) {
      unsigned spins = 0;
      while (__hip_atomic_load(cnt, __ATOMIC_RELAXED, __HIP_MEMORY_SCOPE_AGENT) < 4u && spins < (1u << 20)) { __builtin_amdgcn_s_sleep(1); ++spins; }
      __builtin_amdgcn_fence(__ATOMIC_ACQUIRE, "agent");
      asm volatile("s_waitcnt vmcnt(0)" ::: "memory");
    }
    __syncthreads();
    if (tid < 256) {
      float t = 0.f;
#pragma unroll
      for (int q = 0; q < 4; ++q) t += __hip_atomic_load(xs + q * 256 + tid, __ATOMIC_RELAXED, __HIP_MEMORY_SCOPE_AGENT);
      rsl[tid] = rsqrtf(t * (1.0f / DM) + 1e-6f);
    }
    __syncthreads();
#pragma unroll
    for (int ai = 0; ai < 2; ++ai)
#pragma unroll
      for (int m = 0; m < 4; ++m) {
        const int rl = ai * HALF + wr * 64 + m * 16 + fr;
        const float rs = rsl[rl];
#pragma unroll
        for (int bj = 0; bj < 2; ++bj) {
          const int col = bcol + bj * HALF + wc * 32 + 8 * fq;
          const f32x4 g0 = *(const f32x4*)(p.fg + col), g1 = *(const f32x4*)(p.fg + col + 4);
          float* o = p.out + (size_t)(brow + rl) * DM + col;
          __builtin_nontemporal_store(acc[ai][bj][m][0] * rs * g0, (f32x4*)o); __builtin_nontemporal_store(acc[ai][bj][m][1] * rs * g1, (f32x4*)(o + 4));
        }
      }
    __syncthreads();
  }
}

DI void tile_of(int L, int nM, int nN, int& pm, int& pn) {
  const int nwg = nM * nN, NX = 8, WGM = 8;
  int wgid = L; { const int q = nwg / NX, r = nwg % NX, xcd = wgid % NX, off = wgid / NX; wgid = (xcd < r ? xcd * (q + 1) : r * (q + 1) + (xcd - r) * q) + off; }
  const int nig = WGM * nN, gid = wgid / nig, fm = gid * WGM, gsz = (nM - fm) < WGM ? (nM - fm) : WGM;
  pm = fm + ((wgid % nig) % gsz); pn = (wgid % nig) / gsz;
}


template <int EPI>
DI void phase_gemm(LAS unsigned char* lds, const Params& p, int bid, int nb) {
  constexpr int K = 1024, nt = K / BK, HTB = HALF * BK * 2;
  const bf16_t* A = EPI == 1 ? p.xb : p.mixed; const bf16_t* Bt = EPI == 1 ? p.winT : p.woutT;
  const int nM = T_TOK / BM, nN = (EPI == 1 ? NW : DM) / BM, nT = nM * nN;
  const int tid = threadIdx.x, wid = __builtin_amdgcn_readfirstlane(tid >> 6), lane = tid & 63, wr = wid >> 2, wc = wid & 3, fr = lane & 15, fq = lane >> 4;
  unsigned voff[2];
#pragma unroll
  for (int i = 0; i < 2; ++i) { int R, C; stage_rc(tid * 16 + i * 8192, R, C); voff[i] = (unsigned)(R * K + C) * 2u; }
  const unsigned ldsw = (unsigned)wid * 1024u;
  const int aoff = lds_byte(wr * 64 + fr, fq * 8), boff = lds_byte(wc * 32 + fr, fq * 8);
  const size_t kstep = (size_t)(BK * 2), hstep = (size_t)HALF * K * 2, tstep = 2 * hstep;
#define SAo(b, h) (((b) * 2 + (h)) * HTB)
#define SBo(b, h) ((4 + (b) * 2 + (h)) * HTB)
#define STAGEP(bufoff, gptr) do { _Pragma("unroll") for (int _i = 0; _i < 2; ++_i) \
    __builtin_amdgcn_global_load_lds((const unsigned*)((gptr) + voff[_i]), (LAS unsigned*)(lds + (bufoff) + ldsw + _i * 8192), 16, 0, 0); } while (0)
#define LDA(dst, b, h) do { _Pragma("unroll") for (int m = 0; m < 4; ++m) _Pragma("unroll") for (int k = 0; k < 2; ++k) \
    dst[m][k] = *(const LAS bf16x8*)(lds + SAo(b, h) + aoff + m * 2048 + k * 1024); } while (0)
#define LDB(dst, b, h) do { _Pragma("unroll") for (int n = 0; n < 2; ++n) _Pragma("unroll") for (int k = 0; k < 2; ++k) \
    dst[n][k] = *(const LAS bf16x8*)(lds + SBo(b, h) + boff + n * 2048 + k * 1024); } while (0)
#define MMA(ai, bj, At, Bt_) do { __builtin_amdgcn_s_setprio(1); \
    _Pragma("unroll") for (int m = 0; m < 4; ++m) _Pragma("unroll") for (int n = 0; n < 2; ++n) _Pragma("unroll") for (int k = 0; k < 2; ++k) \
      acc[ai][bj][m][n] = __builtin_amdgcn_mfma_f32_16x16x32_bf16(Bt_[n][k], At[m][k], acc[ai][bj][m][n], 0, 0, 0); \
    __builtin_amdgcn_s_setprio(0); } while (0)
#define WAIT_V(n) asm volatile("s_waitcnt vmcnt(" #n ")" ::: "memory")
#define WAIT_L(n) asm volatile("s_waitcnt lgkmcnt(" #n ")" ::: "memory")
#define BAR __builtin_amdgcn_s_barrier()
#define SCHED __builtin_amdgcn_sched_barrier(0)
  int L = bid;
  if (L >= nT) return;
  int pm, pn; tile_of(L, nM, nN, pm, pn);
  f32x4 acc[2][2][4][2];
#pragma unroll
  for (int a = 0; a < 2; ++a)
#pragma unroll
    for (int b = 0; b < 2; ++b)
#pragma unroll
      for (int m = 0; m < 4; ++m)
#pragma unroll
        for (int n = 0; n < 2; ++n) acc[a][b][m][n] = (f32x4){0.f, 0.f, 0.f, 0.f};
  bf16x8 At[4][2], B0[2][2], B1[2][2];
  const char* cA = (const char*)A + (size_t)pm * tstep; const char* cB = (const char*)Bt + (size_t)pn * tstep;
  WAIT_V(0);
  STAGEP(SBo(0, 0), cB); STAGEP(SBo(0, 1), cB + hstep); STAGEP(SAo(0, 0), cA); STAGEP(SAo(0, 1), cA + hstep);
  if (wr == 1) BAR;
  WAIT_V(2); BAR;
  STAGEP(SBo(1, 0), cB + kstep); STAGEP(SAo(1, 0), cA + kstep); STAGEP(SBo(1, 1), cB + hstep + kstep);
  WAIT_V(6); BAR;
  for (;;) {
    const bool has_next = (L + nb < nT);
    int npm = pm, npn = pn;
    if (has_next) tile_of(L + nb, nM, nN, npm, npn);
    const char* nA = (const char*)A + (size_t)npm * tstep; const char* nB = (const char*)Bt + (size_t)npn * tstep;
    for (int t = 0; t < nt; t += 2) {
      const bool last = (t == nt - 2);
      const char* a1 = cA + (size_t)(t + 1) * kstep;
      const char* a2 = last ? nA : cA + (size_t)(t + 2) * kstep; const char* b2 = last ? nB : cB + (size_t)(t + 2) * kstep;
      const char* a3 = a2 + kstep; const char* b3 = b2 + kstep;
      LDB(B0, 0, 0); LDB(B1, 0, 1); SCHED; LDA(At, 0, 0); STAGEP(SAo(1, 1), a1 + hstep);
      WAIT_V(8); WAIT_L(0); BAR; MMA(0, 0, At, B0); MMA(0, 1, At, B1); BAR; SCHED;
      LDA(At, 0, 1); STAGEP(SBo(0, 0), b2); STAGEP(SBo(0, 1), b2 + hstep); STAGEP(SAo(0, 0), a2);
      WAIT_V(8); WAIT_L(0); BAR; MMA(1, 0, At, B0); MMA(1, 1, At, B1); BAR; SCHED;
      LDB(B0, 1, 0); LDB(B1, 1, 1); SCHED; LDA(At, 1, 0); STAGEP(SAo(0, 1), a2 + hstep);
      WAIT_V(8); WAIT_L(0); BAR; MMA(0, 0, At, B0); MMA(0, 1, At, B1); BAR; SCHED;
      LDA(At, 1, 1); STAGEP(SBo(1, 0), b3); STAGEP(SBo(1, 1), b3 + hstep); STAGEP(SAo(1, 0), a3);
      WAIT_V(8); WAIT_L(0); BAR; MMA(1, 0, At, B0); MMA(1, 1, At, B1); BAR; SCHED;
    }
    if (wr == 0) BAR;
    gemm_epi<EPI>(lds, acc, pm * BM, pn * BM, p);
    if (!has_next) break;
#pragma unroll
    for (int a = 0; a < 2; ++a)
#pragma unroll
      for (int b = 0; b < 2; ++b)
#pragma unroll
        for (int m = 0; m < 4; ++m)
#pragma unroll
          for (int n = 0; n < 2; ++n) acc[a][b][m][n] = (f32x4){0.f, 0.f, 0.f, 0.f};
    pm = npm; pn = npn; cA = nA; cB = nB; L += nb;
    if (wr == 1) BAR;
  }
  WAIT_V(0);
  BAR;
}

DI float ret_log2g(int h) { return log2f(1.0f - exp2f(-5.0f - (float)h)); }

typedef float f32x16 __attribute__((ext_vector_type(16)));
typedef short s16x4 __attribute__((ext_vector_type(4)));
#define MFMA32(a, b, c) __builtin_amdgcn_mfma_f32_32x32x16_bf16((a), (b), (c), 0, 0, 0)
DI s16x4 tr_read(LAS unsigned char* a) { return __builtin_amdgcn_ds_read_tr16_b64_v4i16((LAS s16x4*)a); }
DI bf16x8 tr_frag(LAS unsigned char* a, int rowstride8) {
  const s16x4 lo = tr_read(a), hi = tr_read(a + rowstride8);
  return __builtin_shufflevector(lo, hi, 0, 1, 2, 3, 4, 5, 6, 7);
}
DI bf16x8 pack8(const f32x16& x, int s) {
  u32x4 w;
  w.x = pack2(x[8 * s + 0], x[8 * s + 1]); w.y = pack2(x[8 * s + 2], x[8 * s + 3]); w.z = pack2(x[8 * s + 4], x[8 * s + 5]); w.w = pack2(x[8 * s + 6], x[8 * s + 7]);
  return __builtin_bit_cast(bf16x8, w);
}
DI float fexp2(float x) { return __builtin_amdgcn_exp2f(x); }
DI float half_max(float x) { const u32x2 r = __builtin_amdgcn_permlane32_swap(__float_as_uint(x), __float_as_uint(x), false, false); return fmaxf(__uint_as_float(r[0]), __uint_as_float(r[1])); }
DI float half_sum(float x) { const u32x2 r = __builtin_amdgcn_permlane32_swap(__float_as_uint(x), __float_as_uint(x), false, false); return __uint_as_float(r[0]) + __uint_as_float(r[1]); }
DI float silu(float g) { return g / (1.0f + __expf(-g)); }

constexpr int AT_ROWB = 136, AT_LS = 512 * AT_ROWB, AT_VST = AT_LS + 2048, VROW = 192, KROW = 144, KST_W = 32 * KROW, VST_W = KST_W + 32 * VROW;
constexpr int ATTN_LDS = AT_VST + 8 * VST_W;
constexpr float LOG2E = 1.4426950408889634f;

constexpr int PT_ROW = 136;

DI void softmax_pv(f32x16& S, f32x16& O0, f32x16& O1, float& m, float& l, const bf16x8 (&Vf)[2][2], const bool mlow, const bool mhigh, const int r, const int h) {
  if (mlow || mhigh) {
#pragma unroll
    for (int i = 0; i < 16; ++i) {
      const int keyrow = (i & 3) + 8 * (i >> 2) + 4 * h;
      const bool bad = (mlow && keyrow < r) || (mhigh && keyrow > r);
      S[i] = bad ? -1e30f : S[i];
    }
  }
  float mx = fmaxf(S[0], S[1]);
#pragma unroll
  for (int i = 2; i < 16; ++i) mx = fmaxf(mx, S[i]);
  mx = half_max(mx);
  const float mn = fmaxf(m, mx);
  if (__builtin_amdgcn_ballot_w64(mn > m) != 0ull) {
    const float al = fexp2(m - mn);
    l *= al;
#pragma unroll
    for (int i = 0; i < 16; ++i) { O0[i] *= al; O1[i] *= al; }
    m = mn;
  }
  float ps = 0.f;
#pragma unroll
  for (int i = 0; i < 16; ++i) { S[i] = fexp2(S[i] - mn); ps += S[i]; }
  l += half_sum(ps);
#pragma unroll
  for (int s = 0; s < 2; ++s) {
    const bf16x8 Pb = pack8(S, s);
    O0 = MFMA32(Vf[s][0], Pb, O0);
    O1 = MFMA32(Vf[s][1], Pb, O1);
  }
}

DI void attn_tile2(const u32x4 (&Kc)[4], const u32x4 (&Vc)[4], const bf16x8 (&QA)[4], const bf16x8 (&QB)[4],
                   f32x16& A0, f32x16& A1, float& mA, float& lA, f32x16& B0, f32x16& B1, float& mB, float& lB,
                   LAS unsigned char* kst, LAS unsigned char* vst, LAS unsigned char* trp, const int lane, const int kt) {
  const int r = lane & 31, h = lane >> 5;
#pragma unroll
  for (int c = 0; c < 4; ++c) {
    *(LAS u32x4*)(kst + ((lane >> 3) + 8 * c) * KROW + (lane & 7) * 16) = Kc[c];
    *(LAS u32x4*)(vst + ((lane >> 3) + 8 * c) * VROW + (lane & 7) * 16) = Vc[c];
  }
  bf16x8 Kf[4], Vf[2][2];
#pragma unroll
  for (int ks = 0; ks < 4; ++ks) Kf[ks] = *(const LAS bf16x8*)(kst + r * KROW + (2 * ks + h) * 16);
#pragma unroll
  for (int s = 0; s < 2; ++s) { Vf[s][0] = tr_frag(trp + 16 * s * VROW, 8 * VROW); Vf[s][1] = tr_frag(trp + 16 * s * VROW + 64, 8 * VROW); }
  if (kt <= 4) {
    f32x16 S;
#pragma unroll
    for (int i = 0; i < 16; ++i) S[i] = 0.f;
#pragma unroll
    for (int ks = 0; ks < 4; ++ks) S = MFMA32(Kf[ks], QA[ks], S);
    softmax_pv(S, A0, A1, mA, lA, Vf, kt == 0, kt == 4, r, h);
  }
  if (kt >= 1) {
    f32x16 S;
#pragma unroll
    for (int i = 0; i < 16; ++i) S[i] = 0.f;
#pragma unroll
    for (int ks = 0; ks < 4; ++ks) S = MFMA32(Kf[ks], QB[ks], S);
    softmax_pv(S, B0, B1, mB, lB, Vf, kt == 1, kt == 5, r, h);
  }
}

DI void attn_merge(const Params& p, LAS unsigned char* T, const f32x16& O0, const f32x16& O1, const float m, const float l, const int lane,
                   const int tokq0  , const int sh, const int hh, const bool first, const bool last) {
  const int r = lane & 31, h = lane >> 5;
  const int rowc = lane >> 3, ch = lane & 7;
  float lse = m + __log2f(l);
  float w1 = 1.0f / l, w0 = 0.f;
  if (!first) {
#pragma unroll
    for (int c = 0; c < 4; ++c) {
      const size_t tk = (size_t)(tokq0 + ((rowc + 8 * c) << sh));
      *(LAS u32x4*)(T + (rowc + 8 * c) * PT_ROW + ch * 16) = *(const u32x4*)(p.ob + (tk * 8 + hh) * 64 + ch * 8);
    }
    const float lp = p.lseg[(size_t)(tokq0 + (r << sh)) * 8 + hh];
    const float M = fmaxf(lse, lp), e1 = fexp2(lse - M), e0 = fexp2(lp - M), den = e0 + e1, id = 1.0f / den;
    w1 *= e1 * id; w0 = e0 * id; lse = M + __log2f(den);
  }
  LAS unsigned char* ob = T + r * PT_ROW + 8 * h;
#pragma unroll
  for (int dt = 0; dt < 2; ++dt)
#pragma unroll
    for (int g = 0; g < 4; ++g) {
      float f0, f1, f2, f3;
      if (dt == 0) { f0 = O0[4 * g] * w1; f1 = O0[4 * g + 1] * w1; f2 = O0[4 * g + 2] * w1; f3 = O0[4 * g + 3] * w1; }
      else { f0 = O1[4 * g] * w1; f1 = O1[4 * g + 1] * w1; f2 = O1[4 * g + 2] * w1; f3 = O1[4 * g + 3] * w1; }
      LAS u32x2* a = (LAS u32x2*)(ob + 64 * dt + 16 * g);
      if (!first) { const u32x2 pv = *a; f0 += w0 * bflo(pv.x); f1 += w0 * bfhi(pv.x); f2 += w0 * bflo(pv.y); f3 += w0 * bfhi(pv.y); }
      u32x2 wv; wv.x = pack2(f0, f1); wv.y = pack2(f2, f3);
      *a = wv;
    }
  if (!last) {
    if (h == 0) p.lseg[(size_t)(tokq0 + (r << sh)) * 8 + hh] = lse;
#pragma unroll
    for (int c = 0; c < 4; ++c) {
      const size_t tk = (size_t)(tokq0 + ((rowc + 8 * c) << sh));
      *(u32x4*)(p.ob + (tk * 8 + hh) * 64 + ch * 8) = *(const LAS u32x4*)(T + (rowc + 8 * c) * PT_ROW + ch * 16);
    }
  } else {
#pragma unroll
    for (int c = 0; c < 4; ++c) {
      const size_t tk = (size_t)(tokq0 + ((rowc + 8 * c) << sh));
      const u32x4 a = *(const LAS u32x4*)(T + (rowc + 8 * c) * PT_ROW + ch * 16);
      const u32x4 g = *(const u32x4*)(p.proj + tk * NW + OFF_GA + hh * 64 + ch * 8);
      u32x4 w;
      w.x = pack2(bflo(a.x) * silu(bflo(g.x)), bfhi(a.x) * silu(bfhi(g.x)));
      w.y = pack2(bflo(a.y) * silu(bflo(g.y)), bfhi(a.y) * silu(bfhi(g.y)));
      w.z = pack2(bflo(a.z) * silu(bflo(g.z)), bfhi(a.z) * silu(bfhi(g.z)));
      w.w = pack2(bflo(a.w) * silu(bflo(g.w)), bfhi(a.w) * silu(bfhi(g.w)));
      *(u32x4*)(p.mixed + tk * DM + hh * 64 + ch * 8) = w;
    }
  }
}

DI void attn_task2(const Params& p, LAS unsigned char* kst, const int lane, const int tokbase, const int hh,
                   const int sh, const int r_res, const int l0, const bool first, const bool last) {
  const int r = lane & 31, h = lane >> 5;
  const int i16 = lane & 15, q4 = i16 >> 2, pp = i16 & 3, blk = (lane >> 4) & 1;
  LAS unsigned char* vst = kst + KST_W;
  LAS unsigned char* trp = vst + (4 * h + q4) * VROW + 32 * blk + 8 * pp;
  const bf16_t* qpA = p.proj + (size_t)(tokbase + r_res + ((l0 + r) << sh)) * NW + OFF_QA + hh * 64 + 8 * h;
  const bf16_t* qpB = qpA + (size_t)(32 << sh) * NW;
  bf16x8 QA[4], QB[4];
#pragma unroll
  for (int ks = 0; ks < 4; ++ks) { QA[ks] = *(const bf16x8*)(qpA + 16 * ks); QB[ks] = *(const bf16x8*)(qpB + 16 * ks); }
  f32x16 A0, A1, B0, B1;
#pragma unroll
  for (int i = 0; i < 16; ++i) { A0[i] = 0.f; A1[i] = 0.f; B0[i] = 0.f; B1[i] = 0.f; }
  float mA = -1e30f, lA = 0.f, mB = -1e30f, lB = 0.f;
  const int kt0 = (l0 >= 128) ? 0 : (4 - (l0 >> 5));
#define LOAD_KV(Kd, Vd, kt_) do { const int lk0_ = l0 - 128 + 32 * (kt_) + (lane >> 3); \
    _Pragma("unroll") for (int c_ = 0; c_ < 4; ++c_) { \
      const bf16_t* kp_ = p.proj + (size_t)(tokbase + r_res + ((lk0_ + 8 * c_) << sh)) * NW + OFF_KA + hh * 64 + 8 * (lane & 7); \
      Kd[c_] = *(const u32x4*)kp_; Vd[c_] = *(const u32x4*)(kp_ + (OFF_VA - OFF_KA)); } } while (0)
  for (int kt = kt0; kt < 6; kt += 2) {
    u32x4 K0[4], K1[4], V0[4], V1[4];
    LOAD_KV(K0, V0, kt);
    LOAD_KV(K1, V1, kt + 1);
    attn_tile2(K0, V0, QA, QB, A0, A1, mA, lA, B0, B1, mB, lB, kst, vst, trp, lane, kt);
    attn_tile2(K1, V1, QA, QB, A0, A1, mA, lA, B0, B1, mB, lB, kst, vst, trp, lane, kt + 1);
  }
#undef LOAD_KV
  const int tokA = tokbase + r_res + (l0 << sh);
  attn_merge(p, kst, A0, A1, mA, lA, lane, tokA, sh, hh, first, last);
  attn_merge(p, kst, B0, B1, mB, lB, lane, tokA + (32 << sh), sh, hh, first, last);
}

DI void phase_attn(LAS unsigned char* lds, const Params& p, int bid, int nb) {
  const int tid = threadIdx.x, wid = __builtin_amdgcn_readfirstlane(tid >> 6), lane = tid & 63;
  LAS unsigned char* kst = lds + wid * VST_W;
  for (int unit = bid; unit < 256; unit += nb) {
    const int xj = unit >> 3, bhh = (unit & 7) * 8 + (xj >> 2), sp = xj & 3, hh = bhh & 7, b = bhh >> 3;
    const int tokbase = b * SEQ;
    for (int stage = 0; stage < 3; ++stage) {
      const int sh = stage == 0 ? 4 : (stage == 1 ? 2 : 0);
      for (int tk = 0; tk < 2; ++tk) {
        const int idx = wid + 8 * tk;
        int r_res, l0;
        if (stage == 0) { r_res = idx; l0 = 64 * sp; }
        else if (stage == 1) { r_res = idx >> 2; l0 = 256 * sp + 64 * (idx & 3); }
        else { r_res = 0; l0 = 1024 * sp + 64 * idx; }
        attn_task2(p, kst, lane, tokbase, hh, sh, r_res, l0, stage == 0, stage == 2);
      }
      __syncthreads();
    }
  }
}

constexpr int RV_ROW = 320, RK_ROW = 192, RV_OFF = 0, RK_OFF = 128 * RV_ROW  , RRED_OFF = RK_OFF + 128 * RK_ROW  ;

DI void retout_unit(LAS unsigned char* lds, const Params& p, const int u);
DI void phase_retkv(LAS unsigned char* lds, const Params& p, int bid, int nb) {
  const int tid = threadIdx.x, wid = __builtin_amdgcn_readfirstlane(tid >> 6), lane = tid & 63;
  const int r = lane & 31, h = lane >> 5, i16 = lane & 15, q4 = i16 >> 2, pp = i16 & 3, blk = (lane >> 4) & 1;
  const int vt = wid >> 1, dt = wid & 1;
  LAS int* uslot = (LAS int*)(lds + RRED_OFF);
  for (;;) {
    if (tid == 0) *uslot = (int)__hip_atomic_fetch_add(p.bar + 200, 1u, __ATOMIC_RELAXED, __HIP_MEMORY_SCOPE_AGENT);
    __syncthreads();
    const int u = __builtin_amdgcn_readfirstlane(*uslot);
    if (u >= 2048) break;
    if (u >= 1024) { __syncthreads(); retout_unit(lds, p, u - 1024); continue; }
    const int n = u & 31, hh = (u >> 5) & 3, b = u >> 7;
    const float lg = ret_log2g(hh);
    const bf16_t* base = p.proj + (size_t)(b * SEQ + n * 128) * NW;
#pragma unroll
    for (int it = 0; it < 4; ++it) {
      const int c = tid + 512 * it, j = c >> 4, cc = c & 15;
      *(LAS u32x4*)(lds + RV_OFF + j * RV_ROW + cc * 16) = *(const u32x4*)(base + (size_t)j * NW + OFF_VR + hh * 128 + cc * 8);
    }
#pragma unroll
    for (int it = 0; it < 2; ++it) {
      const int c = tid + 512 * it, j = c >> 3, cc = c & 7;
      const u32x4 w = *(const u32x4*)(base + (size_t)j * NW + OFF_KR + hh * 64 + cc * 8);
      const float dk = exp2f((float)(127 - j) * lg);
      u32x4 o;
      o.x = pack2(bflo(w.x) * dk, bfhi(w.x) * dk); o.y = pack2(bflo(w.y) * dk, bfhi(w.y) * dk);
      o.z = pack2(bflo(w.z) * dk, bfhi(w.z) * dk); o.w = pack2(bflo(w.w) * dk, bfhi(w.w) * dk);
      *(LAS u32x4*)(lds + RK_OFF + j * RK_ROW + cc * 16) = o;
    }
    __syncthreads();
    f32x16 acc;
#pragma unroll
    for (int i = 0; i < 16; ++i) acc[i] = 0.f;
    LAS unsigned char* va = lds + RV_OFF + (4 * h + q4) * RV_ROW + (32 * vt + 16 * blk + 4 * pp) * 2;
    LAS unsigned char* ka = lds + RK_OFF + (4 * h + q4) * RK_ROW + (32 * dt + 16 * blk + 4 * pp) * 2;
#pragma unroll
    for (int s = 0; s < 8; ++s) {
      const bf16x8 A = tr_frag(va + 16 * s * RV_ROW, 8 * RV_ROW), B = tr_frag(ka + 16 * s * RK_ROW, 8 * RK_ROW);
      acc = MFMA32(A, B, acc);
    }
    float* o = p.kvT + ((size_t)u << 13) + (32 * vt + 4 * h) * 64 + 32 * dt + r;
#pragma unroll
    for (int i = 0; i < 16; ++i) __hip_atomic_store(o + ((i & 3) + 8 * (i >> 2)) * 64, acc[i], __ATOMIC_RELAXED, __HIP_MEMORY_SCOPE_AGENT);
    asm volatile("s_waitcnt vmcnt(0)" ::: "memory");
    __syncthreads();
    const int bh = u >> 5;
    if (tid == 0) uslot[1] = (__hip_atomic_fetch_add(p.bar + 208 + bh, 1u, __ATOMIC_RELAXED, __HIP_MEMORY_SCOPE_AGENT) == 31u) ? 1 : 0;
    __syncthreads();
    if (__builtin_amdgcn_readfirstlane(uslot[1]) != 0) {
      if (tid == 0) { __builtin_amdgcn_fence(__ATOMIC_ACQUIRE, "agent"); asm volatile("s_waitcnt vmcnt(0)" ::: "memory"); }
      __syncthreads();
      typedef float f32x2 __attribute__((ext_vector_type(2)));
      const float cd = exp2f(128.0f * lg);
      for (int e2 = tid; e2 < 4096; e2 += 512) {
        const int e = e2 * 2;
        f32x2 kr[31];
#pragma unroll
        for (int nn = 0; nn < 31; ++nn) {
          const float* a = p.kvT + ((size_t)(bh * 32 + nn) << 13) + e;
          kr[nn][0] = __hip_atomic_load(a, __ATOMIC_RELAXED, __HIP_MEMORY_SCOPE_AGENT); kr[nn][1] = __hip_atomic_load(a + 1, __ATOMIC_RELAXED, __HIP_MEMORY_SCOPE_AGENT);
        }
        float s0 = 0.f, s1 = 0.f;
#pragma unroll
        for (int nn = 0; nn < 32; ++nn) {
          __hip_atomic_store((unsigned*)(p.stT + ((size_t)(bh * 32 + nn) << 13) + e), pack2(s0, s1), __ATOMIC_RELAXED, __HIP_MEMORY_SCOPE_AGENT);
          if (nn < 31) { s0 = s0 * cd + kr[nn][0]; s1 = s1 * cd + kr[nn][1]; }
        }
      }
      asm volatile("s_waitcnt vmcnt(0)" ::: "memory");
      __syncthreads();
      if (tid == 0) __hip_atomic_store(p.bar + 16 + bh, 1u, __ATOMIC_RELAXED, __HIP_MEMORY_SCOPE_AGENT);
    }
    __syncthreads();
  }
}

constexpr int RKO = 40960, RQO = RKO + 128 * 144, RSO = RQO + 128 * 144, RGO = RSO + 128 * 144, RG_ROW = 272, RRED2 = RGO + 128 * RG_ROW;
DI void retout_unit(LAS unsigned char* lds, const Params& p, const int u) {
  const int tid = threadIdx.x, wid = __builtin_amdgcn_readfirstlane(tid >> 6), lane = tid & 63;
  const int r = lane & 31, h = lane >> 5, i16 = lane & 15, q4 = i16 >> 2, pp = i16 & 3, blk = (lane >> 4) & 1;
  const int it = wid & 3, vh = wid >> 2;
  LAS float* red = (LAS float*)(lds + RRED2);
  {
    if (tid == 0) {
      unsigned spins = 0;
      while (__hip_atomic_load(p.bar + 16 + (u >> 5), __ATOMIC_RELAXED, __HIP_MEMORY_SCOPE_AGENT) == 0u && spins < (1u << 22)) { __builtin_amdgcn_s_sleep(2); ++spins; }
      __builtin_amdgcn_fence(__ATOMIC_ACQUIRE, "agent");
      asm volatile("s_waitcnt vmcnt(0)" ::: "memory");
    }
    __syncthreads();
    const int n = u & 31, hh = (u >> 5) & 3, b = u >> 7;
    const float lg = ret_log2g(hh);
    const int tok0 = b * SEQ + n * 128;
    const bf16_t* base = p.proj + (size_t)tok0 * NW;
    {
      u32x4 tv[4], tg[4], tk[2], tq[2], ts[2];
#pragma unroll
      for (int k = 0; k < 4; ++k) {
        const int c = tid + 512 * k, j = c >> 4, cc = c & 15;
        tv[k] = *(const u32x4*)(base + (size_t)j * NW + OFF_VR + hh * 128 + cc * 8);
        tg[k] = *(const u32x4*)(base + (size_t)j * NW + OFF_GR + hh * 128 + cc * 8);
      }
#pragma unroll
      for (int k = 0; k < 2; ++k) {
        const int c = tid + 512 * k, j = c >> 3, cc = c & 7;
        tk[k] = *(const u32x4*)(base + (size_t)j * NW + OFF_KR + hh * 64 + cc * 8);
        tq[k] = *(const u32x4*)(base + (size_t)j * NW + OFF_QR + hh * 64 + cc * 8);
        ts[k] = *(const u32x4*)(p.stT + ((size_t)u << 13) + (size_t)c * 8);
      }
#pragma unroll
      for (int k = 0; k < 4; ++k) {
        const int c = tid + 512 * k, j = c >> 4, cc = c & 15;
        *(LAS u32x4*)(lds + RV_OFF + j * RV_ROW + cc * 16) = tv[k];
        *(LAS u32x4*)(lds + RGO + j * RG_ROW + cc * 16) = tg[k];
      }
#pragma unroll
      for (int k = 0; k < 2; ++k) {
        const int c = tid + 512 * k, j = c >> 3, cc = c & 7;
        *(LAS u32x4*)(lds + RKO + j * 144 + cc * 16) = tk[k];
        *(LAS u32x4*)(lds + RQO + j * 144 + cc * 16) = tq[k];
        *(LAS u32x4*)(lds + RSO + j * 144 + cc * 16) = ts[k];
      }
    }
    __syncthreads();
    const int qi = 32 * it + r;
    bf16x8 Qf[4];
#pragma unroll
    for (int ks = 0; ks < 4; ++ks) Qf[ks] = *(const LAS bf16x8*)(lds + RQO + qi * 144 + (2 * ks + h) * 16);
    f32x16 O0, O1;
#pragma unroll
    for (int i = 0; i < 16; ++i) { O0[i] = 0.f; O1[i] = 0.f; }
    {
#pragma unroll
      for (int ks = 0; ks < 4; ++ks) {
        const bf16x8 S0 = *(const LAS bf16x8*)(lds + RSO + (64 * vh + r) * 144 + (2 * ks + h) * 16);
        const bf16x8 S1 = *(const LAS bf16x8*)(lds + RSO + (64 * vh + 32 + r) * 144 + (2 * ks + h) * 16);
        O0 = MFMA32(S0, Qf[ks], O0); O1 = MFMA32(S1, Qf[ks], O1);
      }
      const float qd = exp2f((float)(qi + 1) * lg);
#pragma unroll
      for (int i = 0; i < 16; ++i) { O0[i] *= qd; O1[i] *= qd; }
    }
    LAS unsigned char* va = lds + RV_OFF + (4 * h + q4) * RV_ROW + (64 * vh + 16 * blk + 4 * pp) * 2;
    for (int jt = 0; jt <= it; ++jt) {
      f32x16 S;
#pragma unroll
      for (int i = 0; i < 16; ++i) S[i] = 0.f;
#pragma unroll
      for (int ks = 0; ks < 4; ++ks) { const bf16x8 Kf = *(const LAS bf16x8*)(lds + RKO + (32 * jt + r) * 144 + (2 * ks + h) * 16); S = MFMA32(Kf, Qf[ks], S); }
#pragma unroll
      for (int i = 0; i < 16; ++i) {
        const int dj = qi - (32 * jt + (i & 3) + 8 * (i >> 2) + 4 * h);
        S[i] = dj >= 0 ? S[i] * fexp2((float)dj * lg) : 0.f;
      }
#pragma unroll
      for (int s2 = 0; s2 < 2; ++s2) {
        const bf16x8 Pb = pack8(S, s2);
        const bf16x8 V0 = tr_frag(va + (32 * jt + 16 * s2) * RV_ROW, 8 * RV_ROW), V1 = tr_frag(va + (32 * jt + 16 * s2) * RV_ROW + 64, 8 * RV_ROW);
        O0 = MFMA32(V0, Pb, O0);
        O1 = MFMA32(V1, Pb, O1);
      }
    }
    float s1 = 0.f, s2 = 0.f;
#pragma unroll
    for (int i = 0; i < 16; ++i) { s1 += O0[i] + O1[i]; s2 += O0[i] * O0[i] + O1[i] * O1[i]; }
    s1 += __shfl_xor(s1, 32); s2 += __shfl_xor(s2, 32);
    if (h == 0) { red[(vh * 128 + qi) * 2] = s1; red[(vh * 128 + qi) * 2 + 1] = s2; }
    __syncthreads();
    s1 += red[((vh ^ 1) * 128 + qi) * 2]; s2 += red[((vh ^ 1) * 128 + qi) * 2 + 1];
    const float mu = s1 * (1.0f / 128.0f), var = fmaxf(s2 * (1.0f / 128.0f) - mu * mu, 0.f), rs = rsqrtf(var + 1e-5f);
    const float* gnp = p.gn + hh * 128 + 64 * vh + 4 * h;
    LAS unsigned char* gt = lds + RGO + qi * RG_ROW + (64 * vh + 4 * h) * 2;
#pragma unroll
    for (int dt = 0; dt < 2; ++dt)
#pragma unroll
      for (int g = 0; g < 4; ++g) {
        const int vo = 32 * dt + 8 * g;
        LAS u32x2* ga = (LAS u32x2*)(gt + vo * 2);
        const u32x2 gwv = *ga;
        const f32x4 gnv = *(const f32x4*)(gnp + vo);
        float f0, f1, f2, f3;
        if (dt == 0) { f0 = O0[4 * g]; f1 = O0[4 * g + 1]; f2 = O0[4 * g + 2]; f3 = O0[4 * g + 3]; }
        else { f0 = O1[4 * g]; f1 = O1[4 * g + 1]; f2 = O1[4 * g + 2]; f3 = O1[4 * g + 3]; }
        f0 = (f0 - mu) * rs * gnv[0] * silu(bflo(gwv.x)); f1 = (f1 - mu) * rs * gnv[1] * silu(bfhi(gwv.x));
        f2 = (f2 - mu) * rs * gnv[2] * silu(bflo(gwv.y)); f3 = (f3 - mu) * rs * gnv[3] * silu(bfhi(gwv.y));
        u32x2 wv; wv.x = pack2(f0, f1); wv.y = pack2(f2, f3);
        *ga = wv;
      }
    __syncthreads();
#pragma unroll
    for (int k = 0; k < 4; ++k) {
      const int c = tid + 512 * k, j = c >> 4, cc = c & 15;
      *(u32x4*)(p.mixed + (size_t)(tok0 + j) * DM + 512 + hh * 128 + cc * 8) = *(const LAS u32x4*)(lds + RGO + j * RG_ROW + cc * 16);
    }
    __syncthreads();
  }
}

DI void grid_barrier(unsigned* ctr, unsigned target) {
  asm volatile("s_waitcnt vmcnt(0) lgkmcnt(0)" ::: "memory");
  __syncthreads();
  if (threadIdx.x == 0) {
    __builtin_amdgcn_fence(__ATOMIC_RELEASE, "agent");
    asm volatile("s_waitcnt vmcnt(0)" ::: "memory");
    __hip_atomic_fetch_add(ctr, 1u, __ATOMIC_RELAXED, __HIP_MEMORY_SCOPE_AGENT);
    unsigned spins = 0;
    while (__hip_atomic_load(ctr, __ATOMIC_RELAXED, __HIP_MEMORY_SCOPE_AGENT) < target && spins < (1u << 22)) { __builtin_amdgcn_s_sleep(2); ++spins; }
    __builtin_amdgcn_fence(__ATOMIC_ACQUIRE, "agent");
    asm volatile("s_waitcnt vmcnt(0)" ::: "memory");
  }
  __syncthreads();
}

__global__ void __launch_bounds__(512) k_mega(Params p) {
  extern __shared__ __attribute__((aligned(16))) unsigned char shm_[];
  LAS unsigned char* shm = (LAS unsigned char*)shm_;
  const int bid = blockIdx.x, nb = gridDim.x;
  unsigned bar_n = 0;
#ifdef PROBE_PHASE
#ifndef PROBE_BLK
#define PROBE_BLK 0
#endif
  unsigned long long ts_a = 0, ts_b = 0; int ph_i = 0;
  if (PROBE_PHASE == 0) ts_a = __builtin_amdgcn_s_memrealtime();
#define GRID_BAR() do { bar_n += (unsigned)nb; grid_barrier(p.bar, bar_n); ++ph_i; if (ph_i == PROBE_PHASE) ts_a = __builtin_amdgcn_s_memrealtime(); if (ph_i == PROBE_PHASE + 1) ts_b = __builtin_amdgcn_s_memrealtime(); } while (0)
#else
#define GRID_BAR() do { bar_n += (unsigned)nb; grid_barrier(p.bar, bar_n); } while (0)
#endif
  phase_prep(p, bid, nb);
  GRID_BAR();
  phase_gemm<1>(shm, p, bid, nb);
  GRID_BAR();
  phase_attn(shm, p, bid, nb);
#ifdef PROBE_SUB
  ts_b = __builtin_amdgcn_s_memrealtime(); ph_i = 100;
#endif
  phase_retkv(shm, p, bid, nb);
  GRID_BAR();
  phase_gemm<2>(shm, p, bid, nb);
#ifdef PROBE_PHASE
  if (PROBE_PHASE == 3) ts_b = __builtin_amdgcn_s_memrealtime();
  if (bid == PROBE_BLK && threadIdx.x == 0) {
    const unsigned long long until = __builtin_amdgcn_s_memrealtime() + 9ull * (ts_b - ts_a);
    while (__builtin_amdgcn_s_memrealtime() < until) __builtin_amdgcn_s_sleep(8);
  }
#endif
}

extern "C" void kernel_launch(void* const* d_in, const int* in_sizes, int n_in, void* d_out, int out_size, void* d_ws, size_t ws_size, hipStream_t stream) {
  Params p{};
  p.x = (const float*)d_in[0]; p.ng = (const float*)d_in[1]; p.w_in = (const float*)d_in[2]; p.gn = (const float*)d_in[3];
  p.w_out = (const float*)d_in[4]; p.fg = (const float*)d_in[5];
  p.out = (float*)d_out;
  char* w = (char*)d_ws; size_t o = 0;
  auto take = [&](size_t bytes) { char* r = w + o; o += (bytes + 255) & ~(size_t)255; return r; };
  p.xb = (bf16_t*)take((size_t)T_TOK * DM * 2);
  p.proj = (bf16_t*)take((size_t)T_TOK * NW * 2);
  p.mixed = (bf16_t*)take((size_t)T_TOK * DM * 2);
  p.winT = (bf16_t*)take((size_t)NW * DM * 2);
  p.woutT = (bf16_t*)take((size_t)DM * DM * 2);
  p.rstd = (float*)take((size_t)T_TOK * 4);
  p.rowss = (float*)take((size_t)T_TOK * 4);
  p.ropeT = (float2*)take((size_t)SEQ * 32 * 8);
  p.retT = (float2*)take((size_t)SEQ * 32 * 8);
  p.kvT = (float*)take((size_t)1024 * 8192 * 4);
  p.stT = (bf16_t*)take((size_t)1024 * 8192 * 2);
  p.bar = (unsigned*)take(1024);
  p.ob = (bf16_t*)take((size_t)T_TOK * 512 * 2);
  p.lseg = (float*)take((size_t)T_TOK * 8 * 4);
  static int grid_blocks = 0;
  if (!grid_blocks) {
    (void)hipFuncSetAttribute((const void*)k_mega, hipFuncAttributeMaxDynamicSharedMemorySize, ATTN_LDS);
    int dev = 0, cus = 0, per_cu = 0;
    (void)hipGetDevice(&dev);
    (void)hipDeviceGetAttribute(&cus, hipDeviceAttributeMultiprocessorCount, dev);
    (void)hipOccupancyMaxActiveBlocksPerMultiprocessor(&per_cu, k_mega, 512, ATTN_LDS);
    if (per_cu < 1) per_cu = 1;
    grid_blocks = cus;
  }
  (void)hipMemsetAsync(p.bar, 0, 1024, stream);
  hipLaunchKernelGGL(k_mega, dim3(grid_blocks), dim3(512), ATTN_LDS, stream, p);
}
```

```cpp
#include <hip/hip_runtime.h>
#include <hip/hip_cooperative_groups.h>
#include <cstdint>
#include <cstdio>
namespace cg = cooperative_groups;

typedef unsigned short bf16_t;
typedef short bf16x8 __attribute__((ext_vector_type(8)));
typedef float f32x4 __attribute__((ext_vector_type(4)));
typedef unsigned u32x4 __attribute__((ext_vector_type(4)));
typedef unsigned u32x2 __attribute__((ext_vector_type(2)));

constexpr int T_TOK = 32768, DM = 1024, NW = 3584, SEQ = 4096;
constexpr int OFF_QA = 0, OFF_KA = 512, OFF_VA = 1024, OFF_GA = 1536, OFF_QR = 2048, OFF_KR = 2304, OFF_VR = 2560, OFF_GR = 3072;

struct Params {
  const float* x; const float* ng; const float* w_in; const float* gn; const float* w_out; const float* fg;
  float* out;
  bf16_t* xb; bf16_t* proj; bf16_t* mixed; bf16_t* winT; bf16_t* woutT;
  float* rstd; float* rowss; float2* ropeT; float2* retT; float* kvT; bf16_t* stT; unsigned* bar; bf16_t* ob; float* lseg;
};

#define DI __device__ __forceinline__
DI unsigned short f2bf(float x) { unsigned u = __float_as_uint(x); u += 0x7fffu + ((u >> 16) & 1u); return (unsigned short)(u >> 16); }
DI float bf2f(unsigned short b) { return __uint_as_float(((unsigned)b) << 16); }
typedef float f32x2_t __attribute__((ext_vector_type(2)));
typedef __bf16 bf16x2_t __attribute__((ext_vector_type(2)));
DI unsigned pack2(float lo, float hi) { const f32x2_t v = {lo, hi}; return __builtin_bit_cast(unsigned, __builtin_convertvector(v, bf16x2_t)); }
DI float bflo(unsigned w) { return __uint_as_float(w << 16); }
DI float bfhi(unsigned w) { return __uint_as_float(w & 0xffff0000u); }
DI int perm32(int rho) { const int n = rho >> 4, i = rho & 15; return 8 * (i >> 2) + 4 * n + (i & 3); }
DI int cmap(int p) { return (p & ~31) + perm32(p & 31); }
DI int cmapA(int p) { return (p & ~127) + ((p >> 6) & 1) * 64 + ((p >> 4) & 1) * 32 + ((p >> 5) & 1) * 16 + (p & 15); }

DI void phase_prep(const Params& p, int bid, int nb) {
  const int tid = threadIdx.x, lane = tid & 63, wid = tid >> 6, nw = blockDim.x >> 6;
  if (wid < 6)
  for (int row0 = (bid * 6 + wid) * 4; row0 < T_TOK; row0 += nb * 6 * 4) {
    f32x4 v[4][4];
#pragma unroll
    for (int rr = 0; rr < 4; ++rr)
#pragma unroll
      for (int it = 0; it < 4; ++it) v[rr][it] = __builtin_nontemporal_load((const f32x4*)(p.x + (size_t)(row0 + rr) * DM + it * 256 + lane * 4));
#pragma unroll
    for (int rr = 0; rr < 4; ++rr) {
      float ss = 0.f;
#pragma unroll
      for (int it = 0; it < 4; ++it) ss += v[rr][it][0] * v[rr][it][0] + v[rr][it][1] * v[rr][it][1] + v[rr][it][2] * v[rr][it][2] + v[rr][it][3] * v[rr][it][3];
#pragma unroll
      for (int o = 32; o >= 1; o >>= 1) ss += __shfl_xor(ss, o);
#pragma unroll
      for (int it = 0; it < 4; ++it) { u32x2 w; w.x = pack2(v[rr][it][0], v[rr][it][1]); w.y = pack2(v[rr][it][2], v[rr][it][3]); *(u32x2*)(p.xb + (size_t)(row0 + rr) * DM + it * 256 + lane * 4) = w; }
      if (lane == 0) p.rstd[row0 + rr] = rsqrtf(ss * (1.0f / DM) + 1e-6f);
    }
  }
  if (wid < 6) return;
  const int gt = bid * 128 + (tid - 384), gn = nb * 128;
  for (int idx = gt; idx < (NW / 4) * 128; idx += gn) {
    const int p4 = idx % (NW / 4), kc = idx / (NW / 4), pp = p4 * 4, c = pp < 1024 ? cmapA(pp) : cmap(pp);
    f32x4 f[8];
#pragma unroll
    for (int j = 0; j < 8; ++j) { const int k = kc * 8 + j; f[j] = *(const f32x4*)(p.w_in + (size_t)k * NW + c) * p.ng[k]; }
#pragma unroll
    for (int e = 0; e < 4; ++e) {
      u32x4 w; w.x = pack2(f[0][e], f[1][e]); w.y = pack2(f[2][e], f[3][e]); w.z = pack2(f[4][e], f[5][e]); w.w = pack2(f[6][e], f[7][e]);
      *(u32x4*)(p.winT + (size_t)(pp + e) * DM + kc * 8) = w;
    }
  }
  for (int idx = gt; idx < (DM / 4) * 128; idx += gn) {
    const int p4 = idx % (DM / 4), kc = idx / (DM / 4), pp = p4 * 4, c = cmap(pp);
    f32x4 f[8];
#pragma unroll
    for (int j = 0; j < 8; ++j) { const int k = kc * 8 + j; f[j] = *(const f32x4*)(p.w_out + (size_t)k * DM + c); }
#pragma unroll
    for (int e = 0; e < 4; ++e) {
      u32x4 w; w.x = pack2(f[0][e], f[1][e]); w.y = pack2(f[2][e], f[3][e]); w.z = pack2(f[4][e], f[5][e]); w.w = pack2(f[6][e], f[7][e]);
      *(u32x4*)(p.woutT + (size_t)(pp + e) * DM + kc * 8) = w;
    }
  }
  for (int idx = gt; idx < SEQ * 32; idx += gn) {
    const int pos = idx >> 5, i = idx & 31;
    const float inv1 = powf(10000.0f, -(float)i / 32.0f);
    const float inv2 = 1.0f / powf(10000.0f, (float)i / 31.0f);
    const float a1 = (float)pos * inv1, a2 = (float)pos * inv2;
    p.ropeT[idx] = make_float2(cosf(a1), sinf(a1));
    p.retT[idx] = make_float2(cosf(a2), sinf(a2));
  }
}

constexpr int BM = 256, BK = 64, HALF = 128, HT = HALF * BK;
constexpr int GEMM_LDS = 8 * HT * 2;
DI int lds_byte(int r, int c) { int st = (r >> 4) * 2 + (c >> 5), rr = r & 15, cc = c & 31, ob = rr * 64 + cc * 2; return st * 1024 + (ob ^ (((ob >> 9) & 1) << 5)); }
DI void stage_rc(int b, int& R, int& C) { int st = b / 1024, sb = b % 1024, swz = sb ^ (((sb >> 9) & 1) << 5); R = (st >> 1) * 16 + swz / 64; C = (st & 1) * 32 + (swz % 64) / 2; }

#define LAS __attribute__((address_space(3)))
template <int EPI>
DI void gemm_epi(LAS unsigned char* lds, f32x4 (&acc)[2][2][4][2], const int brow, const int bcol, const Params& p) {
  const int tid = threadIdx.x, wid = __builtin_amdgcn_readfirstlane(tid >> 6), lane = tid & 63, wr = wid >> 2, wc = wid & 3, fr = lane & 15, fq = lane >> 4;
  if (EPI == 1) {
    const int pn = bcol >> 8;
    if (pn < 4) {
      const float sc = pn < 2 ? 0.125f * 1.4426950408889634f : 1.0f;
      const int i0 = 16 * (wc & 1) + 4 * fq;
#pragma unroll
      for (int ai = 0; ai < 2; ++ai)
#pragma unroll
        for (int m = 0; m < 4; ++m) {
          const int row = brow + ai * HALF + wr * 64 + m * 16 + fr;
          const float rs = p.rstd[row] * sc;
          const float* tb = (const float*)(p.ropeT + (row & (SEQ - 1)) * 32 + i0);
          const f32x4 t0 = *(const f32x4*)tb, t1 = *(const f32x4*)(tb + 4);
#pragma unroll
          for (int bj = 0; bj < 2; ++bj) {
            const f32x4 x1 = acc[ai][bj][m][0] * rs, x2 = acc[ai][bj][m][1] * rs;
            u32x2 wa, wb;
            wa.x = pack2(x1[0] * t0[0] - x2[0] * t0[1], x1[1] * t0[2] - x2[1] * t0[3]);
            wa.y = pack2(x1[2] * t1[0] - x2[2] * t1[1], x1[3] * t1[2] - x2[3] * t1[3]);
            wb.x = pack2(x2[0] * t0[0] + x1[0] * t0[1], x2[1] * t0[2] + x1[1] * t0[3]);
            wb.y = pack2(x2[2] * t1[0] + x1[2] * t1[1], x2[3] * t1[2] + x1[3] * t1[3]);
            bf16_t* o = p.proj + (size_t)row * NW + bcol + bj * HALF + (wc >> 1) * 64 + i0;
            *(u32x2*)o = wa; *(u32x2*)(o + 32) = wb;
          }
        }
    } else if (pn == 8 || pn == 9) {
      const float sc = pn == 9 ? 0.125f : 1.0f;
      const int i0 = 16 * (wc & 1) + 4 * fq;
#pragma unroll
      for (int ai = 0; ai < 2; ++ai)
#pragma unroll
        for (int m = 0; m < 4; ++m) {
          const int row = brow + ai * HALF + wr * 64 + m * 16 + fr;
          const float rs = p.rstd[row] * sc;
          const float* tb = (const float*)(p.retT + (row & (SEQ - 1)) * 32 + i0);
          const f32x4 t0 = *(const f32x4*)tb, t1 = *(const f32x4*)(tb + 4);
#pragma unroll
          for (int bj = 0; bj < 2; ++bj) {
            const f32x4 v0 = acc[ai][bj][m][0] * rs, v1 = acc[ai][bj][m][1] * rs;
            u32x4 w;
            w.x = pack2(v0[0] * t0[0] - v0[1] * t0[1], v0[1] * t0[0] + v0[0] * t0[1]);
            w.y = pack2(v0[2] * t0[2] - v0[3] * t0[3], v0[3] * t0[2] + v0[2] * t0[3]);
            w.z = pack2(v1[0] * t1[0] - v1[1] * t1[1], v1[1] * t1[0] + v1[0] * t1[1]);
            w.w = pack2(v1[2] * t1[2] - v1[3] * t1[3], v1[3] * t1[2] + v1[2] * t1[3]);
            *(u32x4*)(p.proj + (size_t)row * NW + bcol + bj * HALF + wc * 32 + 8 * fq) = w;
          }
        }
    } else {
#pragma unroll
    for (int ai = 0; ai < 2; ++ai)
#pragma unroll
      for (int m = 0; m < 4; ++m) {
        const int row = brow + ai * HALF + wr * 64 + m * 16 + fr;
        const float rs = p.rstd[row];
#pragma unroll
        for (int bj = 0; bj < 2; ++bj) {
          const f32x4 v0 = acc[ai][bj][m][0] * rs, v1 = acc[ai][bj][m][1] * rs;
          u32x4 w; w.x = pack2(v0[0], v0[1]); w.y = pack2(v0[2], v0[3]); w.z = pack2(v1[0], v1[1]); w.w = pack2(v1[2], v1[3]);
          *(u32x4*)(p.proj + (size_t)row * NW + bcol + bj * HALF + wc * 32 + 8 * fq) = w;
        }
      }
    }
  } else {
    const int pm = brow >> 8, pn = bcol >> 8;
    LAS float* part = (LAS float*)(lds + GEMM_LDS);
    LAS float* rsl = (LAS float*)(lds + GEMM_LDS + 4096);
#pragma unroll
    for (int ai = 0; ai < 2; ++ai)
#pragma unroll
      for (int m = 0; m < 4; ++m) {
        const int rl = ai * HALF + wr * 64 + m * 16 + fr;
        float ss = 0.f;
#pragma unroll
        for (int bj = 0; bj < 2; ++bj) {
          const size_t off = (size_t)(brow + rl) * DM + bcol + bj * HALF + wc * 32 + 8 * fq;
          const f32x4 x0 = __builtin_nontemporal_load((const f32x4*)(p.x + off)), x1 = __builtin_nontemporal_load((const f32x4*)(p.x + off + 4));
          const f32x4 y0 = acc[ai][bj][m][0] + x0, y1 = acc[ai][bj][m][1] + x1;
          acc[ai][bj][m][0] = y0; acc[ai][bj][m][1] = y1;
          ss += y0[0] * y0[0] + y0[1] * y0[1] + y0[2] * y0[2] + y0[3] * y0[3] + y1[0] * y1[0] + y1[1] * y1[1] + y1[2] * y1[2] + y1[3] * y1[3];
        }
        ss += __shfl_xor(ss, 16); ss += __shfl_xor(ss, 32);
        if (fq == 0) part[wc * 256 + rl] = ss;
      }
    __syncthreads();
    float* xs = p.rowss + (size_t)(pm * 4) * 256;
    if (tid < 256) {
      const float tot = part[tid] + part[256 + tid] + part[512 + tid] + part[768 + tid];
      __hip_atomic_store(xs + pn * 256 + tid, tot, __ATOMIC_RELAXED, __HIP_MEMORY_SCOPE_AGENT);
    }
    asm volatile("s_waitcnt vmcnt(0)" ::: "memory");
    __syncthreads();
    unsigned* cnt = p.bar + 64 + pm;
    if (tid == 0) __hip_atomic_fetch_add(cnt, 1u, __ATOMIC_RELAXED, __HIP_MEMORY_SCOPE_AGENT);
    if (wid == 0) {
      unsigned spins = 0;
      while (__hip_atomic_load(cnt, __ATOMIC_RELAXED, __HIP_MEMORY_SCOPE_AGENT) < 4u && spins < (1u << 20)) { __builtin_amdgcn_s_sleep(1); ++spins; }
      __builtin_amdgcn_fence(__ATOMIC_ACQUIRE, "agent");
      asm volatile("s_waitcnt vmcnt(0)" ::: "memory");
    }
    __syncthreads();
    if (tid < 256) {
      float t = 0.f;
#pragma unroll
      for (int q = 0; q < 4; ++q) t += __hip_atomic_load(xs + q * 256 + tid, __ATOMIC_RELAXED, __HIP_MEMORY_SCOPE_AGENT);
      rsl[tid] = rsqrtf(t * (1.0f / DM) + 1e-6f);
    }
    __syncthreads();
#pragma unroll
    for (int ai = 0; ai < 2; ++ai)
#pragma unroll
      for (int m = 0; m < 4; ++m) {
        const int rl = ai * HALF + wr * 64 + m * 16 + fr;
        const float rs = rsl[rl];
#pragma unroll
        for (int bj = 0; bj < 2; ++bj) {
          const int col = bcol + bj * HALF + wc * 32 + 8 * fq;
          const f32x4 g0 = *(const f32x4*)(p.fg + col), g1 = *(const f32x4*)(p.fg + col + 4);
          float* o = p.out + (size_t)(brow + rl) * DM + col;
          __builtin_nontemporal_store(acc[ai][bj][m][0] * rs * g0, (f32x4*)o); __builtin_nontemporal_store(acc[ai][bj][m][1] * rs * g1, (f32x4*)(o + 4));
        }
      }
    __syncthreads();
  }
}

DI void tile_of(int L, int nM, int nN, int& pm, int& pn) {
  const int nwg = nM * nN, NX = 8, WGM = 8;
  int wgid = L; { const int q = nwg / NX, r = nwg % NX, xcd = wgid % NX, off = wgid / NX; wgid = (xcd < r ? xcd * (q + 1) : r * (q + 1) + (xcd - r) * q) + off; }
  const int nig = WGM * nN, gid = wgid / nig, fm = gid * WGM, gsz = (nM - fm) < WGM ? (nM - fm) : WGM;
  pm = fm + ((wgid % nig) % gsz); pn = (wgid % nig) / gsz;
}


template <int EPI>
DI void phase_gemm(LAS unsigned char* lds, const Params& p, int bid, int nb) {
  constexpr int K = 1024, nt = K / BK, HTB = HALF * BK * 2;
  const bf16_t* A = EPI == 1 ? p.xb : p.mixed; const bf16_t* Bt = EPI == 1 ? p.winT : p.woutT;
  const int nM = T_TOK / BM, nN = (EPI == 1 ? NW : DM) / BM, nT = nM * nN;
  const int tid = threadIdx.x, wid = __builtin_amdgcn_readfirstlane(tid >> 6), lane = tid & 63, wr = wid >> 2, wc = wid & 3, fr = lane & 15, fq = lane >> 4;
  unsigned voff[2];
#pragma unroll
  for (int i = 0; i < 2; ++i) { int R, C; stage_rc(tid * 16 + i * 8192, R, C); voff[i] = (unsigned)(R * K + C) * 2u; }
  const unsigned ldsw = (unsigned)wid * 1024u;
  const int aoff = lds_byte(wr * 64 + fr, fq * 8), boff = lds_byte(wc * 32 + fr, fq * 8);
  const size_t kstep = (size_t)(BK * 2), hstep = (size_t)HALF * K * 2, tstep = 2 * hstep;
#define SAo(b, h) (((b) * 2 + (h)) * HTB)
#define SBo(b, h) ((4 + (b) * 2 + (h)) * HTB)
#define STAGEP(bufoff, gptr) do { _Pragma("unroll") for (int _i = 0; _i < 2; ++_i) \
    __builtin_amdgcn_global_load_lds((const unsigned*)((gptr) + voff[_i]), (LAS unsigned*)(lds + (bufoff) + ldsw + _i * 8192), 16, 0, 0); } while (0)
#define LDA(dst, b, h) do { _Pragma("unroll") for (int m = 0; m < 4; ++m) _Pragma("unroll") for (int k = 0; k < 2; ++k) \
    dst[m][k] = *(const LAS bf16x8*)(lds + SAo(b, h) + aoff + m * 2048 + k * 1024); } while (0)
#define LDB(dst, b, h) do { _Pragma("unroll") for (int n = 0; n < 2; ++n) _Pragma("unroll") for (int k = 0; k < 2; ++k) \
    dst[n][k] = *(const LAS bf16x8*)(lds + SBo(b, h) + boff + n * 2048 + k * 1024); } while (0)
#define MMA(ai, bj, At, Bt_) do { __builtin_amdgcn_s_setprio(1); \
    _Pragma("unroll") for (int m = 0; m < 4; ++m) _Pragma("unroll") for (int n = 0; n < 2; ++n) _Pragma("unroll") for (int k = 0; k < 2; ++k) \
      acc[ai][bj][m][n] = __builtin_amdgcn_mfma_f32_16x16x32_bf16(Bt_[n][k], At[m][k], acc[ai][bj][m][n], 0, 0, 0); \
    __builtin_amdgcn_s_setprio(0); } while (0)
#define WAIT_V(n) asm volatile("s_waitcnt vmcnt(" #n ")" ::: "memory")
#define WAIT_L(n) asm volatile("s_waitcnt lgkmcnt(" #n ")" ::: "memory")
#define BAR __builtin_amdgcn_s_barrier()
#define SCHED __builtin_amdgcn_sched_barrier(0)
  int L = bid;
  if (L >= nT) return;
  int pm, pn; tile_of(L, nM, nN, pm, pn);
  f32x4 acc[2][2][4][2];
#pragma unroll
  for (int a = 0; a < 2; ++a)
#pragma unroll
    for (int b = 0; b < 2; ++b)
#pragma unroll
      for (int m = 0; m < 4; ++m)
#pragma unroll
        for (int n = 0; n < 2; ++n) acc[a][b][m][n] = (f32x4){0.f, 0.f, 0.f, 0.f};
  bf16x8 At[4][2], B0[2][2], B1[2][2];
  const char* cA = (const char*)A + (size_t)pm * tstep; const char* cB = (const char*)Bt + (size_t)pn * tstep;
  WAIT_V(0);
  STAGEP(SBo(0, 0), cB); STAGEP(SBo(0, 1), cB + hstep); STAGEP(SAo(0, 0), cA); STAGEP(SAo(0, 1), cA + hstep);
  if (wr == 1) BAR;
  WAIT_V(2); BAR;
  STAGEP(SBo(1, 0), cB + kstep); STAGEP(SAo(1, 0), cA + kstep); STAGEP(SBo(1, 1), cB + hstep + kstep);
  WAIT_V(6); BAR;
  for (;;) {
    const bool has_next = (L + nb < nT);
    int npm = pm, npn = pn;
    if (has_next) tile_of(L + nb, nM, nN, npm, npn);
    const char* nA = (const char*)A + (size_t)npm * tstep; const char* nB = (const char*)Bt + (size_t)npn * tstep;
    for (int t = 0; t < nt; t += 2) {
      const bool last = (t == nt - 2);
      const char* a1 = cA + (size_t)(t + 1) * kstep;
      const char* a2 = last ? nA : cA + (size_t)(t + 2) * kstep; const char* b2 = last ? nB : cB + (size_t)(t + 2) * kstep;
      const char* a3 = a2 + kstep; const char* b3 = b2 + kstep;
      LDB(B0, 0, 0); LDB(B1, 0, 1); SCHED; LDA(At, 0, 0); STAGEP(SAo(1, 1), a1 + hstep);
      WAIT_V(8); WAIT_L(0); BAR; MMA(0, 0, At, B0); MMA(0, 1, At, B1); BAR; SCHED;
      LDA(At, 0, 1); STAGEP(SBo(0, 0), b2); STAGEP(SBo(0, 1), b2 + hstep); STAGEP(SAo(0, 0), a2);
      WAIT_V(8); WAIT_L(0); BAR; MMA(1, 0, At, B0); MMA(1, 1, At, B1); BAR; SCHED;
      LDB(B0, 1, 0); LDB(B1, 1, 1); SCHED; LDA(At, 1, 0); STAGEP(SAo(0, 1), a2 + hstep);
      WAIT_V(8); WAIT_L(0); BAR; MMA(0, 0, At, B0); MMA(0, 1, At, B1); BAR; SCHED;
      LDA(At, 1, 1); STAGEP(SBo(1, 0), b3); STAGEP(SBo(1, 1), b3 + hstep); STAGEP(SAo(1, 0), a3);
      WAIT_V(8); WAIT_L(0); BAR; MMA(1, 0, At, B0); MMA(1, 1, At, B1); BAR; SCHED;
    }
    if (wr == 0) BAR;
    gemm_epi<EPI>(lds, acc, pm * BM, pn * BM, p);
    if (!has_next) break;
#pragma unroll
    for (int a = 0; a < 2; ++a)
#pragma unroll
      for (int b = 0; b < 2; ++b)
#pragma unroll
        for (int m = 0; m < 4; ++m)
#pragma unroll
          for (int n = 0; n < 2; ++n) acc[a][b][m][n] = (f32x4){0.f, 0.f, 0.f, 0.f};
    pm = npm; pn = npn; cA = nA; cB = nB; L += nb;
    if (wr == 1) BAR;
  }
  WAIT_V(0);
  BAR;
}

DI float ret_log2g(int h) { return log2f(1.0f - exp2f(-5.0f - (float)h)); }

typedef float f32x16 __attribute__((ext_vector_type(16)));
typedef short s16x4 __attribute__((ext_vector_type(4)));
#define MFMA32(a, b, c) __builtin_amdgcn_mfma_f32_32x32x16_bf16((a), (b), (c), 0, 0, 0)
DI s16x4 tr_read(LAS unsigned char* a) { return __builtin_amdgcn_ds_read_tr16_b64_v4i16((LAS s16x4*)a); }
DI bf16x8 tr_frag(LAS unsigned char* a, int rowstride8) {
  const s16x4 lo = tr_read(a), hi = tr_read(a + rowstride8);
  return __builtin_shufflevector(lo, hi, 0, 1, 2, 3, 4, 5, 6, 7);
}
DI bf16x8 pack8(const f32x16& x, int s) {
  u32x4 w;
  w.x = pack2(x[8 * s + 0], x[8 * s + 1]); w.y = pack2(x[8 * s + 2], x[8 * s + 3]); w.z = pack2(x[8 * s + 4], x[8 * s + 5]); w.w = pack2(x[8 * s + 6], x[8 * s + 7]);
  return __builtin_bit_cast(bf16x8, w);
}
DI float fexp2(float x) { return __builtin_amdgcn_exp2f(x); }
DI float half_max(float x) { const u32x2 r = __builtin_amdgcn_permlane32_swap(__float_as_uint(x), __float_as_uint(x), false, false); return fmaxf(__uint_as_float(r[0]), __uint_as_float(r[1])); }
DI float half_sum(float x) { const u32x2 r = __builtin_amdgcn_permlane32_swap(__float_as_uint(x), __float_as_uint(x), false, false); return __uint_as_float(r[0]) + __uint_as_float(r[1]); }
DI float silu(float g) { return g * __builtin_amdgcn_rcpf(1.0f + __builtin_amdgcn_exp2f(-1.4426950408889634f * g)); }

constexpr int AT_ROWB = 136, AT_LS = 512 * AT_ROWB, AT_VST = AT_LS + 2048, VROW = 192, KROW = 144, KST_W = 32 * KROW, VST_W = KST_W + 32 * VROW;
constexpr int ATTN_LDS = AT_VST + 8 * VST_W;
constexpr float LOG2E = 1.4426950408889634f;

constexpr int PT_ROW = 136;

DI void softmax_pv(f32x16& S, f32x16& O0, f32x16& O1, float& m, float& l, const bf16x8 (&Vf)[2][2], const bool mlow, const bool mhigh, const int r, const int h) {
  if (mlow || mhigh) {
#pragma unroll
    for (int i = 0; i < 16; ++i) {
      const int keyrow = (i & 3) + 8 * (i >> 2) + 4 * h;
      const bool bad = (mlow && keyrow < r) || (mhigh && keyrow > r);
      S[i] = bad ? -1e30f : S[i];
    }
  }
  float mx = fmaxf(S[0], S[1]);
#pragma unroll
  for (int i = 2; i < 16; ++i) mx = fmaxf(mx, S[i]);
  mx = half_max(mx);
  const float mn = fmaxf(m, mx);
  if (__builtin_amdgcn_ballot_w64(mn > m) != 0ull) {
    const float al = fexp2(m - mn);
    l *= al;
#pragma unroll
    for (int i = 0; i < 16; ++i) { O0[i] *= al; O1[i] *= al; }
    m = mn;
  }
  float ps = 0.f;
#pragma unroll
  for (int i = 0; i < 16; ++i) { S[i] = fexp2(S[i] - mn); ps += S[i]; }
  l += half_sum(ps);
#pragma unroll
  for (int s = 0; s < 2; ++s) {
    const bf16x8 Pb = pack8(S, s);
    O0 = MFMA32(Vf[s][0], Pb, O0);
    O1 = MFMA32(Vf[s][1], Pb, O1);
  }
}

DI void attn_tile2(const u32x4 (&Kc)[4], const u32x4 (&Vc)[4], const bf16x8 (&QA)[4], const bf16x8 (&QB)[4],
                   f32x16& A0, f32x16& A1, float& mA, float& lA, f32x16& B0, f32x16& B1, float& mB, float& lB,
                   LAS unsigned char* kst, LAS unsigned char* vst, LAS unsigned char* trp, const int lane, const int kt) {
  const int r = lane & 31, h = lane >> 5;
#pragma unroll
  for (int c = 0; c < 4; ++c) {
    *(LAS u32x4*)(kst + ((lane >> 3) + 8 * c) * KROW + (lane & 7) * 16) = Kc[c];
    *(LAS u32x4*)(vst + ((lane >> 3) + 8 * c) * VROW + (lane & 7) * 16) = Vc[c];
  }
  bf16x8 Kf[4], Vf[2][2];
#pragma unroll
  for (int ks = 0; ks < 4; ++ks) Kf[ks] = *(const LAS bf16x8*)(kst + r * KROW + (2 * ks + h) * 16);
#pragma unroll
  for (int s = 0; s < 2; ++s) { Vf[s][0] = tr_frag(trp + 16 * s * VROW, 8 * VROW); Vf[s][1] = tr_frag(trp + 16 * s * VROW + 64, 8 * VROW); }
  if (kt <= 4) {
    f32x16 S;
#pragma unroll
    for (int i = 0; i < 16; ++i) S[i] = 0.f;
#pragma unroll
    for (int ks = 0; ks < 4; ++ks) S = MFMA32(Kf[ks], QA[ks], S);
    softmax_pv(S, A0, A1, mA, lA, Vf, kt == 0, kt == 4, r, h);
  }
  if (kt >= 1) {
    f32x16 S;
#pragma unroll
    for (int i = 0; i < 16; ++i) S[i] = 0.f;
#pragma unroll
    for (int ks = 0; ks < 4; ++ks) S = MFMA32(Kf[ks], QB[ks], S);
    softmax_pv(S, B0, B1, mB, lB, Vf, kt == 1, kt == 5, r, h);
  }
}

DI void attn_merge(const Params& p, LAS unsigned char* T, const f32x16& O0, const f32x16& O1, const float m, const float l, const int lane,
                   const int tokq0  , const int sh, const int hh, const bool first, const bool last) {
  const int r = lane & 31, h = lane >> 5;
  const int rowc = lane >> 3, ch = lane & 7;
  float lse = m + __log2f(l);
  float w1 = 1.0f / l, w0 = 0.f;
  if (!first) {
#pragma unroll
    for (int c = 0; c < 4; ++c) {
      const size_t tk = (size_t)(tokq0 + ((rowc + 8 * c) << sh));
      *(LAS u32x4*)(T + (rowc + 8 * c) * PT_ROW + ch * 16) = *(const u32x4*)(p.ob + (tk * 8 + hh) * 64 + ch * 8);
    }
    const float lp = p.lseg[(size_t)(tokq0 + (r << sh)) * 8 + hh];
    const float M = fmaxf(lse, lp), e1 = fexp2(lse - M), e0 = fexp2(lp - M), den = e0 + e1, id = 1.0f / den;
    w1 *= e1 * id; w0 = e0 * id; lse = M + __log2f(den);
  }
  LAS unsigned char* ob = T + r * PT_ROW + 8 * h;
#pragma unroll
  for (int dt = 0; dt < 2; ++dt)
#pragma unroll
    for (int g = 0; g < 4; ++g) {
      float f0, f1, f2, f3;
      if (dt == 0) { f0 = O0[4 * g] * w1; f1 = O0[4 * g + 1] * w1; f2 = O0[4 * g + 2] * w1; f3 = O0[4 * g + 3] * w1; }
      else { f0 = O1[4 * g] * w1; f1 = O1[4 * g + 1] * w1; f2 = O1[4 * g + 2] * w1; f3 = O1[4 * g + 3] * w1; }
      LAS u32x2* a = (LAS u32x2*)(ob + 64 * dt + 16 * g);
      if (!first) { const u32x2 pv = *a; f0 += w0 * bflo(pv.x); f1 += w0 * bfhi(pv.x); f2 += w0 * bflo(pv.y); f3 += w0 * bfhi(pv.y); }
      u32x2 wv; wv.x = pack2(f0, f1); wv.y = pack2(f2, f3);
      *a = wv;
    }
  if (!last) {
    if (h == 0) p.lseg[(size_t)(tokq0 + (r << sh)) * 8 + hh] = lse;
#pragma unroll
    for (int c = 0; c < 4; ++c) {
      const size_t tk = (size_t)(tokq0 + ((rowc + 8 * c) << sh));
      *(u32x4*)(p.ob + (tk * 8 + hh) * 64 + ch * 8) = *(const LAS u32x4*)(T + (rowc + 8 * c) * PT_ROW + ch * 16);
    }
  } else {
#pragma unroll
    for (int c = 0; c < 4; ++c) {
      const size_t tk = (size_t)(tokq0 + ((rowc + 8 * c) << sh));
      const u32x4 a = *(const LAS u32x4*)(T + (rowc + 8 * c) * PT_ROW + ch * 16);
      const u32x4 g = *(const u32x4*)(p.proj + tk * NW + OFF_GA + hh * 64 + ch * 8);
      u32x4 w;
      w.x = pack2(bflo(a.x) * silu(bflo(g.x)), bfhi(a.x) * silu(bfhi(g.x)));
      w.y = pack2(bflo(a.y) * silu(bflo(g.y)), bfhi(a.y) * silu(bfhi(g.y)));
      w.z = pack2(bflo(a.z) * silu(bflo(g.z)), bfhi(a.z) * silu(bfhi(g.z)));
      w.w = pack2(bflo(a.w) * silu(bflo(g.w)), bfhi(a.w) * silu(bfhi(g.w)));
      *(u32x4*)(p.mixed + tk * DM + hh * 64 + ch * 8) = w;
    }
  }
}

DI void attn_task2(const Params& p, LAS unsigned char* kst, const int lane, const int tokbase, const int hh,
                   const int sh, const int r_res, const int l0, const bool first, const bool last) {
  const int r = lane & 31, h = lane >> 5;
  const int i16 = lane & 15, q4 = i16 >> 2, pp = i16 & 3, blk = (lane >> 4) & 1;
  LAS unsigned char* vst = kst + KST_W;
  LAS unsigned char* trp = vst + (4 * h + q4) * VROW + 32 * blk + 8 * pp;
  const bf16_t* qpA = p.proj + (size_t)(tokbase + r_res + ((l0 + r) << sh)) * NW + OFF_QA + hh * 64 + 8 * h;
  const bf16_t* qpB = qpA + (size_t)(32 << sh) * NW;
  bf16x8 QA[4], QB[4];
#pragma unroll
  for (int ks = 0; ks < 4; ++ks) { QA[ks] = *(const bf16x8*)(qpA + 16 * ks); QB[ks] = *(const bf16x8*)(qpB + 16 * ks); }
  f32x16 A0, A1, B0, B1;
#pragma unroll
  for (int i = 0; i < 16; ++i) { A0[i] = 0.f; A1[i] = 0.f; B0[i] = 0.f; B1[i] = 0.f; }
  float mA = -1e30f, lA = 0.f, mB = -1e30f, lB = 0.f;
  const int kt0 = (l0 >= 128) ? 0 : (4 - (l0 >> 5));
#define LOAD_KV(Kd, Vd, kt_) do { const int lk0_ = l0 - 128 + 32 * (kt_) + (lane >> 3); \
    _Pragma("unroll") for (int c_ = 0; c_ < 4; ++c_) { \
      const bf16_t* kp_ = p.proj + (size_t)(tokbase + r_res + ((lk0_ + 8 * c_) << sh)) * NW + OFF_KA + hh * 64 + 8 * (lane & 7); \
      Kd[c_] = *(const u32x4*)kp_; Vd[c_] = *(const u32x4*)(kp_ + (OFF_VA - OFF_KA)); } } while (0)
  for (int kt = kt0; kt < 6; kt += 2) {
    u32x4 K0[4], K1[4], V0[4], V1[4];
    LOAD_KV(K0, V0, kt);
    LOAD_KV(K1, V1, kt + 1);
    attn_tile2(K0, V0, QA, QB, A0, A1, mA, lA, B0, B1, mB, lB, kst, vst, trp, lane, kt);
    attn_tile2(K1, V1, QA, QB, A0, A1, mA, lA, B0, B1, mB, lB, kst, vst, trp, lane, kt + 1);
  }
#undef LOAD_KV
  const int tokA = tokbase + r_res + (l0 << sh);
  attn_merge(p, kst, A0, A1, mA, lA, lane, tokA, sh, hh, first, last);
  attn_merge(p, kst, B0, B1, mB, lB, lane, tokA + (32 << sh), sh, hh, first, last);
}

DI void phase_attn(LAS unsigned char* lds, const Params& p, int bid, int nb) {
  const int tid = threadIdx.x, wid = __builtin_amdgcn_readfirstlane(tid >> 6), lane = tid & 63;
  LAS unsigned char* kst = lds + wid * VST_W;
  for (int unit = bid; unit < 256; unit += nb) {
    const int xj = unit >> 3, bhh = (unit & 7) * 8 + (xj >> 2), sp = xj & 3, hh = bhh & 7, b = bhh >> 3;
    const int tokbase = b * SEQ;
    for (int stage = 0; stage < 3; ++stage) {
      const int sh = stage == 0 ? 4 : (stage == 1 ? 2 : 0);
      for (int tk = 0; tk < 2; ++tk) {
        const int idx = wid + 8 * tk;
        int r_res, l0;
        if (stage == 0) { r_res = idx; l0 = 64 * sp; }
        else if (stage == 1) { r_res = idx >> 2; l0 = 256 * sp + 64 * (idx & 3); }
        else { r_res = 0; l0 = 1024 * sp + 64 * idx; }
        attn_task2(p, kst, lane, tokbase, hh, sh, r_res, l0, stage == 0, stage == 2);
      }
      __syncthreads();
    }
  }
}

constexpr int RV_ROW = 320, RK_ROW = 192, RV_OFF = 0, RK_OFF = 128 * RV_ROW  , RRED_OFF = RK_OFF + 128 * RK_ROW  ;

DI void retout_unit(LAS unsigned char* lds, const Params& p, const int u);
DI void phase_retkv(LAS unsigned char* lds, const Params& p, int bid, int nb, const int mode) {
  const int tid = threadIdx.x, wid = __builtin_amdgcn_readfirstlane(tid >> 6), lane = tid & 63;
  const int r = lane & 31, h = lane >> 5, i16 = lane & 15, q4 = i16 >> 2, pp = i16 & 3, blk = (lane >> 4) & 1;
  const int vt = wid >> 1, dt = wid & 1;
  LAS int* uslot = (LAS int*)(lds + RRED_OFF);
  for (;;) {
    if (tid == 0) *uslot = (int)__hip_atomic_fetch_add(p.bar + 200 + mode, 1u, __ATOMIC_RELAXED, __HIP_MEMORY_SCOPE_AGENT);
    __syncthreads();
    const int u = __builtin_amdgcn_readfirstlane(*uslot);
    if (u >= 1024) break;
    if (mode) { __syncthreads(); retout_unit(lds, p, u); continue; }
    const int n = u & 31, hh = (u >> 5) & 3, b = u >> 7;
    const float lg = ret_log2g(hh);
    const bf16_t* base = p.proj + (size_t)(b * SEQ + n * 128) * NW;
#pragma unroll
    for (int it = 0; it < 4; ++it) {
      const int c = tid + 512 * it, j = c >> 4, cc = c & 15;
      *(LAS u32x4*)(lds + RV_OFF + j * RV_ROW + cc * 16) = *(const u32x4*)(base + (size_t)j * NW + OFF_VR + hh * 128 + cc * 8);
    }
#pragma unroll
    for (int it = 0; it < 2; ++it) {
      const int c = tid + 512 * it, j = c >> 3, cc = c & 7;
      const u32x4 w = *(const u32x4*)(base + (size_t)j * NW + OFF_KR + hh * 64 + cc * 8);
      const float dk = exp2f((float)(127 - j) * lg);
      u32x4 o;
      o.x = pack2(bflo(w.x) * dk, bfhi(w.x) * dk); o.y = pack2(bflo(w.y) * dk, bfhi(w.y) * dk);
      o.z = pack2(bflo(w.z) * dk, bfhi(w.z) * dk); o.w = pack2(bflo(w.w) * dk, bfhi(w.w) * dk);
      *(LAS u32x4*)(lds + RK_OFF + j * RK_ROW + cc * 16) = o;
    }
    __syncthreads();
    f32x16 acc;
#pragma unroll
    for (int i = 0; i < 16; ++i) acc[i] = 0.f;
    LAS unsigned char* va = lds + RV_OFF + (4 * h + q4) * RV_ROW + (32 * vt + 16 * blk + 4 * pp) * 2;
    LAS unsigned char* ka = lds + RK_OFF + (4 * h + q4) * RK_ROW + (32 * dt + 16 * blk + 4 * pp) * 2;
#pragma unroll
    for (int s = 0; s < 8; ++s) {
      const bf16x8 A = tr_frag(va + 16 * s * RV_ROW, 8 * RV_ROW), B = tr_frag(ka + 16 * s * RK_ROW, 8 * RK_ROW);
      acc = MFMA32(A, B, acc);
    }
    float* o = p.kvT + ((size_t)u << 13) + (32 * vt + 4 * h) * 64 + 32 * dt + r;
#pragma unroll
    for (int i = 0; i < 16; ++i) __hip_atomic_store(o + ((i & 3) + 8 * (i >> 2)) * 64, acc[i], __ATOMIC_RELAXED, __HIP_MEMORY_SCOPE_AGENT);
    asm volatile("s_waitcnt vmcnt(0)" ::: "memory");
    __syncthreads();
    const int bh = u >> 5;
    if (tid == 0) uslot[1] = (__hip_atomic_fetch_add(p.bar + 208 + bh, 1u, __ATOMIC_RELAXED, __HIP_MEMORY_SCOPE_AGENT) == 31u) ? 1 : 0;
    __syncthreads();
    if (__builtin_amdgcn_readfirstlane(uslot[1]) != 0) {
      if (tid == 0) { __builtin_amdgcn_fence(__ATOMIC_ACQUIRE, "agent"); asm volatile("s_waitcnt vmcnt(0)" ::: "memory"); }
      __syncthreads();
      typedef float f32x2 __attribute__((ext_vector_type(2)));
      const float cd = exp2f(128.0f * lg);
      for (int e2 = tid; e2 < 4096; e2 += 512) {
        const int e = e2 * 2;
        f32x2 kr[31];
#pragma unroll
        for (int nn = 0; nn < 31; ++nn) {
          const float* a = p.kvT + ((size_t)(bh * 32 + nn) << 13) + e;
          kr[nn][0] = __hip_atomic_load(a, __ATOMIC_RELAXED, __HIP_MEMORY_SCOPE_AGENT); kr[nn][1] = __hip_atomic_load(a + 1, __ATOMIC_RELAXED, __HIP_MEMORY_SCOPE_AGENT);
        }
        float s0 = 0.f, s1 = 0.f;
#pragma unroll
        for (int nn = 0; nn < 32; ++nn) {
          __hip_atomic_store((unsigned*)(p.stT + ((size_t)(bh * 32 + nn) << 13) + e), pack2(s0, s1), __ATOMIC_RELAXED, __HIP_MEMORY_SCOPE_AGENT);
          if (nn < 31) { s0 = s0 * cd + kr[nn][0]; s1 = s1 * cd + kr[nn][1]; }
        }
      }
      asm volatile("s_waitcnt vmcnt(0)" ::: "memory");
      __syncthreads();
      if (tid == 0) __hip_atomic_store(p.bar + 16 + bh, 1u, __ATOMIC_RELAXED, __HIP_MEMORY_SCOPE_AGENT);
    }
    __syncthreads();
  }
  __syncthreads();
}

constexpr int RKO = 40960, RQO = RKO + 128 * 144, RSO = RQO + 128 * 144, RGO = RSO + 128 * 144, RG_ROW = 272, RRED2 = RGO + 128 * RG_ROW;
DI void retout_unit(LAS unsigned char* lds, const Params& p, const int u) {
  const int tid = threadIdx.x, wid = __builtin_amdgcn_readfirstlane(tid >> 6), lane = tid & 63;
  const int r = lane & 31, h = lane >> 5, i16 = lane & 15, q4 = i16 >> 2, pp = i16 & 3, blk = (lane >> 4) & 1;
  const int it = wid & 3, vh = wid >> 2;
  LAS float* red = (LAS float*)(lds + RRED2);
  {
    if (tid == 0) {
      unsigned spins = 0;
      while (__hip_atomic_load(p.bar + 16 + (u >> 5), __ATOMIC_RELAXED, __HIP_MEMORY_SCOPE_AGENT) == 0u && spins < (1u << 22)) { __builtin_amdgcn_s_sleep(2); ++spins; }
      __builtin_amdgcn_fence(__ATOMIC_ACQUIRE, "agent");
      asm volatile("s_waitcnt vmcnt(0)" ::: "memory");
    }
    __syncthreads();
    const int n = u & 31, hh = (u >> 5) & 3, b = u >> 7;
    const float lg = ret_log2g(hh);
    const int tok0 = b * SEQ + n * 128;
    const bf16_t* base = p.proj + (size_t)tok0 * NW;
    {
      u32x4 tv[4], tg[4], tk[2], tq[2], ts[2];
#pragma unroll
      for (int k = 0; k < 4; ++k) {
        const int c = tid + 512 * k, j = c >> 4, cc = c & 15;
        tv[k] = *(const u32x4*)(base + (size_t)j * NW + OFF_VR + hh * 128 + cc * 8);
        tg[k] = *(const u32x4*)(base + (size_t)j * NW + OFF_GR + hh * 128 + cc * 8);
      }
#pragma unroll
      for (int k = 0; k < 2; ++k) {
        const int c = tid + 512 * k, j = c >> 3, cc = c & 7;
        tk[k] = *(const u32x4*)(base + (size_t)j * NW + OFF_KR + hh * 64 + cc * 8);
        tq[k] = *(const u32x4*)(base + (size_t)j * NW + OFF_QR + hh * 64 + cc * 8);
        ts[k] = *(const u32x4*)(p.stT + ((size_t)u << 13) + (size_t)c * 8);
      }
#pragma unroll
      for (int k = 0; k < 4; ++k) {
        const int c = tid + 512 * k, j = c >> 4, cc = c & 15;
        *(LAS u32x4*)(lds + RV_OFF + j * RV_ROW + cc * 16) = tv[k];
        *(LAS u32x4*)(lds + RGO + j * RG_ROW + cc * 16) = tg[k];
      }
#pragma unroll
      for (int k = 0; k < 2; ++k) {
        const int c = tid + 512 * k, j = c >> 3, cc = c & 7;
        *(LAS u32x4*)(lds + RKO + j * 144 + cc * 16) = tk[k];
        *(LAS u32x4*)(lds + RQO + j * 144 + cc * 16) = tq[k];
        *(LAS u32x4*)(lds + RSO + j * 144 + cc * 16) = ts[k];
      }
    }
    __syncthreads();
    const int qi = 32 * it + r;
    bf16x8 Qf[4];
#pragma unroll
    for (int ks = 0; ks < 4; ++ks) Qf[ks] = *(const LAS bf16x8*)(lds + RQO + qi * 144 + (2 * ks + h) * 16);
    f32x16 O0, O1;
#pragma unroll
    for (int i = 0; i < 16; ++i) { O0[i] = 0.f; O1[i] = 0.f; }
    {
#pragma unroll
      for (int ks = 0; ks < 4; ++ks) {
        const bf16x8 S0 = *(const LAS bf16x8*)(lds + RSO + (64 * vh + r) * 144 + (2 * ks + h) * 16);
        const bf16x8 S1 = *(const LAS bf16x8*)(lds + RSO + (64 * vh + 32 + r) * 144 + (2 * ks + h) * 16);
        O0 = MFMA32(S0, Qf[ks], O0); O1 = MFMA32(S1, Qf[ks], O1);
      }
      const float qd = exp2f((float)(qi + 1) * lg);
#pragma unroll
      for (int i = 0; i < 16; ++i) { O0[i] *= qd; O1[i] *= qd; }
    }
    LAS unsigned char* va = lds + RV_OFF + (4 * h + q4) * RV_ROW + (64 * vh + 16 * blk + 4 * pp) * 2;
    for (int jt = 0; jt <= it; ++jt) {
      f32x16 S;
#pragma unroll
      for (int i = 0; i < 16; ++i) S[i] = 0.f;
#pragma unroll
      for (int ks = 0; ks < 4; ++ks) { const bf16x8 Kf = *(const LAS bf16x8*)(lds + RKO + (32 * jt + r) * 144 + (2 * ks + h) * 16); S = MFMA32(Kf, Qf[ks], S); }
#pragma unroll
      for (int i = 0; i < 16; ++i) {
        const int dj = qi - (32 * jt + (i & 3) + 8 * (i >> 2) + 4 * h);
        S[i] = dj >= 0 ? S[i] * fexp2((float)dj * lg) : 0.f;
      }
#pragma unroll
      for (int s2 = 0; s2 < 2; ++s2) {
        const bf16x8 Pb = pack8(S, s2);
        const bf16x8 V0 = tr_frag(va + (32 * jt + 16 * s2) * RV_ROW, 8 * RV_ROW), V1 = tr_frag(va + (32 * jt + 16 * s2) * RV_ROW + 64, 8 * RV_ROW);
        O0 = MFMA32(V0, Pb, O0);
        O1 = MFMA32(V1, Pb, O1);
      }
    }
    float s1 = 0.f, s2 = 0.f;
#pragma unroll
    for (int i = 0; i < 16; ++i) { s1 += O0[i] + O1[i]; s2 += O0[i] * O0[i] + O1[i] * O1[i]; }
    s1 += __shfl_xor(s1, 32); s2 += __shfl_xor(s2, 32);
    if (h == 0) { red[(vh * 128 + qi) * 2] = s1; red[(vh * 128 + qi) * 2 + 1] = s2; }
    __syncthreads();
    s1 += red[((vh ^ 1) * 128 + qi) * 2]; s2 += red[((vh ^ 1) * 128 + qi) * 2 + 1];
    const float mu = s1 * (1.0f / 128.0f), var = fmaxf(s2 * (1.0f / 128.0f) - mu * mu, 0.f), rs = rsqrtf(var + 1e-5f);
    const float* gnp = p.gn + hh * 128 + 64 * vh + 4 * h;
    LAS unsigned char* gt = lds + RGO + qi * RG_ROW + (64 * vh + 4 * h) * 2;
#pragma unroll
    for (int dt = 0; dt < 2; ++dt)
#pragma unroll
      for (int g = 0; g < 4; ++g) {
        const int vo = 32 * dt + 8 * g;
        LAS u32x2* ga = (LAS u32x2*)(gt + vo * 2);
        const u32x2 gwv = *ga;
        const f32x4 gnv = *(const f32x4*)(gnp + vo);
        float f0, f1, f2, f3;
        if (dt == 0) { f0 = O0[4 * g]; f1 = O0[4 * g + 1]; f2 = O0[4 * g + 2]; f3 = O0[4 * g + 3]; }
        else { f0 = O1[4 * g]; f1 = O1[4 * g + 1]; f2 = O1[4 * g + 2]; f3 = O1[4 * g + 3]; }
        f0 = (f0 - mu) * rs * gnv[0] * silu(bflo(gwv.x)); f1 = (f1 - mu) * rs * gnv[1] * silu(bfhi(gwv.x));
        f2 = (f2 - mu) * rs * gnv[2] * silu(bflo(gwv.y)); f3 = (f3 - mu) * rs * gnv[3] * silu(bfhi(gwv.y));
        u32x2 wv; wv.x = pack2(f0, f1); wv.y = pack2(f2, f3);
        *ga = wv;
      }
    __syncthreads();
#pragma unroll
    for (int k = 0; k < 4; ++k) {
      const int c = tid + 512 * k, j = c >> 4, cc = c & 15;
      *(u32x4*)(p.mixed + (size_t)(tok0 + j) * DM + 512 + hh * 128 + cc * 8) = *(const LAS u32x4*)(lds + RGO + j * RG_ROW + cc * 16);
    }
    __syncthreads();
  }
}

DI void grid_barrier(unsigned* ctr, unsigned target) {
  asm volatile("s_waitcnt vmcnt(0) lgkmcnt(0)" ::: "memory");
  __syncthreads();
  if (threadIdx.x == 0) {
    __builtin_amdgcn_fence(__ATOMIC_RELEASE, "agent");
    asm volatile("s_waitcnt vmcnt(0)" ::: "memory");
    __hip_atomic_fetch_add(ctr, 1u, __ATOMIC_RELAXED, __HIP_MEMORY_SCOPE_AGENT);
    unsigned spins = 0;
    while (__hip_atomic_load(ctr, __ATOMIC_RELAXED, __HIP_MEMORY_SCOPE_AGENT) < target && spins < (1u << 22)) { __builtin_amdgcn_s_sleep(2); ++spins; }
    __builtin_amdgcn_fence(__ATOMIC_ACQUIRE, "agent");
    asm volatile("s_waitcnt vmcnt(0)" ::: "memory");
  }
  __syncthreads();
}

__global__ void __launch_bounds__(512) k_mega(Params p) {
  extern __shared__ __attribute__((aligned(16))) unsigned char shm_[];
  LAS unsigned char* shm = (LAS unsigned char*)shm_;
  const int bid = blockIdx.x, nb = gridDim.x;
  unsigned bar_n = 0;
#ifdef PROBE_PHASE
#ifndef PROBE_BLK
#define PROBE_BLK 0
#endif
  unsigned long long ts_a = 0, ts_b = 0; int ph_i = 0;
  if (PROBE_PHASE == 0) ts_a = __builtin_amdgcn_s_memrealtime();
#define GRID_BAR() do { bar_n += (unsigned)nb; grid_barrier(p.bar, bar_n); ++ph_i; if (ph_i == PROBE_PHASE) ts_a = __builtin_amdgcn_s_memrealtime(); if (ph_i == PROBE_PHASE + 1) ts_b = __builtin_amdgcn_s_memrealtime(); } while (0)
#else
#define GRID_BAR() do { bar_n += (unsigned)nb; grid_barrier(p.bar, bar_n); } while (0)
#endif
  phase_prep(p, bid, nb);
  GRID_BAR();
  phase_gemm<1>(shm, p, bid, nb);
  GRID_BAR();
  phase_retkv(shm, p, bid, nb, 0);
  phase_attn(shm, p, bid, nb);
#ifdef PROBE_SUB
  ts_b = __builtin_amdgcn_s_memrealtime(); ph_i = 100;
#endif
  phase_retkv(shm, p, bid, nb, 1);
  GRID_BAR();
  phase_gemm<2>(shm, p, bid, nb);
#ifdef PROBE_PHASE
  if (PROBE_PHASE == 3) ts_b = __builtin_amdgcn_s_memrealtime();
  if (bid == PROBE_BLK && threadIdx.x == 0) {
    const unsigned long long until = __builtin_amdgcn_s_memrealtime() + 9ull * (ts_b - ts_a);
    while (__builtin_amdgcn_s_memrealtime() < until) __builtin_amdgcn_s_sleep(8);
  }
#endif
}

extern "C" void kernel_launch(void* const* d_in, const int* in_sizes, int n_in, void* d_out, int out_size, void* d_ws, size_t ws_size, hipStream_t stream) {
  Params p{};
  p.x = (const float*)d_in[0]; p.ng = (const float*)d_in[1]; p.w_in = (const float*)d_in[2]; p.gn = (const float*)d_in[3];
  p.w_out = (const float*)d_in[4]; p.fg = (const float*)d_in[5];
  p.out = (float*)d_out;
  char* w = (char*)d_ws; size_t o = 0;
  auto take = [&](size_t bytes) { char* r = w + o; o += (bytes + 255) & ~(size_t)255; return r; };
  p.xb = (bf16_t*)take((size_t)T_TOK * DM * 2);
  p.proj = (bf16_t*)take((size_t)T_TOK * NW * 2);
  p.mixed = (bf16_t*)take((size_t)T_TOK * DM * 2);
  p.winT = (bf16_t*)take((size_t)NW * DM * 2);
  p.woutT = (bf16_t*)take((size_t)DM * DM * 2);
  p.rstd = (float*)take((size_t)T_TOK * 4);
  p.rowss = (float*)take((size_t)T_TOK * 4);
  p.ropeT = (float2*)take((size_t)SEQ * 32 * 8);
  p.retT = (float2*)take((size_t)SEQ * 32 * 8);
  p.kvT = (float*)take((size_t)1024 * 8192 * 4);
  p.stT = (bf16_t*)take((size_t)1024 * 8192 * 2);
  p.bar = (unsigned*)take(1024);
  p.ob = (bf16_t*)take((size_t)T_TOK * 512 * 2);
  p.lseg = (float*)take((size_t)T_TOK * 8 * 4);
  static int grid_blocks = 0;
  if (!grid_blocks) {
    (void)hipFuncSetAttribute((const void*)k_mega, hipFuncAttributeMaxDynamicSharedMemorySize, ATTN_LDS);
    int dev = 0, cus = 0, per_cu = 0;
    (void)hipGetDevice(&dev);
    (void)hipDeviceGetAttribute(&cus, hipDeviceAttributeMultiprocessorCount, dev);
    (void)hipOccupancyMaxActiveBlocksPerMultiprocessor(&per_cu, k_mega, 512, ATTN_LDS);
    if (per_cu < 1) per_cu = 1;
    grid_blocks = cus;
  }
  (void)hipMemsetAsync(p.bar, 0, 1024, stream);
  hipLaunchKernelGGL(k_mega, dim3(grid_blocks), dim3(512), ATTN_LDS, stream, p);
}
```

```cpp
#include <hip/hip_runtime.h>
#include <hip/hip_cooperative_groups.h>
#include <cstdint>
#include <cstdio>
namespace cg = cooperative_groups;

typedef unsigned short bf16_t;
typedef short bf16x8 __attribute__((ext_vector_type(8)));
typedef float f32x4 __attribute__((ext_vector_type(4)));
typedef unsigned u32x4 __attribute__((ext_vector_type(4)));
typedef unsigned u32x2 __attribute__((ext_vector_type(2)));

constexpr int T_TOK = 32768, DM = 1024, NW = 3584, SEQ = 4096;
constexpr int OFF_QA = 0, OFF_KA = 512, OFF_VA = 1024, OFF_GA = 1536, OFF_QR = 2048, OFF_KR = 2304, OFF_VR = 2560, OFF_GR = 3072;

struct Params {
  const float* x; const float* ng; const float* w_in; const float* gn; const float* w_out; const float* fg;
  float* out;
  bf16_t* xb; bf16_t* proj; bf16_t* mixed; bf16_t* winT; bf16_t* woutT;
  float* rstd; float* rowss; float2* ropeT; float2* retT; float* kvT; bf16_t* stT; unsigned* bar; bf16_t* ob; float* lseg;
};

#define DI __device__ __forceinline__
DI unsigned short f2bf(float x) { unsigned u = __float_as_uint(x); u += 0x7fffu + ((u >> 16) & 1u); return (unsigned short)(u >> 16); }
DI float bf2f(unsigned short b) { return __uint_as_float(((unsigned)b) << 16); }
typedef float f32x2_t __attribute__((ext_vector_type(2)));
typedef __bf16 bf16x2_t __attribute__((ext_vector_type(2)));
DI unsigned pack2(float lo, float hi) { const f32x2_t v = {lo, hi}; return __builtin_bit_cast(unsigned, __builtin_convertvector(v, bf16x2_t)); }
DI float bflo(unsigned w) { return __uint_as_float(w << 16); }
DI float bfhi(unsigned w) { return __uint_as_float(w & 0xffff0000u); }
DI int perm32(int rho) { const int n = rho >> 4, i = rho & 15; return 8 * (i >> 2) + 4 * n + (i & 3); }
DI int cmap(int p) { return (p & ~31) + perm32(p & 31); }
DI int cmapA(int p) { return (p & ~127) + ((p >> 6) & 1) * 64 + ((p >> 4) & 1) * 32 + ((p >> 5) & 1) * 16 + (p & 15); }

DI void phase_prep(const Params& p, int bid, int nb) {
  const int tid = threadIdx.x, lane = tid & 63, wid = tid >> 6, nw = blockDim.x >> 6;
  if (wid < 6)
  for (int row0 = (bid * 6 + wid) * 4; row0 < T_TOK; row0 += nb * 6 * 4) {
    f32x4 v[4][4];
#pragma unroll
    for (int rr = 0; rr < 4; ++rr)
#pragma unroll
      for (int it = 0; it < 4; ++it) v[rr][it] = __builtin_nontemporal_load((const f32x4*)(p.x + (size_t)(row0 + rr) * DM + it * 256 + lane * 4));
#pragma unroll
    for (int rr = 0; rr < 4; ++rr) {
      float ss = 0.f;
#pragma unroll
      for (int it = 0; it < 4; ++it) ss += v[rr][it][0] * v[rr][it][0] + v[rr][it][1] * v[rr][it][1] + v[rr][it][2] * v[rr][it][2] + v[rr][it][3] * v[rr][it][3];
#pragma unroll
      for (int o = 32; o >= 1; o >>= 1) ss += __shfl_xor(ss, o);
#pragma unroll
      for (int it = 0; it < 4; ++it) { u32x2 w; w.x = pack2(v[rr][it][0], v[rr][it][1]); w.y = pack2(v[rr][it][2], v[rr][it][3]); *(u32x2*)(p.xb + (size_t)(row0 + rr) * DM + it * 256 + lane * 4) = w; }
      if (lane == 0) p.rstd[row0 + rr] = rsqrtf(ss * (1.0f / DM) + 1e-6f);
    }
  }
  if (wid < 6) return;
  const int gt = bid * 128 + (tid - 384), gn = nb * 128;
  for (int idx = gt; idx < (NW / 4) * 128; idx += gn) {
    const int p4 = idx % (NW / 4), kc = idx / (NW / 4), pp = p4 * 4, c = pp < 1024 ? cmapA(pp) : cmap(pp);
    f32x4 f[8];
#pragma unroll
    for (int j = 0; j < 8; ++j) { const int k = kc * 8 + j; f[j] = *(const f32x4*)(p.w_in + (size_t)k * NW + c) * p.ng[k]; }
#pragma unroll
    for (int e = 0; e < 4; ++e) {
      u32x4 w; w.x = pack2(f[0][e], f[1][e]); w.y = pack2(f[2][e], f[3][e]); w.z = pack2(f[4][e], f[5][e]); w.w = pack2(f[6][e], f[7][e]);
      *(u32x4*)(p.winT + (size_t)(pp + e) * DM + kc * 8) = w;
    }
  }
  for (int idx = gt; idx < (DM / 4) * 128; idx += gn) {
    const int p4 = idx % (DM / 4), kc = idx / (DM / 4), pp = p4 * 4, c = cmap(pp);
    f32x4 f[8];
#pragma unroll
    for (int j = 0; j < 8; ++j) { const int k = kc * 8 + j; f[j] = *(const f32x4*)(p.w_out + (size_t)k * DM + c); }
#pragma unroll
    for (int e = 0; e < 4; ++e) {
      u32x4 w; w.x = pack2(f[0][e], f[1][e]); w.y = pack2(f[2][e], f[3][e]); w.z = pack2(f[4][e], f[5][e]); w.w = pack2(f[6][e], f[7][e]);
      *(u32x4*)(p.woutT + (size_t)(pp + e) * DM + kc * 8) = w;
    }
  }
  for (int idx = gt; idx < SEQ * 32; idx += gn) {
    const int pos = idx >> 5, i = idx & 31;
    const float inv1 = powf(10000.0f, -(float)i / 32.0f);
    const float inv2 = 1.0f / powf(10000.0f, (float)i / 31.0f);
    const float a1 = (float)pos * inv1, a2 = (float)pos * inv2;
    p.ropeT[idx] = make_float2(cosf(a1), sinf(a1));
    p.retT[idx] = make_float2(cosf(a2), sinf(a2));
  }
}

constexpr int BM = 256, BK = 64, HALF = 128, HT = HALF * BK;
constexpr int GEMM_LDS = 8 * HT * 2;
DI int lds_byte(int r, int c) { int st = (r >> 4) * 2 + (c >> 5), rr = r & 15, cc = c & 31, ob = rr * 64 + cc * 2; return st * 1024 + (ob ^ (((ob >> 9) & 1) << 5)); }
DI void stage_rc(int b, int& R, int& C) { int st = b / 1024, sb = b % 1024, swz = sb ^ (((sb >> 9) & 1) << 5); R = (st >> 1) * 16 + swz / 64; C = (st & 1) * 32 + (swz % 64) / 2; }

#define LAS __attribute__((address_space(3)))
template <int EPI>
DI void gemm_epi(LAS unsigned char* lds, f32x4 (&acc)[2][2][4][2], const int brow, const int bcol, const Params& p) {
  const int tid = threadIdx.x, wid = __builtin_amdgcn_readfirstlane(tid >> 6), lane = tid & 63, wr = wid >> 2, wc = wid & 3, fr = lane & 15, fq = lane >> 4;
  if (EPI == 1) {
    const int pn = bcol >> 8;
    if (pn < 4) {
      const float sc = pn < 2 ? 0.125f * 1.4426950408889634f : 1.0f;
      const int i0 = 16 * (wc & 1) + 4 * fq;
#pragma unroll
      for (int ai = 0; ai < 2; ++ai)
#pragma unroll
        for (int m = 0; m < 4; ++m) {
          const int row = brow + ai * HALF + wr * 64 + m * 16 + fr;
          const float rs = p.rstd[row] * sc;
          const float* tb = (const float*)(p.ropeT + (row & (SEQ - 1)) * 32 + i0);
          const f32x4 t0 = *(const f32x4*)tb, t1 = *(const f32x4*)(tb + 4);
#pragma unroll
          for (int bj = 0; bj < 2; ++bj) {
            const f32x4 x1 = acc[ai][bj][m][0] * rs, x2 = acc[ai][bj][m][1] * rs;
            u32x2 wa, wb;
            wa.x = pack2(x1[0] * t0[0] - x2[0] * t0[1], x1[1] * t0[2] - x2[1] * t0[3]);
            wa.y = pack2(x1[2] * t1[0] - x2[2] * t1[1], x1[3] * t1[2] - x2[3] * t1[3]);
            wb.x = pack2(x2[0] * t0[0] + x1[0] * t0[1], x2[1] * t0[2] + x1[1] * t0[3]);
            wb.y = pack2(x2[2] * t1[0] + x1[2] * t1[1], x2[3] * t1[2] + x1[3] * t1[3]);
            bf16_t* o = p.proj + (size_t)row * NW + bcol + bj * HALF + (wc >> 1) * 64 + i0;
            *(u32x2*)o = wa; *(u32x2*)(o + 32) = wb;
          }
        }
    } else if (pn == 8 || pn == 9) {
      const float sc = pn == 9 ? 0.125f : 1.0f;
      const int i0 = 16 * (wc & 1) + 4 * fq;
#pragma unroll
      for (int ai = 0; ai < 2; ++ai)
#pragma unroll
        for (int m = 0; m < 4; ++m) {
          const int row = brow + ai * HALF + wr * 64 + m * 16 + fr;
          const float rs = p.rstd[row] * sc;
          const float* tb = (const float*)(p.retT + (row & (SEQ - 1)) * 32 + i0);
          const f32x4 t0 = *(const f32x4*)tb, t1 = *(const f32x4*)(tb + 4);
#pragma unroll
          for (int bj = 0; bj < 2; ++bj) {
            const f32x4 v0 = acc[ai][bj][m][0] * rs, v1 = acc[ai][bj][m][1] * rs;
            u32x4 w;
            w.x = pack2(v0[0] * t0[0] - v0[1] * t0[1], v0[1] * t0[0] + v0[0] * t0[1]);
            w.y = pack2(v0[2] * t0[2] - v0[3] * t0[3], v0[3] * t0[2] + v0[2] * t0[3]);
            w.z = pack2(v1[0] * t1[0] - v1[1] * t1[1], v1[1] * t1[0] + v1[0] * t1[1]);
            w.w = pack2(v1[2] * t1[2] - v1[3] * t1[3], v1[3] * t1[2] + v1[2] * t1[3]);
            *(u32x4*)(p.proj + (size_t)row * NW + bcol + bj * HALF + wc * 32 + 8 * fq) = w;
          }
        }
    } else {
#pragma unroll
    for (int ai = 0; ai < 2; ++ai)
#pragma unroll
      for (int m = 0; m < 4; ++m) {
        const int row = brow + ai * HALF + wr * 64 + m * 16 + fr;
        const float rs = p.rstd[row];
#pragma unroll
        for (int bj = 0; bj < 2; ++bj) {
          const f32x4 v0 = acc[ai][bj][m][0] * rs, v1 = acc[ai][bj][m][1] * rs;
          u32x4 w; w.x = pack2(v0[0], v0[1]); w.y = pack2(v0[2], v0[3]); w.z = pack2(v1[0], v1[1]); w.w = pack2(v1[2], v1[3]);
          *(u32x4*)(p.proj + (size_t)row * NW + bcol + bj * HALF + wc * 32 + 8 * fq) = w;
        }
      }
    }
  } else {
    const int pm = brow >> 8, pn = bcol >> 8;
    LAS float* part = (LAS float*)(lds + GEMM_LDS);
    LAS float* rsl = (LAS float*)(lds + GEMM_LDS + 4096);
#pragma unroll
    for (int ai = 0; ai < 2; ++ai)
#pragma unroll
      for (int m = 0; m < 4; ++m) {
        const int rl = ai * HALF + wr * 64 + m * 16 + fr;
        float ss = 0.f;
#pragma unroll
        for (int bj = 0; bj < 2; ++bj) {
          const size_t off = (size_t)(brow + rl) * DM + bcol + bj * HALF + wc * 32 + 8 * fq;
          const f32x4 x0 = __builtin_nontemporal_load((const f32x4*)(p.x + off)), x1 = __builtin_nontemporal_load((const f32x4*)(p.x + off + 4));
          const f32x4 y0 = acc[ai][bj][m][0] + x0, y1 = acc[ai][bj][m][1] + x1;
          acc[ai][bj][m][0] = y0; acc[ai][bj][m][1] = y1;
          ss += y0[0] * y0[0] + y0[1] * y0[1] + y0[2] * y0[2] + y0[3] * y0[3] + y1[0] * y1[0] + y1[1] * y1[1] + y1[2] * y1[2] + y1[3] * y1[3];
        }
        ss += __shfl_xor(ss, 16); ss += __shfl_xor(ss, 32);
        if (fq == 0) part[wc * 256 + rl] = ss;
      }
    __syncthreads();
    float* xs = p.rowss + (size_t)(pm * 4) * 256;
    if (tid < 256) {
      const float tot = part[tid] + part[256 + tid] + part[512 + tid] + part[768 + tid];
      __hip_atomic_store(xs + pn * 256 + tid, tot, __ATOMIC_RELAXED, __HIP_MEMORY_SCOPE_AGENT);
    }
    asm volatile("s_waitcnt vmcnt(0)" ::: "memory");
    __syncthreads();
    unsigned* cnt = p.bar + 64 + pm;
    if (tid == 0) __hip_atomic_fetch_add(cnt, 1u, __ATOMIC_RELAXED, __HIP_MEMORY_SCOPE_AGENT);
    if (wid == 0) {
      unsigned spins = 0;
      while (__hip_atomic_load(cnt, __ATOMIC_RELAXED, __HIP_MEMORY_SCOPE_AGENT) < 4u && spins < (1u << 20)) { __builtin_amdgcn_s_sleep(1); ++spins; }
      __builtin_amdgcn_fence(__ATOMIC_ACQUIRE, "agent");
      asm volatile("s_waitcnt vmcnt(0)" ::: "memory");
    }
    __syncthreads();
    if (tid < 256) {
      float t = 0.f;
#pragma unroll
      for (int q = 0; q < 4; ++q) t += __hip_atomic_load(xs + q * 256 + tid, __ATOMIC_RELAXED, __HIP_MEMORY_SCOPE_AGENT);
      rsl[tid] = rsqrtf(t * (1.0f / DM) + 1e-6f);
    }
    __syncthreads();
#pragma unroll
    for (int ai = 0; ai < 2; ++ai)
#pragma unroll
      for (int m = 0; m < 4; ++m) {
        const int rl = ai * HALF + wr * 64 + m * 16 + fr;
        const float rs = rsl[rl];
#pragma unroll
        for (int bj = 0; bj < 2; ++bj) {
          const int col = bcol + bj * HALF + wc * 32 + 8 * fq;
          const f32x4 g0 = *(const f32x4*)(p.fg + col), g1 = *(const f32x4*)(p.fg + col + 4);
          float* o = p.out + (size_t)(brow + rl) * DM + col;
          __builtin_nontemporal_store(acc[ai][bj][m][0] * rs * g0, (f32x4*)o); __builtin_nontemporal_store(acc[ai][bj][m][1] * rs * g1, (f32x4*)(o + 4));
        }
      }
    __syncthreads();
  }
}

DI void tile_of(int L, int nM, int nN, int& pm, int& pn) {
  const int nwg = nM * nN, NX = 8, WGM = 8;
  int wgid = L; { const int q = nwg / NX, r = nwg % NX, xcd = wgid % NX, off = wgid / NX; wgid = (xcd < r ? xcd * (q + 1) : r * (q + 1) + (xcd - r) * q) + off; }
  const int nig = WGM * nN, gid = wgid / nig, fm = gid * WGM, gsz = (nM - fm) < WGM ? (nM - fm) : WGM;
  pm = fm + ((wgid % nig) % gsz); pn = (wgid % nig) / gsz;
}


template <int EPI>
DI void phase_gemm(LAS unsigned char* lds, const Params& p, int bid, int nb) {
  constexpr int K = 1024, nt = K / BK, HTB = HALF * BK * 2;
  const bf16_t* A = EPI == 1 ? p.xb : p.mixed; const bf16_t* Bt = EPI == 1 ? p.winT : p.woutT;
  const int nM = T_TOK / BM, nN = (EPI == 1 ? NW : DM) / BM, nT = nM * nN;
  const int tid = threadIdx.x, wid = __builtin_amdgcn_readfirstlane(tid >> 6), lane = tid & 63, wr = wid >> 2, wc = wid & 3, fr = lane & 15, fq = lane >> 4;
  unsigned voff[2];
#pragma unroll
  for (int i = 0; i < 2; ++i) { int R, C; stage_rc(tid * 16 + i * 8192, R, C); voff[i] = (unsigned)(R * K + C) * 2u; }
  const unsigned ldsw = (unsigned)wid * 1024u;
  const int aoff = lds_byte(wr * 64 + fr, fq * 8), boff = lds_byte(wc * 32 + fr, fq * 8);
  const size_t kstep = (size_t)(BK * 2), hstep = (size_t)HALF * K * 2, tstep = 2 * hstep;
#define SAo(b, h) (((b) * 2 + (h)) * HTB)
#define SBo(b, h) ((4 + (b) * 2 + (h)) * HTB)
#define STAGEP(bufoff, gptr) do { _Pragma("unroll") for (int _i = 0; _i < 2; ++_i) \
    __builtin_amdgcn_global_load_lds((const unsigned*)((gptr) + voff[_i]), (LAS unsigned*)(lds + (bufoff) + ldsw + _i * 8192), 16, 0, 0); } while (0)
#define LDA(dst, b, h) do { _Pragma("unroll") for (int m = 0; m < 4; ++m) _Pragma("unroll") for (int k = 0; k < 2; ++k) \
    dst[m][k] = *(const LAS bf16x8*)(lds + SAo(b, h) + aoff + m * 2048 + k * 1024); } while (0)
#define LDB(dst, b, h) do { _Pragma("unroll") for (int n = 0; n < 2; ++n) _Pragma("unroll") for (int k = 0; k < 2; ++k) \
    dst[n][k] = *(const LAS bf16x8*)(lds + SBo(b, h) + boff + n * 2048 + k * 1024); } while (0)
#define MMA(ai, bj, At, Bt_) do { __builtin_amdgcn_s_setprio(1); \
    _Pragma("unroll") for (int m = 0; m < 4; ++m) _Pragma("unroll") for (int n = 0; n < 2; ++n) _Pragma("unroll") for (int k = 0; k < 2; ++k) \
      acc[ai][bj][m][n] = __builtin_amdgcn_mfma_f32_16x16x32_bf16(Bt_[n][k], At[m][k], acc[ai][bj][m][n], 0, 0, 0); \
    __builtin_amdgcn_s_setprio(0); } while (0)
#define WAIT_V(n) asm volatile("s_waitcnt vmcnt(" #n ")" ::: "memory")
#define WAIT_L(n) asm volatile("s_waitcnt lgkmcnt(" #n ")" ::: "memory")
#define BAR __builtin_amdgcn_s_barrier()
#define SCHED __builtin_amdgcn_sched_barrier(0)
  int L = bid;
  if (L >= nT) return;
  int pm, pn; tile_of(L, nM, nN, pm, pn);
  f32x4 acc[2][2][4][2];
#pragma unroll
  for (int a = 0; a < 2; ++a)
#pragma unroll
    for (int b = 0; b < 2; ++b)
#pragma unroll
      for (int m = 0; m < 4; ++m)
#pragma unroll
        for (int n = 0; n < 2; ++n) acc[a][b][m][n] = (f32x4){0.f, 0.f, 0.f, 0.f};
  bf16x8 At[4][2], B0[2][2], B1[2][2];
  const char* cA = (const char*)A + (size_t)pm * tstep; const char* cB = (const char*)Bt + (size_t)pn * tstep;
  WAIT_V(0);
  STAGEP(SBo(0, 0), cB); STAGEP(SBo(0, 1), cB + hstep); STAGEP(SAo(0, 0), cA); STAGEP(SAo(0, 1), cA + hstep);
  if (wr == 1) BAR;
  WAIT_V(2); BAR;
  STAGEP(SBo(1, 0), cB + kstep); STAGEP(SAo(1, 0), cA + kstep); STAGEP(SBo(1, 1), cB + hstep + kstep);
  WAIT_V(6); BAR;
  for (;;) {
    const bool has_next = (L + nb < nT);
    int npm = pm, npn = pn;
    if (has_next) tile_of(L + nb, nM, nN, npm, npn);
    const char* nA = (const char*)A + (size_t)npm * tstep; const char* nB = (const char*)Bt + (size_t)npn * tstep;
    for (int t = 0; t < nt; t += 2) {
      const bool last = (t == nt - 2);
      const char* a1 = cA + (size_t)(t + 1) * kstep;
      const char* a2 = last ? nA : cA + (size_t)(t + 2) * kstep; const char* b2 = last ? nB : cB + (size_t)(t + 2) * kstep;
      const char* a3 = a2 + kstep; const char* b3 = b2 + kstep;
      LDB(B0, 0, 0); LDB(B1, 0, 1); SCHED; LDA(At, 0, 0); STAGEP(SAo(1, 1), a1 + hstep);
      WAIT_V(8); WAIT_L(0); BAR; MMA(0, 0, At, B0); MMA(0, 1, At, B1); BAR; SCHED;
      LDA(At, 0, 1); STAGEP(SBo(0, 0), b2); STAGEP(SBo(0, 1), b2 + hstep); STAGEP(SAo(0, 0), a2);
      WAIT_V(8); WAIT_L(0); BAR; MMA(1, 0, At, B0); MMA(1, 1, At, B1); BAR; SCHED;
      LDB(B0, 1, 0); LDB(B1, 1, 1); SCHED; LDA(At, 1, 0); STAGEP(SAo(0, 1), a2 + hstep);
      WAIT_V(8); WAIT_L(0); BAR; MMA(0, 0, At, B0); MMA(0, 1, At, B1); BAR; SCHED;
      LDA(At, 1, 1); STAGEP(SBo(1, 0), b3); STAGEP(SBo(1, 1), b3 + hstep); STAGEP(SAo(1, 0), a3);
      WAIT_V(8); WAIT_L(0); BAR; MMA(1, 0, At, B0); MMA(1, 1, At, B1); BAR; SCHED;
    }
    if (wr == 0) BAR;
    gemm_epi<EPI>(lds, acc, pm * BM, pn * BM, p);
    if (!has_next) break;
#pragma unroll
    for (int a = 0; a < 2; ++a)
#pragma unroll
      for (int b = 0; b < 2; ++b)
#pragma unroll
        for (int m = 0; m < 4; ++m)
#pragma unroll
          for (int n = 0; n < 2; ++n) acc[a][b][m][n] = (f32x4){0.f, 0.f, 0.f, 0.f};
    pm = npm; pn = npn; cA = nA; cB = nB; L += nb;
    if (wr == 1) BAR;
  }
  WAIT_V(0);
  BAR;
}

DI float ret_log2g(int h) { return log2f(1.0f - exp2f(-5.0f - (float)h)); }

typedef float f32x16 __attribute__((ext_vector_type(16)));
typedef short s16x4 __attribute__((ext_vector_type(4)));
#define MFMA32(a, b, c) __builtin_amdgcn_mfma_f32_32x32x16_bf16((a), (b), (c), 0, 0, 0)
DI s16x4 tr_read(LAS unsigned char* a) { return __builtin_amdgcn_ds_read_tr16_b64_v4i16((LAS s16x4*)a); }
DI bf16x8 tr_frag(LAS unsigned char* a, int rowstride8) {
  const s16x4 lo = tr_read(a), hi = tr_read(a + rowstride8);
  return __builtin_shufflevector(lo, hi, 0, 1, 2, 3, 4, 5, 6, 7);
}
DI bf16x8 pack8(const f32x16& x, int s) {
  u32x4 w;
  w.x = pack2(x[8 * s + 0], x[8 * s + 1]); w.y = pack2(x[8 * s + 2], x[8 * s + 3]); w.z = pack2(x[8 * s + 4], x[8 * s + 5]); w.w = pack2(x[8 * s + 6], x[8 * s + 7]);
  return __builtin_bit_cast(bf16x8, w);
}
DI float fexp2(float x) { return __builtin_amdgcn_exp2f(x); }
DI float half_max(float x) { const u32x2 r = __builtin_amdgcn_permlane32_swap(__float_as_uint(x), __float_as_uint(x), false, false); return fmaxf(__uint_as_float(r[0]), __uint_as_float(r[1])); }
DI float half_sum(float x) { const u32x2 r = __builtin_amdgcn_permlane32_swap(__float_as_uint(x), __float_as_uint(x), false, false); return __uint_as_float(r[0]) + __uint_as_float(r[1]); }
DI float silu(float g) { return g * __builtin_amdgcn_rcpf(1.0f + __builtin_amdgcn_exp2f(-1.4426950408889634f * g)); }

constexpr int AT_ROWB = 136, AT_LS = 512 * AT_ROWB, AT_VST = AT_LS + 2048, VROW = 192, KROW = 144, KST_W = 32 * KROW, VST_W = KST_W + 32 * VROW;
constexpr int ATTN_LDS = AT_VST + 8 * VST_W;
constexpr float LOG2E = 1.4426950408889634f;

constexpr int PT_ROW = 136;

DI void softmax_pv(f32x16& S, f32x16& O0, f32x16& O1, float& m, float& l, const bf16x8 (&Vf)[2][2], const bool mlow, const bool mhigh, const int r, const int h) {
  if (mlow || mhigh) {
#pragma unroll
    for (int i = 0; i < 16; ++i) {
      const int keyrow = (i & 3) + 8 * (i >> 2) + 4 * h;
      const bool bad = (mlow && keyrow < r) || (mhigh && keyrow > r);
      S[i] = bad ? -1e30f : S[i];
    }
  }
  float mx = fmaxf(S[0], S[1]);
#pragma unroll
  for (int i = 2; i < 16; ++i) mx = fmaxf(mx, S[i]);
  mx = half_max(mx);
  const float mn = fmaxf(m, mx);
  if (__builtin_amdgcn_ballot_w64(mn > m) != 0ull) {
    const float al = fexp2(m - mn);
    l *= al;
#pragma unroll
    for (int i = 0; i < 16; ++i) { O0[i] *= al; O1[i] *= al; }
    m = mn;
  }
  float ps = 0.f;
#pragma unroll
  for (int i = 0; i < 16; ++i) { S[i] = fexp2(S[i] - mn); ps += S[i]; }
  l += half_sum(ps);
#pragma unroll
  for (int s = 0; s < 2; ++s) {
    const bf16x8 Pb = pack8(S, s);
    O0 = MFMA32(Vf[s][0], Pb, O0);
    O1 = MFMA32(Vf[s][1], Pb, O1);
  }
}

DI void attn_tile2(const u32x4 (&Kc)[4], const u32x4 (&Vc)[4], const bf16x8 (&QA)[4], const bf16x8 (&QB)[4],
                   f32x16& A0, f32x16& A1, float& mA, float& lA, f32x16& B0, f32x16& B1, float& mB, float& lB,
                   LAS unsigned char* kst, LAS unsigned char* vst, LAS unsigned char* trp, const int lane, const int kt) {
  const int r = lane & 31, h = lane >> 5;
#pragma unroll
  for (int c = 0; c < 4; ++c) {
    *(LAS u32x4*)(kst + ((lane >> 3) + 8 * c) * KROW + (lane & 7) * 16) = Kc[c];
    *(LAS u32x4*)(vst + ((lane >> 3) + 8 * c) * VROW + (lane & 7) * 16) = Vc[c];
  }
  bf16x8 Kf[4], Vf[2][2];
#pragma unroll
  for (int ks = 0; ks < 4; ++ks) Kf[ks] = *(const LAS bf16x8*)(kst + r * KROW + (2 * ks + h) * 16);
#pragma unroll
  for (int s = 0; s < 2; ++s) { Vf[s][0] = tr_frag(trp + 16 * s * VROW, 8 * VROW); Vf[s][1] = tr_frag(trp + 16 * s * VROW + 64, 8 * VROW); }
  if (kt <= 4) {
    f32x16 S;
#pragma unroll
    for (int i = 0; i < 16; ++i) S[i] = 0.f;
#pragma unroll
    for (int ks = 0; ks < 4; ++ks) S = MFMA32(Kf[ks], QA[ks], S);
    softmax_pv(S, A0, A1, mA, lA, Vf, kt == 0, kt == 4, r, h);
  }
  if (kt >= 1) {
    f32x16 S;
#pragma unroll
    for (int i = 0; i < 16; ++i) S[i] = 0.f;
#pragma unroll
    for (int ks = 0; ks < 4; ++ks) S = MFMA32(Kf[ks], QB[ks], S);
    softmax_pv(S, B0, B1, mB, lB, Vf, kt == 1, kt == 5, r, h);
  }
}

DI void attn_merge(const Params& p, LAS unsigned char* T, const f32x16& O0, const f32x16& O1, const float m, const float l, const int lane,
                   const int tokq0  , const int sh, const int hh, const bool first, const bool last) {
  const int r = lane & 31, h = lane >> 5;
  const int rowc = lane >> 3, ch = lane & 7;
  float lse = m + __log2f(l);
  float w1 = 1.0f / l, w0 = 0.f;
  if (!first) {
#pragma unroll
    for (int c = 0; c < 4; ++c) {
      const size_t tk = (size_t)(tokq0 + ((rowc + 8 * c) << sh));
      *(LAS u32x4*)(T + (rowc + 8 * c) * PT_ROW + ch * 16) = *(const u32x4*)(p.ob + (tk * 8 + hh) * 64 + ch * 8);
    }
    const float lp = p.lseg[(size_t)(tokq0 + (r << sh)) * 8 + hh];
    const float M = fmaxf(lse, lp), e1 = fexp2(lse - M), e0 = fexp2(lp - M), den = e0 + e1, id = 1.0f / den;
    w1 *= e1 * id; w0 = e0 * id; lse = M + __log2f(den);
  }
  LAS unsigned char* ob = T + r * PT_ROW + 8 * h;
#pragma unroll
  for (int dt = 0; dt < 2; ++dt)
#pragma unroll
    for (int g = 0; g < 4; ++g) {
      float f0, f1, f2, f3;
      if (dt == 0) { f0 = O0[4 * g] * w1; f1 = O0[4 * g + 1] * w1; f2 = O0[4 * g + 2] * w1; f3 = O0[4 * g + 3] * w1; }
      else { f0 = O1[4 * g] * w1; f1 = O1[4 * g + 1] * w1; f2 = O1[4 * g + 2] * w1; f3 = O1[4 * g + 3] * w1; }
      LAS u32x2* a = (LAS u32x2*)(ob + 64 * dt + 16 * g);
      if (!first) { const u32x2 pv = *a; f0 += w0 * bflo(pv.x); f1 += w0 * bfhi(pv.x); f2 += w0 * bflo(pv.y); f3 += w0 * bfhi(pv.y); }
      u32x2 wv; wv.x = pack2(f0, f1); wv.y = pack2(f2, f3);
      *a = wv;
    }
  if (!last) {
    if (h == 0) p.lseg[(size_t)(tokq0 + (r << sh)) * 8 + hh] = lse;
#pragma unroll
    for (int c = 0; c < 4; ++c) {
      const size_t tk = (size_t)(tokq0 + ((rowc + 8 * c) << sh));
      *(u32x4*)(p.ob + (tk * 8 + hh) * 64 + ch * 8) = *(const LAS u32x4*)(T + (rowc + 8 * c) * PT_ROW + ch * 16);
    }
  } else {
#pragma unroll
    for (int c = 0; c < 4; ++c) {
      const size_t tk = (size_t)(tokq0 + ((rowc + 8 * c) << sh));
      const u32x4 a = *(const LAS u32x4*)(T + (rowc + 8 * c) * PT_ROW + ch * 16);
      const u32x4 g = *(const u32x4*)(p.proj + tk * NW + OFF_GA + hh * 64 + ch * 8);
      u32x4 w;
      w.x = pack2(bflo(a.x) * silu(bflo(g.x)), bfhi(a.x) * silu(bfhi(g.x)));
      w.y = pack2(bflo(a.y) * silu(bflo(g.y)), bfhi(a.y) * silu(bfhi(g.y)));
      w.z = pack2(bflo(a.z) * silu(bflo(g.z)), bfhi(a.z) * silu(bfhi(g.z)));
      w.w = pack2(bflo(a.w) * silu(bflo(g.w)), bfhi(a.w) * silu(bfhi(g.w)));
      *(u32x4*)(p.mixed + tk * DM + hh * 64 + ch * 8) = w;
    }
  }
}

DI void attn_task2(const Params& p, LAS unsigned char* kst, const int lane, const int tokbase, const int hh,
                   const int sh, const int r_res, const int l0, const bool first, const bool last) {
  const int r = lane & 31, h = lane >> 5;
  const int i16 = lane & 15, q4 = i16 >> 2, pp = i16 & 3, blk = (lane >> 4) & 1;
  LAS unsigned char* vst = kst + KST_W;
  LAS unsigned char* trp = vst + (4 * h + q4) * VROW + 32 * blk + 8 * pp;
  const bf16_t* qpA = p.proj + (size_t)(tokbase + r_res + ((l0 + r) << sh)) * NW + OFF_QA + hh * 64 + 8 * h;
  const bf16_t* qpB = qpA + (size_t)(32 << sh) * NW;
  bf16x8 QA[4], QB[4];
#pragma unroll
  for (int ks = 0; ks < 4; ++ks) { QA[ks] = *(const bf16x8*)(qpA + 16 * ks); QB[ks] = *(const bf16x8*)(qpB + 16 * ks); }
  f32x16 A0, A1, B0, B1;
#pragma unroll
  for (int i = 0; i < 16; ++i) { A0[i] = 0.f; A1[i] = 0.f; B0[i] = 0.f; B1[i] = 0.f; }
  float mA = -1e30f, lA = 0.f, mB = -1e30f, lB = 0.f;
  const int kt0 = (l0 >= 128) ? 0 : (4 - (l0 >> 5));
#define LOAD_KV(Kd, Vd, kt_) do { const int lk0_ = l0 - 128 + 32 * (kt_) + (lane >> 3); \
    _Pragma("unroll") for (int c_ = 0; c_ < 4; ++c_) { \
      const bf16_t* kp_ = p.proj + (size_t)(tokbase + r_res + ((lk0_ + 8 * c_) << sh)) * NW + OFF_KA + hh * 64 + 8 * (lane & 7); \
      Kd[c_] = *(const u32x4*)kp_; Vd[c_] = *(const u32x4*)(kp_ + (OFF_VA - OFF_KA)); } } while (0)
  for (int kt = kt0; kt < 6; kt += 2) {
    u32x4 K0[4], K1[4], V0[4], V1[4];
    LOAD_KV(K0, V0, kt);
    LOAD_KV(K1, V1, kt + 1);
    attn_tile2(K0, V0, QA, QB, A0, A1, mA, lA, B0, B1, mB, lB, kst, vst, trp, lane, kt);
    attn_tile2(K1, V1, QA, QB, A0, A1, mA, lA, B0, B1, mB, lB, kst, vst, trp, lane, kt + 1);
  }
#undef LOAD_KV
  const int tokA = tokbase + r_res + (l0 << sh);
  attn_merge(p, kst, A0, A1, mA, lA, lane, tokA, sh, hh, first, last);
  attn_merge(p, kst, B0, B1, mB, lB, lane, tokA + (32 << sh), sh, hh, first, last);
}

DI void phase_attn(LAS unsigned char* lds, const Params& p, int bid, int nb) {
  const int tid = threadIdx.x, wid = __builtin_amdgcn_readfirstlane(tid >> 6), lane = tid & 63;
  LAS unsigned char* kst = lds + wid * VST_W;
  for (int unit = bid; unit < 256; unit += nb) {
    const int xj = unit >> 3, bhh = (unit & 7) * 8 + (xj >> 2), sp = xj & 3, hh = bhh & 7, b = bhh >> 3;
    const int tokbase = b * SEQ;
    for (int stage = 0; stage < 3; ++stage) {
      const int sh = stage == 0 ? 4 : (stage == 1 ? 2 : 0);
      for (int tk = 0; tk < 2; ++tk) {
        const int idx = wid + 8 * tk;
        int r_res, l0;
        if (stage == 0) { r_res = idx; l0 = 64 * sp; }
        else if (stage == 1) { r_res = idx >> 2; l0 = 256 * sp + 64 * (idx & 3); }
        else { r_res = 0; l0 = 1024 * sp + 64 * idx; }
        attn_task2(p, kst, lane, tokbase, hh, sh, r_res, l0, stage == 0, stage == 2);
      }
      __syncthreads();
    }
  }
}

constexpr int RV_ROW = 320, RK_ROW = 192, RV_OFF = 0, RK_OFF = 128 * RV_ROW  , RRED_OFF = RK_OFF + 128 * RK_ROW  ;

DI void retout_unit(LAS unsigned char* lds, const Params& p, const int u);
DI void phase_retkv(LAS unsigned char* lds, const Params& p, int bid, int nb, const int mode) {
  const int tid = threadIdx.x, wid = __builtin_amdgcn_readfirstlane(tid >> 6), lane = tid & 63;
  const int r = lane & 31, h = lane >> 5, i16 = lane & 15, q4 = i16 >> 2, pp = i16 & 3, blk = (lane >> 4) & 1;
  const int vt = wid >> 1, dt = wid & 1;
  LAS int* uslot = (LAS int*)(lds + RRED_OFF);
  for (;;) {
    if (tid == 0) *uslot = (int)__hip_atomic_fetch_add(p.bar + 200 + mode, 1u, __ATOMIC_RELAXED, __HIP_MEMORY_SCOPE_AGENT);
    __syncthreads();
    const int u = __builtin_amdgcn_readfirstlane(*uslot);
    if (u >= 1024) break;
    if (mode) { __syncthreads(); retout_unit(lds, p, u); continue; }
    const int n = u & 31, hh = (u >> 5) & 3, b = u >> 7;
    const float lg = ret_log2g(hh);
    const bf16_t* base = p.proj + (size_t)(b * SEQ + n * 128) * NW;
#pragma unroll
    for (int it = 0; it < 4; ++it) {
      const int c = tid + 512 * it, j = c >> 4, cc = c & 15;
      *(LAS u32x4*)(lds + RV_OFF + j * RV_ROW + cc * 16) = *(const u32x4*)(base + (size_t)j * NW + OFF_VR + hh * 128 + cc * 8);
    }
#pragma unroll
    for (int it = 0; it < 2; ++it) {
      const int c = tid + 512 * it, j = c >> 3, cc = c & 7;
      const u32x4 w = *(const u32x4*)(base + (size_t)j * NW + OFF_KR + hh * 64 + cc * 8);
      const float dk = exp2f((float)(127 - j) * lg);
      u32x4 o;
      o.x = pack2(bflo(w.x) * dk, bfhi(w.x) * dk); o.y = pack2(bflo(w.y) * dk, bfhi(w.y) * dk);
      o.z = pack2(bflo(w.z) * dk, bfhi(w.z) * dk); o.w = pack2(bflo(w.w) * dk, bfhi(w.w) * dk);
      *(LAS u32x4*)(lds + RK_OFF + j * RK_ROW + cc * 16) = o;
    }
    __syncthreads();
    f32x16 acc;
#pragma unroll
    for (int i = 0; i < 16; ++i) acc[i] = 0.f;
    LAS unsigned char* va = lds + RV_OFF + (4 * h + q4) * RV_ROW + (32 * vt + 16 * blk + 4 * pp) * 2;
    LAS unsigned char* ka = lds + RK_OFF + (4 * h + q4) * RK_ROW + (32 * dt + 16 * blk + 4 * pp) * 2;
#pragma unroll
    for (int s = 0; s < 8; ++s) {
      const bf16x8 A = tr_frag(va + 16 * s * RV_ROW, 8 * RV_ROW), B = tr_frag(ka + 16 * s * RK_ROW, 8 * RK_ROW);
      acc = MFMA32(A, B, acc);
    }
    float* o = p.kvT + ((size_t)u << 13) + (32 * vt + 4 * h) * 64 + 32 * dt + r;
#pragma unroll
    for (int i = 0; i < 16; ++i) __hip_atomic_store(o + ((i & 3) + 8 * (i >> 2)) * 64, acc[i], __ATOMIC_RELAXED, __HIP_MEMORY_SCOPE_AGENT);
    asm volatile("s_waitcnt vmcnt(0)" ::: "memory");
    __syncthreads();
    const int bh = u >> 5;
    if (tid == 0) uslot[1] = (__hip_atomic_fetch_add(p.bar + 208 + bh, 1u, __ATOMIC_RELAXED, __HIP_MEMORY_SCOPE_AGENT) == 31u) ? 1 : 0;
    __syncthreads();
    if (__builtin_amdgcn_readfirstlane(uslot[1]) != 0) {
      if (tid == 0) { __builtin_amdgcn_fence(__ATOMIC_ACQUIRE, "agent"); asm volatile("s_waitcnt vmcnt(0)" ::: "memory"); }
      __syncthreads();
      typedef float f32x2 __attribute__((ext_vector_type(2)));
      const float cd = exp2f(128.0f * lg);
      for (int e2 = tid; e2 < 4096; e2 += 1024) {
        const int ea = e2 * 2, eb = (e2 + 512) * 2;
        f32x2 ka[31], kb[31];
#pragma unroll
        for (int nn = 0; nn < 31; ++nn) {
          const float* a = p.kvT + ((size_t)(bh * 32 + nn) << 13);
          ka[nn] = *(const f32x2*)(a + ea); kb[nn] = *(const f32x2*)(a + eb);
        }
        float a0 = 0.f, a1 = 0.f, b0 = 0.f, b1 = 0.f;
#pragma unroll
        for (int nn = 0; nn < 32; ++nn) {
          bf16_t* o = p.stT + ((size_t)(bh * 32 + nn) << 13);
          __hip_atomic_store((unsigned*)(o + ea), pack2(a0, a1), __ATOMIC_RELAXED, __HIP_MEMORY_SCOPE_AGENT);
          __hip_atomic_store((unsigned*)(o + eb), pack2(b0, b1), __ATOMIC_RELAXED, __HIP_MEMORY_SCOPE_AGENT);
          if (nn < 31) { a0 = a0 * cd + ka[nn][0]; a1 = a1 * cd + ka[nn][1]; b0 = b0 * cd + kb[nn][0]; b1 = b1 * cd + kb[nn][1]; }
        }
      }
      asm volatile("s_waitcnt vmcnt(0)" ::: "memory");
      __syncthreads();
      if (tid == 0) __hip_atomic_store(p.bar + 16 + bh, 1u, __ATOMIC_RELAXED, __HIP_MEMORY_SCOPE_AGENT);
    }
    __syncthreads();
  }
  __syncthreads();
}

constexpr int RKO = 40960, RQO = RKO + 128 * 144, RSO = RQO + 128 * 144, RGO = RSO + 128 * 144, RG_ROW = 272, RRED2 = RGO + 128 * RG_ROW;
DI void retout_unit(LAS unsigned char* lds, const Params& p, const int u) {
  const int tid = threadIdx.x, wid = __builtin_amdgcn_readfirstlane(tid >> 6), lane = tid & 63;
  const int r = lane & 31, h = lane >> 5, i16 = lane & 15, q4 = i16 >> 2, pp = i16 & 3, blk = (lane >> 4) & 1;
  const int it = wid & 3, vh = wid >> 2;
  LAS float* red = (LAS float*)(lds + RRED2);
  {
    if (tid == 0) {
      unsigned spins = 0;
      while (__hip_atomic_load(p.bar + 16 + (u >> 5), __ATOMIC_RELAXED, __HIP_MEMORY_SCOPE_AGENT) == 0u && spins < (1u << 22)) { __builtin_amdgcn_s_sleep(2); ++spins; }
      __builtin_amdgcn_fence(__ATOMIC_ACQUIRE, "agent");
      asm volatile("s_waitcnt vmcnt(0)" ::: "memory");
    }
    __syncthreads();
    const int n = u & 31, hh = (u >> 5) & 3, b = u >> 7;
    const float lg = ret_log2g(hh);
    const int tok0 = b * SEQ + n * 128;
    const bf16_t* base = p.proj + (size_t)tok0 * NW;
    {
      u32x4 tv[4], tg[4], tk[2], tq[2], ts[2];
#pragma unroll
      for (int k = 0; k < 4; ++k) {
        const int c = tid + 512 * k, j = c >> 4, cc = c & 15;
        tv[k] = *(const u32x4*)(base + (size_t)j * NW + OFF_VR + hh * 128 + cc * 8);
        tg[k] = *(const u32x4*)(base + (size_t)j * NW + OFF_GR + hh * 128 + cc * 8);
      }
#pragma unroll
      for (int k = 0; k < 2; ++k) {
        const int c = tid + 512 * k, j = c >> 3, cc = c & 7;
        tk[k] = *(const u32x4*)(base + (size_t)j * NW + OFF_KR + hh * 64 + cc * 8);
        tq[k] = *(const u32x4*)(base + (size_t)j * NW + OFF_QR + hh * 64 + cc * 8);
        ts[k] = *(const u32x4*)(p.stT + ((size_t)u << 13) + (size_t)c * 8);
      }
#pragma unroll
      for (int k = 0; k < 4; ++k) {
        const int c = tid + 512 * k, j = c >> 4, cc = c & 15;
        *(LAS u32x4*)(lds + RV_OFF + j * RV_ROW + cc * 16) = tv[k];
        *(LAS u32x4*)(lds + RGO + j * RG_ROW + cc * 16) = tg[k];
      }
#pragma unroll
      for (int k = 0; k < 2; ++k) {
        const int c = tid + 512 * k, j = c >> 3, cc = c & 7;
        *(LAS u32x4*)(lds + RKO + j * 144 + cc * 16) = tk[k];
        *(LAS u32x4*)(lds + RQO + j * 144 + cc * 16) = tq[k];
        *(LAS u32x4*)(lds + RSO + j * 144 + cc * 16) = ts[k];
      }
    }
    __syncthreads();
    const int qi = 32 * it + r;
    bf16x8 Qf[4];
#pragma unroll
    for (int ks = 0; ks < 4; ++ks) Qf[ks] = *(const LAS bf16x8*)(lds + RQO + qi * 144 + (2 * ks + h) * 16);
    f32x16 O0, O1;
#pragma unroll
    for (int i = 0; i < 16; ++i) { O0[i] = 0.f; O1[i] = 0.f; }
    {
#pragma unroll
      for (int ks = 0; ks < 4; ++ks) {
        const bf16x8 S0 = *(const LAS bf16x8*)(lds + RSO + (64 * vh + r) * 144 + (2 * ks + h) * 16);
        const bf16x8 S1 = *(const LAS bf16x8*)(lds + RSO + (64 * vh + 32 + r) * 144 + (2 * ks + h) * 16);
        O0 = MFMA32(S0, Qf[ks], O0); O1 = MFMA32(S1, Qf[ks], O1);
      }
      const float qd = exp2f((float)(qi + 1) * lg);
#pragma unroll
      for (int i = 0; i < 16; ++i) { O0[i] *= qd; O1[i] *= qd; }
    }
    LAS unsigned char* va = lds + RV_OFF + (4 * h + q4) * RV_ROW + (64 * vh + 16 * blk + 4 * pp) * 2;
    for (int jt = 0; jt <= it; ++jt) {
      f32x16 S;
#pragma unroll
      for (int i = 0; i < 16; ++i) S[i] = 0.f;
#pragma unroll
      for (int ks = 0; ks < 4; ++ks) { const bf16x8 Kf = *(const LAS bf16x8*)(lds + RKO + (32 * jt + r) * 144 + (2 * ks + h) * 16); S = MFMA32(Kf, Qf[ks], S); }
#pragma unroll
      for (int i = 0; i < 16; ++i) {
        const int dj = qi - (32 * jt + (i & 3) + 8 * (i >> 2) + 4 * h);
        S[i] = dj >= 0 ? S[i] * fexp2((float)dj * lg) : 0.f;
      }
#pragma unroll
      for (int s2 = 0; s2 < 2; ++s2) {
        const bf16x8 Pb = pack8(S, s2);
        const bf16x8 V0 = tr_frag(va + (32 * jt + 16 * s2) * RV_ROW, 8 * RV_ROW), V1 = tr_frag(va + (32 * jt + 16 * s2) * RV_ROW + 64, 8 * RV_ROW);
        O0 = MFMA32(V0, Pb, O0);
        O1 = MFMA32(V1, Pb, O1);
      }
    }
    float s1 = 0.f, s2 = 0.f;
#pragma unroll
    for (int i = 0; i < 16; ++i) { s1 += O0[i] + O1[i]; s2 += O0[i] * O0[i] + O1[i] * O1[i]; }
    s1 += __shfl_xor(s1, 32); s2 += __shfl_xor(s2, 32);
    if (h == 0) { red[(vh * 128 + qi) * 2] = s1; red[(vh * 128 + qi) * 2 + 1] = s2; }
    __syncthreads();
    s1 += red[((vh ^ 1) * 128 + qi) * 2]; s2 += red[((vh ^ 1) * 128 + qi) * 2 + 1];
    const float mu = s1 * (1.0f / 128.0f), var = fmaxf(s2 * (1.0f / 128.0f) - mu * mu, 0.f), rs = rsqrtf(var + 1e-5f);
    const float* gnp = p.gn + hh * 128 + 64 * vh + 4 * h;
    LAS unsigned char* gt = lds + RGO + qi * RG_ROW + (64 * vh + 4 * h) * 2;
#pragma unroll
    for (int dt = 0; dt < 2; ++dt)
#pragma unroll
      for (int g = 0; g < 4; ++g) {
        const int vo = 32 * dt + 8 * g;
        LAS u32x2* ga = (LAS u32x2*)(gt + vo * 2);
        const u32x2 gwv = *ga;
        const f32x4 gnv = *(const f32x4*)(gnp + vo);
        float f0, f1, f2, f3;
        if (dt == 0) { f0 = O0[4 * g]; f1 = O0[4 * g + 1]; f2 = O0[4 * g + 2]; f3 = O0[4 * g + 3]; }
        else { f0 = O1[4 * g]; f1 = O1[4 * g + 1]; f2 = O1[4 * g + 2]; f3 = O1[4 * g + 3]; }
        f0 = (f0 - mu) * rs * gnv[0] * silu(bflo(gwv.x)); f1 = (f1 - mu) * rs * gnv[1] * silu(bfhi(gwv.x));
        f2 = (f2 - mu) * rs * gnv[2] * silu(bflo(gwv.y)); f3 = (f3 - mu) * rs * gnv[3] * silu(bfhi(gwv.y));
        u32x2 wv; wv.x = pack2(f0, f1); wv.y = pack2(f2, f3);
        *ga = wv;
      }
    __syncthreads();
#pragma unroll
    for (int k = 0; k < 4; ++k) {
      const int c = tid + 512 * k, j = c >> 4, cc = c & 15;
      *(u32x4*)(p.mixed + (size_t)(tok0 + j) * DM + 512 + hh * 128 + cc * 8) = *(const LAS u32x4*)(lds + RGO + j * RG_ROW + cc * 16);
    }
    __syncthreads();
  }
}

DI void grid_barrier(unsigned* ctr, unsigned target) {
  asm volatile("s_waitcnt vmcnt(0) lgkmcnt(0)" ::: "memory");
  __syncthreads();
  if (threadIdx.x == 0) {
    __builtin_amdgcn_fence(__ATOMIC_RELEASE, "agent");
    asm volatile("s_waitcnt vmcnt(0)" ::: "memory");
    __hip_atomic_fetch_add(ctr, 1u, __ATOMIC_RELAXED, __HIP_MEMORY_SCOPE_AGENT);
    unsigned spins = 0;
    while (__hip_atomic_load(ctr, __ATOMIC_RELAXED, __HIP_MEMORY_SCOPE_AGENT) < target && spins < (1u << 22)) { __builtin_amdgcn_s_sleep(2); ++spins; }
    __builtin_amdgcn_fence(__ATOMIC_ACQUIRE, "agent");
    asm volatile("s_waitcnt vmcnt(0)" ::: "memory");
  }
  __syncthreads();
}

__global__ void __launch_bounds__(512) k_mega(Params p) {
  extern __shared__ __attribute__((aligned(16))) unsigned char shm_[];
  LAS unsigned char* shm = (LAS unsigned char*)shm_;
  const int bid = blockIdx.x, nb = gridDim.x;
  unsigned bar_n = 0;
#ifdef PROBE_PHASE
#ifndef PROBE_BLK
#define PROBE_BLK 0
#endif
  unsigned long long ts_a = 0, ts_b = 0; int ph_i = 0;
  if (PROBE_PHASE == 0) ts_a = __builtin_amdgcn_s_memrealtime();
#define GRID_BAR() do { bar_n += (unsigned)nb; grid_barrier(p.bar, bar_n); ++ph_i; if (ph_i == PROBE_PHASE) ts_a = __builtin_amdgcn_s_memrealtime(); if (ph_i == PROBE_PHASE + 1) ts_b = __builtin_amdgcn_s_memrealtime(); } while (0)
#else
#define GRID_BAR() do { bar_n += (unsigned)nb; grid_barrier(p.bar, bar_n); } while (0)
#endif
  phase_prep(p, bid, nb);
  GRID_BAR();
  phase_gemm<1>(shm, p, bid, nb);
  GRID_BAR();
  phase_retkv(shm, p, bid, nb, 0);
  phase_attn(shm, p, bid, nb);
#ifdef PROBE_SUB
  ts_b = __builtin_amdgcn_s_memrealtime(); ph_i = 100;
#endif
  phase_retkv(shm, p, bid, nb, 1);
  GRID_BAR();
  phase_gemm<2>(shm, p, bid, nb);
#ifdef PROBE_PHASE
  if (PROBE_PHASE == 3) ts_b = __builtin_amdgcn_s_memrealtime();
  if (bid == PROBE_BLK && threadIdx.x == 0) {
    const unsigned long long until = __builtin_amdgcn_s_memrealtime() + 9ull * (ts_b - ts_a);
    while (__builtin_amdgcn_s_memrealtime() < until) __builtin_amdgcn_s_sleep(8);
  }
#endif
}

extern "C" void kernel_launch(void* const* d_in, const int* in_sizes, int n_in, void* d_out, int out_size, void* d_ws, size_t ws_size, hipStream_t stream) {
  Params p{};
  p.x = (const float*)d_in[0]; p.ng = (const float*)d_in[1]; p.w_in = (const float*)d_in[2]; p.gn = (const float*)d_in[3];
  p.w_out = (const float*)d_in[4]; p.fg = (const float*)d_in[5];
  p.out = (float*)d_out;
  char* w = (char*)d_ws; size_t o = 0;
  auto take = [&](size_t bytes) { char* r = w + o; o += (bytes + 255) & ~(size_t)255; return r; };
  p.xb = (bf16_t*)take((size_t)T_TOK * DM * 2);
  p.proj = (bf16_t*)take((size_t)T_TOK * NW * 2);
  p.mixed = (bf16_t*)take((size_t)T_TOK * DM * 2);
  p.winT = (bf16_t*)take((size_t)NW * DM * 2);
  p.woutT = (bf16_t*)take((size_t)DM * DM * 2);
  p.rstd = (float*)take((size_t)T_TOK * 4);
  p.rowss = (float*)take((size_t)T_TOK * 4);
  p.ropeT = (float2*)take((size_t)SEQ * 32 * 8);
  p.retT = (float2*)take((size_t)SEQ * 32 * 8);
  p.kvT = (float*)take((size_t)1024 * 8192 * 4);
  p.stT = (bf16_t*)take((size_t)1024 * 8192 * 2);
  p.bar = (unsigned*)take(1024);
  p.ob = (bf16_t*)take((size_t)T_TOK * 512 * 2);
  p.lseg = (float*)take((size_t)T_TOK * 8 * 4);
  static int grid_blocks = 0;
  if (!grid_blocks) {
    (void)hipFuncSetAttribute((const void*)k_mega, hipFuncAttributeMaxDynamicSharedMemorySize, ATTN_LDS);
    int dev = 0, cus = 0, per_cu = 0;
    (void)hipGetDevice(&dev);
    (void)hipDeviceGetAttribute(&cus, hipDeviceAttributeMultiprocessorCount, dev);
    (void)hipOccupancyMaxActiveBlocksPerMultiprocessor(&per_cu, k_mega, 512, ATTN_LDS);
    if (per_cu < 1) per_cu = 1;
    grid_blocks = cus;
  }
  (void)hipMemsetAsync(p.bar, 0, 1024, stream);
  hipLaunchKernelGGL(k_mega, dim3(grid_blocks), dim3(512), ATTN_LDS, stream, p);
}
```

```cpp
#include <hip/hip_runtime.h>
#include <hip/hip_cooperative_groups.h>
#include <cstdint>
#include <cstdio>
namespace cg = cooperative_groups;

typedef unsigned short bf16_t;
typedef short bf16x8 __attribute__((ext_vector_type(8)));
typedef float f32x4 __attribute__((ext_vector_type(4)));
typedef unsigned u32x4 __attribute__((ext_vector_type(4)));
typedef unsigned u32x2 __attribute__((ext_vector_type(2)));

constexpr int T_TOK = 32768, DM = 1024, NW = 3584, SEQ = 4096;
constexpr int OFF_QA = 0, OFF_KA = 512, OFF_VA = 1024, OFF_GA = 1536, OFF_QR = 2048, OFF_KR = 2304, OFF_VR = 2560, OFF_GR = 3072;

struct Params {
  const float* x; const float* ng; const float* w_in; const float* gn; const float* w_out; const float* fg;
  float* out;
  bf16_t* xb; bf16_t* proj; bf16_t* mixed; bf16_t* winT; bf16_t* woutT;
  float* rstd; float* rowss; float2* ropeT; float2* retT; float* kvT; bf16_t* stT; unsigned* bar; bf16_t* ob; float* lseg;
};

#define DI __device__ __forceinline__
DI unsigned short f2bf(float x) { unsigned u = __float_as_uint(x); u += 0x7fffu + ((u >> 16) & 1u); return (unsigned short)(u >> 16); }
DI float bf2f(unsigned short b) { return __uint_as_float(((unsigned)b) << 16); }
typedef float f32x2_t __attribute__((ext_vector_type(2)));
typedef __bf16 bf16x2_t __attribute__((ext_vector_type(2)));
DI unsigned pack2(float lo, float hi) { const f32x2_t v = {lo, hi}; return __builtin_bit_cast(unsigned, __builtin_convertvector(v, bf16x2_t)); }
DI float bflo(unsigned w) { return __uint_as_float(w << 16); }
DI float bfhi(unsigned w) { return __uint_as_float(w & 0xffff0000u); }
DI int perm32(int rho) { const int n = rho >> 4, i = rho & 15; return 8 * (i >> 2) + 4 * n + (i & 3); }
DI int cmap(int p) { return (p & ~31) + perm32(p & 31); }
DI int cmapA(int p) { return (p & ~127) + ((p >> 6) & 1) * 64 + ((p >> 4) & 1) * 32 + ((p >> 5) & 1) * 16 + (p & 15); }

DI void phase_prep(const Params& p, int bid, int nb) {
  const int tid = threadIdx.x, lane = tid & 63, wid = tid >> 6, nw = blockDim.x >> 6;
  if (wid < 6)
  for (int row0 = (bid * 6 + wid) * 4; row0 < T_TOK; row0 += nb * 6 * 4) {
    f32x4 v[4][4];
#pragma unroll
    for (int rr = 0; rr < 4; ++rr)
#pragma unroll
      for (int it = 0; it < 4; ++it) v[rr][it] = __builtin_nontemporal_load((const f32x4*)(p.x + (size_t)(row0 + rr) * DM + it * 256 + lane * 4));
#pragma unroll
    for (int rr = 0; rr < 4; ++rr) {
      float ss = 0.f;
#pragma unroll
      for (int it = 0; it < 4; ++it) ss += v[rr][it][0] * v[rr][it][0] + v[rr][it][1] * v[rr][it][1] + v[rr][it][2] * v[rr][it][2] + v[rr][it][3] * v[rr][it][3];
#pragma unroll
      for (int o = 32; o >= 1; o >>= 1) ss += __shfl_xor(ss, o);
#pragma unroll
      for (int it = 0; it < 4; ++it) { u32x2 w; w.x = pack2(v[rr][it][0], v[rr][it][1]); w.y = pack2(v[rr][it][2], v[rr][it][3]); *(u32x2*)(p.xb + (size_t)(row0 + rr) * DM + it * 256 + lane * 4) = w; }
      if (lane == 0) p.rstd[row0 + rr] = rsqrtf(ss * (1.0f / DM) + 1e-6f);
    }
  }
  if (wid < 6) return;
  const int gt = bid * 128 + (tid - 384), gn = nb * 128;
  for (int idx = gt; idx < (NW / 4) * 128; idx += gn) {
    const int p4 = idx % (NW / 4), kc = idx / (NW / 4), pp = p4 * 4, c = pp < 1024 ? cmapA(pp) : cmap(pp);
    f32x4 f[8];
#pragma unroll
    for (int j = 0; j < 8; ++j) { const int k = kc * 8 + j; f[j] = *(const f32x4*)(p.w_in + (size_t)k * NW + c) * p.ng[k]; }
#pragma unroll
    for (int e = 0; e < 4; ++e) {
      u32x4 w; w.x = pack2(f[0][e], f[1][e]); w.y = pack2(f[2][e], f[3][e]); w.z = pack2(f[4][e], f[5][e]); w.w = pack2(f[6][e], f[7][e]);
      *(u32x4*)(p.winT + (size_t)(pp + e) * DM + kc * 8) = w;
    }
  }
  for (int idx = gt; idx < (DM / 4) * 128; idx += gn) {
    const int p4 = idx % (DM / 4), kc = idx / (DM / 4), pp = p4 * 4, c = cmap(pp);
    f32x4 f[8];
#pragma unroll
    for (int j = 0; j < 8; ++j) { const int k = kc * 8 + j; f[j] = *(const f32x4*)(p.w_out + (size_t)k * DM + c); }
#pragma unroll
    for (int e = 0; e < 4; ++e) {
      u32x4 w; w.x = pack2(f[0][e], f[1][e]); w.y = pack2(f[2][e], f[3][e]); w.z = pack2(f[4][e], f[5][e]); w.w = pack2(f[6][e], f[7][e]);
      *(u32x4*)(p.woutT + (size_t)(pp + e) * DM + kc * 8) = w;
    }
  }
  for (int idx = gt; idx < SEQ * 32; idx += gn) {
    const int pos = idx >> 5, i = idx & 31;
    const float inv1 = powf(10000.0f, -(float)i / 32.0f);
    const float inv2 = 1.0f / powf(10000.0f, (float)i / 31.0f);
    const float a1 = (float)pos * inv1, a2 = (float)pos * inv2;
    p.ropeT[idx] = make_float2(cosf(a1), sinf(a1));
    p.retT[idx] = make_float2(cosf(a2), sinf(a2));
  }
}

constexpr int BM = 256, BK = 64, HALF = 128, HT = HALF * BK;
constexpr int GEMM_LDS = 8 * HT * 2;
DI int lds_byte(int r, int c) { int st = (r >> 4) * 2 + (c >> 5), rr = r & 15, cc = c & 31, ob = rr * 64 + cc * 2; return st * 1024 + (ob ^ (((ob >> 9) & 1) << 5)); }
DI void stage_rc(int b, int& R, int& C) { int st = b / 1024, sb = b % 1024, swz = sb ^ (((sb >> 9) & 1) << 5); R = (st >> 1) * 16 + swz / 64; C = (st & 1) * 32 + (swz % 64) / 2; }

#define LAS __attribute__((address_space(3)))
template <int EPI>
DI void gemm_epi(LAS unsigned char* lds, f32x4 (&acc)[2][2][4][2], const int brow, const int bcol, const Params& p) {
  const int tid = threadIdx.x, wid = __builtin_amdgcn_readfirstlane(tid >> 6), lane = tid & 63, wr = wid >> 2, wc = wid & 3, fr = lane & 15, fq = lane >> 4;
  if (EPI == 1) {
    const int pn = bcol >> 8;
    if (pn < 4) {
      const float sc = pn < 2 ? 0.125f * 1.4426950408889634f : 1.0f;
      const int i0 = 16 * (wc & 1) + 4 * fq;
#pragma unroll
      for (int ai = 0; ai < 2; ++ai)
#pragma unroll
        for (int m = 0; m < 4; ++m) {
          const int row = brow + ai * HALF + wr * 64 + m * 16 + fr;
          const float rs = p.rstd[row] * sc;
          const float* tb = (const float*)(p.ropeT + (row & (SEQ - 1)) * 32 + i0);
          const f32x4 t0 = *(const f32x4*)tb, t1 = *(const f32x4*)(tb + 4);
#pragma unroll
          for (int bj = 0; bj < 2; ++bj) {
            const f32x4 x1 = acc[ai][bj][m][0] * rs, x2 = acc[ai][bj][m][1] * rs;
            u32x2 wa, wb;
            wa.x = pack2(x1[0] * t0[0] - x2[0] * t0[1], x1[1] * t0[2] - x2[1] * t0[3]);
            wa.y = pack2(x1[2] * t1[0] - x2[2] * t1[1], x1[3] * t1[2] - x2[3] * t1[3]);
            wb.x = pack2(x2[0] * t0[0] + x1[0] * t0[1], x2[1] * t0[2] + x1[1] * t0[3]);
            wb.y = pack2(x2[2] * t1[0] + x1[2] * t1[1], x2[3] * t1[2] + x1[3] * t1[3]);
            bf16_t* o = p.proj + (size_t)row * NW + bcol + bj * HALF + (wc >> 1) * 64 + i0;
            *(u32x2*)o = wa; *(u32x2*)(o + 32) = wb;
          }
        }
    } else if (pn == 8 || pn == 9) {
      const float sc = pn == 9 ? 0.125f : 1.0f;
      const int i0 = 16 * (wc & 1) + 4 * fq;
#pragma unroll
      for (int ai = 0; ai < 2; ++ai)
#pragma unroll
        for (int m = 0; m < 4; ++m) {
          const int row = brow + ai * HALF + wr * 64 + m * 16 + fr;
          const float rs = p.rstd[row] * sc;
          const float* tb = (const float*)(p.retT + (row & (SEQ - 1)) * 32 + i0);
          const f32x4 t0 = *(const f32x4*)tb, t1 = *(const f32x4*)(tb + 4);
#pragma unroll
          for (int bj = 0; bj < 2; ++bj) {
            const f32x4 v0 = acc[ai][bj][m][0] * rs, v1 = acc[ai][bj][m][1] * rs;
            u32x4 w;
            w.x = pack2(v0[0] * t0[0] - v0[1] * t0[1], v0[1] * t0[0] + v0[0] * t0[1]);
            w.y = pack2(v0[2] * t0[2] - v0[3] * t0[3], v0[3] * t0[2] + v0[2] * t0[3]);
            w.z = pack2(v1[0] * t1[0] - v1[1] * t1[1], v1[1] * t1[0] + v1[0] * t1[1]);
            w.w = pack2(v1[2] * t1[2] - v1[3] * t1[3], v1[3] * t1[2] + v1[2] * t1[3]);
            *(u32x4*)(p.proj + (size_t)row * NW + bcol + bj * HALF + wc * 32 + 8 * fq) = w;
          }
        }
    } else {
#pragma unroll
    for (int ai = 0; ai < 2; ++ai)
#pragma unroll
      for (int m = 0; m < 4; ++m) {
        const int row = brow + ai * HALF + wr * 64 + m * 16 + fr;
        const float rs = p.rstd[row];
#pragma unroll
        for (int bj = 0; bj < 2; ++bj) {
          const f32x4 v0 = acc[ai][bj][m][0] * rs, v1 = acc[ai][bj][m][1] * rs;
          u32x4 w; w.x = pack2(v0[0], v0[1]); w.y = pack2(v0[2], v0[3]); w.z = pack2(v1[0], v1[1]); w.w = pack2(v1[2], v1[3]);
          *(u32x4*)(p.proj + (size_t)row * NW + bcol + bj * HALF + wc * 32 + 8 * fq) = w;
        }
      }
    }
  } else {
    const int pm = brow >> 8, pn = bcol >> 8;
    LAS float* part = (LAS float*)(lds + GEMM_LDS);
    LAS float* rsl = (LAS float*)(lds + GEMM_LDS + 4096);
#pragma unroll
    for (int ai = 0; ai < 2; ++ai)
#pragma unroll
      for (int m = 0; m < 4; ++m) {
        const int rl = ai * HALF + wr * 64 + m * 16 + fr;
        float ss = 0.f;
#pragma unroll
        for (int bj = 0; bj < 2; ++bj) {
          const size_t off = (size_t)(brow + rl) * DM + bcol + bj * HALF + wc * 32 + 8 * fq;
          const f32x4 x0 = __builtin_nontemporal_load((const f32x4*)(p.x + off)), x1 = __builtin_nontemporal_load((const f32x4*)(p.x + off + 4));
          const f32x4 y0 = acc[ai][bj][m][0] + x0, y1 = acc[ai][bj][m][1] + x1;
          acc[ai][bj][m][0] = y0; acc[ai][bj][m][1] = y1;
          ss += y0[0] * y0[0] + y0[1] * y0[1] + y0[2] * y0[2] + y0[3] * y0[3] + y1[0] * y1[0] + y1[1] * y1[1] + y1[2] * y1[2] + y1[3] * y1[3];
        }
        ss += __shfl_xor(ss, 16); ss += __shfl_xor(ss, 32);
        if (fq == 0) part[wc * 256 + rl] = ss;
      }
    __syncthreads();
    float* xs = p.rowss + (size_t)(pm * 4) * 256;
    if (tid < 256) {
      const float tot = part[tid] + part[256 + tid] + part[512 + tid] + part[768 + tid];
      __hip_atomic_store(xs + pn * 256 + tid, tot, __ATOMIC_RELAXED, __HIP_MEMORY_SCOPE_AGENT);
    }
    asm volatile("s_waitcnt vmcnt(0)" ::: "memory");
    __syncthreads();
    unsigned* cnt = p.bar + 64 + pm;
    if (tid == 0) __hip_atomic_fetch_add(cnt, 1u, __ATOMIC_RELAXED, __HIP_MEMORY_SCOPE_AGENT);
    if (wid == 0) {
      unsigned spins = 0;
      while (__hip_atomic_load(cnt, __ATOMIC_RELAXED, __HIP_MEMORY_SCOPE_AGENT) < 4u && spins < (1u << 20)) { __builtin_amdgcn_s_sleep(1); ++spins; }
      __builtin_amdgcn_fence(__ATOMIC_ACQUIRE, "agent");
      asm volatile("s_waitcnt vmcnt(0)" ::: "memory");
    }
    __syncthreads();
    if (tid < 256) {
      float t = 0.f;
#pragma unroll
      for (int q = 0; q < 4; ++q) t += __hip_atomic_load(xs + q * 256 + tid, __ATOMIC_RELAXED, __HIP_MEMORY_SCOPE_AGENT);
      rsl[tid] = rsqrtf(t * (1.0f / DM) + 1e-6f);
    }
    __syncthreads();
#pragma unroll
    for (int ai = 0; ai < 2; ++ai)
#pragma unroll
      for (int m = 0; m < 4; ++m) {
        const int rl = ai * HALF + wr * 64 + m * 16 + fr;
        const float rs = rsl[rl];
#pragma unroll
        for (int bj = 0; bj < 2; ++bj) {
          const int col = bcol + bj * HALF + wc * 32 + 8 * fq;
          const f32x4 g0 = *(const f32x4*)(p.fg + col), g1 = *(const f32x4*)(p.fg + col + 4);
          float* o = p.out + (size_t)(brow + rl) * DM + col;
          __builtin_nontemporal_store(acc[ai][bj][m][0] * rs * g0, (f32x4*)o); __builtin_nontemporal_store(acc[ai][bj][m][1] * rs * g1, (f32x4*)(o + 4));
        }
      }
    __syncthreads();
  }
}

DI void tile_of(int L, int nM, int nN, int& pm, int& pn) {
  const int nwg = nM * nN, NX = 8, WGM = 8;
  int wgid = L; { const int q = nwg / NX, r = nwg % NX, xcd = wgid % NX, off = wgid / NX; wgid = (xcd < r ? xcd * (q + 1) : r * (q + 1) + (xcd - r) * q) + off; }
  const int nig = WGM * nN, gid = wgid / nig, fm = gid * WGM, gsz = (nM - fm) < WGM ? (nM - fm) : WGM;
  pm = fm + ((wgid % nig) % gsz); pn = (wgid % nig) / gsz;
}


template <int EPI>
DI void phase_gemm(LAS unsigned char* lds, const Params& p, int bid, int nb) {
  constexpr int K = 1024, nt = K / BK, HTB = HALF * BK * 2;
  const bf16_t* A = EPI == 1 ? p.xb : p.mixed; const bf16_t* Bt = EPI == 1 ? p.winT : p.woutT;
  const int nM = T_TOK / BM, nN = (EPI == 1 ? NW : DM) / BM, nT = nM * nN;
  const int tid = threadIdx.x, wid = __builtin_amdgcn_readfirstlane(tid >> 6), lane = tid & 63, wr = wid >> 2, wc = wid & 3, fr = lane & 15, fq = lane >> 4;
  unsigned voff[2];
#pragma unroll
  for (int i = 0; i < 2; ++i) { int R, C; stage_rc(tid * 16 + i * 8192, R, C); voff[i] = (unsigned)(R * K + C) * 2u; }
  const unsigned ldsw = (unsigned)wid * 1024u;
  const int aoff = lds_byte(wr * 64 + fr, fq * 8), boff = lds_byte(wc * 32 + fr, fq * 8);
  const size_t kstep = (size_t)(BK * 2), hstep = (size_t)HALF * K * 2, tstep = 2 * hstep;
#define SAo(b, h) (((b) * 2 + (h)) * HTB)
#define SBo(b, h) ((4 + (b) * 2 + (h)) * HTB)
#define STAGEP(bufoff, gptr) do { _Pragma("unroll") for (int _i = 0; _i < 2; ++_i) \
    __builtin_amdgcn_global_load_lds((const unsigned*)((gptr) + voff[_i]), (LAS unsigned*)(lds + (bufoff) + ldsw + _i * 8192), 16, 0, 0); } while (0)
#define LDA(dst, b, h) do { _Pragma("unroll") for (int m = 0; m < 4; ++m) _Pragma("unroll") for (int k = 0; k < 2; ++k) \
    dst[m][k] = *(const LAS bf16x8*)(lds + SAo(b, h) + aoff + m * 2048 + k * 1024); } while (0)
#define LDB(dst, b, h) do { _Pragma("unroll") for (int n = 0; n < 2; ++n) _Pragma("unroll") for (int k = 0; k < 2; ++k) \
    dst[n][k] = *(const LAS bf16x8*)(lds + SBo(b, h) + boff + n * 2048 + k * 1024); } while (0)
#define MMA(ai, bj, At, Bt_) do { __builtin_amdgcn_s_setprio(1); \
    _Pragma("unroll") for (int m = 0; m < 4; ++m) _Pragma("unroll") for (int n = 0; n < 2; ++n) _Pragma("unroll") for (int k = 0; k < 2; ++k) \
      acc[ai][bj][m][n] = __builtin_amdgcn_mfma_f32_16x16x32_bf16(Bt_[n][k], At[m][k], acc[ai][bj][m][n], 0, 0, 0); \
    __builtin_amdgcn_s_setprio(0); } while (0)
#define WAIT_V(n) asm volatile("s_waitcnt vmcnt(" #n ")" ::: "memory")
#define WAIT_L(n) asm volatile("s_waitcnt lgkmcnt(" #n ")" ::: "memory")
#define BAR __builtin_amdgcn_s_barrier()
#define SCHED __builtin_amdgcn_sched_barrier(0)
  int L = bid;
  if (L >= nT) return;
  int pm, pn; tile_of(L, nM, nN, pm, pn);
  f32x4 acc[2][2][4][2];
#pragma unroll
  for (int a = 0; a < 2; ++a)
#pragma unroll
    for (int b = 0; b < 2; ++b)
#pragma unroll
      for (int m = 0; m < 4; ++m)
#pragma unroll
        for (int n = 0; n < 2; ++n) acc[a][b][m][n] = (f32x4){0.f, 0.f, 0.f, 0.f};
  bf16x8 At[4][2], B0[2][2], B1[2][2];
  const char* cA = (const char*)A + (size_t)pm * tstep; const char* cB = (const char*)Bt + (size_t)pn * tstep;
  WAIT_V(0);
  STAGEP(SBo(0, 0), cB); STAGEP(SBo(0, 1), cB + hstep); STAGEP(SAo(0, 0), cA); STAGEP(SAo(0, 1), cA + hstep);
  if (wr == 1) BAR;
  WAIT_V(2); BAR;
  STAGEP(SBo(1, 0), cB + kstep); STAGEP(SAo(1, 0), cA + kstep); STAGEP(SBo(1, 1), cB + hstep + kstep);
  WAIT_V(6); BAR;
  for (;;) {
    const bool has_next = (L + nb < nT);
    int npm = pm, npn = pn;
    if (has_next) tile_of(L + nb, nM, nN, npm, npn);
    const char* nA = (const char*)A + (size_t)npm * tstep; const char* nB = (const char*)Bt + (size_t)npn * tstep;
    for (int t = 0; t < nt; t += 2) {
      const bool last = (t == nt - 2);
      const char* a1 = cA + (size_t)(t + 1) * kstep;
      const char* a2 = last ? nA : cA + (size_t)(t + 2) * kstep; const char* b2 = last ? nB : cB + (size_t)(t + 2) * kstep;
      const char* a3 = a2 + kstep; const char* b3 = b2 + kstep;
      LDB(B0, 0, 0); LDB(B1, 0, 1); SCHED; LDA(At, 0, 0); STAGEP(SAo(1, 1), a1 + hstep);
      WAIT_V(8); WAIT_L(0); BAR; MMA(0, 0, At, B0); MMA(0, 1, At, B1); BAR; SCHED;
      LDA(At, 0, 1); STAGEP(SBo(0, 0), b2); STAGEP(SBo(0, 1), b2 + hstep); STAGEP(SAo(0, 0), a2);
      WAIT_V(8); WAIT_L(0); BAR; MMA(1, 0, At, B0); MMA(1, 1, At, B1); BAR; SCHED;
      LDB(B0, 1, 0); LDB(B1, 1, 1); SCHED; LDA(At, 1, 0); STAGEP(SAo(0, 1), a2 + hstep);
      WAIT_V(8); WAIT_L(0); BAR; MMA(0, 0, At, B0); MMA(0, 1, At, B1); BAR; SCHED;
      LDA(At, 1, 1); STAGEP(SBo(1, 0), b3); STAGEP(SBo(1, 1), b3 + hstep); STAGEP(SAo(1, 0), a3);
      WAIT_V(8); WAIT_L(0); BAR; MMA(1, 0, At, B0); MMA(1, 1, At, B1); BAR; SCHED;
    }
    if (wr == 0) BAR;
    gemm_epi<EPI>(lds, acc, pm * BM, pn * BM, p);
    if (!has_next) break;
#pragma unroll
    for (int a = 0; a < 2; ++a)
#pragma unroll
      for (int b = 0; b < 2; ++b)
#pragma unroll
        for (int m = 0; m < 4; ++m)
#pragma unroll
          for (int n = 0; n < 2; ++n) acc[a][b][m][n] = (f32x4){0.f, 0.f, 0.f, 0.f};
    pm = npm; pn = npn; cA = nA; cB = nB; L += nb;
    if (wr == 1) BAR;
  }
  WAIT_V(0);
  BAR;
}

DI float ret_log2g(int h) { return log2f(1.0f - exp2f(-5.0f - (float)h)); }

typedef float f32x16 __attribute__((ext_vector_type(16)));
typedef short s16x4 __attribute__((ext_vector_type(4)));
#define MFMA32(a, b, c) __builtin_amdgcn_mfma_f32_32x32x16_bf16((a), (b), (c), 0, 0, 0)
DI s16x4 tr_read(LAS unsigned char* a) { return __builtin_amdgcn_ds_read_tr16_b64_v4i16((LAS s16x4*)a); }
DI bf16x8 tr_frag(LAS unsigned char* a, int rowstride8) {
  const s16x4 lo = tr_read(a), hi = tr_read(a + rowstride8);
  return __builtin_shufflevector(lo, hi, 0, 1, 2, 3, 4, 5, 6, 7);
}
DI bf16x8 pack8(const f32x16& x, int s) {
  u32x4 w;
  w.x = pack2(x[8 * s + 0], x[8 * s + 1]); w.y = pack2(x[8 * s + 2], x[8 * s + 3]); w.z = pack2(x[8 * s + 4], x[8 * s + 5]); w.w = pack2(x[8 * s + 6], x[8 * s + 7]);
  return __builtin_bit_cast(bf16x8, w);
}
DI float fexp2(float x) { return __builtin_amdgcn_exp2f(x); }
DI float half_max(float x) { const u32x2 r = __builtin_amdgcn_permlane32_swap(__float_as_uint(x), __float_as_uint(x), false, false); return fmaxf(__uint_as_float(r[0]), __uint_as_float(r[1])); }
DI float half_sum(float x) { const u32x2 r = __builtin_amdgcn_permlane32_swap(__float_as_uint(x), __float_as_uint(x), false, false); return __uint_as_float(r[0]) + __uint_as_float(r[1]); }
DI float silu(float g) { return g * __builtin_amdgcn_rcpf(1.0f + __builtin_amdgcn_exp2f(-1.4426950408889634f * g)); }

constexpr int AT_ROWB = 136, AT_LS = 512 * AT_ROWB, AT_VST = AT_LS + 2048, VROW = 192, KROW = 144, KST_W = 32 * KROW, VST_W = KST_W + 32 * VROW;
constexpr int ATTN_LDS = AT_VST + 8 * VST_W;
constexpr float LOG2E = 1.4426950408889634f;

constexpr int PT_ROW = 136;

DI void softmax_pv(f32x16& S, f32x16& O0, f32x16& O1, float& m, float& l, const bf16x8 (&Vf)[2][2], const bool mlow, const bool mhigh, const int r, const int h) {
  if (mlow || mhigh) {
#pragma unroll
    for (int i = 0; i < 16; ++i) {
      const int keyrow = (i & 3) + 8 * (i >> 2) + 4 * h;
      const bool bad = (mlow && keyrow < r) || (mhigh && keyrow > r);
      S[i] = bad ? -1e30f : S[i];
    }
  }
  float mx = fmaxf(S[0], S[1]);
#pragma unroll
  for (int i = 2; i < 16; ++i) mx = fmaxf(mx, S[i]);
  mx = half_max(mx);
  const float mn = fmaxf(m, mx);
  if (__builtin_amdgcn_ballot_w64(mn > m) != 0ull) {
    const float al = fexp2(m - mn);
    l *= al;
#pragma unroll
    for (int i = 0; i < 16; ++i) { O0[i] *= al; O1[i] *= al; }
    m = mn;
  }
  float ps = 0.f;
#pragma unroll
  for (int i = 0; i < 16; ++i) { S[i] = fexp2(S[i] - mn); ps += S[i]; }
  l += half_sum(ps);
#pragma unroll
  for (int s = 0; s < 2; ++s) {
    const bf16x8 Pb = pack8(S, s);
    O0 = MFMA32(Vf[s][0], Pb, O0);
    O1 = MFMA32(Vf[s][1], Pb, O1);
  }
}

DI void attn_tile2(const u32x4 (&Kc)[4], const u32x4 (&Vc)[4], const bf16x8 (&QA)[4], const bf16x8 (&QB)[4],
                   f32x16& A0, f32x16& A1, float& mA, float& lA, f32x16& B0, f32x16& B1, float& mB, float& lB,
                   LAS unsigned char* kst, LAS unsigned char* vst, LAS unsigned char* trp, const int lane, const int kt) {
  const int r = lane & 31, h = lane >> 5;
#pragma unroll
  for (int c = 0; c < 4; ++c) {
    *(LAS u32x4*)(kst + ((lane >> 3) + 8 * c) * KROW + (lane & 7) * 16) = Kc[c];
    *(LAS u32x4*)(vst + ((lane >> 3) + 8 * c) * VROW + (lane & 7) * 16) = Vc[c];
  }
  bf16x8 Kf[4], Vf[2][2];
#pragma unroll
  for (int ks = 0; ks < 4; ++ks) Kf[ks] = *(const LAS bf16x8*)(kst + r * KROW + (2 * ks + h) * 16);
#pragma unroll
  for (int s = 0; s < 2; ++s) { Vf[s][0] = tr_frag(trp + 16 * s * VROW, 8 * VROW); Vf[s][1] = tr_frag(trp + 16 * s * VROW + 64, 8 * VROW); }
  if (kt <= 4) {
    f32x16 S;
#pragma unroll
    for (int i = 0; i < 16; ++i) S[i] = 0.f;
#pragma unroll
    for (int ks = 0; ks < 4; ++ks) S = MFMA32(Kf[ks], QA[ks], S);
    softmax_pv(S, A0, A1, mA, lA, Vf, kt == 0, kt == 4, r, h);
  }
  if (kt >= 1) {
    f32x16 S;
#pragma unroll
    for (int i = 0; i < 16; ++i) S[i] = 0.f;
#pragma unroll
    for (int ks = 0; ks < 4; ++ks) S = MFMA32(Kf[ks], QB[ks], S);
    softmax_pv(S, B0, B1, mB, lB, Vf, kt == 1, kt == 5, r, h);
  }
}

DI void attn_merge(const Params& p, LAS unsigned char* T, const f32x16& O0, const f32x16& O1, const float m, const float l, const int lane,
                   const int tokq0  , const int sh, const int hh, const bool first, const bool last) {
  const int r = lane & 31, h = lane >> 5;
  const int rowc = lane >> 3, ch = lane & 7;
  float lse = m + __log2f(l);
  float w1 = 1.0f / l, w0 = 0.f;
  if (!first) {
#pragma unroll
    for (int c = 0; c < 4; ++c) {
      const size_t tk = (size_t)(tokq0 + ((rowc + 8 * c) << sh));
      *(LAS u32x4*)(T + (rowc + 8 * c) * PT_ROW + ch * 16) = *(const u32x4*)(p.ob + (tk * 8 + hh) * 64 + ch * 8);
    }
    const float lp = p.lseg[(size_t)(tokq0 + (r << sh)) * 8 + hh];
    const float M = fmaxf(lse, lp), e1 = fexp2(lse - M), e0 = fexp2(lp - M), den = e0 + e1, id = 1.0f / den;
    w1 *= e1 * id; w0 = e0 * id; lse = M + __log2f(den);
  }
  LAS unsigned char* ob = T + r * PT_ROW + 8 * h;
#pragma unroll
  for (int dt = 0; dt < 2; ++dt)
#pragma unroll
    for (int g = 0; g < 4; ++g) {
      float f0, f1, f2, f3;
      if (dt == 0) { f0 = O0[4 * g] * w1; f1 = O0[4 * g + 1] * w1; f2 = O0[4 * g + 2] * w1; f3 = O0[4 * g + 3] * w1; }
      else { f0 = O1[4 * g] * w1; f1 = O1[4 * g + 1] * w1; f2 = O1[4 * g + 2] * w1; f3 = O1[4 * g + 3] * w1; }
      LAS u32x2* a = (LAS u32x2*)(ob + 64 * dt + 16 * g);
      if (!first) { const u32x2 pv = *a; f0 += w0 * bflo(pv.x); f1 += w0 * bfhi(pv.x); f2 += w0 * bflo(pv.y); f3 += w0 * bfhi(pv.y); }
      u32x2 wv; wv.x = pack2(f0, f1); wv.y = pack2(f2, f3);
      *a = wv;
    }
  if (!last) {
    if (h == 0) p.lseg[(size_t)(tokq0 + (r << sh)) * 8 + hh] = lse;
#pragma unroll
    for (int c = 0; c < 4; ++c) {
      const size_t tk = (size_t)(tokq0 + ((rowc + 8 * c) << sh));
      *(u32x4*)(p.ob + (tk * 8 + hh) * 64 + ch * 8) = *(const LAS u32x4*)(T + (rowc + 8 * c) * PT_ROW + ch * 16);
    }
  } else {
#pragma unroll
    for (int c = 0; c < 4; ++c) {
      const size_t tk = (size_t)(tokq0 + ((rowc + 8 * c) << sh));
      const u32x4 a = *(const LAS u32x4*)(T + (rowc + 8 * c) * PT_ROW + ch * 16);
      const u32x4 g = *(const u32x4*)(p.proj + tk * NW + OFF_GA + hh * 64 + ch * 8);
      u32x4 w;
      w.x = pack2(bflo(a.x) * silu(bflo(g.x)), bfhi(a.x) * silu(bfhi(g.x)));
      w.y = pack2(bflo(a.y) * silu(bflo(g.y)), bfhi(a.y) * silu(bfhi(g.y)));
      w.z = pack2(bflo(a.z) * silu(bflo(g.z)), bfhi(a.z) * silu(bfhi(g.z)));
      w.w = pack2(bflo(a.w) * silu(bflo(g.w)), bfhi(a.w) * silu(bfhi(g.w)));
      *(u32x4*)(p.mixed + tk * DM + hh * 64 + ch * 8) = w;
    }
  }
}

DI void attn_task2(const Params& p, LAS unsigned char* kst, const int lane, const int tokbase, const int hh,
                   const int sh, const int r_res, const int l0, const bool first, const bool last) {
  const int r = lane & 31, h = lane >> 5;
  const int i16 = lane & 15, q4 = i16 >> 2, pp = i16 & 3, blk = (lane >> 4) & 1;
  LAS unsigned char* vst = kst + KST_W;
  LAS unsigned char* trp = vst + (4 * h + q4) * VROW + 32 * blk + 8 * pp;
  const bf16_t* qpA = p.proj + (size_t)(tokbase + r_res + ((l0 + r) << sh)) * NW + OFF_QA + hh * 64 + 8 * h;
  const bf16_t* qpB = qpA + (size_t)(32 << sh) * NW;
  bf16x8 QA[4], QB[4];
#pragma unroll
  for (int ks = 0; ks < 4; ++ks) { QA[ks] = *(const bf16x8*)(qpA + 16 * ks); QB[ks] = *(const bf16x8*)(qpB + 16 * ks); }
  f32x16 A0, A1, B0, B1;
#pragma unroll
  for (int i = 0; i < 16; ++i) { A0[i] = 0.f; A1[i] = 0.f; B0[i] = 0.f; B1[i] = 0.f; }
  float mA = -1e30f, lA = 0.f, mB = -1e30f, lB = 0.f;
  const int kt0 = (l0 >= 128) ? 0 : (4 - (l0 >> 5));
#define LOAD_KV(Kd, Vd, kt_) do { const int lk0_ = l0 - 128 + 32 * (kt_) + (lane >> 3); \
    _Pragma("unroll") for (int c_ = 0; c_ < 4; ++c_) { \
      const bf16_t* kp_ = p.proj + (size_t)(tokbase + r_res + ((lk0_ + 8 * c_) << sh)) * NW + OFF_KA + hh * 64 + 8 * (lane & 7); \
      Kd[c_] = *(const u32x4*)kp_; Vd[c_] = *(const u32x4*)(kp_ + (OFF_VA - OFF_KA)); } } while (0)
  for (int kt = kt0; kt < 6; kt += 2) {
    u32x4 K0[4], K1[4], V0[4], V1[4];
    LOAD_KV(K0, V0, kt);
    LOAD_KV(K1, V1, kt + 1);
    attn_tile2(K0, V0, QA, QB, A0, A1, mA, lA, B0, B1, mB, lB, kst, vst, trp, lane, kt);
    attn_tile2(K1, V1, QA, QB, A0, A1, mA, lA, B0, B1, mB, lB, kst, vst, trp, lane, kt + 1);
  }
#undef LOAD_KV
  const int tokA = tokbase + r_res + (l0 << sh);
  attn_merge(p, kst, A0, A1, mA, lA, lane, tokA, sh, hh, first, last);
  attn_merge(p, kst, B0, B1, mB, lB, lane, tokA + (32 << sh), sh, hh, first, last);
}

DI void phase_attn(LAS unsigned char* lds, const Params& p, int bid, int nb) {
  const int tid = threadIdx.x, wid = __builtin_amdgcn_readfirstlane(tid >> 6), lane = tid & 63;
  LAS unsigned char* kst = lds + wid * VST_W;
  for (int unit = bid; unit < 256; unit += nb) {
    const int xj = unit >> 3, bhh = (unit & 7) * 8 + (xj >> 2), sp = xj & 3, hh = bhh & 7, b = bhh >> 3;
    const int tokbase = b * SEQ;
    for (int stage = 0; stage < 3; ++stage) {
      const int sh = stage == 0 ? 4 : (stage == 1 ? 2 : 0);
      for (int tk = 0; tk < 2; ++tk) {
        const int idx = wid + 8 * tk;
        int r_res, l0;
        if (stage == 0) { r_res = idx; l0 = 64 * sp; }
        else if (stage == 1) { r_res = idx >> 2; l0 = 256 * sp + 64 * (idx & 3); }
        else { r_res = 0; l0 = 1024 * sp + 64 * idx; }
        attn_task2(p, kst, lane, tokbase, hh, sh, r_res, l0, stage == 0, stage == 2);
      }
      __syncthreads();
    }
  }
}

constexpr int RV_ROW = 320, RK_ROW = 192, RV_OFF = 0, RK_OFF = 128 * RV_ROW  , RRED_OFF = RK_OFF + 128 * RK_ROW  ;

DI void retout_unit(LAS unsigned char* lds, const Params& p, const int u);
DI void phase_retkv(LAS unsigned char* lds, const Params& p, int bid, int nb, const int mode) {
  const int tid = threadIdx.x, wid = __builtin_amdgcn_readfirstlane(tid >> 6), lane = tid & 63;
  const int r = lane & 31, h = lane >> 5, i16 = lane & 15, q4 = i16 >> 2, pp = i16 & 3, blk = (lane >> 4) & 1;
  const int vt = wid >> 1, dt = wid & 1;
  LAS int* uslot = (LAS int*)(lds + RRED_OFF);
  for (;;) {
    if (tid == 0) *uslot = (int)__hip_atomic_fetch_add(p.bar + 200 + mode, 1u, __ATOMIC_RELAXED, __HIP_MEMORY_SCOPE_AGENT);
    __syncthreads();
    const int u = __builtin_amdgcn_readfirstlane(*uslot);
    if (u >= 1024) break;
    if (mode) { __syncthreads(); retout_unit(lds, p, u); continue; }
    const int n = u & 31, hh = (u >> 5) & 3, b = u >> 7;
    const float lg = ret_log2g(hh);
    const bf16_t* base = p.proj + (size_t)(b * SEQ + n * 128) * NW;
#pragma unroll
    for (int it = 0; it < 4; ++it) {
      const int c = tid + 512 * it, j = c >> 4, cc = c & 15;
      *(LAS u32x4*)(lds + RV_OFF + j * RV_ROW + cc * 16) = *(const u32x4*)(base + (size_t)j * NW + OFF_VR + hh * 128 + cc * 8);
    }
#pragma unroll
    for (int it = 0; it < 2; ++it) {
      const int c = tid + 512 * it, j = c >> 3, cc = c & 7;
      const u32x4 w = *(const u32x4*)(base + (size_t)j * NW + OFF_KR + hh * 64 + cc * 8);
      const float dk = exp2f((float)(127 - j) * lg);
      u32x4 o;
      o.x = pack2(bflo(w.x) * dk, bfhi(w.x) * dk); o.y = pack2(bflo(w.y) * dk, bfhi(w.y) * dk);
      o.z = pack2(bflo(w.z) * dk, bfhi(w.z) * dk); o.w = pack2(bflo(w.w) * dk, bfhi(w.w) * dk);
      *(LAS u32x4*)(lds + RK_OFF + j * RK_ROW + cc * 16) = o;
    }
    __syncthreads();
    f32x16 acc;
#pragma unroll
    for (int i = 0; i < 16; ++i) acc[i] = 0.f;
    LAS unsigned char* va = lds + RV_OFF + (4 * h + q4) * RV_ROW + (32 * vt + 16 * blk + 4 * pp) * 2;
    LAS unsigned char* ka = lds + RK_OFF + (4 * h + q4) * RK_ROW + (32 * dt + 16 * blk + 4 * pp) * 2;
#pragma unroll
    for (int s = 0; s < 8; ++s) {
      const bf16x8 A = tr_frag(va + 16 * s * RV_ROW, 8 * RV_ROW), B = tr_frag(ka + 16 * s * RK_ROW, 8 * RK_ROW);
      acc = MFMA32(A, B, acc);
    }
    float* o = p.kvT + ((size_t)u << 13) + (32 * vt + 4 * h) * 64 + 32 * dt + r;
#pragma unroll
    for (int i = 0; i < 16; ++i) __hip_atomic_store(o + ((i & 3) + 8 * (i >> 2)) * 64, acc[i], __ATOMIC_RELAXED, __HIP_MEMORY_SCOPE_AGENT);
    asm volatile("s_waitcnt vmcnt(0)" ::: "memory");
    __syncthreads();
    const int bh = u >> 5;
    if (tid == 0) uslot[1] = (__hip_atomic_fetch_add(p.bar + 208 + bh, 1u, __ATOMIC_RELAXED, __HIP_MEMORY_SCOPE_AGENT) == 31u) ? 1 : 0;
    __syncthreads();
    if (__builtin_amdgcn_readfirstlane(uslot[1]) != 0) {
      if (tid == 0) { __builtin_amdgcn_fence(__ATOMIC_ACQUIRE, "agent"); asm volatile("s_waitcnt vmcnt(0)" ::: "memory"); }
      __syncthreads();
      typedef float f32x2 __attribute__((ext_vector_type(2)));
      const float cd = exp2f(128.0f * lg);
      for (int e2 = tid; e2 < 4096; e2 += 1024) {
        const int ea = e2 * 2, eb = (e2 + 512) * 2;
        f32x2 ka[31], kb[31];
#pragma unroll
        for (int nn = 0; nn < 31; ++nn) {
          const float* a = p.kvT + ((size_t)(bh * 32 + nn) << 13);
          ka[nn] = *(const f32x2*)(a + ea); kb[nn] = *(const f32x2*)(a + eb);
        }
        float a0 = 0.f, a1 = 0.f, b0 = 0.f, b1 = 0.f;
#pragma unroll
        for (int nn = 0; nn < 32; ++nn) {
          bf16_t* o = p.stT + ((size_t)(bh * 32 + nn) << 13);
          __hip_atomic_store((unsigned*)(o + ea), pack2(a0, a1), __ATOMIC_RELAXED, __HIP_MEMORY_SCOPE_AGENT);
          __hip_atomic_store((unsigned*)(o + eb), pack2(b0, b1), __ATOMIC_RELAXED, __HIP_MEMORY_SCOPE_AGENT);
          if (nn < 31) { a0 = a0 * cd + ka[nn][0]; a1 = a1 * cd + ka[nn][1]; b0 = b0 * cd + kb[nn][0]; b1 = b1 * cd + kb[nn][1]; }
        }
      }
      asm volatile("s_waitcnt vmcnt(0)" ::: "memory");
      __syncthreads();
      if (tid == 0) __hip_atomic_store(p.bar + 16 + bh, 1u, __ATOMIC_RELAXED, __HIP_MEMORY_SCOPE_AGENT);
    }
    __syncthreads();
  }
  __syncthreads();
}

constexpr int RKO = 40960, RQO = RKO + 128 * 144, RSO = RQO + 128 * 144, RGO = RSO + 128 * 144, RG_ROW = 272, RRED2 = RGO + 128 * RG_ROW;
DI void retout_unit(LAS unsigned char* lds, const Params& p, const int u) {
  const int tid = threadIdx.x, wid = __builtin_amdgcn_readfirstlane(tid >> 6), lane = tid & 63;
  const int r = lane & 31, h = lane >> 5, i16 = lane & 15, q4 = i16 >> 2, pp = i16 & 3, blk = (lane >> 4) & 1;
  const int it = wid & 3, vh = wid >> 2;
  LAS float* red = (LAS float*)(lds + RRED2);
  {
    if (tid == 0) {
      unsigned spins = 0;
      while (__hip_atomic_load(p.bar + 16 + (u >> 5), __ATOMIC_RELAXED, __HIP_MEMORY_SCOPE_AGENT) == 0u && spins < (1u << 22)) { __builtin_amdgcn_s_sleep(2); ++spins; }
      __builtin_amdgcn_fence(__ATOMIC_ACQUIRE, "agent");
      asm volatile("s_waitcnt vmcnt(0)" ::: "memory");
    }
    __syncthreads();
    const int n = u & 31, hh = (u >> 5) & 3, b = u >> 7;
    const float lg = ret_log2g(hh);
    const int tok0 = b * SEQ + n * 128;
    const bf16_t* base = p.proj + (size_t)tok0 * NW;
    {
      u32x4 tv[4], tg[4], tk[2], tq[2], ts[2];
#pragma unroll
      for (int k = 0; k < 4; ++k) {
        const int c = tid + 512 * k, j = c >> 4, cc = c & 15;
        tv[k] = *(const u32x4*)(base + (size_t)j * NW + OFF_VR + hh * 128 + cc * 8);
        tg[k] = *(const u32x4*)(base + (size_t)j * NW + OFF_GR + hh * 128 + cc * 8);
      }
#pragma unroll
      for (int k = 0; k < 2; ++k) {
        const int c = tid + 512 * k, j = c >> 3, cc = c & 7;
        tk[k] = *(const u32x4*)(base + (size_t)j * NW + OFF_KR + hh * 64 + cc * 8);
        tq[k] = *(const u32x4*)(base + (size_t)j * NW + OFF_QR + hh * 64 + cc * 8);
        ts[k] = *(const u32x4*)(p.stT + ((size_t)u << 13) + (size_t)c * 8);
      }
#pragma unroll
      for (int k = 0; k < 4; ++k) {
        const int c = tid + 512 * k, j = c >> 4, cc = c & 15;
        *(LAS u32x4*)(lds + RV_OFF + j * RV_ROW + cc * 16) = tv[k];
        *(LAS u32x4*)(lds + RGO + j * RG_ROW + cc * 16) = tg[k];
      }
#pragma unroll
      for (int k = 0; k < 2; ++k) {
        const int c = tid + 512 * k, j = c >> 3, cc = c & 7;
        *(LAS u32x4*)(lds + RKO + j * 144 + cc * 16) = tk[k];
        *(LAS u32x4*)(lds + RQO + j * 144 + cc * 16) = tq[k];
        *(LAS u32x4*)(lds + RSO + j * 144 + cc * 16) = ts[k];
      }
    }
    __syncthreads();
    const int qi = 32 * it + r;
    bf16x8 Qf[4];
#pragma unroll
    for (int ks = 0; ks < 4; ++ks) Qf[ks] = *(const LAS bf16x8*)(lds + RQO + qi * 144 + (2 * ks + h) * 16);
    f32x16 O0, O1;
#pragma unroll
    for (int i = 0; i < 16; ++i) { O0[i] = 0.f; O1[i] = 0.f; }
    {
#pragma unroll
      for (int ks = 0; ks < 4; ++ks) {
        const bf16x8 S0 = *(const LAS bf16x8*)(lds + RSO + (64 * vh + r) * 144 + (2 * ks + h) * 16);
        const bf16x8 S1 = *(const LAS bf16x8*)(lds + RSO + (64 * vh + 32 + r) * 144 + (2 * ks + h) * 16);
        O0 = MFMA32(S0, Qf[ks], O0); O1 = MFMA32(S1, Qf[ks], O1);
      }
      const float qd = exp2f((float)(qi + 1) * lg);
#pragma unroll
      for (int i = 0; i < 16; ++i) { O0[i] *= qd; O1[i] *= qd; }
    }
    LAS unsigned char* va = lds + RV_OFF + (4 * h + q4) * RV_ROW + (64 * vh + 16 * blk + 4 * pp) * 2;
    for (int jt = 0; jt <= it; ++jt) {
      f32x16 S;
#pragma unroll
      for (int i = 0; i < 16; ++i) S[i] = 0.f;
#pragma unroll
      for (int ks = 0; ks < 4; ++ks) { const bf16x8 Kf = *(const LAS bf16x8*)(lds + RKO + (32 * jt + r) * 144 + (2 * ks + h) * 16); S = MFMA32(Kf, Qf[ks], S); }
#pragma unroll
      for (int i = 0; i < 16; ++i) {
        const int dj = qi - (32 * jt + (i & 3) + 8 * (i >> 2) + 4 * h);
        S[i] = dj >= 0 ? S[i] * fexp2((float)dj * lg) : 0.f;
      }
#pragma unroll
      for (int s2 = 0; s2 < 2; ++s2) {
        const bf16x8 Pb = pack8(S, s2);
        const bf16x8 V0 = tr_frag(va + (32 * jt + 16 * s2) * RV_ROW, 8 * RV_ROW), V1 = tr_frag(va + (32 * jt + 16 * s2) * RV_ROW + 64, 8 * RV_ROW);
        O0 = MFMA32(V0, Pb, O0);
        O1 = MFMA32(V1, Pb, O1);
      }
    }
    float s1 = 0.f, s2 = 0.f;
#pragma unroll
    for (int i = 0; i < 16; ++i) { s1 += O0[i] + O1[i]; s2 += O0[i] * O0[i] + O1[i] * O1[i]; }
    s1 += __shfl_xor(s1, 32); s2 += __shfl_xor(s2, 32);
    if (h == 0) { red[(vh * 128 + qi) * 2] = s1; red[(vh * 128 + qi) * 2 + 1] = s2; }
    __syncthreads();
    s1 += red[((vh ^ 1) * 128 + qi) * 2]; s2 += red[((vh ^ 1) * 128 + qi) * 2 + 1];
    const float mu = s1 * (1.0f / 128.0f), var = fmaxf(s2 * (1.0f / 128.0f) - mu * mu, 0.f), rs = rsqrtf(var + 1e-5f);
    const float* gnp = p.gn + hh * 128 + 64 * vh + 4 * h;
    LAS unsigned char* gt = lds + RGO + qi * RG_ROW + (64 * vh + 4 * h) * 2;
#pragma unroll
    for (int dt = 0; dt < 2; ++dt)
#pragma unroll
      for (int g = 0; g < 4; ++g) {
        const int vo = 32 * dt + 8 * g;
        LAS u32x2* ga = (LAS u32x2*)(gt + vo * 2);
        const u32x2 gwv = *ga;
        const f32x4 gnv = *(const f32x4*)(gnp + vo);
        float f0, f1, f2, f3;
        if (dt == 0) { f0 = O0[4 * g]; f1 = O0[4 * g + 1]; f2 = O0[4 * g + 2]; f3 = O0[4 * g + 3]; }
        else { f0 = O1[4 * g]; f1 = O1[4 * g + 1]; f2 = O1[4 * g + 2]; f3 = O1[4 * g + 3]; }
        f0 = (f0 - mu) * rs * gnv[0] * silu(bflo(gwv.x)); f1 = (f1 - mu) * rs * gnv[1] * silu(bfhi(gwv.x));
        f2 = (f2 - mu) * rs * gnv[2] * silu(bflo(gwv.y)); f3 = (f3 - mu) * rs * gnv[3] * silu(bfhi(gwv.y));
        u32x2 wv; wv.x = pack2(f0, f1); wv.y = pack2(f2, f3);
        *ga = wv;
      }
    __syncthreads();
#pragma unroll
    for (int k = 0; k < 4; ++k) {
      const int c = tid + 512 * k, j = c >> 4, cc = c & 15;
      *(u32x4*)(p.mixed + (size_t)(tok0 + j) * DM + 512 + hh * 128 + cc * 8) = *(const LAS u32x4*)(lds + RGO + j * RG_ROW + cc * 16);
    }
    __syncthreads();
  }
}

#define XB_TMO      128
#define XB_XCNT(j)  (256  + 64 * (j))
#define XB_XSUB(j)  (1280 + 64 * (j))
#define XB_XGEN(j)  (2304 + 64 * (j))
#define XB_TOP      3328
#define XB_TOPGEN   3392
#define XCD_BAR_WORDS 3456
#define XB_SPIN_CAP (1u << 20)
DI unsigned xb_ld(unsigned* q) { return __hip_atomic_load(q, __ATOMIC_RELAXED, __HIP_MEMORY_SCOPE_AGENT); }
DI unsigned xb_add(unsigned* q, unsigned v) { return __hip_atomic_fetch_add(q, v, __ATOMIC_RELAXED, __HIP_MEMORY_SCOPE_AGENT); }
DI unsigned xb_xcc_id() { return (unsigned)__builtin_amdgcn_s_getreg((3 << 11) | 20) & 0xFu; }
#define XB_SPIN(cond, bar) do { unsigned _sp = 0; while (cond) { __builtin_amdgcn_s_sleep(1); \
    if ((++_sp & 255u) == 0u) { if (xb_ld(&(bar)[XB_TMO])) break; if (_sp > XB_SPIN_CAP) { atomicAdd(&(bar)[XB_TMO], 1u); break; } } } } while (0)
struct XcdBarrier { unsigned* bar; unsigned x; volatile LAS unsigned* st; };
DI XcdBarrier xcd_barrier_post(unsigned* bar, volatile LAS unsigned* st) {
  XcdBarrier b; b.bar = bar; b.x = xb_xcc_id(); b.st = st;
  if (threadIdx.x == 0) (void)xb_add(&bar[XB_XCNT(b.x)], 1u);
  return b;
}
DI void xcd_barrier_complete(unsigned* bar, unsigned x, unsigned& nloc, unsigned& nx) {
  const unsigned G = gridDim.x * gridDim.y * gridDim.z;
  unsigned sum, cnt, mine, sp = 0u;
  for (;;) {
    sum = 0u; cnt = 0u; mine = 0u;
#pragma unroll
    for (unsigned j = 0; j < 16; ++j) { const unsigned c = xb_ld(&bar[XB_XCNT(j)]); sum += c; cnt += (c > 0u) ? 1u : 0u; mine = (j == x) ? c : mine; }
    if (sum == G) break;
    __builtin_amdgcn_s_sleep(1);
    if ((++sp & 255u) == 0u) { if (xb_ld(&bar[XB_TMO])) break; if (sp > XB_SPIN_CAP) { atomicAdd(&bar[XB_TMO], 1u); break; } }
  }
  nloc = mine > 0u ? mine : 1u; nx = cnt > 0u ? cnt : 1u;
}
DI void xcd_barrier(const XcdBarrier& b) {
  asm volatile("s_waitcnt vmcnt(0)" ::: "memory");
  __syncthreads();
  if (threadIdx.x == 0) {
    unsigned* bar = b.bar;
    __builtin_amdgcn_s_waitcnt(0);
    unsigned nloc = b.st[0], nx = b.st[1];
    if (nloc == 0u) { xcd_barrier_complete(bar, b.x, nloc, nx); b.st[0] = nloc; b.st[1] = nx; }
    const unsigned old = xb_add(&bar[XB_XSUB(b.x)], 1u);
    const unsigned gen = old / nloc;
    if (old + 1u == (gen + 1u) * nloc) {
      __builtin_amdgcn_fence(__ATOMIC_RELEASE, "agent");
      asm volatile("s_waitcnt vmcnt(0)" ::: "memory");
      const unsigned og = xb_add(&bar[XB_TOP], 1u);
      const unsigned tg = og / nx;
      if (og + 1u == (tg + 1u) * nx) xb_add(&bar[XB_TOPGEN], 1u);
      else XB_SPIN(xb_ld(&bar[XB_TOPGEN]) == tg, bar);
      __builtin_amdgcn_fence(__ATOMIC_ACQUIRE, "agent");
      xb_add(&bar[XB_XGEN(b.x)], 1u);
      asm volatile("s_waitcnt vmcnt(0)" ::: "memory");
    } else {
      XB_SPIN(xb_ld(&bar[XB_XGEN(b.x)]) == gen, bar);
      __builtin_amdgcn_fence(__ATOMIC_ACQUIRE, "agent");
      asm volatile("s_waitcnt vmcnt(0)" ::: "memory");
    }
  }
  __syncthreads();
}

DI void grid_barrier(unsigned* ctr, unsigned target) {
  asm volatile("s_waitcnt vmcnt(0) lgkmcnt(0)" ::: "memory");
  __syncthreads();
  if (threadIdx.x == 0) {
    __builtin_amdgcn_fence(__ATOMIC_RELEASE, "agent");
    asm volatile("s_waitcnt vmcnt(0)" ::: "memory");
    __hip_atomic_fetch_add(ctr, 1u, __ATOMIC_RELAXED, __HIP_MEMORY_SCOPE_AGENT);
    unsigned spins = 0;
    while (__hip_atomic_load(ctr, __ATOMIC_RELAXED, __HIP_MEMORY_SCOPE_AGENT) < target && spins < (1u << 22)) { __builtin_amdgcn_s_sleep(2); ++spins; }
    __builtin_amdgcn_fence(__ATOMIC_ACQUIRE, "agent");
    asm volatile("s_waitcnt vmcnt(0)" ::: "memory");
  }
  __syncthreads();
}

__global__ void __launch_bounds__(512) k_mega(Params p) {
  extern __shared__ __attribute__((aligned(16))) unsigned char shm_[];
  LAS unsigned char* shm = (LAS unsigned char*)shm_;
  const int bid = blockIdx.x, nb = gridDim.x;
  unsigned bar_n = 0;
  volatile LAS unsigned* xst = (volatile LAS unsigned*)(shm + 150016);
  if (threadIdx.x == 0) { xst[0] = 0u; xst[1] = 0u; }
  __syncthreads();
  const XcdBarrier xbar = xcd_barrier_post(p.bar + 256, xst);
#ifdef PROBE_PHASE
#ifndef PROBE_BLK
#define PROBE_BLK 0
#endif
  unsigned long long ts_a = 0, ts_b = 0; int ph_i = 0;
  if (PROBE_PHASE == 0) ts_a = __builtin_amdgcn_s_memrealtime();
#define GRID_BAR() do { bar_n += (unsigned)nb; grid_barrier(p.bar, bar_n); ++ph_i; if (ph_i == PROBE_PHASE) ts_a = __builtin_amdgcn_s_memrealtime(); if (ph_i == PROBE_PHASE + 1) ts_b = __builtin_amdgcn_s_memrealtime(); } while (0)
#else
#define GRID_BAR() do { xcd_barrier(xbar); } while (0)
#endif
  phase_prep(p, bid, nb);
  GRID_BAR();
  phase_gemm<1>(shm, p, bid, nb);
  GRID_BAR();
  phase_retkv(shm, p, bid, nb, 0);
  phase_attn(shm, p, bid, nb);
#ifdef PROBE_SUB
  ts_b = __builtin_amdgcn_s_memrealtime(); ph_i = 100;
#endif
  phase_retkv(shm, p, bid, nb, 1);
  GRID_BAR();
  phase_gemm<2>(shm, p, bid, nb);
#ifdef PROBE_PHASE
  if (PROBE_PHASE == 3) ts_b = __builtin_amdgcn_s_memrealtime();
  if (bid == PROBE_BLK && threadIdx.x == 0) {
    const unsigned long long until = __builtin_amdgcn_s_memrealtime() + 9ull * (ts_b - ts_a);
    while (__builtin_amdgcn_s_memrealtime() < until) __builtin_amdgcn_s_sleep(8);
  }
#endif
}

extern "C" void kernel_launch(void* const* d_in, const int* in_sizes, int n_in, void* d_out, int out_size, void* d_ws, size_t ws_size, hipStream_t stream) {
  Params p{};
  p.x = (const float*)d_in[0]; p.ng = (const float*)d_in[1]; p.w_in = (const float*)d_in[2]; p.gn = (const float*)d_in[3];
  p.w_out = (const float*)d_in[4]; p.fg = (const float*)d_in[5];
  p.out = (float*)d_out;
  char* w = (char*)d_ws; size_t o = 0;
  auto take = [&](size_t bytes) { char* r = w + o; o += (bytes + 255) & ~(size_t)255; return r; };
  p.xb = (bf16_t*)take((size_t)T_TOK * DM * 2);
  p.proj = (bf16_t*)take((size_t)T_TOK * NW * 2);
  p.mixed = (bf16_t*)take((size_t)T_TOK * DM * 2);
  p.winT = (bf16_t*)take((size_t)NW * DM * 2);
  p.woutT = (bf16_t*)take((size_t)DM * DM * 2);
  p.rstd = (float*)take((size_t)T_TOK * 4);
  p.rowss = (float*)take((size_t)T_TOK * 4);
  p.ropeT = (float2*)take((size_t)SEQ * 32 * 8);
  p.retT = (float2*)take((size_t)SEQ * 32 * 8);
  p.kvT = (float*)take((size_t)1024 * 8192 * 4);
  p.stT = (bf16_t*)take((size_t)1024 * 8192 * 2);
  p.bar = (unsigned*)take(1024 + XCD_BAR_WORDS * 4);
  p.ob = (bf16_t*)take((size_t)T_TOK * 512 * 2);
  p.lseg = (float*)take((size_t)T_TOK * 8 * 4);
  static int grid_blocks = 0;
  if (!grid_blocks) {
    (void)hipFuncSetAttribute((const void*)k_mega, hipFuncAttributeMaxDynamicSharedMemorySize, ATTN_LDS);
    int dev = 0, cus = 0, per_cu = 0;
    (void)hipGetDevice(&dev);
    (void)hipDeviceGetAttribute(&cus, hipDeviceAttributeMultiprocessorCount, dev);
    (void)hipOccupancyMaxActiveBlocksPerMultiprocessor(&per_cu, k_mega, 512, ATTN_LDS);
    if (per_cu < 1) per_cu = 1;
    grid_blocks = cus;
  }
  (void)hipMemsetAsync(p.bar, 0, 1024 + XCD_BAR_WORDS * 4, stream);
  hipLaunchKernelGGL(k_mega, dim3(grid_blocks), dim3(512), ATTN_LDS, stream, p);
}
```

```cpp
#include <hip/hip_runtime.h>
#include <hip/hip_cooperative_groups.h>
#include <cstdint>
#include <cstdio>
namespace cg = cooperative_groups;

typedef unsigned short bf16_t;
typedef short bf16x8 __attribute__((ext_vector_type(8)));
typedef float f32x4 __attribute__((ext_vector_type(4)));
typedef unsigned u32x4 __attribute__((ext_vector_type(4)));
typedef unsigned u32x2 __attribute__((ext_vector_type(2)));

constexpr int T_TOK = 32768, DM = 1024, NW = 3584, SEQ = 4096;
constexpr int OFF_QA = 0, OFF_KA = 512, OFF_VA = 1024, OFF_GA = 1536, OFF_QR = 2048, OFF_KR = 2304, OFF_VR = 2560, OFF_GR = 3072;

struct Params {
  const float* x; const float* ng; const float* w_in; const float* gn; const float* w_out; const float* fg;
  float* out;
  bf16_t* xb; bf16_t* proj; bf16_t* mixed; bf16_t* winT; bf16_t* woutT;
  float* rstd; float* rowss; float2* ropeT; float2* retT; float* kvT; bf16_t* stT; unsigned* bar; bf16_t* ob; float* lseg;
};

#define DI __device__ __forceinline__
DI unsigned short f2bf(float x) { unsigned u = __float_as_uint(x); u += 0x7fffu + ((u >> 16) & 1u); return (unsigned short)(u >> 16); }
DI float bf2f(unsigned short b) { return __uint_as_float(((unsigned)b) << 16); }
typedef float f32x2_t __attribute__((ext_vector_type(2)));
typedef __bf16 bf16x2_t __attribute__((ext_vector_type(2)));
DI unsigned pack2(float lo, float hi) { const f32x2_t v = {lo, hi}; return __builtin_bit_cast(unsigned, __builtin_convertvector(v, bf16x2_t)); }
DI float bflo(unsigned w) { return __uint_as_float(w << 16); }
DI float bfhi(unsigned w) { return __uint_as_float(w & 0xffff0000u); }
DI int perm32(int rho) { const int n = rho >> 4, i = rho & 15; return 8 * (i >> 2) + 4 * n + (i & 3); }
DI int cmap(int p) { return (p & ~31) + perm32(p & 31); }
DI int cmapA(int p) { return (p & ~127) + ((p >> 6) & 1) * 64 + ((p >> 4) & 1) * 32 + ((p >> 5) & 1) * 16 + (p & 15); }

DI void phase_prep(const Params& p, int bid, int nb) {
  const int tid = threadIdx.x, lane = tid & 63, wid = tid >> 6, nw = blockDim.x >> 6;
  if (wid < 6)
  for (int row0 = (bid * 6 + wid) * 4; row0 < T_TOK; row0 += nb * 6 * 4) {
    f32x4 v[4][4];
#pragma unroll
    for (int rr = 0; rr < 4; ++rr)
#pragma unroll
      for (int it = 0; it < 4; ++it) v[rr][it] = __builtin_nontemporal_load((const f32x4*)(p.x + (size_t)(row0 + rr) * DM + it * 256 + lane * 4));
#pragma unroll
    for (int rr = 0; rr < 4; ++rr) {
      float ss = 0.f;
#pragma unroll
      for (int it = 0; it < 4; ++it) ss += v[rr][it][0] * v[rr][it][0] + v[rr][it][1] * v[rr][it][1] + v[rr][it][2] * v[rr][it][2] + v[rr][it][3] * v[rr][it][3];
#pragma unroll
      for (int o = 32; o >= 1; o >>= 1) ss += __shfl_xor(ss, o);
#pragma unroll
      for (int it = 0; it < 4; ++it) { u32x2 w; w.x = pack2(v[rr][it][0], v[rr][it][1]); w.y = pack2(v[rr][it][2], v[rr][it][3]); *(u32x2*)(p.xb + (size_t)(row0 + rr) * DM + it * 256 + lane * 4) = w; }
      if (lane == 0) p.rstd[row0 + rr] = rsqrtf(ss * (1.0f / DM) + 1e-6f);
    }
  }
  if (wid < 6) return;
  const int gt = bid * 128 + (tid - 384), gn = nb * 128;
  for (int idx = gt; idx < (NW / 4) * 128; idx += gn) {
    const int p4 = idx % (NW / 4), kc = idx / (NW / 4), pp = p4 * 4, c = pp < 1024 ? cmapA(pp) : cmap(pp);
    f32x4 f[8];
#pragma unroll
    for (int j = 0; j < 8; ++j) { const int k = kc * 8 + j; f[j] = *(const f32x4*)(p.w_in + (size_t)k * NW + c) * p.ng[k]; }
#pragma unroll
    for (int e = 0; e < 4; ++e) {
      u32x4 w; w.x = pack2(f[0][e], f[1][e]); w.y = pack2(f[2][e], f[3][e]); w.z = pack2(f[4][e], f[5][e]); w.w = pack2(f[6][e], f[7][e]);
      *(u32x4*)(p.winT + (size_t)(pp + e) * DM + kc * 8) = w;
    }
  }
  for (int idx = gt; idx < (DM / 4) * 128; idx += gn) {
    const int p4 = idx % (DM / 4), kc = idx / (DM / 4), pp = p4 * 4, c = cmap(pp);
    f32x4 f[8];
#pragma unroll
    for (int j = 0; j < 8; ++j) { const int k = kc * 8 + j; f[j] = *(const f32x4*)(p.w_out + (size_t)k * DM + c); }
#pragma unroll
    for (int e = 0; e < 4; ++e) {
      u32x4 w; w.x = pack2(f[0][e], f[1][e]); w.y = pack2(f[2][e], f[3][e]); w.z = pack2(f[4][e], f[5][e]); w.w = pack2(f[6][e], f[7][e]);
      *(u32x4*)(p.woutT + (size_t)(pp + e) * DM + kc * 8) = w;
    }
  }
  for (int idx = gt; idx < SEQ * 32; idx += gn) {
    const int pos = idx >> 5, i = idx & 31;
    const float inv1 = powf(10000.0f, -(float)i / 32.0f);
    const float inv2 = 1.0f / powf(10000.0f, (float)i / 31.0f);
    const float a1 = (float)pos * inv1, a2 = (float)pos * inv2;
    p.ropeT[idx] = make_float2(cosf(a1), sinf(a1));
    p.retT[idx] = make_float2(cosf(a2), sinf(a2));
  }
}

constexpr int BM = 256, BK = 64, HALF = 128, HT = HALF * BK;
constexpr int GEMM_LDS = 8 * HT * 2;
DI int lds_byte(int r, int c) { int st = (r >> 4) * 2 + (c >> 5), rr = r & 15, cc = c & 31, ob = rr * 64 + cc * 2; return st * 1024 + (ob ^ (((ob >> 9) & 1) << 5)); }
DI void stage_rc(int b, int& R, int& C) { int st = b / 1024, sb = b % 1024, swz = sb ^ (((sb >> 9) & 1) << 5); R = (st >> 1) * 16 + swz / 64; C = (st & 1) * 32 + (swz % 64) / 2; }

#define LAS __attribute__((address_space(3)))
template <int EPI>
DI void gemm_epi(LAS unsigned char* lds, f32x4 (&acc)[2][2][4][2], const int brow, const int bcol, const Params& p) {
  const int tid = threadIdx.x, wid = __builtin_amdgcn_readfirstlane(tid >> 6), lane = tid & 63, wr = wid >> 2, wc = wid & 3, fr = lane & 15, fq = lane >> 4;
  if (EPI == 1) {
    const int pn = bcol >> 8;
    if (pn < 4) {
      const float sc = pn < 2 ? 0.125f * 1.4426950408889634f : 1.0f;
      const int i0 = 16 * (wc & 1) + 4 * fq;
#pragma unroll
      for (int ai = 0; ai < 2; ++ai)
#pragma unroll
        for (int m = 0; m < 4; ++m) {
          const int row = brow + ai * HALF + wr * 64 + m * 16 + fr;
          const float rs = p.rstd[row] * sc;
          const float* tb = (const float*)(p.ropeT + (row & (SEQ - 1)) * 32 + i0);
          const f32x4 t0 = *(const f32x4*)tb, t1 = *(const f32x4*)(tb + 4);
#pragma unroll
          for (int bj = 0; bj < 2; ++bj) {
            const f32x4 x1 = acc[ai][bj][m][0] * rs, x2 = acc[ai][bj][m][1] * rs;
            u32x2 wa, wb;
            wa.x = pack2(x1[0] * t0[0] - x2[0] * t0[1], x1[1] * t0[2] - x2[1] * t0[3]);
            wa.y = pack2(x1[2] * t1[0] - x2[2] * t1[1], x1[3] * t1[2] - x2[3] * t1[3]);
            wb.x = pack2(x2[0] * t0[0] + x1[0] * t0[1], x2[1] * t0[2] + x1[1] * t0[3]);
            wb.y = pack2(x2[2] * t1[0] + x1[2] * t1[1], x2[3] * t1[2] + x1[3] * t1[3]);
            bf16_t* o = p.proj + (size_t)row * NW + bcol + bj * HALF + (wc >> 1) * 64 + i0;
            *(u32x2*)o = wa; *(u32x2*)(o + 32) = wb;
          }
        }
    } else if (pn == 8 || pn == 9) {
      const float sc = pn == 9 ? 0.125f : 1.0f;
      const int i0 = 16 * (wc & 1) + 4 * fq;
#pragma unroll
      for (int ai = 0; ai < 2; ++ai)
#pragma unroll
        for (int m = 0; m < 4; ++m) {
          const int row = brow + ai * HALF + wr * 64 + m * 16 + fr;
          const float rs = p.rstd[row] * sc;
          const float* tb = (const float*)(p.retT + (row & (SEQ - 1)) * 32 + i0);
          const f32x4 t0 = *(const f32x4*)tb, t1 = *(const f32x4*)(tb + 4);
#pragma unroll
          for (int bj = 0; bj < 2; ++bj) {
            const f32x4 v0 = acc[ai][bj][m][0] * rs, v1 = acc[ai][bj][m][1] * rs;
            u32x4 w;
            w.x = pack2(v0[0] * t0[0] - v0[1] * t0[1], v0[1] * t0[0] + v0[0] * t0[1]);
            w.y = pack2(v0[2] * t0[2] - v0[3] * t0[3], v0[3] * t0[2] + v0[2] * t0[3]);
            w.z = pack2(v1[0] * t1[0] - v1[1] * t1[1], v1[1] * t1[0] + v1[0] * t1[1]);
            w.w = pack2(v1[2] * t1[2] - v1[3] * t1[3], v1[3] * t1[2] + v1[2] * t1[3]);
            *(u32x4*)(p.proj + (size_t)row * NW + bcol + bj * HALF + wc * 32 + 8 * fq) = w;
          }
        }
    } else {
#pragma unroll
    for (int ai = 0; ai < 2; ++ai)
#pragma unroll
      for (int m = 0; m < 4; ++m) {
        const int row = brow + ai * HALF + wr * 64 + m * 16 + fr;
        const float rs = p.rstd[row];
#pragma unroll
        for (int bj = 0; bj < 2; ++bj) {
          const f32x4 v0 = acc[ai][bj][m][0] * rs, v1 = acc[ai][bj][m][1] * rs;
          u32x4 w; w.x = pack2(v0[0], v0[1]); w.y = pack2(v0[2], v0[3]); w.z = pack2(v1[0], v1[1]); w.w = pack2(v1[2], v1[3]);
          *(u32x4*)(p.proj + (size_t)row * NW + bcol + bj * HALF + wc * 32 + 8 * fq) = w;
        }
      }
    }
  } else {
    const int pm = brow >> 8, pn = bcol >> 8;
    LAS float* part = (LAS float*)(lds + GEMM_LDS);
    LAS float* rsl = (LAS float*)(lds + GEMM_LDS + 4096);
#pragma unroll
    for (int ai = 0; ai < 2; ++ai)
#pragma unroll
      for (int m = 0; m < 4; ++m) {
        const int rl = ai * HALF + wr * 64 + m * 16 + fr;
        float ss = 0.f;
#pragma unroll
        for (int bj = 0; bj < 2; ++bj) {
          const size_t off = (size_t)(brow + rl) * DM + bcol + bj * HALF + wc * 32 + 8 * fq;
          const f32x4 x0 = __builtin_nontemporal_load((const f32x4*)(p.x + off)), x1 = __builtin_nontemporal_load((const f32x4*)(p.x + off + 4));
          const f32x4 y0 = acc[ai][bj][m][0] + x0, y1 = acc[ai][bj][m][1] + x1;
          acc[ai][bj][m][0] = y0; acc[ai][bj][m][1] = y1;
          ss += y0[0] * y0[0] + y0[1] * y0[1] + y0[2] * y0[2] + y0[3] * y0[3] + y1[0] * y1[0] + y1[1] * y1[1] + y1[2] * y1[2] + y1[3] * y1[3];
        }
        ss += __shfl_xor(ss, 16); ss += __shfl_xor(ss, 32);
        if (fq == 0) part[wc * 256 + rl] = ss;
      }
    __syncthreads();
    float* xs = p.rowss + (size_t)(pm * 4) * 256;
    if (tid < 256) {
      const float tot = part[tid] + part[256 + tid] + part[512 + tid] + part[768 + tid];
      __hip_atomic_store(xs + pn * 256 + tid, tot, __ATOMIC_RELAXED, __HIP_MEMORY_SCOPE_AGENT);
    }
    asm volatile("s_waitcnt vmcnt(0)" ::: "memory");
    __syncthreads();
    unsigned* cnt = p.bar + 64 + pm;
    if (tid == 0) __hip_atomic_fetch_add(cnt, 1u, __ATOMIC_RELAXED, __HIP_MEMORY_SCOPE_AGENT);
    if (wid == 0) {
      unsigned spins = 0;
      while (__hip_atomic_load(cnt, __ATOMIC_RELAXED, __HIP_MEMORY_SCOPE_AGENT) < 4u && spins < (1u << 20)) { __builtin_amdgcn_s_sleep(1); ++spins; }
      __builtin_amdgcn_fence(__ATOMIC_ACQUIRE, "agent");
      asm volatile("s_waitcnt vmcnt(0)" ::: "memory");
    }
    __syncthreads();
    if (tid < 256) {
      float t = 0.f;
#pragma unroll
      for (int q = 0; q < 4; ++q) t += __hip_atomic_load(xs + q * 256 + tid, __ATOMIC_RELAXED, __HIP_MEMORY_SCOPE_AGENT);
      rsl[tid] = rsqrtf(t * (1.0f / DM) + 1e-6f);
    }
    __syncthreads();
#pragma unroll
    for (int ai = 0; ai < 2; ++ai)
#pragma unroll
      for (int m = 0; m < 4; ++m) {
        const int rl = ai * HALF + wr * 64 + m * 16 + fr;
        const float rs = rsl[rl];
#pragma unroll
        for (int bj = 0; bj < 2; ++bj) {
          const int col = bcol + bj * HALF + wc * 32 + 8 * fq;
          const f32x4 g0 = *(const f32x4*)(p.fg + col), g1 = *(const f32x4*)(p.fg + col + 4);
          float* o = p.out + (size_t)(brow + rl) * DM + col;
          __builtin_nontemporal_store(acc[ai][bj][m][0] * rs * g0, (f32x4*)o); __builtin_nontemporal_store(acc[ai][bj][m][1] * rs * g1, (f32x4*)(o + 4));
        }
      }
    __syncthreads();
  }
}

DI void tile_of(int L, int nM, int nN, int& pm, int& pn) {
  const int nwg = nM * nN, NX = 8, WGM = 8;
  int wgid = L; { const int q = nwg / NX, r = nwg % NX, xcd = wgid % NX, off = wgid / NX; wgid = (xcd < r ? xcd * (q + 1) : r * (q + 1) + (xcd - r) * q) + off; }
  const int nig = WGM * nN, gid = wgid / nig, fm = gid * WGM, gsz = (nM - fm) < WGM ? (nM - fm) : WGM;
  pm = fm + ((wgid % nig) % gsz); pn = (wgid % nig) / gsz;
}


template <int EPI>
DI void phase_gemm(LAS unsigned char* lds, const Params& p, int bid, int nb) {
  constexpr int K = 1024, nt = K / BK, HTB = HALF * BK * 2;
  const bf16_t* A = EPI == 1 ? p.xb : p.mixed; const bf16_t* Bt = EPI == 1 ? p.winT : p.woutT;
  const int nM = T_TOK / BM, nN = (EPI == 1 ? NW : DM) / BM, nT = nM * nN;
  const int tid = threadIdx.x, wid = __builtin_amdgcn_readfirstlane(tid >> 6), lane = tid & 63, wr = wid >> 2, wc = wid & 3, fr = lane & 15, fq = lane >> 4;
  unsigned voff[2];
#pragma unroll
  for (int i = 0; i < 2; ++i) { int R, C; stage_rc(tid * 16 + i * 8192, R, C); voff[i] = (unsigned)(R * K + C) * 2u; }
  const unsigned ldsw = (unsigned)wid * 1024u;
  const int aoff = lds_byte(wr * 64 + fr, fq * 8), boff = lds_byte(wc * 32 + fr, fq * 8);
  const size_t kstep = (size_t)(BK * 2), hstep = (size_t)HALF * K * 2, tstep = 2 * hstep;
#define SAo(b, h) (((b) * 2 + (h)) * HTB)
#define SBo(b, h) ((4 + (b) * 2 + (h)) * HTB)
#define STAGEP(bufoff, gptr) do { _Pragma("unroll") for (int _i = 0; _i < 2; ++_i) \
    __builtin_amdgcn_global_load_lds((const unsigned*)((gptr) + voff[_i]), (LAS unsigned*)(lds + (bufoff) + ldsw + _i * 8192), 16, 0, 0); } while (0)
#define LDA(dst, b, h) do { _Pragma("unroll") for (int m = 0; m < 4; ++m) _Pragma("unroll") for (int k = 0; k < 2; ++k) \
    dst[m][k] = *(const LAS bf16x8*)(lds + SAo(b, h) + aoff + m * 2048 + k * 1024); } while (0)
#define LDB(dst, b, h) do { _Pragma("unroll") for (int n = 0; n < 2; ++n) _Pragma("unroll") for (int k = 0; k < 2; ++k) \
    dst[n][k] = *(const LAS bf16x8*)(lds + SBo(b, h) + boff + n * 2048 + k * 1024); } while (0)
#define MMA(ai, bj, At, Bt_) do { __builtin_amdgcn_s_setprio(1); \
    _Pragma("unroll") for (int m = 0; m < 4; ++m) _Pragma("unroll") for (int n = 0; n < 2; ++n) _Pragma("unroll") for (int k = 0; k < 2; ++k) \
      acc[ai][bj][m][n] = __builtin_amdgcn_mfma_f32_16x16x32_bf16(Bt_[n][k], At[m][k], acc[ai][bj][m][n], 0, 0, 0); \
    __builtin_amdgcn_s_setprio(0); } while (0)
#define WAIT_V(n) asm volatile("s_waitcnt vmcnt(" #n ")" ::: "memory")
#define WAIT_L(n) asm volatile("s_waitcnt lgkmcnt(" #n ")" ::: "memory")
#define BAR __builtin_amdgcn_s_barrier()
#define SCHED __builtin_amdgcn_sched_barrier(0)
  int L = bid;
  if (L >= nT) return;
  int pm, pn; tile_of(L, nM, nN, pm, pn);
  f32x4 acc[2][2][4][2];
#pragma unroll
  for (int a = 0; a < 2; ++a)
#pragma unroll
    for (int b = 0; b < 2; ++b)
#pragma unroll
      for (int m = 0; m < 4; ++m)
#pragma unroll
        for (int n = 0; n < 2; ++n) acc[a][b][m][n] = (f32x4){0.f, 0.f, 0.f, 0.f};
  bf16x8 At[4][2], B0[2][2], B1[2][2];
  const char* cA = (const char*)A + (size_t)pm * tstep; const char* cB = (const char*)Bt + (size_t)pn * tstep;
  WAIT_V(0);
  STAGEP(SBo(0, 0), cB); STAGEP(SBo(0, 1), cB + hstep); STAGEP(SAo(0, 0), cA); STAGEP(SAo(0, 1), cA + hstep);
  if (wr == 1) BAR;
  WAIT_V(2); BAR;
  STAGEP(SBo(1, 0), cB + kstep); STAGEP(SAo(1, 0), cA + kstep); STAGEP(SBo(1, 1), cB + hstep + kstep);
  WAIT_V(6); BAR;
  for (;;) {
    const bool has_next = (L + nb < nT);
    int npm = pm, npn = pn;
    if (has_next) tile_of(L + nb, nM, nN, npm, npn);
    const char* nA = (const char*)A + (size_t)npm * tstep; const char* nB = (const char*)Bt + (size_t)npn * tstep;
    for (int t = 0; t < nt; t += 2) {
      const bool last = (t == nt - 2);
      const char* a1 = cA + (size_t)(t + 1) * kstep;
      const char* a2 = last ? nA : cA + (size_t)(t + 2) * kstep; const char* b2 = last ? nB : cB + (size_t)(t + 2) * kstep;
      const char* a3 = a2 + kstep; const char* b3 = b2 + kstep;
      LDB(B0, 0, 0); LDB(B1, 0, 1); SCHED; LDA(At, 0, 0); STAGEP(SAo(1, 1), a1 + hstep);
      WAIT_V(8); WAIT_L(0); BAR; MMA(0, 0, At, B0); MMA(0, 1, At, B1); BAR; SCHED;
      LDA(At, 0, 1); STAGEP(SBo(0, 0), b2); STAGEP(SBo(0, 1), b2 + hstep); STAGEP(SAo(0, 0), a2);
      WAIT_V(8); WAIT_L(0); BAR; MMA(1, 0, At, B0); MMA(1, 1, At, B1); BAR; SCHED;
      LDB(B0, 1, 0); LDB(B1, 1, 1); SCHED; LDA(At, 1, 0); STAGEP(SAo(0, 1), a2 + hstep);
      WAIT_V(8); WAIT_L(0); BAR; MMA(0, 0, At, B0); MMA(0, 1, At, B1); BAR; SCHED;
      LDA(At, 1, 1); STAGEP(SBo(1, 0), b3); STAGEP(SBo(1, 1), b3 + hstep); STAGEP(SAo(1, 0), a3);
      WAIT_V(8); WAIT_L(0); BAR; MMA(1, 0, At, B0); MMA(1, 1, At, B1); BAR; SCHED;
    }
    if (wr == 0) BAR;
    gemm_epi<EPI>(lds, acc, pm * BM, pn * BM, p);
    if (!has_next) break;
#pragma unroll
    for (int a = 0; a < 2; ++a)
#pragma unroll
      for (int b = 0; b < 2; ++b)
#pragma unroll
        for (int m = 0; m < 4; ++m)
#pragma unroll
          for (int n = 0; n < 2; ++n) acc[a][b][m][n] = (f32x4){0.f, 0.f, 0.f, 0.f};
    pm = npm; pn = npn; cA = nA; cB = nB; L += nb;
    if (wr == 1) BAR;
  }
  WAIT_V(0);
  BAR;
}

DI float ret_log2g(int h) { return log2f(1.0f - exp2f(-5.0f - (float)h)); }

typedef float f32x16 __attribute__((ext_vector_type(16)));
typedef short s16x4 __attribute__((ext_vector_type(4)));
#define MFMA32(a, b, c) __builtin_amdgcn_mfma_f32_32x32x16_bf16((a), (b), (c), 0, 0, 0)
DI s16x4 tr_read(LAS unsigned char* a) { return __builtin_amdgcn_ds_read_tr16_b64_v4i16((LAS s16x4*)a); }
DI bf16x8 tr_frag(LAS unsigned char* a, int rowstride8) {
  const s16x4 lo = tr_read(a), hi = tr_read(a + rowstride8);
  return __builtin_shufflevector(lo, hi, 0, 1, 2, 3, 4, 5, 6, 7);
}
DI bf16x8 pack8(const f32x16& x, int s) {
  u32x4 w;
  w.x = pack2(x[8 * s + 0], x[8 * s + 1]); w.y = pack2(x[8 * s + 2], x[8 * s + 3]); w.z = pack2(x[8 * s + 4], x[8 * s + 5]); w.w = pack2(x[8 * s + 6], x[8 * s + 7]);
  return __builtin_bit_cast(bf16x8, w);
}
DI float fexp2(float x) { return __builtin_amdgcn_exp2f(x); }
DI float half_max(float x) { const u32x2 r = __builtin_amdgcn_permlane32_swap(__float_as_uint(x), __float_as_uint(x), false, false); return fmaxf(__uint_as_float(r[0]), __uint_as_float(r[1])); }
DI float half_sum(float x) { const u32x2 r = __builtin_amdgcn_permlane32_swap(__float_as_uint(x), __float_as_uint(x), false, false); return __uint_as_float(r[0]) + __uint_as_float(r[1]); }
DI float silu(float g) { return g * __builtin_amdgcn_rcpf(1.0f + __builtin_amdgcn_exp2f(-1.4426950408889634f * g)); }

constexpr int AT_ROWB = 136, AT_LS = 512 * AT_ROWB, AT_VST = AT_LS + 2048, VROW = 192, KROW = 144, KST_W = 32 * KROW, VST_W = KST_W + 32 * VROW;
constexpr int ATTN_LDS = AT_VST + 8 * VST_W;
constexpr float LOG2E = 1.4426950408889634f;

constexpr int PT_ROW = 136;

DI void softmax_pv(f32x16& S, f32x16& O0, f32x16& O1, float& m, float& l, const bf16x8 (&Vf)[2][2], const bool mlow, const bool mhigh, const int r, const int h) {
  if (mlow || mhigh) {
#pragma unroll
    for (int i = 0; i < 16; ++i) {
      const int keyrow = (i & 3) + 8 * (i >> 2) + 4 * h;
      const bool bad = (mlow && keyrow < r) || (mhigh && keyrow > r);
      S[i] = bad ? -1e30f : S[i];
    }
  }
  float mx = fmaxf(S[0], S[1]);
#pragma unroll
  for (int i = 2; i < 16; ++i) mx = fmaxf(mx, S[i]);
  mx = half_max(mx);
  const float mn = fmaxf(m, mx);
  if (__builtin_amdgcn_ballot_w64(mn > m) != 0ull) {
    const float al = fexp2(m - mn);
    l *= al;
#pragma unroll
    for (int i = 0; i < 16; ++i) { O0[i] *= al; O1[i] *= al; }
    m = mn;
  }
  float ps = 0.f;
#pragma unroll
  for (int i = 0; i < 16; ++i) { S[i] = fexp2(S[i] - mn); ps += S[i]; }
  l += half_sum(ps);
#pragma unroll
  for (int s = 0; s < 2; ++s) {
    const bf16x8 Pb = pack8(S, s);
    O0 = MFMA32(Vf[s][0], Pb, O0);
    O1 = MFMA32(Vf[s][1], Pb, O1);
  }
}

DI void attn_tile2(const u32x4 (&Kc)[4], const u32x4 (&Vc)[4], const bf16x8 (&QA)[4], const bf16x8 (&QB)[4],
                   f32x16& A0, f32x16& A1, float& mA, float& lA, f32x16& B0, f32x16& B1, float& mB, float& lB,
                   LAS unsigned char* kst, LAS unsigned char* vst, LAS unsigned char* trp, const int lane, const int kt) {
  const int r = lane & 31, h = lane >> 5;
#pragma unroll
  for (int c = 0; c < 4; ++c) {
    *(LAS u32x4*)(kst + ((lane >> 3) + 8 * c) * KROW + (lane & 7) * 16) = Kc[c];
    *(LAS u32x4*)(vst + ((lane >> 3) + 8 * c) * VROW + (lane & 7) * 16) = Vc[c];
  }
  bf16x8 Kf[4], Vf[2][2];
#pragma unroll
  for (int ks = 0; ks < 4; ++ks) Kf[ks] = *(const LAS bf16x8*)(kst + r * KROW + (2 * ks + h) * 16);
#pragma unroll
  for (int s = 0; s < 2; ++s) { Vf[s][0] = tr_frag(trp + 16 * s * VROW, 8 * VROW); Vf[s][1] = tr_frag(trp + 16 * s * VROW + 64, 8 * VROW); }
  if (kt <= 4) {
    f32x16 S;
#pragma unroll
    for (int i = 0; i < 16; ++i) S[i] = 0.f;
#pragma unroll
    for (int ks = 0; ks < 4; ++ks) S = MFMA32(Kf[ks], QA[ks], S);
    softmax_pv(S, A0, A1, mA, lA, Vf, kt == 0, kt == 4, r, h);
  }
  if (kt >= 1) {
    f32x16 S;
#pragma unroll
    for (int i = 0; i < 16; ++i) S[i] = 0.f;
#pragma unroll
    for (int ks = 0; ks < 4; ++ks) S = MFMA32(Kf[ks], QB[ks], S);
    softmax_pv(S, B0, B1, mB, lB, Vf, kt == 1, kt == 5, r, h);
  }
}

DI void attn_merge(const Params& p, LAS unsigned char* T, const f32x16& O0, const f32x16& O1, const float m, const float l, const int lane,
                   const int tokq0  , const int sh, const int hh, const bool first, const bool last) {
  const int r = lane & 31, h = lane >> 5;
  const int rowc = lane >> 3, ch = lane & 7;
  float lse = m + __log2f(l);
  float w1 = 1.0f / l, w0 = 0.f;
  if (!first) {
#pragma unroll
    for (int c = 0; c < 4; ++c) {
      const size_t tk = (size_t)(tokq0 + ((rowc + 8 * c) << sh));
      *(LAS u32x4*)(T + (rowc + 8 * c) * PT_ROW + ch * 16) = *(const u32x4*)(p.ob + (tk * 8 + hh) * 64 + ch * 8);
    }
    const float lp = p.lseg[(size_t)(tokq0 + (r << sh)) * 8 + hh];
    const float M = fmaxf(lse, lp), e1 = fexp2(lse - M), e0 = fexp2(lp - M), den = e0 + e1, id = 1.0f / den;
    w1 *= e1 * id; w0 = e0 * id; lse = M + __log2f(den);
  }
  LAS unsigned char* ob = T + r * PT_ROW + 8 * h;
#pragma unroll
  for (int dt = 0; dt < 2; ++dt)
#pragma unroll
    for (int g = 0; g < 4; ++g) {
      float f0, f1, f2, f3;
      if (dt == 0) { f0 = O0[4 * g] * w1; f1 = O0[4 * g + 1] * w1; f2 = O0[4 * g + 2] * w1; f3 = O0[4 * g + 3] * w1; }
      else { f0 = O1[4 * g] * w1; f1 = O1[4 * g + 1] * w1; f2 = O1[4 * g + 2] * w1; f3 = O1[4 * g + 3] * w1; }
      LAS u32x2* a = (LAS u32x2*)(ob + 64 * dt + 16 * g);
      if (!first) { const u32x2 pv = *a; f0 += w0 * bflo(pv.x); f1 += w0 * bfhi(pv.x); f2 += w0 * bflo(pv.y); f3 += w0 * bfhi(pv.y); }
      u32x2 wv; wv.x = pack2(f0, f1); wv.y = pack2(f2, f3);
      *a = wv;
    }
  if (!last) {
    if (h == 0) p.lseg[(size_t)(tokq0 + (r << sh)) * 8 + hh] = lse;
#pragma unroll
    for (int c = 0; c < 4; ++c) {
      const size_t tk = (size_t)(tokq0 + ((rowc + 8 * c) << sh));
      *(u32x4*)(p.ob + (tk * 8 + hh) * 64 + ch * 8) = *(const LAS u32x4*)(T + (rowc + 8 * c) * PT_ROW + ch * 16);
    }
  } else {
#pragma unroll
    for (int c = 0; c < 4; ++c) {
      const size_t tk = (size_t)(tokq0 + ((rowc + 8 * c) << sh));
      const u32x4 a = *(const LAS u32x4*)(T + (rowc + 8 * c) * PT_ROW + ch * 16);
      const u32x4 g = *(const u32x4*)(p.proj + tk * NW + OFF_GA + hh * 64 + ch * 8);
      u32x4 w;
      w.x = pack2(bflo(a.x) * silu(bflo(g.x)), bfhi(a.x) * silu(bfhi(g.x)));
      w.y = pack2(bflo(a.y) * silu(bflo(g.y)), bfhi(a.y) * silu(bfhi(g.y)));
      w.z = pack2(bflo(a.z) * silu(bflo(g.z)), bfhi(a.z) * silu(bfhi(g.z)));
      w.w = pack2(bflo(a.w) * silu(bflo(g.w)), bfhi(a.w) * silu(bfhi(g.w)));
      *(u32x4*)(p.mixed + tk * DM + hh * 64 + ch * 8) = w;
    }
  }
}

DI void attn_task2(const Params& p, LAS unsigned char* kst, const int lane, const int tokbase, const int hh,
                   const int sh, const int r_res, const int l0, const bool first, const bool last) {
  const int r = lane & 31, h = lane >> 5;
  const int i16 = lane & 15, q4 = i16 >> 2, pp = i16 & 3, blk = (lane >> 4) & 1;
  LAS unsigned char* vst = kst + KST_W;
  LAS unsigned char* trp = vst + (4 * h + q4) * VROW + 32 * blk + 8 * pp;
  const bf16_t* qpA = p.proj + (size_t)(tokbase + r_res + ((l0 + r) << sh)) * NW + OFF_QA + hh * 64 + 8 * h;
  const bf16_t* qpB = qpA + (size_t)(32 << sh) * NW;
  bf16x8 QA[4], QB[4];
#pragma unroll
  for (int ks = 0; ks < 4; ++ks) { QA[ks] = *(const bf16x8*)(qpA + 16 * ks); QB[ks] = *(const bf16x8*)(qpB + 16 * ks); }
  f32x16 A0, A1, B0, B1;
#pragma unroll
  for (int i = 0; i < 16; ++i) { A0[i] = 0.f; A1[i] = 0.f; B0[i] = 0.f; B1[i] = 0.f; }
  float mA = -1e30f, lA = 0.f, mB = -1e30f, lB = 0.f;
  const int kt0 = (l0 >= 128) ? 0 : (4 - (l0 >> 5));
#define LOAD_KV(Kd, Vd, kt_) do { const int lk0_ = l0 - 128 + 32 * (kt_) + (lane >> 3); \
    _Pragma("unroll") for (int c_ = 0; c_ < 4; ++c_) { \
      const bf16_t* kp_ = p.proj + (size_t)(tokbase + r_res + ((lk0_ + 8 * c_) << sh)) * NW + OFF_KA + hh * 64 + 8 * (lane & 7); \
      Kd[c_] = *(const u32x4*)kp_; Vd[c_] = *(const u32x4*)(kp_ + (OFF_VA - OFF_KA)); } } while (0)
  for (int kt = kt0; kt < 6; kt += 2) {
    u32x4 K0[4], K1[4], V0[4], V1[4];
    LOAD_KV(K0, V0, kt);
    LOAD_KV(K1, V1, kt + 1);
    attn_tile2(K0, V0, QA, QB, A0, A1, mA, lA, B0, B1, mB, lB, kst, vst, trp, lane, kt);
    attn_tile2(K1, V1, QA, QB, A0, A1, mA, lA, B0, B1, mB, lB, kst, vst, trp, lane, kt + 1);
  }
#undef LOAD_KV
  const int tokA = tokbase + r_res + (l0 << sh);
  attn_merge(p, kst, A0, A1, mA, lA, lane, tokA, sh, hh, first, last);
  attn_merge(p, kst, B0, B1, mB, lB, lane, tokA + (32 << sh), sh, hh, first, last);
}

DI void phase_attn(LAS unsigned char* lds, const Params& p, int bid, int nb) {
  const int tid = threadIdx.x, wid = __builtin_amdgcn_readfirstlane(tid >> 6), lane = tid & 63;
  LAS unsigned char* kst = lds + wid * VST_W;
  for (int unit = bid; unit < 256; unit += nb) {
    const int xj = unit >> 3, bhh = (unit & 7) * 8 + (xj >> 2), sp = xj & 3, hh = bhh & 7, b = bhh >> 3;
    const int tokbase = b * SEQ;
    for (int stage = 0; stage < 3; ++stage) {
      const int sh = stage == 0 ? 4 : (stage == 1 ? 2 : 0);
      for (int tk = 0; tk < 2; ++tk) {
        const int idx = wid + 8 * tk;
        int r_res, l0;
        if (stage == 0) { r_res = idx; l0 = 64 * sp; }
        else if (stage == 1) { r_res = idx >> 2; l0 = 256 * sp + 64 * (idx & 3); }
        else { r_res = 0; l0 = 1024 * sp + 64 * idx; }
        attn_task2(p, kst, lane, tokbase, hh, sh, r_res, l0, stage == 0, stage == 2);
      }
      __syncthreads();
    }
  }
}

constexpr int RV_ROW = 320, RK_ROW = 192, RV_OFF = 0, RK_OFF = 128 * RV_ROW  , RRED_OFF = RK_OFF + 128 * RK_ROW  ;

DI void retout_unit(LAS unsigned char* lds, const Params& p, const int u);
DI void phase_retkv(LAS unsigned char* lds, const Params& p, int bid, int nb, const int mode) {
  const int tid = threadIdx.x, wid = __builtin_amdgcn_readfirstlane(tid >> 6), lane = tid & 63;
  const int r = lane & 31, h = lane >> 5, i16 = lane & 15, q4 = i16 >> 2, pp = i16 & 3, blk = (lane >> 4) & 1;
  const int vt = wid >> 1, dt = wid & 1;
  LAS int* uslot = (LAS int*)(lds + RRED_OFF);
  for (;;) {
    if (tid == 0) *uslot = (int)__hip_atomic_fetch_add(p.bar + 200 + mode, 1u, __ATOMIC_RELAXED, __HIP_MEMORY_SCOPE_AGENT);
    __syncthreads();
    const int u = __builtin_amdgcn_readfirstlane(*uslot);
    if (u >= 1024) break;
    if (mode) { __syncthreads(); retout_unit(lds, p, u); continue; }
    const int n = u & 31, hh = (u >> 5) & 3, b = u >> 7;
    const float lg = ret_log2g(hh);
    const bf16_t* base = p.proj + (size_t)(b * SEQ + n * 128) * NW;
#pragma unroll
    for (int it = 0; it < 4; ++it) {
      const int c = tid + 512 * it, j = c >> 4, cc = c & 15;
      *(LAS u32x4*)(lds + RV_OFF + j * RV_ROW + cc * 16) = *(const u32x4*)(base + (size_t)j * NW + OFF_VR + hh * 128 + cc * 8);
    }
#pragma unroll
    for (int it = 0; it < 2; ++it) {
      const int c = tid + 512 * it, j = c >> 3, cc = c & 7;
      const u32x4 w = *(const u32x4*)(base + (size_t)j * NW + OFF_KR + hh * 64 + cc * 8);
      const float dk = exp2f((float)(127 - j) * lg);
      u32x4 o;
      o.x = pack2(bflo(w.x) * dk, bfhi(w.x) * dk); o.y = pack2(bflo(w.y) * dk, bfhi(w.y) * dk);
      o.z = pack2(bflo(w.z) * dk, bfhi(w.z) * dk); o.w = pack2(bflo(w.w) * dk, bfhi(w.w) * dk);
      *(LAS u32x4*)(lds + RK_OFF + j * RK_ROW + cc * 16) = o;
    }
    __syncthreads();
    f32x16 acc;
#pragma unroll
    for (int i = 0; i < 16; ++i) acc[i] = 0.f;
    LAS unsigned char* va = lds + RV_OFF + (4 * h + q4) * RV_ROW + (32 * vt + 16 * blk + 4 * pp) * 2;
    LAS unsigned char* ka = lds + RK_OFF + (4 * h + q4) * RK_ROW + (32 * dt + 16 * blk + 4 * pp) * 2;
#pragma unroll
    for (int s = 0; s < 8; ++s) {
      const bf16x8 A = tr_frag(va + 16 * s * RV_ROW, 8 * RV_ROW), B = tr_frag(ka + 16 * s * RK_ROW, 8 * RK_ROW);
      acc = MFMA32(A, B, acc);
    }
    float* o = p.kvT + ((size_t)u << 13) + (32 * vt + 4 * h) * 64 + 32 * dt + r;
#pragma unroll
    for (int i = 0; i < 16; ++i) __hip_atomic_store(o + ((i & 3) + 8 * (i >> 2)) * 64, acc[i], __ATOMIC_RELAXED, __HIP_MEMORY_SCOPE_AGENT);
    asm volatile("s_waitcnt vmcnt(0)" ::: "memory");
    __syncthreads();
    const int bh = u >> 5;
    if (tid == 0) uslot[1] = (__hip_atomic_fetch_add(p.bar + 208 + bh, 1u, __ATOMIC_RELAXED, __HIP_MEMORY_SCOPE_AGENT) == 31u) ? 1 : 0;
    __syncthreads();
    if (__builtin_amdgcn_readfirstlane(uslot[1]) != 0) {
      if (tid == 0) { __builtin_amdgcn_fence(__ATOMIC_ACQUIRE, "agent"); asm volatile("s_waitcnt vmcnt(0)" ::: "memory"); }
      __syncthreads();
      typedef float f32x2 __attribute__((ext_vector_type(2)));
      const float cd = exp2f(128.0f * lg);
      for (int e2 = tid; e2 < 4096; e2 += 1024) {
        const int ea = e2 * 2, eb = (e2 + 512) * 2;
        f32x2 ka[31], kb[31];
#pragma unroll
        for (int nn = 0; nn < 31; ++nn) {
          const float* a = p.kvT + ((size_t)(bh * 32 + nn) << 13);
          ka[nn] = *(const f32x2*)(a + ea); kb[nn] = *(const f32x2*)(a + eb);
        }
        float a0 = 0.f, a1 = 0.f, b0 = 0.f, b1 = 0.f;
#pragma unroll
        for (int nn = 0; nn < 32; ++nn) {
          bf16_t* o = p.stT + ((size_t)(bh * 32 + nn) << 13);
          __hip_atomic_store((unsigned*)(o + ea), pack2(a0, a1), __ATOMIC_RELAXED, __HIP_MEMORY_SCOPE_AGENT);
          __hip_atomic_store((unsigned*)(o + eb), pack2(b0, b1), __ATOMIC_RELAXED, __HIP_MEMORY_SCOPE_AGENT);
          if (nn < 31) { a0 = a0 * cd + ka[nn][0]; a1 = a1 * cd + ka[nn][1]; b0 = b0 * cd + kb[nn][0]; b1 = b1 * cd + kb[nn][1]; }
        }
      }
      asm volatile("s_waitcnt vmcnt(0)" ::: "memory");
      __syncthreads();
      if (tid == 0) {
        __hip_atomic_store(p.bar + 16 + bh, 1u, __ATOMIC_RELAXED, __HIP_MEMORY_SCOPE_AGENT);
        asm volatile("s_waitcnt vmcnt(0)" ::: "memory");
        __hip_atomic_fetch_add(p.bar + 248, 1u, __ATOMIC_RELAXED, __HIP_MEMORY_SCOPE_AGENT);
      }
    }
    __syncthreads();
  }
  __syncthreads();
}

constexpr int RKO = 40960, RQO = RKO + 128 * 144, RSO = RQO + 128 * 144, RGO = RSO + 128 * 144, RG_ROW = 272, RRED2 = RGO + 128 * RG_ROW;
DI void retout_unit(LAS unsigned char* lds, const Params& p, const int u) {
  const int tid = threadIdx.x, wid = __builtin_amdgcn_readfirstlane(tid >> 6), lane = tid & 63;
  const int r = lane & 31, h = lane >> 5, i16 = lane & 15, q4 = i16 >> 2, pp = i16 & 3, blk = (lane >> 4) & 1;
  const int it = wid & 3, vh = wid >> 2;
  LAS float* red = (LAS float*)(lds + RRED2);
  {
    if (tid == 0) {
      LAS int* seen = (LAS int*)(lds + 150032);
      if (*seen == 0) {
        unsigned spins = 0;
        while (__hip_atomic_load(p.bar + 16 + (u >> 5), __ATOMIC_RELAXED, __HIP_MEMORY_SCOPE_AGENT) == 0u && spins < (1u << 22)) { __builtin_amdgcn_s_sleep(2); ++spins; }
        const unsigned npub = __hip_atomic_load(p.bar + 248, __ATOMIC_RELAXED, __HIP_MEMORY_SCOPE_AGENT);
        __builtin_amdgcn_fence(__ATOMIC_ACQUIRE, "agent");
        asm volatile("s_waitcnt vmcnt(0)" ::: "memory");
        if (npub >= 32u) *seen = 1;
      }
    }
    __syncthreads();
    const int n = u & 31, hh = (u >> 5) & 3, b = u >> 7;
    const float lg = ret_log2g(hh);
    const int tok0 = b * SEQ + n * 128;
    const bf16_t* base = p.proj + (size_t)tok0 * NW;
    {
      u32x4 tv[4], tg[4], tk[2], tq[2], ts[2];
#pragma unroll
      for (int k = 0; k < 4; ++k) {
        const int c = tid + 512 * k, j = c >> 4, cc = c & 15;
        tv[k] = *(const u32x4*)(base + (size_t)j * NW + OFF_VR + hh * 128 + cc * 8);
        tg[k] = *(const u32x4*)(base + (size_t)j * NW + OFF_GR + hh * 128 + cc * 8);
      }
#pragma unroll
      for (int k = 0; k < 2; ++k) {
        const int c = tid + 512 * k, j = c >> 3, cc = c & 7;
        tk[k] = *(const u32x4*)(base + (size_t)j * NW + OFF_KR + hh * 64 + cc * 8);
        tq[k] = *(const u32x4*)(base + (size_t)j * NW + OFF_QR + hh * 64 + cc * 8);
        ts[k] = *(const u32x4*)(p.stT + ((size_t)u << 13) + (size_t)c * 8);
      }
#pragma unroll
      for (int k = 0; k < 4; ++k) {
        const int c = tid + 512 * k, j = c >> 4, cc = c & 15;
        *(LAS u32x4*)(lds + RV_OFF + j * RV_ROW + cc * 16) = tv[k];
        *(LAS u32x4*)(lds + RGO + j * RG_ROW + cc * 16) = tg[k];
      }
#pragma unroll
      for (int k = 0; k < 2; ++k) {
        const int c = tid + 512 * k, j = c >> 3, cc = c & 7;
        *(LAS u32x4*)(lds + RKO + j * 144 + cc * 16) = tk[k];
        *(LAS u32x4*)(lds + RQO + j * 144 + cc * 16) = tq[k];
        *(LAS u32x4*)(lds + RSO + j * 144 + cc * 16) = ts[k];
      }
    }
    __syncthreads();
    const int qi = 32 * it + r;
    bf16x8 Qf[4];
#pragma unroll
    for (int ks = 0; ks < 4; ++ks) Qf[ks] = *(const LAS bf16x8*)(lds + RQO + qi * 144 + (2 * ks + h) * 16);
    f32x16 O0, O1;
#pragma unroll
    for (int i = 0; i < 16; ++i) { O0[i] = 0.f; O1[i] = 0.f; }
    {
#pragma unroll
      for (int ks = 0; ks < 4; ++ks) {
        const bf16x8 S0 = *(const LAS bf16x8*)(lds + RSO + (64 * vh + r) * 144 + (2 * ks + h) * 16);
        const bf16x8 S1 = *(const LAS bf16x8*)(lds + RSO + (64 * vh + 32 + r) * 144 + (2 * ks + h) * 16);
        O0 = MFMA32(S0, Qf[ks], O0); O1 = MFMA32(S1, Qf[ks], O1);
      }
      const float qd = exp2f((float)(qi + 1) * lg);
#pragma unroll
      for (int i = 0; i < 16; ++i) { O0[i] *= qd; O1[i] *= qd; }
    }
    LAS unsigned char* va = lds + RV_OFF + (4 * h + q4) * RV_ROW + (64 * vh + 16 * blk + 4 * pp) * 2;
    for (int jt = 0; jt <= it; ++jt) {
      f32x16 S;
#pragma unroll
      for (int i = 0; i < 16; ++i) S[i] = 0.f;
#pragma unroll
      for (int ks = 0; ks < 4; ++ks) { const bf16x8 Kf = *(const LAS bf16x8*)(lds + RKO + (32 * jt + r) * 144 + (2 * ks + h) * 16); S = MFMA32(Kf, Qf[ks], S); }
#pragma unroll
      for (int i = 0; i < 16; ++i) {
        const int dj = qi - (32 * jt + (i & 3) + 8 * (i >> 2) + 4 * h);
        S[i] = dj >= 0 ? S[i] * fexp2((float)dj * lg) : 0.f;
      }
#pragma unroll
      for (int s2 = 0; s2 < 2; ++s2) {
        const bf16x8 Pb = pack8(S, s2);
        const bf16x8 V0 = tr_frag(va + (32 * jt + 16 * s2) * RV_ROW, 8 * RV_ROW), V1 = tr_frag(va + (32 * jt + 16 * s2) * RV_ROW + 64, 8 * RV_ROW);
        O0 = MFMA32(V0, Pb, O0);
        O1 = MFMA32(V1, Pb, O1);
      }
    }
    float s1 = 0.f, s2 = 0.f;
#pragma unroll
    for (int i = 0; i < 16; ++i) { s1 += O0[i] + O1[i]; s2 += O0[i] * O0[i] + O1[i] * O1[i]; }
    s1 += __shfl_xor(s1, 32); s2 += __shfl_xor(s2, 32);
    if (h == 0) { red[(vh * 128 + qi) * 2] = s1; red[(vh * 128 + qi) * 2 + 1] = s2; }
    __syncthreads();
    s1 += red[((vh ^ 1) * 128 + qi) * 2]; s2 += red[((vh ^ 1) * 128 + qi) * 2 + 1];
    const float mu = s1 * (1.0f / 128.0f), var = fmaxf(s2 * (1.0f / 128.0f) - mu * mu, 0.f), rs = rsqrtf(var + 1e-5f);
    const float* gnp = p.gn + hh * 128 + 64 * vh + 4 * h;
    LAS unsigned char* gt = lds + RGO + qi * RG_ROW + (64 * vh + 4 * h) * 2;
#pragma unroll
    for (int dt = 0; dt < 2; ++dt)
#pragma unroll
      for (int g = 0; g < 4; ++g) {
        const int vo = 32 * dt + 8 * g;
        LAS u32x2* ga = (LAS u32x2*)(gt + vo * 2);
        const u32x2 gwv = *ga;
        const f32x4 gnv = *(const f32x4*)(gnp + vo);
        float f0, f1, f2, f3;
        if (dt == 0) { f0 = O0[4 * g]; f1 = O0[4 * g + 1]; f2 = O0[4 * g + 2]; f3 = O0[4 * g + 3]; }
        else { f0 = O1[4 * g]; f1 = O1[4 * g + 1]; f2 = O1[4 * g + 2]; f3 = O1[4 * g + 3]; }
        f0 = (f0 - mu) * rs * gnv[0] * silu(bflo(gwv.x)); f1 = (f1 - mu) * rs * gnv[1] * silu(bfhi(gwv.x));
        f2 = (f2 - mu) * rs * gnv[2] * silu(bflo(gwv.y)); f3 = (f3 - mu) * rs * gnv[3] * silu(bfhi(gwv.y));
        u32x2 wv; wv.x = pack2(f0, f1); wv.y = pack2(f2, f3);
        *ga = wv;
      }
    __syncthreads();
#pragma unroll
    for (int k = 0; k < 4; ++k) {
      const int c = tid + 512 * k, j = c >> 4, cc = c & 15;
      *(u32x4*)(p.mixed + (size_t)(tok0 + j) * DM + 512 + hh * 128 + cc * 8) = *(const LAS u32x4*)(lds + RGO + j * RG_ROW + cc * 16);
    }
    __syncthreads();
  }
}

#define XB_TMO      128
#define XB_XCNT(j)  (256  + 64 * (j))
#define XB_XSUB(j)  (1280 + 64 * (j))
#define XB_XGEN(j)  (2304 + 64 * (j))
#define XB_TOP      3328
#define XB_TOPGEN   3392
#define XCD_BAR_WORDS 3456
#define XB_SPIN_CAP (1u << 20)
DI unsigned xb_ld(unsigned* q) { return __hip_atomic_load(q, __ATOMIC_RELAXED, __HIP_MEMORY_SCOPE_AGENT); }
DI unsigned xb_add(unsigned* q, unsigned v) { return __hip_atomic_fetch_add(q, v, __ATOMIC_RELAXED, __HIP_MEMORY_SCOPE_AGENT); }
DI unsigned xb_xcc_id() { return (unsigned)__builtin_amdgcn_s_getreg((3 << 11) | 20) & 0xFu; }
#define XB_SPIN(cond, bar) do { unsigned _sp = 0; while (cond) { __builtin_amdgcn_s_sleep(1); \
    if ((++_sp & 255u) == 0u) { if (xb_ld(&(bar)[XB_TMO])) break; if (_sp > XB_SPIN_CAP) { atomicAdd(&(bar)[XB_TMO], 1u); break; } } } } while (0)
struct XcdBarrier { unsigned* bar; unsigned x; volatile LAS unsigned* st; };
DI XcdBarrier xcd_barrier_post(unsigned* bar, volatile LAS unsigned* st) {
  XcdBarrier b; b.bar = bar; b.x = xb_xcc_id(); b.st = st;
  if (threadIdx.x == 0) (void)xb_add(&bar[XB_XCNT(b.x)], 1u);
  return b;
}
DI void xcd_barrier_complete(unsigned* bar, unsigned x, unsigned& nloc, unsigned& nx) {
  const unsigned G = gridDim.x * gridDim.y * gridDim.z;
  unsigned sum, cnt, mine, sp = 0u;
  for (;;) {
    sum = 0u; cnt = 0u; mine = 0u;
#pragma unroll
    for (unsigned j = 0; j < 16; ++j) { const unsigned c = xb_ld(&bar[XB_XCNT(j)]); sum += c; cnt += (c > 0u) ? 1u : 0u; mine = (j == x) ? c : mine; }
    if (sum == G) break;
    __builtin_amdgcn_s_sleep(1);
    if ((++sp & 255u) == 0u) { if (xb_ld(&bar[XB_TMO])) break; if (sp > XB_SPIN_CAP) { atomicAdd(&bar[XB_TMO], 1u); break; } }
  }
  nloc = mine > 0u ? mine : 1u; nx = cnt > 0u ? cnt : 1u;
}
DI void xcd_barrier(const XcdBarrier& b) {
  asm volatile("s_waitcnt vmcnt(0)" ::: "memory");
  __syncthreads();
  if (threadIdx.x == 0) {
    unsigned* bar = b.bar;
    __builtin_amdgcn_s_waitcnt(0);
    unsigned nloc = b.st[0], nx = b.st[1];
    if (nloc == 0u) { xcd_barrier_complete(bar, b.x, nloc, nx); b.st[0] = nloc; b.st[1] = nx; }
    const unsigned old = xb_add(&bar[XB_XSUB(b.x)], 1u);
    const unsigned gen = old / nloc;
    if (old + 1u == (gen + 1u) * nloc) {
      __builtin_amdgcn_fence(__ATOMIC_RELEASE, "agent");
      asm volatile("s_waitcnt vmcnt(0)" ::: "memory");
      const unsigned og = xb_add(&bar[XB_TOP], 1u);
      const unsigned tg = og / nx;
      if (og + 1u == (tg + 1u) * nx) xb_add(&bar[XB_TOPGEN], 1u);
      else XB_SPIN(xb_ld(&bar[XB_TOPGEN]) == tg, bar);
      __builtin_amdgcn_fence(__ATOMIC_ACQUIRE, "agent");
      xb_add(&bar[XB_XGEN(b.x)], 1u);
      asm volatile("s_waitcnt vmcnt(0)" ::: "memory");
    } else {
      XB_SPIN(xb_ld(&bar[XB_XGEN(b.x)]) == gen, bar);
      __builtin_amdgcn_fence(__ATOMIC_ACQUIRE, "agent");
      asm volatile("s_waitcnt vmcnt(0)" ::: "memory");
    }
  }
  __syncthreads();
}

DI void grid_barrier(unsigned* ctr, unsigned target) {
  asm volatile("s_waitcnt vmcnt(0) lgkmcnt(0)" ::: "memory");
  __syncthreads();
  if (threadIdx.x == 0) {
    __builtin_amdgcn_fence(__ATOMIC_RELEASE, "agent");
    asm volatile("s_waitcnt vmcnt(0)" ::: "memory");
    __hip_atomic_fetch_add(ctr, 1u, __ATOMIC_RELAXED, __HIP_MEMORY_SCOPE_AGENT);
    unsigned spins = 0;
    while (__hip_atomic_load(ctr, __ATOMIC_RELAXED, __HIP_MEMORY_SCOPE_AGENT) < target && spins < (1u << 22)) { __builtin_amdgcn_s_sleep(2); ++spins; }
    __builtin_amdgcn_fence(__ATOMIC_ACQUIRE, "agent");
    asm volatile("s_waitcnt vmcnt(0)" ::: "memory");
  }
  __syncthreads();
}

__global__ void __launch_bounds__(512) k_mega(Params p) {
  extern __shared__ __attribute__((aligned(16))) unsigned char shm_[];
  LAS unsigned char* shm = (LAS unsigned char*)shm_;
  const int bid = blockIdx.x, nb = gridDim.x;
  unsigned bar_n = 0;
  volatile LAS unsigned* xst = (volatile LAS unsigned*)(shm + 150016);
  if (threadIdx.x == 0) { xst[0] = 0u; xst[1] = 0u; xst[4] = 0u; }
  __syncthreads();
  const XcdBarrier xbar = xcd_barrier_post(p.bar + 256, xst);
#ifdef PROBE_PHASE
#ifndef PROBE_BLK
#define PROBE_BLK 0
#endif
  unsigned long long ts_a = 0, ts_b = 0; int ph_i = 0;
  if (PROBE_PHASE == 0) ts_a = __builtin_amdgcn_s_memrealtime();
#define GRID_BAR() do { bar_n += (unsigned)nb; grid_barrier(p.bar, bar_n); ++ph_i; if (ph_i == PROBE_PHASE) ts_a = __builtin_amdgcn_s_memrealtime(); if (ph_i == PROBE_PHASE + 1) ts_b = __builtin_amdgcn_s_memrealtime(); } while (0)
#else
#define GRID_BAR() do { xcd_barrier(xbar); } while (0)
#endif
  phase_prep(p, bid, nb);
  GRID_BAR();
  phase_gemm<1>(shm, p, bid, nb);
  GRID_BAR();
  phase_retkv(shm, p, bid, nb, 0);
  phase_attn(shm, p, bid, nb);
#ifdef PROBE_SUB
  ts_b = __builtin_amdgcn_s_memrealtime(); ph_i = 100;
#endif
  phase_retkv(shm, p, bid, nb, 1);
  GRID_BAR();
  phase_gemm<2>(shm, p, bid, nb);
#ifdef PROBE_PHASE
  if (PROBE_PHASE == 3) ts_b = __builtin_amdgcn_s_memrealtime();
  if (bid == PROBE_BLK && threadIdx.x == 0) {
    const unsigned long long until = __builtin_amdgcn_s_memrealtime() + 9ull * (ts_b - ts_a);
    while (__builtin_amdgcn_s_memrealtime() < until) __builtin_amdgcn_s_sleep(8);
  }
#endif
}

extern "C" void kernel_launch(void* const* d_in, const int* in_sizes, int n_in, void* d_out, int out_size, void* d_ws, size_t ws_size, hipStream_t stream) {
  Params p{};
  p.x = (const float*)d_in[0]; p.ng = (const float*)d_in[1]; p.w_in = (const float*)d_in[2]; p.gn = (const float*)d_in[3];
  p.w_out = (const float*)d_in[4]; p.fg = (const float*)d_in[5];
  p.out = (float*)d_out;
  char* w = (char*)d_ws; size_t o = 0;
  auto take = [&](size_t bytes) { char* r = w + o; o += (bytes + 255) & ~(size_t)255; return r; };
  p.xb = (bf16_t*)take((size_t)T_TOK * DM * 2);
  p.proj = (bf16_t*)take((size_t)T_TOK * NW * 2);
  p.mixed = (bf16_t*)take((size_t)T_TOK * DM * 2);
  p.winT = (bf16_t*)take((size_t)NW * DM * 2);
  p.woutT = (bf16_t*)take((size_t)DM * DM * 2);
  p.rstd = (float*)take((size_t)T_TOK * 4);
  p.rowss = (float*)take((size_t)T_TOK * 4);
  p.ropeT = (float2*)take((size_t)SEQ * 32 * 8);
  p.retT = (float2*)take((size_t)SEQ * 32 * 8);
  p.kvT = (float*)take((size_t)1024 * 8192 * 4);
  p.stT = (bf16_t*)take((size_t)1024 * 8192 * 2);
  p.bar = (unsigned*)take(1024 + XCD_BAR_WORDS * 4);
  p.ob = (bf16_t*)take((size_t)T_TOK * 512 * 2);
  p.lseg = (float*)take((size_t)T_TOK * 8 * 4);
  static int grid_blocks = 0;
  if (!grid_blocks) {
    (void)hipFuncSetAttribute((const void*)k_mega, hipFuncAttributeMaxDynamicSharedMemorySize, ATTN_LDS);
    int dev = 0, cus = 0, per_cu = 0;
    (void)hipGetDevice(&dev);
    (void)hipDeviceGetAttribute(&cus, hipDeviceAttributeMultiprocessorCount, dev);
    (void)hipOccupancyMaxActiveBlocksPerMultiprocessor(&per_cu, k_mega, 512, ATTN_LDS);
    if (per_cu < 1) per_cu = 1;
    grid_blocks = cus;
  }
  (void)hipMemsetAsync(p.bar, 0, 1024 + XCD_BAR_WORDS * 4, stream);
  hipLaunchKernelGGL(k_mega, dim3(grid_blocks), dim3(512), ATTN_LDS, stream, p);
}
```
